# Optimizing an MI355X kernel written in HIP

```python
import math
import jax, jax.numpy as jnp
from jax import lax
import numpy as np

D_MODEL = 1024
BATCH = 8
SEQ = 2048
DEPTH = 2
DEC_BATCH = 128
DEC_SEQ = 4
PAST_LEN = 16384
PAGE_SIZE = 128

S5_WIDTH = D_MODEL // 4
S5_GROUP = 16
S5_N_GROUPS = S5_WIDTH // S5_GROUP
S5_STATE = 64
LRU_WIDTH = D_MODEL // 4
LRU_BLOCKS = 8
LRU_BLOCK = LRU_WIDTH // LRU_BLOCKS
LRU_C = 8.0
CONV_WIDTH = 4
GDN_WIDTH = D_MODEL // 2
GDN_HEAD_DIM = 128
GDN_HEADS = GDN_WIDTH // GDN_HEAD_DIM
GDN_CHUNK = 64
MIX_WIDTH = S5_WIDTH + LRU_WIDTH + GDN_WIDTH
IN_SPLITS = (S5_WIDTH, LRU_WIDTH, LRU_WIDTH, 3 * GDN_WIDTH, GDN_HEADS, GDN_HEADS, GDN_WIDTH)
IN_COLS = S5_WIDTH + 2 * LRU_WIDTH + 4 * GDN_WIDTH + 2 * GDN_HEADS
FFN_HIDDEN = ((8 * D_MODEL // 3 + 255) // 256) * 256
NORM_EPS = 1e-6

kernel_name = "hybrid_s5_rglru_gdn_decode_step"


def rms_norm(x, w):
    xf = x.astype(jnp.float32)
    y = xf * lax.rsqrt(jnp.mean(xf * xf, axis=-1, keepdims=True) + NORM_EPS)
    return (y * w.astype(jnp.float32)).astype(x.dtype)


def l2_normalize(x):
    xf = x.astype(jnp.float32)
    return xf * lax.rsqrt(jnp.sum(xf * xf, axis=-1, keepdims=True) + NORM_EPS)


def causal_conv(x, buf, w):
    L = x.shape[1]
    xp = jnp.concatenate([buf.astype(x.dtype), x], axis=1)
    y = xp[:, 0:L] * w[0]
    for j in range(1, w.shape[0]):
        y = y + xp[:, j:j + L] * w[j]
    return y, xp[:, L:]


def _cmul(ar, ai, br, bi):
    return ar * br - ai * bi, ar * bi + ai * br


def _s5_combine(e1, e2):
    a1r, a1i, b1r, b1i = e1
    a2r, a2i, b2r, b2i = e2
    ar, ai = _cmul(a2r, a2i, a1r, a1i)
    br, bi = _cmul(a2r, a2i, b1r, b1i)
    return ar, ai, br + b2r, bi + b2i


def _lru_combine(e1, e2):
    a1, b1 = e1
    a2, b2 = e2
    return a1 * a2, a2 * b1 + b2


def s5_mixer(u, h0_re, h0_im, lam_re, lam_im, log_dt, b_re, b_im, c_re, c_im, d, w_glu, b_glu):
    f32 = jnp.float32
    Bsz, L, _ = u.shape
    uf = u.astype(f32)
    ug = uf.reshape(Bsz, L, S5_N_GROUPS, S5_GROUP)
    lr = jnp.minimum(lam_re.astype(f32), -1e-4)
    li = lam_im.astype(f32)
    dt = jnp.exp(log_dt.astype(f32))[:, None]
    mag = jnp.exp(lr * dt)
    ar, ai = mag * jnp.cos(li * dt), mag * jnp.sin(li * dt)
    den = lr * lr + li * li
    fr = ((ar - 1.0) * lr + ai * li) / den
    fi = (ai * lr - (ar - 1.0) * li) / den
    bbr = fr[..., None] * b_re - fi[..., None] * b_im
    bbi = fr[..., None] * b_im + fi[..., None] * b_re
    bu_r = jnp.einsum("blgh,gph->blgp", ug, bbr)
    bu_i = jnp.einsum("blgh,gph->blgp", ug, bbi)
    ir, ii = _cmul(ar, ai, h0_re.astype(f32), h0_im.astype(f32))
    bu_r = bu_r.at[:, 0].add(ir)
    bu_i = bu_i.at[:, 0].add(ii)
    a_r = jnp.broadcast_to(ar, bu_r.shape)
    a_i = jnp.broadcast_to(ai, bu_i.shape)
    _, _, xr, xi = lax.associative_scan(_s5_combine, (a_r, a_i, bu_r, bu_i), axis=1)
    y = jnp.einsum("blgp,ghp->blgh", xr, c_re) - jnp.einsum("blgp,ghp->blgh", xi, c_im)
    y = y.reshape(Bsz, L, S5_WIDTH) + d * uf
    y = jax.nn.gelu(y)
    y = y * jax.nn.sigmoid(y @ w_glu + b_glu)
    return y, xr[:, -1], xi[:, -1]


def lru_mixer(xb, gate, pos, h0, conv_buf, conv_w, conv_b, w_a, b_a, w_x, b_x, lam):
    f32 = jnp.float32
    Bsz, L, _ = xb.shape
    xc, new_buf = causal_conv(xb, conv_buf, conv_w)
    xc = (xc + conv_b).astype(f32)
    xh = xc.reshape(Bsz, L, LRU_BLOCKS, LRU_BLOCK)
    r = jax.nn.sigmoid(jnp.einsum("blhi,hij->blhj", xh, w_a).reshape(Bsz, L, LRU_WIDTH) + b_a)
    gi = jax.nn.sigmoid(jnp.einsum("blhi,hij->blhj", xh, w_x).reshape(Bsz, L, LRU_WIDTH) + b_x)
    log_a = -LRU_C * r * jax.nn.softplus(-lam.astype(f32))
    a = jnp.exp(log_a)
    mult = jnp.sqrt(-jnp.expm1(2.0 * log_a))
    mult = jnp.where((pos == 0)[None, :, None], 1.0, mult)
    b = mult * gi * xc
    b = b.at[:, 0].add(a[:, 0] * h0.astype(f32))
    _, h = lax.associative_scan(_lru_combine, (a, b), axis=1)
    y = h * jax.nn.gelu(gate.astype(f32))
    return y, h[:, -1], new_buf


def _pad_seq(t, pad):
    cfg = [(0, 0)] * t.ndim
    cfg[1] = (0, pad)
    return jnp.pad(t, cfg)


def gated_delta_chunked(q, k, v, g, beta, S0):
    f32 = jnp.float32
    Bsz, L, H, dk = q.shape
    dv = v.shape[-1]
    C = min(GDN_CHUNK, L)
    n = -(-L // C)
    pad = n * C - L
    q = q.astype(f32) * (dk ** -0.5)
    k, v, g, beta = k.astype(f32), v.astype(f32), g.astype(f32), beta.astype(f32)
    if pad:
        q, k, v, g, beta = (_pad_seq(t, pad) for t in (q, k, v, g, beta))

    def chunks(t):
        return jnp.moveaxis(t.reshape((Bsz, n, C, H) + t.shape[3:]), (1, 3), (0, 2))

    qc, kc, vc, gc, bc = (chunks(t) for t in (q, k, v, g, beta))
    gcum = jnp.cumsum(gc, axis=-1)
    idx = jnp.arange(C)
    incl = idx[:, None] >= idx[None, :]
    strict = idx[:, None] > idx[None, :]
    decay = jnp.exp(jnp.where(incl, gcum[..., :, None] - gcum[..., None, :], -jnp.inf))
    kb = kc * bc[..., None]
    vb = vc * bc[..., None]
    M = jnp.where(strict, jnp.einsum("nbhik,nbhjk->nbhij", kb, kc) * decay, 0.0)
    eye = jnp.eye(C, dtype=f32)
    T = lax.linalg.triangular_solve(eye + M, jnp.broadcast_to(eye, M.shape),
                                    left_side=True, lower=True, unit_diagonal=True)
    w_v = T @ vb
    w_k = T @ (kb * jnp.exp(gcum)[..., None])
    q_dec = qc * jnp.exp(gcum)[..., None]
    attn = jnp.einsum("nbhik,nbhjk->nbhij", qc, kc) * decay
    g_last = gcum[..., -1]
    k_dec = kc * jnp.exp(g_last[..., None] - gcum)[..., None]

    def step(S, xs):
        w_v_i, w_k_i, q_dec_i, attn_i, k_dec_i, g_last_i = xs
        v_new = w_v_i - jnp.einsum("bhck,bhkv->bhcv", w_k_i, S)
        o = jnp.einsum("bhck,bhkv->bhcv", q_dec_i, S) + jnp.einsum("bhij,bhjv->bhiv", attn_i, v_new)
        S = S * jnp.exp(g_last_i)[..., None, None] + jnp.einsum("bhck,bhcv->bhkv", k_dec_i, v_new)
        return S, o

    S, o = lax.scan(step, S0.astype(f32), (w_v, w_k, q_dec, attn, k_dec, g_last))
    o = jnp.moveaxis(o, (0, 2), (1, 3)).reshape(Bsz, n * C, H, dv)[:, :L]
    return o, S


def layer(x, pos, st, p):
    s5_re, s5_im, lru_h, lru_conv, gdn_S, gdn_conv = st
    Bsz, L, _ = x.shape
    h = rms_norm(x, p["norm_mix_pre"])
    proj = h @ p["w_in"]
    cuts = [int(c) for c in np.cumsum(IN_SPLITS)[:-1]]
    u_s5, x_lru, g_lru, qkv, a_gdn, b_gdn, z_gdn = jnp.split(proj, cuts, axis=-1)
    y_s5, n_s5_re, n_s5_im = s5_mixer(u_s5, s5_re, s5_im, p["s5_lambda_re"], p["s5_lambda_im"],
                                      p["s5_log_dt"], p["s5_b_re"], p["s5_b_im"], p["s5_c_re"],
                                      p["s5_c_im"], p["s5_d"], p["s5_w_glu"], p["s5_b_glu"])
    y_lru, n_lru_h, n_lru_conv = lru_mixer(x_lru, g_lru, pos, lru_h, lru_conv, p["lru_conv_w"],
                                           p["lru_conv_b"], p["lru_w_a"], p["lru_b_a"],
                                           p["lru_w_x"], p["lru_b_x"], p["lru_lambda"])
    qkv_c, n_gdn_conv = causal_conv(qkv, gdn_conv, p["gdn_conv_w"])
    qkv_c = jax.nn.silu(qkv_c.astype(jnp.float32))
    q, k, v = jnp.split(qkv_c, 3, axis=-1)
    q = l2_normalize(q.reshape(Bsz, L, GDN_HEADS, GDN_HEAD_DIM))
    k = l2_normalize(k.reshape(Bsz, L, GDN_HEADS, GDN_HEAD_DIM))
    v = v.reshape(Bsz, L, GDN_HEADS, GDN_HEAD_DIM)
    g = -jnp.exp(p["gdn_a_log"].astype(jnp.float32)) * jax.nn.softplus(a_gdn.astype(jnp.float32) + p["gdn_dt_bias"])
    beta = jax.nn.sigmoid(b_gdn.astype(jnp.float32))
    o, n_gdn_S = gated_delta_chunked(q, k, v, g, beta, gdn_S)
    z = z_gdn.astype(jnp.float32).reshape(Bsz, L, GDN_HEADS, GDN_HEAD_DIM)
    y_gdn = (rms_norm(o, p["gdn_norm_w"]) * jax.nn.silu(z)).reshape(Bsz, L, GDN_WIDTH)
    mix = jnp.concatenate([y_s5, y_lru, y_gdn], axis=-1).astype(x.dtype) @ p["w_out"]
    x = x + rms_norm(mix, p["norm_mix_post"]).astype(x.dtype)
    h = rms_norm(x, p["norm_ffn_pre"])
    gt, up = jnp.split(h @ p["ffn_w_gate_up"], 2, axis=-1)
    f = (jax.nn.silu(gt) * up) @ p["ffn_w_down"]
    x = x + rms_norm(f, p["norm_ffn_post"]).astype(x.dtype)
    return x, (n_s5_re, n_s5_im, n_lru_h, n_lru_conv, n_gdn_S, n_gdn_conv)


def setup_inputs(seed: int = 0) -> dict:
    key = jax.random.key(seed)
    ks = jax.random.split(key, 40)
    f32 = jnp.float32

    def nrm(k, shape, s):
        return s * jax.random.normal(k, shape, f32)

    G, P, H = S5_N_GROUPS, S5_STATE, S5_GROUP
    gdn_dt = jnp.exp(jax.random.uniform(ks[31], (DEPTH, GDN_HEADS), f32, minval=math.log(1e-3), maxval=math.log(1e-1)))
    lru_u = jax.random.uniform(ks[36], (DEPTH, LRU_WIDTH), f32, minval=0.9, maxval=0.999)
    lru_a0 = lru_u ** (1.0 / LRU_C)
    return {
        "x_prompt": nrm(ks[0], (BATCH, SEQ, D_MODEL), 1.0),
        "x_sample": nrm(ks[1], (DEC_BATCH, DEC_SEQ, D_MODEL), 1.0),
        "state_s5_re": nrm(ks[2], (DEPTH, DEC_BATCH, G, P), 0.3),
        "state_s5_im": nrm(ks[3], (DEPTH, DEC_BATCH, G, P), 0.3),
        "state_lru_h": nrm(ks[4], (DEPTH, DEC_BATCH, LRU_WIDTH), 0.3),
        "state_lru_conv": nrm(ks[5], (DEPTH, DEC_BATCH, CONV_WIDTH - 1, LRU_WIDTH), 1.0),
        "state_gdn_S": nrm(ks[6], (DEPTH, DEC_BATCH, GDN_HEADS, GDN_HEAD_DIM, GDN_HEAD_DIM), 0.05),
        "state_gdn_conv": nrm(ks[7], (DEPTH, DEC_BATCH, CONV_WIDTH - 1, 3 * GDN_WIDTH), 1.0),
        "norm_mix_pre": 1.0 + nrm(ks[8], (DEPTH, D_MODEL), 0.05),
        "norm_mix_post": 1.0 + nrm(ks[9], (DEPTH, D_MODEL), 0.05),
        "norm_ffn_pre": 1.0 + nrm(ks[10], (DEPTH, D_MODEL), 0.05),
        "norm_ffn_post": 1.0 + nrm(ks[11], (DEPTH, D_MODEL), 0.05),
        "w_in": nrm(ks[12], (DEPTH, D_MODEL, IN_COLS), D_MODEL ** -0.5),
        "s5_lambda_re": -0.5 + nrm(ks[13], (DEPTH, G, P), 0.01),
        "s5_lambda_im": jnp.pi * jnp.arange(P, dtype=f32) + nrm(ks[14], (DEPTH, G, P), 0.01),
        "s5_log_dt": jax.random.uniform(ks[15], (DEPTH, G), f32, minval=math.log(1e-3), maxval=math.log(1e-1)),
        "s5_b_re": nrm(ks[16], (DEPTH, G, P, H), (2 * H) ** -0.5),
        "s5_b_im": nrm(ks[17], (DEPTH, G, P, H), (2 * H) ** -0.5),
        "s5_c_re": nrm(ks[18], (DEPTH, G, H, P), P ** -0.5),
        "s5_c_im": nrm(ks[19], (DEPTH, G, H, P), P ** -0.5),
        "s5_d": nrm(ks[20], (DEPTH, S5_WIDTH), 1.0),
        "s5_w_glu": nrm(ks[21], (DEPTH, S5_WIDTH, S5_WIDTH), S5_WIDTH ** -0.5),
        "s5_b_glu": nrm(ks[22], (DEPTH, S5_WIDTH), 0.01),
        "lru_conv_w": nrm(ks[23], (DEPTH, CONV_WIDTH, LRU_WIDTH), CONV_WIDTH ** -0.5),
        "lru_conv_b": nrm(ks[24], (DEPTH, LRU_WIDTH), 0.01),
        "lru_w_a": nrm(ks[25], (DEPTH, LRU_BLOCKS, LRU_BLOCK, LRU_BLOCK), LRU_BLOCK ** -0.5),
        "lru_b_a": nrm(ks[26], (DEPTH, LRU_WIDTH), 0.01),
        "lru_w_x": nrm(ks[27], (DEPTH, LRU_BLOCKS, LRU_BLOCK, LRU_BLOCK), LRU_BLOCK ** -0.5),
        "lru_b_x": nrm(ks[28], (DEPTH, LRU_WIDTH), 0.01),
        "lru_lambda": jnp.log(lru_a0) - jnp.log1p(-lru_a0),
        "gdn_conv_w": nrm(ks[29], (DEPTH, CONV_WIDTH, 3 * GDN_WIDTH), CONV_WIDTH ** -0.5),
        "gdn_a_log": jnp.log(jax.random.uniform(ks[30], (DEPTH, GDN_HEADS), f32, minval=1.0, maxval=16.0)),
        "gdn_dt_bias": gdn_dt + jnp.log(-jnp.expm1(-gdn_dt)),
        "gdn_norm_w": 1.0 + nrm(ks[32], (DEPTH, GDN_HEAD_DIM), 0.05),
        "w_out": nrm(ks[33], (DEPTH, MIX_WIDTH, D_MODEL), MIX_WIDTH ** -0.5),
        "ffn_w_gate_up": nrm(ks[34], (DEPTH, D_MODEL, 2 * FFN_HIDDEN), D_MODEL ** -0.5),
        "ffn_w_down": nrm(ks[35], (DEPTH, FFN_HIDDEN, D_MODEL), FFN_HIDDEN ** -0.5),
    }


def reference(x_prompt, x_sample, state_s5_re, state_s5_im, state_lru_h, state_lru_conv,
              state_gdn_S, state_gdn_conv, norm_mix_pre, norm_mix_post, norm_ffn_pre,
              norm_ffn_post, w_in, s5_lambda_re, s5_lambda_im, s5_log_dt, s5_b_re, s5_b_im,
              s5_c_re, s5_c_im, s5_d, s5_w_glu, s5_b_glu, lru_conv_w, lru_conv_b, lru_w_a,
              lru_b_a, lru_w_x, lru_b_x, lru_lambda, gdn_conv_w, gdn_a_log, gdn_dt_bias,
              gdn_norm_w, w_out, ffn_w_gate_up, ffn_w_down):
    f32 = jnp.float32
    bp = x_prompt.shape[0]
    pos_prompt = jnp.arange(x_prompt.shape[1], dtype=jnp.int32)
    pos_sample = PAST_LEN + jnp.arange(x_sample.shape[1], dtype=jnp.int32)
    y_p, y_s = x_prompt, x_sample
    new_p = [[] for _ in range(6)]
    new_s = [[] for _ in range(6)]
    for l in range(DEPTH):
        p = {
            "norm_mix_pre": norm_mix_pre[l], "norm_mix_post": norm_mix_post[l],
            "norm_ffn_pre": norm_ffn_pre[l], "norm_ffn_post": norm_ffn_post[l],
            "w_in": w_in[l], "s5_lambda_re": s5_lambda_re[l], "s5_lambda_im": s5_lambda_im[l],
            "s5_log_dt": s5_log_dt[l], "s5_b_re": s5_b_re[l], "s5_b_im": s5_b_im[l],
            "s5_c_re": s5_c_re[l], "s5_c_im": s5_c_im[l], "s5_d": s5_d[l],
            "s5_w_glu": s5_w_glu[l], "s5_b_glu": s5_b_glu[l],
            "lru_conv_w": lru_conv_w[l], "lru_conv_b": lru_conv_b[l], "lru_w_a": lru_w_a[l],
            "lru_b_a": lru_b_a[l], "lru_w_x": lru_w_x[l], "lru_b_x": lru_b_x[l],
            "lru_lambda": lru_lambda[l], "gdn_conv_w": gdn_conv_w[l], "gdn_a_log": gdn_a_log[l],
            "gdn_dt_bias": gdn_dt_bias[l], "gdn_norm_w": gdn_norm_w[l], "w_out": w_out[l],
            "ffn_w_gate_up": ffn_w_gate_up[l], "ffn_w_down": ffn_w_down[l],
        }
        st_p = (jnp.zeros((bp, S5_N_GROUPS, S5_STATE), f32),
                jnp.zeros((bp, S5_N_GROUPS, S5_STATE), f32),
                jnp.zeros((bp, LRU_WIDTH), f32),
                jnp.zeros((bp, CONV_WIDTH - 1, LRU_WIDTH), x_prompt.dtype),
                jnp.zeros((bp, GDN_HEADS, GDN_HEAD_DIM, GDN_HEAD_DIM), f32),
                jnp.zeros((bp, CONV_WIDTH - 1, 3 * GDN_WIDTH), x_prompt.dtype))
        st_s = (state_s5_re[l], state_s5_im[l], state_lru_h[l], state_lru_conv[l],
                state_gdn_S[l], state_gdn_conv[l])
        y_p, sp = layer(y_p, pos_prompt, st_p, p)
        y_s, ss = layer(y_s, pos_sample, st_s, p)
        for i in range(6):
            new_p[i].append(sp[i])
            new_s[i].append(ss[i])
    p_s5_re, p_s5_im, p_lru_h, p_lru_conv, p_gdn_S, p_gdn_conv = (jnp.stack(t, axis=0) for t in new_p)
    s_s5_re, s_s5_im, s_lru_h, s_lru_conv, s_gdn_S, s_gdn_conv = (jnp.stack(t, axis=0) for t in new_s)
    return (y_p, y_s, p_s5_re, p_s5_im, p_lru_h, p_lru_conv, p_gdn_S, p_gdn_conv,
            s_s5_re, s_s5_im, s_lru_h, s_lru_conv, s_gdn_S, s_gdn_conv)
```

```cpp
#include <hip/hip_runtime.h>
#include <cstdio>
#include <cstdint>
#include <cmath>
namespace pg8 {
#define PG8_LAS __attribute__((address_space(3)))
typedef unsigned short bf16_t;
typedef short bf16x8 __attribute__((ext_vector_type(8)));
typedef float f32x4 __attribute__((ext_vector_type(4)));
typedef unsigned u32x4 __attribute__((ext_vector_type(4)));
constexpr int BM = 256, BK = 64, HALF = 128, HTB = HALF * BK * 2  , STAGE_BYTES = 8 * HTB, NXCD = 8, WGM = 8;

__host__ __device__ __forceinline__ int lds_byte(int r, int c) { const int st = (r >> 4) * 2 + (c >> 5), rr = r & 15, cc = c & 31, ob = rr * 64 + cc * 2; return st * 1024 + (ob ^ (((ob >> 9) & 1) << 5)); }
__host__ __device__ __forceinline__ void stage_rc(int b, int& R, int& C) { const int st = b / 1024, sb = b % 1024, swz = sb ^ (((sb >> 9) & 1) << 5); R = (st >> 1) * 16 + swz / 64; C = (st & 1) * 32 + (swz % 64) / 2; }
__host__ __device__ __forceinline__ int perm32(int rho) { const int n = rho >> 4, i = rho & 15; return 8 * (i >> 2) + 4 * n + (i & 3); }

struct Unit { int pm, pn; };
struct Gemm { const bf16_t* A; const bf16_t* Bt; int M, N, K; };

struct StaticOrder {
    int nM, nN, nwg, G, c;
    __host__ __device__ void init(int M, int N, int G_, int c_) { nM = M / BM; nN = N / BM; nwg = nM * nN; G = G_; c = c_; }
    __host__ __device__ bool next(int i, Unit& u) const {
        const long L = (long)i * G + c; if (L >= nwg) return false;
        int wgid = (int)L; { const int q = nwg / NXCD, r = nwg % NXCD, xcd = wgid % NXCD, off = wgid / NXCD; wgid = (xcd < r ? xcd * (q + 1) : r * (q + 1) + (xcd - r) * q) + off; }
        const int nig = WGM * nN, gid = wgid / nig, fm = gid * WGM, gsz = (nM - fm) < WGM ? (nM - fm) : WGM;
        u.pm = fm + ((wgid % nig) % gsz); u.pn = (wgid % nig) / gsz; return true;
    }
    __device__ __forceinline__ void a_ready(const Unit&) const {}
    __device__ __forceinline__ void done(const Unit&) const {}
};


__device__ __forceinline__ unsigned cvt_pk_bf16(float lo, float hi) { unsigned r; asm volatile("v_cvt_pk_bf16_f32 %0, %1, %2" : "=v"(r) : "v"(lo), "v"(hi)); return r; }

template <bool WT>
__device__ __forceinline__ void st16(void* p, u32x4 v) {
    if constexpr (WT) asm volatile("global_store_dwordx4 %0, %1, off sc1\n\ts_nop 1" :: "v"(p), "v"(v) : "memory");
    else *(u32x4*)p = v;
}
struct EpiF32 {
    static constexpr bool PERM = false, AFTER_DRAIN = false, KSCALE = false, ROWTAB = false;
    float* C; int ldc;
    template <bool WT>
    __device__ __forceinline__ void run(const f32x4 (&acc)[2][2][4][2], const Unit& u, int wr, int wc, int fr, int fq) const {
        const int row0 = u.pm * BM + wr * 64 + fr, col0 = u.pn * BM + wc * 32 + 4 * fq;
#pragma unroll
        for (int ai = 0; ai < 2; ++ai)
#pragma unroll
            for (int m = 0; m < 4; ++m) { float* rowp = C + (size_t)(row0 + ai * HALF + m * 16) * ldc + col0;
#pragma unroll
                for (int bj = 0; bj < 2; ++bj)
#pragma unroll
                    for (int n = 0; n < 2; ++n) *(f32x4*)(rowp + bj * HALF + n * 16) = acc[ai][bj][m][n]; }
    }
};
struct EpiBf16 {
    static constexpr bool PERM = true, AFTER_DRAIN = false, KSCALE = false, ROWTAB = false;
    bf16_t* O; int ldc; const float* RS;
    template <bool WT>
    __device__ __forceinline__ void run(const f32x4 (&acc)[2][2][4][2], const Unit& u, int wr, int wc, int fr, int fq) const {
        const int row0 = u.pm * BM + wr * 64 + fr; const int col0 = u.pn * BM + wc * 32 + 8 * fq;
        float rsc[2][4];
#pragma unroll
        for (int ai = 0; ai < 2; ++ai)
#pragma unroll
            for (int m = 0; m < 4; ++m) rsc[ai][m] = RS ? RS[row0 + ai * HALF + m * 16] : 1.0f;
#pragma unroll
        for (int ai = 0; ai < 2; ++ai)
#pragma unroll
            for (int m = 0; m < 4; ++m) { bf16_t* rowp = O + (size_t)(row0 + ai * HALF + m * 16) * ldc + col0;
#pragma unroll
                for (int bj = 0; bj < 2; ++bj) { const f32x4 v0 = acc[ai][bj][m][0] * rsc[ai][m], v1 = acc[ai][bj][m][1] * rsc[ai][m];
                    u32x4 w; w.x = cvt_pk_bf16(v0[0], v0[1]); w.y = cvt_pk_bf16(v0[2], v0[3]); w.z = cvt_pk_bf16(v1[0], v1[1]); w.w = cvt_pk_bf16(v1[2], v1[3]);
                    st16<WT>(rowp + bj * HALF, w); } }
    }
};
constexpr int RT_MAXU = 6, RT_TAB = STAGE_BYTES;
struct RowTabPre { float v[RT_MAXU]; };
template <class Sched>
__device__ __forceinline__ void rowtab_load(RowTabPre& p, const float* RS, const Sched& S, int tid) {
#pragma unroll
    for (int i = 0; i < RT_MAXU; ++i) { Unit u; p.v[i] = S.next(i, u) ? RS[u.pm * BM + (tid & 255)] : 0.f; }
}
__device__ __forceinline__ void rowtab_store(const RowTabPre& p, PG8_LAS unsigned char* lds, int tid) {
    if (tid < 256) {
#pragma unroll
        for (int i = 0; i < RT_MAXU; ++i) ((PG8_LAS float*)(lds + RT_TAB))[i * 256 + tid] = p.v[i];
    }
}
struct EpiBf16Rs {
    static constexpr bool PERM = true, AFTER_DRAIN = false, KSCALE = false, ROWTAB = true;
    bf16_t* O; int ldc; const float* RS;
    template <bool WT>
    __device__ __forceinline__ void run(const f32x4 (&acc)[2][2][4][2], const Unit& u, int wr, int wc, int fr, int fq, PG8_LAS unsigned char* lds, int ui) const {
        const int row0 = u.pm * BM + wr * 64 + fr; const int col0 = u.pn * BM + wc * 32 + 8 * fq;
        const PG8_LAS float* tb = (const PG8_LAS float*)(lds + RT_TAB) + ui * 256 + wr * 64 + fr;
#pragma unroll
        for (int ai = 0; ai < 2; ++ai)
#pragma unroll
            for (int m = 0; m < 4; ++m) { bf16_t* rowp = O + (size_t)(row0 + ai * HALF + m * 16) * ldc + col0; const float rs = tb[ai * HALF + m * 16];
#pragma unroll
                for (int bj = 0; bj < 2; ++bj) { const f32x4 v0 = acc[ai][bj][m][0] * rs, v1 = acc[ai][bj][m][1] * rs;
                    u32x4 w; w.x = cvt_pk_bf16(v0[0], v0[1]); w.y = cvt_pk_bf16(v0[2], v0[3]); w.z = cvt_pk_bf16(v1[0], v1[1]); w.w = cvt_pk_bf16(v1[2], v1[3]);
                    st16<WT>(rowp + bj * HALF, w); } }
    }
};
struct EpiBf16HeadNorm {
    static constexpr bool PERM = true, AFTER_DRAIN = false, KSCALE = true, ROWTAB = false;
    static constexpr int KT0 = 8, TAB = STAGE_BYTES;
    bf16_t* O; int ldc; const float* SSQ; float inv_n, eps;
    struct Pre { f32x4 v[8]; };
    __device__ __forceinline__ void setup_load(Pre& p, const Unit& u, int tid) const {
        const float* sp = SSQ + (size_t)(u.pm * BM + (tid & 255)) * 32;
#pragma unroll
        for (int i = 0; i < 8; ++i) p.v[i] = *(const f32x4*)(sp + 4 * i);
    }
    __device__ __forceinline__ void setup_store(const Pre& p, PG8_LAS unsigned char* lds, int tid) const {
        if (tid < 256) {
            float sq[4], rs[4];
#pragma unroll
            for (int h = 0; h < 4; ++h) { const f32x4 a = p.v[2 * h], b = p.v[2 * h + 1]; const float x = ((a.x + a.y) + (a.z + a.w) + (b.x + b.y) + (b.z + b.w)) * inv_n + eps; rs[h] = __builtin_amdgcn_rsqf(x); sq[h] = x * rs[h]; }
            PG8_LAS float* t = (PG8_LAS float*)(lds + TAB) + tid * 8;
            *(PG8_LAS f32x4*)t = (f32x4){sq[0], rs[0] * sq[1], rs[1] * sq[2], rs[2] * sq[3]}; t[4] = rs[3];
        }
    }
    __device__ __forceinline__ void scale(f32x4 (&acc)[2][2][4][2], PG8_LAS unsigned char* lds, int wr, int fr, int p) const {
        const PG8_LAS float* t = (const PG8_LAS float*)(lds + TAB) + (wr * 64 + fr) * 8 + p;
#pragma unroll
        for (int ai = 0; ai < 2; ++ai)
#pragma unroll
            for (int m = 0; m < 4; ++m) { const float f = t[(ai * HALF + m * 16) * 8];
#pragma unroll
                for (int bj = 0; bj < 2; ++bj)
#pragma unroll
                    for (int n = 0; n < 2; ++n) acc[ai][bj][m][n] = acc[ai][bj][m][n] * f; }
    }
    template <bool WT>
    __device__ __forceinline__ void run(const f32x4 (&acc)[2][2][4][2], const Unit& u, int wr, int wc, int fr, int fq) const { EpiBf16 e{O, ldc, nullptr}; e.template run<WT>(acc, u, wr, wc, fr, fq); }
};
struct EpiSwiGLU {
    static constexpr bool PERM = true, AFTER_DRAIN = false, KSCALE = false, ROWTAB = true;
    bf16_t* O; int ldc; const float* RS;
    template <bool WT>
    __device__ __forceinline__ void run(const f32x4 (&acc)[2][2][4][2], const Unit& u, int wr, int wc, int fr, int fq, PG8_LAS unsigned char* lds, int ui) const {
        const int row0 = u.pm * BM + wr * 64 + fr; const int col0 = u.pn * HALF + wc * 32 + 8 * fq;
        const PG8_LAS float* tb = (const PG8_LAS float*)(lds + RT_TAB) + ui * 256 + wr * 64 + fr;
        float rsc[2][4];
#pragma unroll
        for (int ai = 0; ai < 2; ++ai)
#pragma unroll
            for (int m = 0; m < 4; ++m) rsc[ai][m] = tb[ai * HALF + m * 16];
#pragma unroll
        for (int ai = 0; ai < 2; ++ai)
#pragma unroll
            for (int m = 0; m < 4; ++m) { bf16_t* rowp = O + (size_t)(row0 + ai * HALF + m * 16) * ldc + col0;
                float o[8];
#pragma unroll
                for (int n = 0; n < 2; ++n)
#pragma unroll
                    for (int j = 0; j < 4; ++j) { const float g = acc[ai][0][m][n][j] * rsc[ai][m], up = acc[ai][1][m][n][j] * rsc[ai][m]; o[n * 4 + j] = g * up * __builtin_amdgcn_rcpf(1.0f + __expf(-g)); }
                u32x4 w; w.x = cvt_pk_bf16(o[0], o[1]); w.y = cvt_pk_bf16(o[2], o[3]); w.z = cvt_pk_bf16(o[4], o[5]); w.w = cvt_pk_bf16(o[6], o[7]);
                st16<WT>(rowp, w); }
    }
};

#ifndef PG8_LAST_WT
#define PG8_LAST_WT 0
#endif
template <class E, bool K = E::KSCALE> struct Epi_pre { typedef int type; };
template <class E> struct Epi_pre<E, true> { typedef typename E::Pre type; };
template <class Epi, class Sched, bool ALIGN_EPI = false, bool SP2 = false>
__device__ __forceinline__ void gemm_phase(PG8_LAS unsigned char* lds, const Gemm g, const Sched& S, const Epi& E) {
    int tid_ = threadIdx.x; asm volatile("" : "+v"(tid_));
    const int tid = tid_, wid = __builtin_amdgcn_readfirstlane(tid >> 6), lane = tid & 63, wr = wid >> 2, wc = wid & 3, fr = lane & 15, fq = lane >> 4;
    const int K = g.K, nt = K / BK;
    unsigned voffA[2], voffB[2];
#pragma unroll
    for (int i = 0; i < 2; ++i) { int R, C; stage_rc(tid * 16 + i * 8192, R, C); const int Rb = Epi::PERM ? ((R & ~31) + perm32(R & 31)) : R;
        voffA[i] = (unsigned)(R * K + C) * 2u; voffB[i] = (unsigned)(Rb * K + C) * 2u; }
    const size_t kstep = (size_t)(BK * 2);
    const size_t hstep = (size_t)HALF * K * 2;
    const size_t tstep = 2 * hstep;
    const unsigned ldsw = (unsigned)wid * 1024u;
    const int aoff = lds_byte(wr * 64 + fr, fq * 8), boff = lds_byte(wc * 32 + fr, fq * 8);
#define PG8_SA(b, h) (((b) * 2 + (h)) * HTB)
#define PG8_SB(b, h) ((4 + (b) * 2 + (h)) * HTB)
#define PG8_STAGE(bufoff, gbase, voff) do { _Pragma("unroll") for (int _i = 0; _i < 2; ++_i) \
        __builtin_amdgcn_global_load_lds((const unsigned*)((const char*)(gbase) + (voff)[_i]), (PG8_LAS unsigned*)(lds + (bufoff) + ldsw + _i * 8192), 16, 0, 0); } while (0)
#define PG8_LDA(dst, b, h) do { _Pragma("unroll") for (int m = 0; m < 4; ++m) _Pragma("unroll") for (int k = 0; k < 2; ++k) dst[m][k] = *(const PG8_LAS bf16x8*)(lds + PG8_SA(b, h) + aoff + m * 2048 + k * 1024); } while (0)
#define PG8_LDB(dst, b, h) do { _Pragma("unroll") for (int n = 0; n < 2; ++n) _Pragma("unroll") for (int k = 0; k < 2; ++k) dst[n][k] = *(const PG8_LAS bf16x8*)(lds + PG8_SB(b, h) + boff + n * 2048 + k * 1024); } while (0)
#define PG8_MMA(ai, bj, At, Bt) do { __builtin_amdgcn_s_setprio(1); _Pragma("unroll") for (int m = 0; m < 4; ++m) _Pragma("unroll") for (int n = 0; n < 2; ++n) _Pragma("unroll") for (int k = 0; k < 2; ++k) \
        acc[ai][bj][m][n] = __builtin_amdgcn_mfma_f32_16x16x32_bf16(Bt[n][k], At[m][k], acc[ai][bj][m][n], 0, 0, 0); __builtin_amdgcn_s_setprio(0); } while (0)
#define PG8_WAIT_V(n) asm volatile("s_waitcnt vmcnt(" #n ")" ::: "memory")
#define PG8_WAIT_L(n) asm volatile("s_waitcnt lgkmcnt(" #n ")" ::: "memory")
#define PG8_BAR __builtin_amdgcn_s_barrier()
#define PG8_SCHED __builtin_amdgcn_sched_barrier(0)
    Unit cur, nxt; int ui = 0;
    if (!S.next(0, cur)) return;
    f32x4 acc[2][2][4][2];
#pragma unroll
    for (int a = 0; a < 2; ++a)
#pragma unroll
        for (int b = 0; b < 2; ++b)
#pragma unroll
            for (int m = 0; m < 4; ++m)
#pragma unroll
                for (int n = 0; n < 2; ++n) acc[a][b][m][n] = (f32x4){0.f, 0.f, 0.f, 0.f};
    bf16x8 At[4][2], B0[2][2], B1[2][2];
    const char* cA = (const char*)g.A + (size_t)cur.pm * tstep; const char* cB = (const char*)g.Bt + (size_t)cur.pn * tstep;
    S.a_ready(cur);
    typename Epi_pre<Epi>::type epre;
    if constexpr (Epi::KSCALE) E.setup_load(epre, cur, tid);
    RowTabPre rtp; if constexpr (Epi::ROWTAB) rowtab_load(rtp, E.RS, S, tid);
    if constexpr (SP2) {
        PG8_STAGE(PG8_SB(0, 0), cB, voffB); PG8_STAGE(PG8_SB(0, 1), cB + hstep, voffB); PG8_STAGE(PG8_SA(0, 0), cA, voffA); PG8_STAGE(PG8_SA(0, 1), cA + hstep, voffA);
        if (wr == 1) PG8_BAR;
        PG8_WAIT_V(2); PG8_BAR;
        PG8_STAGE(PG8_SB(1, 0), cB + kstep, voffB); PG8_STAGE(PG8_SA(1, 0), cA + kstep, voffA); PG8_STAGE(PG8_SB(1, 1), cB + hstep + kstep, voffB);
        PG8_WAIT_V(6); PG8_BAR;
        if constexpr (Epi::ROWTAB) rowtab_store(rtp, lds, tid);
        if constexpr (Epi::KSCALE) E.setup_store(epre, lds, tid);
    } else {
        PG8_STAGE(PG8_SB(0, 0), cB, voffB); PG8_STAGE(PG8_SA(0, 0), cA, voffA); PG8_STAGE(PG8_SB(0, 1), cB + hstep, voffB); PG8_STAGE(PG8_SA(0, 1), cA + hstep, voffA);
        if (wr == 1) PG8_BAR;
        PG8_WAIT_V(4); PG8_BAR;
        PG8_STAGE(PG8_SB(1, 0), cB + kstep, voffB); PG8_STAGE(PG8_SA(1, 0), cA + kstep, voffA); PG8_STAGE(PG8_SB(1, 1), cB + hstep + kstep, voffB);
        PG8_WAIT_V(6); PG8_BAR;
    }
    for (;;) {
        const bool has_next = S.next(ui + 1, nxt);
        const char* nA = has_next ? (const char*)g.A + (size_t)nxt.pm * tstep : cA; const char* nB = has_next ? (const char*)g.Bt + (size_t)nxt.pn * tstep : cB;
        for (int t = 0; t < nt; t += 2) {
            const bool last = (t == nt - 2);
            const char* a1 = cA + (size_t)(t + 1) * kstep;
            const char* a2 = last ? nA : cA + (size_t)(t + 2) * kstep; const char* b2 = last ? nB : cB + (size_t)(t + 2) * kstep;
            const char* a3 = a2 + kstep; const char* b3 = b2 + kstep;
            if (last && has_next) S.a_ready(nxt);
            if constexpr (Epi::KSCALE) { if (t >= Epi::KT0) E.scale(acc, lds, wr, fr, (t - Epi::KT0) >> 1); }
            if constexpr (SP2) {
            PG8_LDB(B0, 0, 0); PG8_LDB(B1, 0, 1); PG8_SCHED; PG8_LDA(At, 0, 0); PG8_STAGE(PG8_SA(1, 1), a1 + hstep, voffA);
            PG8_WAIT_V(8); PG8_WAIT_L(0); PG8_BAR; PG8_MMA(0, 0, At, B0); PG8_MMA(0, 1, At, B1); PG8_BAR; PG8_SCHED;
            PG8_LDA(At, 0, 1); PG8_STAGE(PG8_SB(0, 0), b2, voffB); PG8_STAGE(PG8_SB(0, 1), b2 + hstep, voffB); PG8_STAGE(PG8_SA(0, 0), a2, voffA);
            PG8_WAIT_V(8); PG8_WAIT_L(0); PG8_BAR; PG8_MMA(1, 0, At, B0); PG8_MMA(1, 1, At, B1); PG8_BAR; PG8_SCHED;
            PG8_LDB(B0, 1, 0); PG8_LDB(B1, 1, 1); PG8_SCHED; PG8_LDA(At, 1, 0); PG8_STAGE(PG8_SA(0, 1), a2 + hstep, voffA);
            PG8_WAIT_V(8); PG8_WAIT_L(0); PG8_BAR; PG8_MMA(0, 0, At, B0); PG8_MMA(0, 1, At, B1); PG8_BAR; PG8_SCHED;
            PG8_LDA(At, 1, 1); PG8_STAGE(PG8_SB(1, 0), b3, voffB); PG8_STAGE(PG8_SB(1, 1), b3 + hstep, voffB); PG8_STAGE(PG8_SA(1, 0), a3, voffA);
            PG8_WAIT_V(8); PG8_WAIT_L(0); PG8_BAR; PG8_MMA(1, 0, At, B0); PG8_MMA(1, 1, At, B1); PG8_BAR; PG8_SCHED;
            } else {
            PG8_LDB(B0, 0, 0); PG8_SCHED; PG8_LDA(At, 0, 0); PG8_STAGE(PG8_SA(1, 1), a1 + hstep, voffA);
            PG8_WAIT_L(8); PG8_BAR; PG8_WAIT_L(0); PG8_MMA(0, 0, At, B0); PG8_BAR; PG8_SCHED;
            PG8_LDB(B1, 0, 1); PG8_STAGE(PG8_SB(0, 0), b2, voffB);
            PG8_BAR; PG8_WAIT_L(0); PG8_MMA(0, 1, At, B1); PG8_BAR;
            PG8_LDA(At, 0, 1); PG8_STAGE(PG8_SA(0, 0), a2, voffA);
            PG8_BAR; PG8_WAIT_L(0); PG8_MMA(1, 0, At, B0); PG8_BAR; PG8_SCHED;
            PG8_STAGE(PG8_SB(0, 1), b2 + hstep, voffB);
            PG8_WAIT_V(6); PG8_BAR; PG8_MMA(1, 1, At, B1); PG8_BAR;
            PG8_LDB(B0, 1, 0); PG8_SCHED; PG8_LDA(At, 1, 0); PG8_STAGE(PG8_SA(0, 1), a2 + hstep, voffA);
            PG8_WAIT_L(8); PG8_BAR; PG8_WAIT_L(0); PG8_MMA(0, 0, At, B0); PG8_BAR; PG8_SCHED;
            PG8_LDB(B1, 1, 1); PG8_STAGE(PG8_SB(1, 0), b3, voffB);
            PG8_BAR; PG8_WAIT_L(0); PG8_MMA(0, 1, At, B1); PG8_BAR;
            PG8_LDA(At, 1, 1); PG8_STAGE(PG8_SA(1, 0), a3, voffA);
            PG8_BAR; PG8_WAIT_L(0); PG8_MMA(1, 0, At, B0); PG8_BAR; PG8_SCHED;
            PG8_STAGE(PG8_SB(1, 1), b3 + hstep, voffB);
            PG8_WAIT_V(6); PG8_BAR; PG8_MMA(1, 1, At, B1); PG8_BAR;
            }
        }
        if constexpr (Epi::KSCALE) E.scale(acc, lds, wr, fr, 4);
        if constexpr (ALIGN_EPI) { if (wr == 0) PG8_BAR; }
        if constexpr (!Epi::AFTER_DRAIN) {
            if constexpr (Epi::ROWTAB) { if (PG8_LAST_WT && !has_next) E.template run<true>(acc, cur, wr, wc, fr, fq, lds, ui); else E.template run<false>(acc, cur, wr, wc, fr, fq, lds, ui); }
            else { if (PG8_LAST_WT && !has_next) E.template run<true>(acc, cur, wr, wc, fr, fq); else E.template run<false>(acc, cur, wr, wc, fr, fq); }
            S.done(cur); }
        if (!has_next) break;
#pragma unroll
        for (int a = 0; a < 2; ++a)
#pragma unroll
            for (int b = 0; b < 2; ++b)
#pragma unroll
                for (int m = 0; m < 4; ++m)
#pragma unroll
                    for (int n = 0; n < 2; ++n) acc[a][b][m][n] = (f32x4){0.f, 0.f, 0.f, 0.f};
        cur = nxt; cA = nA; cB = nB; ++ui;
        if constexpr (ALIGN_EPI) { if (wr == 1) PG8_BAR; }
    }
    PG8_WAIT_V(0);
    if constexpr (!ALIGN_EPI) { if (wr == 0) PG8_BAR; }
    PG8_BAR;
    if constexpr (Epi::AFTER_DRAIN) { E.fused(acc, cur, wr, wc, fr, fq, lds, wid, lane); S.done(cur); }
#undef PG8_SA
#undef PG8_SB
#undef PG8_STAGE
#undef PG8_LDA
#undef PG8_LDB
#undef PG8_MMA
#undef PG8_WAIT_V
#undef PG8_WAIT_L
#undef PG8_BAR
#undef PG8_SCHED
}
}

constexpr int NWAVES = 8, NTHR = 512;
constexpr int DM = 1024, SEQ = 2048, NB_P = 8, MP = NB_P * SEQ, NB_S = 128, DSEQ = 4, MS = NB_S * DSEQ, MT = MP + MS;
constexpr int DEPTH = 2, INC = 2824, NPJ = 2816, FF = 2816, GDH = 4, HD = 128, NCH = SEQ / 64;
constexpr int PU = 0, PXL = 256, PGL = 512, PQ = 768, PK = 1280, PV = 1792, PZ = 2304;
constexpr float EPS = 1e-6f;
#ifndef HEADNORM_IN_GEMM
#define HEADNORM_IN_GEMM 1
#endif
constexpr size_t O_YP = 0, O_YS = O_YP + (size_t)MP * DM, O_PS5RE = O_YS + (size_t)MS * DM, O_PS5IM = O_PS5RE + 2 * 8 * 16 * 64, O_PLRUH = O_PS5IM + 2 * 8 * 16 * 64,
    O_PLRUC = O_PLRUH + 2 * 8 * 256, O_PGS = O_PLRUC + 2 * 8 * 3 * 256, O_PGC = O_PGS + (size_t)2 * 8 * 4 * 128 * 128, O_SS5RE = O_PGC + 2 * 8 * 3 * 1536,
    O_SS5IM = O_SS5RE + 2 * 128 * 16 * 64, O_SLRUH = O_SS5IM + 2 * 128 * 16 * 64, O_SLRUC = O_SLRUH + 2 * 128 * 256, O_SGS = O_SLRUC + 2 * 128 * 3 * 256,
    O_SGC = O_SGS + (size_t)2 * 128 * 4 * 128 * 128, O_END = O_SGC + (size_t)2 * 128 * 3 * 1536;
static_assert(O_END == 37216256, "output size");
constexpr size_t MiB = 1u << 20;
constexpr size_t WS_CTL = 0, CTL_ZERO_BYTES = 1 * MiB;
constexpr size_t WS_S5E = 1 * MiB;
constexpr size_t WS_LAGG = 3 * MiB;
constexpr size_t WS_AB = 3 * MiB + 512 * 1024;
constexpr size_t WS_EGL = 4 * MiB + 256 * 1024;
constexpr size_t WS_WIN = 5 * MiB;
constexpr size_t WS_WOUT = WS_WIN + (size_t)NPJ * DM * 2;
constexpr size_t WS_WGU = WS_WOUT + (size_t)DM * DM * 2;
constexpr size_t WS_WDN = WS_WGU + (size_t)2 * FF * DM * 2;
constexpr size_t WS_WGLU = WS_WDN + (size_t)DM * FF * 2;
constexpr size_t WS_X = 30 * MiB;
constexpr size_t WS_P = 63 * MiB;
constexpr size_t WS_BIG = 154 * MiB;
constexpr size_t WS_PP = WS_BIG, WS_RT = WS_BIG + 32 * MiB, WS_QT = WS_BIG + 64 * MiB, WS_END = WS_BIG + 80 * MiB;
static_assert(WS_WGLU + 256 * 256 * 2 <= WS_X && WS_X + (size_t)MT * DM * 2 <= WS_P && WS_P + (size_t)MT * NPJ * 2 <= WS_BIG && WS_BIG + (size_t)MT * DM * 4 <= WS_END && WS_END + (size_t)MP * 32 * 4 <= 256 * MiB, "ws map");
static_assert(WS_AB + (size_t)MT * 8 * 4 <= WS_EGL && WS_EGL + 4096 <= WS_WIN, "ws map 2");
constexpr size_t WS_SSQ = WS_END;
constexpr size_t WS_OL = WS_END + 2 * MiB;
constexpr size_t WS_DUMH = WS_END + 18 * MiB, WS_DUMF = WS_END + 19 * MiB;
static_assert(WS_DUMF + 2 * MiB <= 256 * MiB, "ws tail");
constexpr int CW_BAR = 4096;
constexpr int RING_BYTES = 131072, LDSCTL_OFF = 143360, LDS_BYTES = 147456;

#define GAS __attribute__((address_space(1)))
#define LAS __attribute__((address_space(3)))
typedef unsigned short bf16;
typedef unsigned v4u __attribute__((ext_vector_type(4)));
typedef unsigned v2u __attribute__((ext_vector_type(2)));
typedef float f32x4 __attribute__((ext_vector_type(4)));
typedef short bf16x8 __attribute__((ext_vector_type(8)));
#define LDS_WAIT() asm volatile("s_waitcnt lgkmcnt(0)" ::: "memory")
#define VM_WAIT() asm volatile("s_waitcnt vmcnt(0)" ::: "memory")
#define MFMA16(a, b, c) __builtin_amdgcn_mfma_f32_16x16x32_bf16(a, b, c, 0, 0, 0)
typedef float f32x2_t __attribute__((ext_vector_type(2))); typedef __bf16 bf16x2_t __attribute__((ext_vector_type(2)));
__device__ __forceinline__ unsigned pk2(float lo, float hi) { f32x2_t v = {lo, hi}; bf16x2_t b = __builtin_convertvector(v, bf16x2_t); return __builtin_bit_cast(unsigned, b); }
__device__ __forceinline__ unsigned f2bf(float f) { return pk2(f, f) & 0xffffu; }
__device__ __forceinline__ float bf2f(unsigned b) { return __builtin_bit_cast(float, b << 16); }
__device__ __forceinline__ float bflo(unsigned w) { return __builtin_bit_cast(float, w << 16); }
__device__ __forceinline__ float bfhi(unsigned w) { return __builtin_bit_cast(float, w & 0xffff0000u); }
__device__ __forceinline__ float frcp(float x) { return __builtin_amdgcn_rcpf(x); }
__device__ __forceinline__ float frsq(float x) { return __builtin_amdgcn_rsqf(x); }
__device__ __forceinline__ float sigmoidf_(float x) { return frcp(1.0f + __expf(-x)); }
__device__ __forceinline__ float siluf_(float x) { return x * frcp(1.0f + __expf(-x)); }
__device__ __forceinline__ float gelu_tanh(float x) { const float z = 0.7978845608028654f * (x + 0.044715f * x * x * x); return x * frcp(1.0f + __expf(-2.0f * z)); }
__device__ __forceinline__ float softplusf_(float x) { return x > 20.f ? x : log1pf(expf(x)); }
__device__ __forceinline__ float softplus_fast(float x) { return x > 20.f ? x : __logf(1.0f + __expf(x)); }
__device__ __forceinline__ float wave_sum(float v) {
#pragma unroll
    for (int o = 1; o < 64; o <<= 1) v += __shfl_xor(v, o);
    return v;
}
__device__ __forceinline__ bf16x8 pack8(const float* f) { v4u w; w.x = pk2(f[0], f[1]); w.y = pk2(f[2], f[3]); w.z = pk2(f[4], f[5]); w.w = pk2(f[6], f[7]); return __builtin_bit_cast(bf16x8, w); }
constexpr int S256 = 272, S128 = 144, S512 = 528;
__device__ __forceinline__ int t256(int row, int col) { return row * S256 + col * 2; }
__device__ __forceinline__ int t128(int row, int col) { return row * S128 + col * 2; }
__device__ __forceinline__ int t512(int row, int col) { return row * S512 + col * 2; }

#define XB_TMO      128
#define XB_XCNT(j)  (256  + 64 * (j))
#define XB_XSUB(j)  (1280 + 64 * (j))
#define XB_XGEN(j)  (2304 + 64 * (j))
#define XB_TOP      3328
#define XB_TOPGEN   3392
#define XCD_BAR_WORDS 3456
#define XB_SPIN_CAP (1u << 20)
__device__ __forceinline__ unsigned xb_ld(unsigned* p)              { return __hip_atomic_load(p, __ATOMIC_RELAXED, __HIP_MEMORY_SCOPE_AGENT); }
__device__ __forceinline__ unsigned xb_add(unsigned* p, unsigned v) { return __hip_atomic_fetch_add(p, v, __ATOMIC_RELAXED, __HIP_MEMORY_SCOPE_AGENT); }
__device__ __forceinline__ unsigned xb_xcc_id() { return (unsigned)__builtin_amdgcn_s_getreg((3 << 11) | 20) & 0xFu; }
#define XB_SPIN(cond, bar) do { unsigned _sp = 0; while (cond) { __builtin_amdgcn_s_sleep(1); \
    if ((++_sp & 255u) == 0u) { if (xb_ld(&(bar)[XB_TMO])) break; if (_sp > XB_SPIN_CAP) { atomicAdd(&(bar)[XB_TMO], 1u); break; } } } } while (0)
struct XcdBarrier { unsigned* bar; unsigned x; volatile LAS unsigned* st; };
__device__ __forceinline__ XcdBarrier xcd_barrier_post(unsigned* bar, volatile LAS unsigned* st) {
    XcdBarrier b; b.bar = bar; b.x = xb_xcc_id(); b.st = st;
    if (threadIdx.x == 0) (void)xb_add(&bar[XB_XCNT(b.x)], 1u);
    return b;
}
__device__ __forceinline__ void xcd_barrier_complete(unsigned* bar, unsigned x, unsigned& nloc, unsigned& nx) {
    const unsigned G = gridDim.x * gridDim.y * gridDim.z;
    unsigned sum, cnt, mine, sp = 0u;
    for (;;) {
        sum = 0u; cnt = 0u; mine = 0u;
#pragma unroll
        for (unsigned j = 0; j < 16; ++j) { const unsigned c = xb_ld(&bar[XB_XCNT(j)]); sum += c; cnt += (c > 0u) ? 1u : 0u; mine = (j == x) ? c : mine; }
        if (sum == G) break;
        __builtin_amdgcn_s_sleep(1);
        if ((++sp & 255u) == 0u) { if (xb_ld(&bar[XB_TMO])) break; if (sp > XB_SPIN_CAP) { atomicAdd(&bar[XB_TMO], 1u); break; } }
    }
    nloc = mine > 0u ? mine : 1u; nx = cnt > 0u ? cnt : 1u;
}
template <bool FENCED = true>
__device__ __forceinline__ void xcd_barrier(const XcdBarrier& b) {
    asm volatile("s_waitcnt vmcnt(0)" ::: "memory");
    __syncthreads();
    if (threadIdx.x == 0) {
        unsigned* bar = b.bar;
        __builtin_amdgcn_s_waitcnt(0);
        unsigned nloc = b.st[0], nx = b.st[1];
        if (nloc == 0u) { xcd_barrier_complete(bar, b.x, nloc, nx); b.st[0] = nloc; b.st[1] = nx; }
        const unsigned old = xb_add(&bar[XB_XSUB(b.x)], 1u);
        const unsigned gen = old / nloc;
        if (old + 1u == (gen + 1u) * nloc) {
            if (FENCED) __builtin_amdgcn_fence(__ATOMIC_RELEASE, "agent");
            asm volatile("s_waitcnt vmcnt(0)" ::: "memory");
            const unsigned og = xb_add(&bar[XB_TOP], 1u);
            const unsigned tg = og / nx;
            if (og + 1u == (tg + 1u) * nx) xb_add(&bar[XB_TOPGEN], 1u);
            else XB_SPIN(xb_ld(&bar[XB_TOPGEN]) == tg, bar);
            if (FENCED) __builtin_amdgcn_fence(__ATOMIC_ACQUIRE, "agent");
            xb_add(&bar[XB_XGEN(b.x)], 1u);
            asm volatile("s_waitcnt vmcnt(0)" ::: "memory");
        } else {
            XB_SPIN(xb_ld(&bar[XB_XGEN(b.x)]) == gen, bar);
            if (FENCED) __builtin_amdgcn_fence(__ATOMIC_ACQUIRE, "agent");
            asm volatile("s_waitcnt vmcnt(0)" ::: "memory");
        }
    }
    __syncthreads();
}

struct Frame {
    LAS unsigned char* lds;
    int tid, lane, wave, wg, G;
    const float* const* in;
    float* out; unsigned char* ws;
};
enum { I_XP = 0, I_XS, I_S5RE, I_S5IM, I_LRUH, I_LRUC, I_GS, I_GC, I_NMPRE, I_NMPOST, I_NFPRE, I_NFPOST, I_WIN, I_LRE, I_LIM, I_LDT, I_BRE, I_BIM, I_CRE, I_CIM, I_S5D, I_WGLU, I_BGLU,
       I_LCW, I_LCB, I_LWA, I_LBA, I_LWX, I_LBX, I_LLAM, I_GCW, I_GALOG, I_GDTB, I_GNW, I_WOUT, I_WGU, I_WDN };

__device__ __forceinline__ void transpose_item(const float* W, int ldw, int K, int k0, int c0, bf16* WT, int r0, LAS float* scr, int lane, const float* ksc = nullptr) {
    float tv[32];
#pragma unroll
    for (int i = 0; i < 32; ++i) tv[i] = W[(size_t)(k0 + 2 * i + (lane >> 5)) * ldw + c0 + (lane & 31)];
    if (ksc) {
#pragma unroll
        for (int i = 0; i < 32; ++i) tv[i] *= ksc[k0 + 2 * i + (lane >> 5)];
    }
#pragma unroll
    for (int i = 0; i < 32; ++i) scr[(2 * i + (lane >> 5)) * 33 + (lane & 31)] = tv[i];
    LDS_WAIT(); asm volatile("" ::: "memory");
    const int c = lane & 7;
#pragma unroll
    for (int j = 0; j < 4; ++j) { const int n = (lane >> 3) + 8 * j; const LAS float* s = scr + (8 * c) * 33 + n;
        v4u o; o.x = pk2(s[0 * 33], s[1 * 33]); o.y = pk2(s[2 * 33], s[3 * 33]); o.z = pk2(s[4 * 33], s[5 * 33]); o.w = pk2(s[6 * 33], s[7 * 33]);
        *(GAS v4u*)(WT + (size_t)(r0 + n) * K + k0 + 8 * c) = o; }
    LDS_WAIT(); asm volatile("" ::: "memory");
}
template <int MASK>
__device__ __forceinline__ void convert_items(Frame& F, int l, int wg0) {
    LAS float* scr = (LAS float*)(F.lds + F.wave * 16384);
    int lane = F.lane; asm volatile("" : "+v"(lane));
    const int gw = (F.wg - wg0) * NWAVES + F.wave, NGW = (F.G - wg0) * NWAVES;
    if (gw < 0) return;
    constexpr int I1 = (MASK & 1) ? 16 * 88 : 0, I2 = (MASK & 2) ? 16 * 32 : 0, I3 = (MASK & 4) ? 16 * 176 : 0, I4 = (MASK & 8) ? 44 * 32 : 0, I5 = (MASK & 16) ? 4 * 8 : 0, NIT = I1 + I2 + I3 + I4 + I5;
    unsigned char* ws = F.ws;
    for (int it = gw; it < NIT; it += NGW) {
        int r = it;
        if (r < I1) { const int kb = r / 88, nb = r % 88; transpose_item(F.in[I_WIN] + (size_t)l * DM * INC, INC, DM, 64 * kb, nb * 32 + (nb >= 72 ? 8 : 0), (bf16*)(ws + WS_WIN), nb * 32, scr, lane, F.in[I_NMPRE] + l * DM); continue; } r -= I1;
        if (r < I2) { const int kb = r / 32, nb = r % 32; transpose_item(F.in[I_WOUT] + (size_t)l * DM * DM, DM, DM, 64 * kb, nb * 32, (bf16*)(ws + WS_WOUT), nb * 32, scr, lane); continue; } r -= I2;
        if (r < I3) { const int kb = r / 176, nb = r % 176, tile = nb >> 3, wi = nb & 7; const int c0 = wi < 4 ? tile * 128 + wi * 32 : FF + tile * 128 + (wi - 4) * 32;
                      transpose_item(F.in[I_WGU] + (size_t)l * DM * 2 * FF, 2 * FF, DM, 64 * kb, c0, (bf16*)(ws + WS_WGU), nb * 32, scr, lane, F.in[I_NFPRE] + l * DM); continue; } r -= I3;
        if (r < I4) { const int kb = r / 32, nb = r % 32; transpose_item(F.in[I_WDN] + (size_t)l * FF * DM, DM, FF, 64 * kb, nb * 32, (bf16*)(ws + WS_WDN), nb * 32, scr, lane); continue; } r -= I4;
        if (r < I5) { const int kb = r / 8, nb = r % 8; transpose_item(F.in[I_WGLU] + (size_t)l * 256 * 256, 256, 256, 64 * kb, nb * 32, (bf16*)(ws + WS_WGLU), nb * 32, scr, lane); }
    }
}
constexpr size_t WS_DEP = 256 * 1024;
__device__ __forceinline__ unsigned* dep_word(Frame& F, int bank, int i) { return (unsigned*)(F.ws + WS_CTL + WS_DEP) + ((size_t)bank * 96 + i) * 64; }
__device__ __forceinline__ void dep_publish(Frame& F, unsigned* w0, unsigned* w1) {
    asm volatile("s_waitcnt vmcnt(0)" ::: "memory");
    __syncthreads();
    if (F.tid == 0) {
        __builtin_amdgcn_fence(__ATOMIC_RELEASE, "agent");
        asm volatile("s_waitcnt vmcnt(0)" ::: "memory");
        (void)xb_add(w0, 1u);
        if (w1) (void)xb_add(w1, 1u);
    }
}
__device__ __forceinline__ void dep_wait(Frame& F, unsigned* w0, unsigned n0, unsigned* w1, unsigned n1, unsigned* bar) {
    if (F.tid == 0) {
        XB_SPIN(xb_ld(w0) < n0, bar);
        if (w1) XB_SPIN(xb_ld(w1) < n1, bar);
        __builtin_amdgcn_fence(__ATOMIC_ACQUIRE, "agent");
        asm volatile("s_waitcnt vmcnt(0)" ::: "memory");
    }
    __syncthreads();
}
template <bool XIN_B, bool XOUT_B, bool LOCAL = false>
__device__ __forceinline__ void row_pass(Frame& F, const float* xp, const float* xs, const bf16* branch, const float* wb, float* xout, const float* wh, float* RS, const float* wab, float* AB, int lbase = 0, unsigned* sw = nullptr, unsigned sn = 0, unsigned* bar = nullptr) {
    int lane = F.lane; asm volatile("" : "+v"(lane));
    const int gw = F.wg * NWAVES + F.wave, NGW = F.G * NWAVES;
    f32x4 wbv[4], whv[4];
#pragma unroll
    for (int j = 0; j < 4; ++j) { wbv[j] = branch ? *(const GAS f32x4*)(wb + 4 * lane + 256 * j) : (f32x4){0.f, 0.f, 0.f, 0.f}; whv[j] = wh ? *(const GAS f32x4*)(wh + 4 * lane + 256 * j) : (f32x4){0.f, 0.f, 0.f, 0.f}; }
    LAS float* WL = (LAS float*)F.lds;
    if (wab) {
        f32x4 wl4[4];
#pragma unroll
        for (int k4 = 0; k4 < 4; ++k4) { const int i = F.tid + k4 * NTHR; const int k = i >> 1, hlf = i & 1; wl4[k4] = *(const GAS f32x4*)(wab + (size_t)k * INC + 2304 + hlf * 4); }
        __syncthreads();
#pragma unroll
        for (int k4 = 0; k4 < 4; ++k4) { const int i = F.tid + k4 * NTHR; const int k = i >> 1, hlf = i & 1; *(LAS f32x4*)(WL + k * 8 + hlf * 4) = wl4[k4]; }
        __syncthreads(); }
    const int nit = LOCAL ? (F.wave < 2 ? 9 : 8) : (MT - gw + NGW - 1) / NGW;
    for (int it = 0; it < nit; ++it) {
        const int m = LOCAL ? (it < 8 ? lbase + it : MP + 2 * F.wg + F.wave) : gw + it * NGW;
        if (LOCAL && it == 8) {
            XB_SPIN(xb_ld(sw) < sn, bar);
            __builtin_amdgcn_fence(__ATOMIC_ACQUIRE, "agent");
            asm volatile("s_waitcnt vmcnt(0)" ::: "memory");
        }
        f32x4 v[4];
        if (XIN_B) {
#pragma unroll
            for (int j = 0; j < 4; ++j) { const v2u w = *(const GAS v2u*)((const bf16*)xp + (size_t)m * DM + 4 * lane + 256 * j); v[j] = (f32x4){bflo(w.x), bfhi(w.x), bflo(w.y), bfhi(w.y)}; }
        } else {
            const float* xr = (xs && m >= MP) ? xs + (size_t)(m - MP) * DM : xp + (size_t)m * DM;
#pragma unroll
            for (int j = 0; j < 4; ++j) v[j] = *(const GAS f32x4*)(xr + 4 * lane + 256 * j);
        }
        if (branch) {
            f32x4 b[4]; float s = 0.f;
#pragma unroll
            for (int j = 0; j < 4; ++j) { const v2u bw = *(const GAS v2u*)(branch + (size_t)m * DM + 4 * lane + 256 * j); b[j] = (f32x4){bflo(bw.x), bfhi(bw.x), bflo(bw.y), bfhi(bw.y)}; s += (b[j].x * b[j].x + b[j].y * b[j].y) + (b[j].z * b[j].z + b[j].w * b[j].w); }
            const float rs = 1.0f / sqrtf(wave_sum(s) * (1.f / DM) + EPS);
#pragma unroll
            for (int j = 0; j < 4; ++j) v[j] = v[j] + b[j] * rs * wbv[j];
        }
        if (xout) {
#pragma unroll
            for (int j = 0; j < 4; ++j) {
                if (XOUT_B) { v2u o; o.x = pk2(v[j].x, v[j].y); o.y = pk2(v[j].z, v[j].w); *(GAS v2u*)((bf16*)xout + (size_t)m * DM + 4 * lane + 256 * j) = o; }
                else *(GAS f32x4*)(xout + (size_t)m * DM + 4 * lane + 256 * j) = v[j];
            }
        }
        if (RS) {
            float s = 0.f;
#pragma unroll
            for (int j = 0; j < 4; ++j) s += (v[j].x * v[j].x + v[j].y * v[j].y) + (v[j].z * v[j].z + v[j].w * v[j].w);
            const float rs = 1.0f / sqrtf(wave_sum(s) * (1.f / DM) + EPS);
            if (lane == 0) RS[m] = rs;
            if (wab) {
#pragma unroll
                for (int j = 0; j < 4; ++j) v[j] = v[j] * rs * whv[j];
            }
            if (wab) {
                float a8[8];
#pragma unroll
                for (int c = 0; c < 8; ++c) a8[c] = 0.f;
#pragma unroll
                for (int j = 0; j < 4; ++j)
#pragma unroll
                    for (int q = 0; q < 4; ++q) { const LAS float* wr = WL + (4 * lane + 256 * j + q) * 8; const f32x4 w0 = *(const LAS f32x4*)wr, w1 = *(const LAS f32x4*)(wr + 4); const float xv = v[j][q];
                        a8[0] += xv * w0.x; a8[1] += xv * w0.y; a8[2] += xv * w0.z; a8[3] += xv * w0.w; a8[4] += xv * w1.x; a8[5] += xv * w1.y; a8[6] += xv * w1.z; a8[7] += xv * w1.w; }
#pragma unroll
                for (int c = 0; c < 8; ++c) a8[c] = wave_sum(a8[c]);
                if (lane == 0) { *(GAS f32x4*)(AB + (size_t)m * 8) = (f32x4){a8[0], a8[1], a8[2], a8[3]}; *(GAS f32x4*)(AB + (size_t)m * 8 + 4) = (f32x4){a8[4], a8[5], a8[6], a8[7]}; }
            }
        }
    }
}

__device__ __forceinline__ void sample_gemm_f32(Frame& F, const bf16* A, const bf16* Bt, int K, bf16* C) {
    int tid = F.tid; asm volatile("" : "+v"(tid)); const int lane = tid & 63, wv = tid >> 6, fr = lane & 15, fq = lane >> 4;
    for (int t = F.wg; t < 256; t += F.G) {
        const int row0 = MP + 32 * (t >> 4) + 16 * (wv >> 2), col0 = 64 * (t & 15) + 16 * (wv & 3);
        const bf16* ap = A + (size_t)(row0 + fr) * K + 8 * fq; const bf16* bp = Bt + (size_t)(col0 + fr) * K + 8 * fq;
        f32x4 acc0 = (f32x4){0.f, 0.f, 0.f, 0.f}, acc1 = (f32x4){0.f, 0.f, 0.f, 0.f};
#pragma unroll 4
        for (int k = 0; k < K; k += 64) {
            const v4u a0 = *(const GAS v4u*)(ap + k), b0 = *(const GAS v4u*)(bp + k), a1 = *(const GAS v4u*)(ap + k + 32), b1 = *(const GAS v4u*)(bp + k + 32);
            acc0 = MFMA16(__builtin_bit_cast(bf16x8, a0), __builtin_bit_cast(bf16x8, b0), acc0); acc1 = MFMA16(__builtin_bit_cast(bf16x8, a1), __builtin_bit_cast(bf16x8, b1), acc1);
        }
#pragma unroll
        for (int r = 0; r < 4; ++r) C[(size_t)(row0 + 4 * fq + r) * DM + col0 + fr] = (bf16)f2bf(acc0[r] + acc1[r]);
    }
}

__device__ __forceinline__ void sample_gemm_lds(Frame& F, const bf16* A, const bf16* Bt, int K, bf16* C) {
    int tid = F.tid; asm volatile("" : "+v"(tid)); const int lane = tid & 63, wv = tid >> 6, fr = lane & 15, fq = lane >> 4;
    LAS unsigned char* L = F.lds;
    constexpr int SA = 32 * S512, SBUF = SA + 64 * S512;
    for (int t = F.wg; t < 256; t += F.G) {
        const int row0 = MP + 32 * (t >> 4), col0 = 64 * (t & 15);
        const int pr = tid >> 5, pc = (tid & 31) * 8;
        const bf16* ap = A + (size_t)(row0 + pr) * K + pc; const bf16* bp = Bt + (size_t)(col0 + pr) * K + pc;
        const size_t s16 = (size_t)16 * K;
        const int sa = pr * S512 + pc * 2, sb = SA + sa;
        v4u ra0 = *(const GAS v4u*)ap, ra1 = *(const GAS v4u*)(ap + s16);
        v4u rb0 = *(const GAS v4u*)bp, rb1 = *(const GAS v4u*)(bp + s16), rb2 = *(const GAS v4u*)(bp + 2 * s16), rb3 = *(const GAS v4u*)(bp + 3 * s16);
        *(LAS v4u*)(L + sa) = ra0; *(LAS v4u*)(L + sa + 16 * S512) = ra1;
        *(LAS v4u*)(L + sb) = rb0; *(LAS v4u*)(L + sb + 16 * S512) = rb1; *(LAS v4u*)(L + sb + 32 * S512) = rb2; *(LAS v4u*)(L + sb + 48 * S512) = rb3;
        __syncthreads();
        f32x4 acc = (f32x4){0.f, 0.f, 0.f, 0.f};
        const int nc = K >> 8;
        for (int kc = 0; kc < nc; ++kc) {
            const int cur = (kc & 1) * SBUF, nxt = ((kc + 1) & 1) * SBUF;
            if (kc + 1 < nc) { const int o = (kc + 1) * 256;
                ra0 = *(const GAS v4u*)(ap + o); ra1 = *(const GAS v4u*)(ap + s16 + o);
                rb0 = *(const GAS v4u*)(bp + o); rb1 = *(const GAS v4u*)(bp + s16 + o); rb2 = *(const GAS v4u*)(bp + 2 * s16 + o); rb3 = *(const GAS v4u*)(bp + 3 * s16 + o); }
#pragma unroll
            for (int ks = 0; ks < 8; ++ks) {
                const bf16x8 af = *(const LAS bf16x8*)(L + cur + (16 * (wv >> 2) + fr) * S512 + (32 * ks + 8 * fq) * 2);
                const bf16x8 bf = *(const LAS bf16x8*)(L + cur + SA + (16 * (wv & 3) + fr) * S512 + (32 * ks + 8 * fq) * 2);
                acc = MFMA16(af, bf, acc);
            }
            if (kc + 1 < nc) { *(LAS v4u*)(L + nxt + sa) = ra0; *(LAS v4u*)(L + nxt + sa + 16 * S512) = ra1;
                *(LAS v4u*)(L + nxt + sb) = rb0; *(LAS v4u*)(L + nxt + sb + 16 * S512) = rb1; *(LAS v4u*)(L + nxt + sb + 32 * S512) = rb2; *(LAS v4u*)(L + nxt + sb + 48 * S512) = rb3; }
            __syncthreads();
        }
#pragma unroll
        for (int r = 0; r < 4; ++r) C[(size_t)(row0 + 16 * (wv >> 2) + 4 * fq + r) * DM + col0 + 16 * (wv & 3) + fr] = (bf16)f2bf(acc[r]);
    }
}

constexpr int G_KN = 0, G_WKT = 0, G_QN = 18432, G_KT = G_QN + 64 * S256, G_VT = G_KT + 128 * S128, G_RAW = G_VT + 128 * S128, G_AT = G_RAW, G_T1 = G_AT + 64 * S128, G_T2 = G_T1 + 64 * S128, G_AF = G_T2 + 64 * S128, G_WVT = G_AF, G_VEC = G_RAW + 52544, G_CW = G_VEC + 1024;
constexpr int RAW_STRIDE = 784;
static_assert(G_RAW + 67 * RAW_STRIDE <= G_VEC && G_CW + 6144 <= LDSCTL_OFF && G_WVT + 128 * S128 <= G_VEC && 64 * S256 <= G_QN && 128 * S128 <= G_QN, "gdn prep lds");
__device__ __forceinline__ void gdn_raw_load(Frame& F, int u, int tid, v4u (&pre)[7], float (&abn)[2]) {
    const int c = u & 31, h = (u >> 5) & 3, b = u >> 7; const bf16* P = (const bf16*)(F.ws + WS_P);
    { const float* ABp = (const float*)(F.ws + WS_AB) + (size_t)(b * SEQ + c * 64 + (tid & 63)) * 8; abn[0] = ABp[h]; abn[1] = ABp[4 + h]; }
#pragma unroll
    for (int k7 = 0; k7 < 7; ++k7) { const int idx = tid + NTHR * k7; const int r = idx / 48, ck = idx % 48, ten = ck >> 4, c16 = ck & 15; const int tt = c * 64 - 3 + r;
        v4u val = (v4u){0u, 0u, 0u, 0u};
        if (idx < 67 * 48 && tt >= 0) val = *(const GAS v4u*)(P + (size_t)(b * SEQ + tt) * NPJ + PQ + ten * 512 + h * HD + c16 * 8);
        pre[k7] = val; }
}
template <int GP_CUT>
__device__ __forceinline__ void gdn_prep(Frame& F, int l, int u, int& cw_head, v4u (&pre)[7], float (&abn)[2], bool have_pre, int u_next) {
    LAS unsigned char* L = F.lds;
    int tid = F.tid; asm volatile("" : "+v"(tid)); const int lane = tid & 63, wv = tid >> 6;
    const int c = u & 31, h = (u >> 5) & 3, b = u >> 7;
    const int row0 = b * SEQ + c * 64;
    const bf16* P = (const bf16*)(F.ws + WS_P);
    const float* AB = (const float*)(F.ws + WS_AB);
    LAS float* VG = (LAS float*)(L + G_VEC); LAS float* VB = VG + 64; LAS float* VEG = VG + 128; LAS float* VEGL = VG + 192;
    const float galog = F.in[I_GALOG][l * 4 + h], gdtb = F.in[I_GDTB][l * 4 + h];
    if (h != cw_head) {
        for (int idx = tid; idx < 1536; idx += NTHR) { const int j = idx / 384, cc = idx % 384; ((LAS float*)(L + G_CW))[idx] = F.in[I_GCW][(size_t)(l * 4 + j) * 1536 + (cc >> 7) * 512 + h * HD + (cc & 127)]; }
        cw_head = h;
    }
    if (!have_pre) gdn_raw_load(F, u, tid, pre, abn);
#pragma unroll
    for (int k7 = 0; k7 < 7; ++k7) { const int idx = tid + NTHR * k7; if (idx < 67 * 48) { const int r = idx / 48, ck = idx % 48; *(LAS v4u*)(L + G_RAW + r * RAW_STRIDE + (ck >> 4) * 256 + (ck & 15) * 16) = pre[k7]; } }
    if (wv == 0) {
        const float a = abn[0], bb = abn[1];
        const float g = -__expf(galog) * softplus_fast(a + gdtb);
        const float be = frcp(1.0f + __expf(-bb));
        float Gc = g;
#pragma unroll
        for (int o = 1; o < 64; o <<= 1) { const float t = __shfl_up(Gc, o); if (lane >= o) Gc += t; }
        const float Gl = __shfl(Gc, 63);
        VG[lane] = Gc; VB[lane] = be; VEG[lane] = __expf(Gc); VEGL[lane] = __expf(Gl - Gc);
        if (lane == 0) ((float*)(F.ws + WS_EGL))[u] = __expf(Gl);
    }
    __syncthreads();
    if (u_next >= 0) gdn_raw_load(F, u_next, tid, pre, abn);
    if (c == 31 && tid < 384) {
        const int ten = tid >> 7, ch = tid & 127;
#pragma unroll
        for (int j = 0; j < 3; ++j) F.out[O_PGC + (size_t)((l * 8 + b) * 3 + j) * 1536 + ten * 512 + h * HD + ch] = bf2f(*(LAS bf16*)(L + G_RAW + (64 + j) * RAW_STRIDE + ten * 256 + ch * 2));
    }
    {
        const int i = tid >> 3, cg = tid & 7;
#pragma unroll 1
        for (int ten = 0; ten < 3; ++ten) {
            float acc[16];
#pragma unroll
            for (int e = 0; e < 16; ++e) acc[e] = 0.f;
#pragma unroll
            for (int j = 0; j < 4; ++j) {
                const v4u x0 = *(LAS v4u*)(L + G_RAW + (i + j) * RAW_STRIDE + ten * 256 + cg * 32), x1 = *(LAS v4u*)(L + G_RAW + (i + j) * RAW_STRIDE + ten * 256 + cg * 32 + 16);
                const LAS float* w = (const LAS float*)(L + G_CW) + j * 384 + ten * 128 + cg * 16;
                const f32x4 w0 = *(const LAS f32x4*)w, w1 = *(const LAS f32x4*)(w + 4), w2 = *(const LAS f32x4*)(w + 8), w3 = *(const LAS f32x4*)(w + 12);
                acc[0] += w0.x * bflo(x0.x); acc[1] += w0.y * bfhi(x0.x); acc[2] += w0.z * bflo(x0.y); acc[3] += w0.w * bfhi(x0.y);
                acc[4] += w1.x * bflo(x0.z); acc[5] += w1.y * bfhi(x0.z); acc[6] += w1.z * bflo(x0.w); acc[7] += w1.w * bfhi(x0.w);
                acc[8] += w2.x * bflo(x1.x); acc[9] += w2.y * bfhi(x1.x); acc[10] += w2.z * bflo(x1.y); acc[11] += w2.w * bfhi(x1.y);
                acc[12] += w3.x * bflo(x1.z); acc[13] += w3.y * bfhi(x1.z); acc[14] += w3.z * bflo(x1.w); acc[15] += w3.w * bfhi(x1.w);
            }
            float ss = 0.f;
#pragma unroll
            for (int e = 0; e < 16; ++e) { acc[e] = siluf_(acc[e]); ss += acc[e] * acc[e]; }
            ss += __shfl_xor(ss, 1); ss += __shfl_xor(ss, 2); ss += __shfl_xor(ss, 4);
            const float sc = ten == 2 ? 1.0f : frsq(ss + EPS) * (ten == 0 ? 0.08838834764831845f : 1.0f);
#pragma unroll
            for (int e = 0; e < 16; ++e) acc[e] *= sc;
            if (ten < 2) { const int base = ten == 0 ? G_QN : G_KN; *(LAS bf16x8*)(L + base + t256(i, cg * 16)) = pack8(acc); *(LAS bf16x8*)(L + base + t256(i, cg * 16 + 8)) = pack8(acc + 8); }
            if (ten > 0) { const int base = ten == 1 ? G_KT : G_VT;
#pragma unroll
                for (int e = 0; e < 16; ++e) *(LAS bf16*)(L + base + t128(cg * 16 + e, i)) = (bf16)f2bf(acc[e]); }
        }
    }
    __syncthreads();
    if constexpr (GP_CUT == 1) return;
    {
        const int prod = wv >> 2, mi = wv & 3, fr = lane & 15, fq = lane >> 4;
        bf16x8 a[4];
#pragma unroll
        for (int ks = 0; ks < 4; ++ks) a[ks] = *(LAS bf16x8*)(L + (prod ? G_QN : G_KN) + t256(16 * mi + fr, 32 * ks + 8 * fq));
#pragma unroll
        for (int nj = 0; nj < 4; ++nj) {
            f32x4 acc = (f32x4){0.f, 0.f, 0.f, 0.f};
            if (nj <= mi) {
#pragma unroll
                for (int ks = 0; ks < 4; ++ks) { const bf16x8 bb = *(LAS bf16x8*)(L + G_KN + t256(16 * nj + fr, 32 * ks + 8 * fq)); acc = MFMA16(a[ks], bb, acc); }
            }
            const int j = 16 * nj + fr; const float Gj = VG[j];
#pragma unroll
            for (int r = 0; r < 4; ++r) {
                const int i = 16 * mi + 4 * fq + r; const float Gi = VG[i];
                const float dec = (i >= j) ? __expf(Gi - Gj) : 0.f;
                if (prod == 0) { const float val = (i > j) ? acc[r] * VB[i] * dec : 0.f; *(LAS float*)(L + G_AF + (i * 64 + j) * 4) = val; }
                else { const float val = (i >= j) ? acc[r] * dec : 0.f; *(LAS bf16*)(L + G_AT + t128(i, j)) = (bf16)f2bf(val); }
            }
        }
    }
    __syncthreads();
    if constexpr (GP_CUT == 2) return;
    if (wv == 0) {
        const int q = lane >> 4, col = lane & 15; const LAS float* Ab = (const LAS float*)(L + G_AF) + (16 * q) * 64 + 16 * q;
        float t[16];
#pragma unroll
        for (int i = 0; i < 16; ++i) {
            float a0 = (col == i) ? 1.f : 0.f, a1 = 0.f, a2 = 0.f, a3 = 0.f;
#pragma unroll
            for (int j4 = 0; j4 < i; j4 += 4) { const f32x4 av = *(const LAS f32x4*)(Ab + i * 64 + j4);
                a0 -= av.x * t[j4]; if (j4 + 1 < i) a1 -= av.y * t[j4 + 1]; if (j4 + 2 < i) a2 -= av.z * t[j4 + 2]; if (j4 + 3 < i) a3 -= av.w * t[j4 + 3]; }
            t[i] = (a0 + a1) + (a2 + a3);
            if ((i & 3) == 3) asm volatile("" ::: "memory");
        }
        LAS float* Tb = (LAS float*)(L + G_AF) + (16 * q) * 64 + 16 * q;
#pragma unroll
        for (int i = 0; i < 16; ++i) Tb[i * 64 + col] = t[i];
    }
    __syncthreads();
    if (wv < 2) {
        LAS float* AF = (LAS float*)(L + G_AF) + (32 * wv) * 64 + 32 * wv; LAS float* X1 = (LAS float*)(L + G_T1) + 1024 + 256 * wv;
        const int fr = lane & 15, fq = lane >> 4;
        f32x4 acc = (f32x4){0.f, 0.f, 0.f, 0.f};
#pragma unroll
        for (int kk = 0; kk < 4; ++kk) { const float av = AF[(16 + fr) * 64 + 4 * kk + fq], bv = AF[(4 * kk + fq) * 64 + fr]; acc = __builtin_amdgcn_mfma_f32_16x16x4f32(av, bv, acc, 0, 0, 0); }
#pragma unroll
        for (int r = 0; r < 4; ++r) X1[(4 * fq + r) * 16 + fr] = acc[r];
        acc = (f32x4){0.f, 0.f, 0.f, 0.f};
#pragma unroll
        for (int kk = 0; kk < 4; ++kk) { const float av = AF[(16 + fr) * 64 + 16 + 4 * kk + fq], bv = X1[(4 * kk + fq) * 16 + fr]; acc = __builtin_amdgcn_mfma_f32_16x16x4f32(av, bv, acc, 0, 0, 0); }
#pragma unroll
        for (int r = 0; r < 4; ++r) AF[(16 + 4 * fq + r) * 64 + fr] = -acc[r];
    }
    __syncthreads();
    if constexpr (GP_CUT == 3) return;
    {
        LAS float* AF = (LAS float*)(L + G_AF); LAS float* XF = (LAS float*)(L + G_T1);
        const int mi2 = wv & 1, nj2 = (wv >> 1) & 1, fr = lane & 15, fq = lane >> 4;
        if (wv < 4) {
            f32x4 acc = (f32x4){0.f, 0.f, 0.f, 0.f};
#pragma unroll
            for (int kk = 0; kk < 8; ++kk) { const float av = AF[(32 + 16 * mi2 + fr) * 64 + 4 * kk + fq], bv = AF[(4 * kk + fq) * 64 + 16 * nj2 + fr]; acc = __builtin_amdgcn_mfma_f32_16x16x4f32(av, bv, acc, 0, 0, 0); }
#pragma unroll
            for (int r = 0; r < 4; ++r) XF[(16 * mi2 + 4 * fq + r) * 32 + 16 * nj2 + fr] = acc[r];
        }
        __syncthreads();
        if (wv < 4) {
            f32x4 acc = (f32x4){0.f, 0.f, 0.f, 0.f};
#pragma unroll
            for (int kk = 0; kk < 8; ++kk) { const float av = AF[(32 + 16 * mi2 + fr) * 64 + 32 + 4 * kk + fq], bv = XF[(4 * kk + fq) * 32 + 16 * nj2 + fr]; acc = __builtin_amdgcn_mfma_f32_16x16x4f32(av, bv, acc, 0, 0, 0); }
#pragma unroll
            for (int r = 0; r < 4; ++r) AF[(32 + 16 * mi2 + 4 * fq + r) * 64 + 16 * nj2 + fr] = -acc[r];
        }
        __syncthreads();
    }
    if constexpr (GP_CUT == 4) return;
    {
        const int i = tid >> 3, c8 = tid & 7; const LAS float* AF = (const LAS float*)(L + G_AF);
        const f32x4 t0 = *(const LAS f32x4*)(AF + i * 64 + 8 * c8), t1 = *(const LAS f32x4*)(AF + i * 64 + 8 * c8 + 4);
        float a1[8], a2[8];
#pragma unroll
        for (int e = 0; e < 8; ++e) { const float tv = e < 4 ? t0[e] : t1[e - 4]; const int j = 8 * c8 + e; a1[e] = tv * VB[j]; a2[e] = a1[e] * VEG[j]; }
        __syncthreads();
        *(LAS bf16x8*)(L + G_T1 + t128(i, 8 * c8)) = pack8(a1); *(LAS bf16x8*)(L + G_T2 + t128(i, 8 * c8)) = pack8(a2);
    }
    __syncthreads();
    if constexpr (GP_CUT == 5) return;
    {
        const int nd = wv, fr = lane & 15, fq = lane >> 4;
#pragma unroll
        for (int prod = 0; prod < 2; ++prod) {
            bf16x8 bfr[2];
#pragma unroll
            for (int ks = 0; ks < 2; ++ks) bfr[ks] = *(LAS bf16x8*)(L + (prod ? G_KT : G_VT) + t128(16 * nd + fr, 32 * ks + 8 * fq));
#pragma unroll
            for (int mi = 0; mi < 4; ++mi) {
                f32x4 acc = (f32x4){0.f, 0.f, 0.f, 0.f};
#pragma unroll
                for (int ks = 0; ks < 2; ++ks) { const bf16x8 af = *(LAS bf16x8*)(L + (prod ? G_T2 : G_T1) + t128(16 * mi + fr, 32 * ks + 8 * fq)); acc = MFMA16(af, bfr[ks], acc); }
                v2u o; o.x = pk2(acc[0], acc[1]); o.y = pk2(acc[2], acc[3]);
                *(LAS v2u*)(L + (prod ? G_WKT : G_WVT) + t128(16 * nd + fr, 16 * mi + 4 * fq)) = o;
            }
        }
    }
    __syncthreads();
    if constexpr (GP_CUT == 6) return;
    {
        const int nd = wv, fr = lane & 15, fq = lane >> 4;
        bf16x8 bk[2], bv[2];
#pragma unroll
        for (int ks = 0; ks < 2; ++ks) { bk[ks] = *(LAS bf16x8*)(L + G_WKT + t128(16 * nd + fr, 32 * ks + 8 * fq)); bv[ks] = *(LAS bf16x8*)(L + G_WVT + t128(16 * nd + fr, 32 * ks + 8 * fq)); }
        bf16* QT = (bf16*)(F.ws + WS_QT) + (size_t)u * 64 * 128; bf16* OL = (bf16*)(F.ws + WS_OL) + (size_t)u * 8192;
#pragma unroll
        for (int mi = 0; mi < 4; ++mi) {
            f32x4 ak = (f32x4){0.f, 0.f, 0.f, 0.f}, av = (f32x4){0.f, 0.f, 0.f, 0.f};
#pragma unroll
            for (int ks = 0; ks < 2; ++ks) { const bf16x8 af = *(LAS bf16x8*)(L + G_AT + t128(16 * mi + fr, 32 * ks + 8 * fq)); ak = MFMA16(af, bk[ks], ak); av = MFMA16(af, bv[ks], av); }
#pragma unroll
            for (int r = 0; r < 4; ++r) { const int i = 16 * mi + 4 * fq + r, d = 16 * nd + fr;
                const float qv = bf2f(*(LAS bf16*)(L + G_QN + t256(i, d)));
                QT[(((mi * 4 + (nd >> 1)) * 64) + (4 * fq + r) + 16 * (2 * (nd & 1) + (fr >> 3))) * 8 + (fr & 7)] = (bf16)f2bf(VEG[i] * qv - ak[r]);
                }
            { v2u o; o.x = pk2(av[0], av[1]); o.y = pk2(av[2], av[3]); *(GAS v2u*)(OL + ((nd * 4 + mi) * 64 + lane) * 4) = o; }
        }
    }
    if constexpr (GP_CUT == 7) return;
    {
        const int fr = lane & 15, fq = lane >> 4;
        bf16x8 kd[2];
#pragma unroll
        for (int ks = 0; ks < 2; ++ks) { const v4u raw = *(LAS v4u*)(L + G_KT + t128(16 * wv + fr, 32 * ks + 8 * fq)); const int i0 = 32 * ks + 8 * fq; float f[8];
            f[0] = bflo(raw.x) * VEGL[i0]; f[1] = bfhi(raw.x) * VEGL[i0 + 1]; f[2] = bflo(raw.y) * VEGL[i0 + 2]; f[3] = bfhi(raw.y) * VEGL[i0 + 3];
            f[4] = bflo(raw.z) * VEGL[i0 + 4]; f[5] = bfhi(raw.z) * VEGL[i0 + 5]; f[6] = bflo(raw.w) * VEGL[i0 + 6]; f[7] = bfhi(raw.w) * VEGL[i0 + 7]; kd[ks] = pack8(f); }
        bf16* PP = (bf16*)(F.ws + WS_PP) + (size_t)u * 128 * 128; bf16* RT = (bf16*)(F.ws + WS_RT) + (size_t)u * 128 * 128;
#pragma unroll 2
        for (int nd = 0; nd < 8; ++nd) {
            f32x4 ar = (f32x4){0.f, 0.f, 0.f, 0.f}, ap = (f32x4){0.f, 0.f, 0.f, 0.f};
#pragma unroll
            for (int ks = 0; ks < 2; ++ks) { const bf16x8 wvf = *(LAS bf16x8*)(L + G_WVT + t128(16 * nd + fr, 32 * ks + 8 * fq)), wkf = *(LAS bf16x8*)(L + G_WKT + t128(16 * nd + fr, 32 * ks + 8 * fq));
                ar = MFMA16(kd[ks], wvf, ar); ap = MFMA16(wkf, kd[ks], ap); }
            v2u o; o.x = pk2(ar[0], ar[1]); o.y = pk2(ar[2], ar[3]); *(GAS v2u*)(RT + (size_t)((nd * 8 + wv) * 64 + lane) * 4) = o;
            o.x = pk2(ap[0], ap[1]); o.y = pk2(ap[2], ap[3]); *(GAS v2u*)(PP + (size_t)(((wv * 4 + (nd >> 1)) * 64) + fr + 16 * (2 * (nd & 1) + (fq >> 1))) * 8 + 4 * (fq & 1)) = o;
        }
    }
    __syncthreads();
}

struct ChainSet { v4u ap[4], aq[4]; v2u rr, ol; float eg; };
constexpr int CH_O = 2 * 16 * S256, CH_S = CH_O + 32 * 4 * 512;
static_assert(CH_S + 32 * 4 * 64 <= LDSCTL_OFF, "chain lds");
struct ChainPtr { const bf16* pp; const bf16* qq; const bf16* rt; const bf16* ol; const float* egl; };
__device__ __forceinline__ void chain_load(ChainSet& s, const ChainPtr& p, int c, bool lowhalf) {
    const bf16* pp = p.pp + (size_t)c * 16384;
#pragma unroll
    for (int ks = 0; ks < 4; ++ks) s.ap[ks] = *(const GAS v4u*)(pp + 512 * ks);
    s.rr = *(const GAS v2u*)(p.rt + (size_t)c * 16384); s.eg = p.egl[c];
    if (lowhalf) {
        const bf16* qq = p.qq + (size_t)c * 8192;
#pragma unroll
        for (int ks = 0; ks < 4; ++ks) s.aq[ks] = *(const GAS v4u*)(qq + 512 * ks);
        s.ol = *(const GAS v2u*)(p.ol + (size_t)c * 8192);
    }
}
template <bool DRY>
__device__ __forceinline__ void gdn_chain(Frame& F, int l, int task) {
    LAS unsigned char* L = F.lds;
    int tid = F.tid; asm volatile("" : "+v"(tid)); const int lane = tid & 63, wv = tid >> 6, fr = lane & 15, fq = lane >> 4;
    const int xcd = task & 7, idx = task >> 3; const int chain = xcd * 4 + (idx >> 3), slab = idx & 7;
    const int b = chain >> 2, h = chain & 3;
    const bf16* PPb = (const bf16*)(F.ws + WS_PP) + (size_t)chain * 32 * 16384; bf16* RTb = (bf16*)(F.ws + WS_RT) + (size_t)chain * 32 * 16384;
    const bf16* QTb = (const bf16*)(F.ws + WS_QT) + (size_t)chain * 32 * 8192;
    bf16* OLb = (bf16*)(F.ws + WS_OL) + (size_t)chain * 32 * 8192;
    float* SSQ = (float*)(F.ws + WS_SSQ);
    const float* EGL = (const float*)(F.ws + WS_EGL) + chain * 32;
    const int row0h = b * SEQ;
    for (int i = F.tid; i < 2 * 16 * S256 / 4; i += NTHR) ((LAS unsigned*)L)[i] = 0u;
    __syncthreads();
    f32x4 S = (f32x4){0.f, 0.f, 0.f, 0.f};
    ChainSet cs[4];
    ChainPtr cp;
    cp.pp = PPb + (size_t)(wv * 4 * 64 + lane) * 8; cp.qq = QTb + (size_t)((wv & 3) * 4 * 64 + lane) * 8;
    cp.rt = RTb + (size_t)((slab * 8 + wv) * 64 + lane) * 4;
    cp.ol = OLb + ((slab * 4 + (wv & 3)) * 64 + lane) * 4; cp.egl = EGL;
    asm volatile("" : "+v"(cp.pp), "+v"(cp.qq), "+v"(cp.rt), "+v"(cp.ol));
    const bool lowhalf = wv < 4;
    chain_load(cs[0], cp, 0, lowhalf); chain_load(cs[1], cp, 1, lowhalf); chain_load(cs[2], cp, 2, lowhalf);
#pragma unroll 1
    for (int c0 = 0; c0 < NCH; c0 += 4) {
#pragma unroll
        for (int s = 0; s < 4; ++s) {
            const int c = c0 + s;
            chain_load(cs[(s + 3) & 3], cp, c + 3 < NCH ? c + 3 : NCH - 1, lowhalf);
            const ChainSet& q = cs[s];
            const LAS unsigned char* St = L + (s & 1) * (16 * S256);
            bf16x8 bs[4];
#pragma unroll
            for (int ks = 0; ks < 4; ++ks) bs[ks] = *(const LAS bf16x8*)(St + t256(fr, 32 * ks + 8 * fq));
            f32x4 acc = (f32x4){0.f, 0.f, 0.f, 0.f};
#pragma unroll
            for (int ks = 0; ks < 4; ++ks) acc = MFMA16(__builtin_bit_cast(bf16x8, q.ap[ks]), bs[ks], acc);
            if (lowhalf) {
                f32x4 ao = (f32x4){0.f, 0.f, 0.f, 0.f};
#pragma unroll
                for (int ks = 0; ks < 4; ++ks) ao = MFMA16(__builtin_bit_cast(bf16x8, q.aq[ks]), bs[ks], ao);
                const float o0 = ao[0] + bflo(q.ol.x), o1 = ao[1] + bfhi(q.ol.x), o2 = ao[2] + bflo(q.ol.y), o3 = ao[3] + bfhi(q.ol.y);
                v2u ov; ov.x = pk2(o0, o1); ov.y = pk2(o2, o3);
                f32x4 ss = (f32x4){o0 * o0, o1 * o1, o2 * o2, o3 * o3};
#pragma unroll
                for (int sh = 1; sh < 16; sh <<= 1) { ss[0] += __shfl_xor(ss[0], sh); ss[1] += __shfl_xor(ss[1], sh); ss[2] += __shfl_xor(ss[2], sh); ss[3] += __shfl_xor(ss[3], sh); }
                {
                    *(LAS v2u*)(L + CH_O + ((c * 4 + wv) * 64 + lane) * 8) = ov;
                    if (fr == 0) *(LAS f32x4*)(L + CH_S + ((c * 4 + wv) * 4 + fq) * 16) = ss;
                }
            }
            S[0] = q.eg * S[0] - acc[0] + bflo(q.rr.x); S[1] = q.eg * S[1] - acc[1] + bfhi(q.rr.x); S[2] = q.eg * S[2] - acc[2] + bflo(q.rr.y); S[3] = q.eg * S[3] - acc[3] + bfhi(q.rr.y);
            v2u o2; o2.x = pk2(S[0], S[1]); o2.y = pk2(S[2], S[3]);
            *(LAS v2u*)(L + ((s + 1) & 1) * (16 * S256) + t256(fr, 16 * wv + 4 * fq)) = o2;
            asm volatile("s_waitcnt lgkmcnt(0)" ::: "memory"); __builtin_amdgcn_s_barrier(); asm volatile("" ::: "memory");
        }
    }
    if (!DRY) {
        bf16* MXh = (bf16*)(F.ws + WS_X) + 512 + h * HD + 16 * slab;
#if HEADNORM_IN_GEMM
        const bf16* Zh = (const bf16*)(F.ws + WS_P) + PZ + h * HD + 16 * slab + 8 * (tid & 1);
        const float* gwp = F.in[I_GNW] + l * HD + 16 * slab + 8 * (tid & 1);
        const f32x4 w0 = *(const GAS f32x4*)gwp, w1 = *(const GAS f32x4*)(gwp + 4);
#endif
#if HEADNORM_IN_GEMM
        v4u zq[8];
#pragma unroll
        for (int k = 0; k < 8; ++k) { const int i = tid + k * NTHR; zq[k] = *(const GAS v4u*)(Zh + (size_t)(row0h + (i >> 7) * 64 + ((i >> 1) & 63)) * NPJ); }
#pragma unroll
        for (int k = 0; k < 8; ++k) { const int i = tid + k * NTHR; const int half = i & 1, rr = (i >> 1) & 63, cc = i >> 7; const int mi = rr >> 4, fq2 = (rr >> 2) & 3, r = rr & 3;
#else
        for (int i = tid; i < 32 * 64 * 2; i += NTHR) { const int half = i & 1, rr = (i >> 1) & 63, cc = i >> 7; const int mi = rr >> 4, fq2 = (rr >> 2) & 3, r = rr & 3;
#endif
            unsigned w[4];
#pragma unroll
            for (int e = 0; e < 4; ++e) { const int f0 = 8 * half + 2 * e;
                const unsigned lo = *(const LAS unsigned short*)(L + CH_O + ((cc * 4 + mi) * 64 + fq2 * 16 + f0) * 8 + r * 2), hi = *(const LAS unsigned short*)(L + CH_O + ((cc * 4 + mi) * 64 + fq2 * 16 + f0 + 1) * 8 + r * 2);
                w[e] = lo | (hi << 16); }
#if HEADNORM_IN_GEMM
            const v4u zv = zq[k];
            float y[8];
            y[0] = bflo(w[0]) * w0.x * siluf_(bflo(zv.x)); y[1] = bfhi(w[0]) * w0.y * siluf_(bfhi(zv.x)); y[2] = bflo(w[1]) * w0.z * siluf_(bflo(zv.y)); y[3] = bfhi(w[1]) * w0.w * siluf_(bfhi(zv.y));
            y[4] = bflo(w[2]) * w1.x * siluf_(bflo(zv.z)); y[5] = bfhi(w[2]) * w1.y * siluf_(bfhi(zv.z)); y[6] = bflo(w[3]) * w1.z * siluf_(bflo(zv.w)); y[7] = bfhi(w[3]) * w1.w * siluf_(bfhi(zv.w));
            *(GAS bf16x8*)(MXh + (size_t)(row0h + cc * 64 + rr) * DM + 8 * half) = pack8(y); }
#else
            *(GAS v4u*)(MXh + (size_t)(row0h + cc * 64 + rr) * DM + 8 * half) = (v4u){w[0], w[1], w[2], w[3]}; }
#endif
        for (int i = tid; i < 32 * 64; i += NTHR) { const int rr = i & 63, cc = i >> 6; const int mi = rr >> 4, fq2 = (rr >> 2) & 3, r = rr & 3;
            SSQ[(size_t)(row0h + cc * 64 + rr) * 32 + h * 8 + slab] = *(const LAS float*)(L + CH_S + ((cc * 4 + mi) * 4 + fq2) * 16 + r * 4); }
        float* So = F.out + O_PGS + (size_t)((l * 8 + b) * 4 + h) * 16384;
#pragma unroll
        for (int r = 0; r < 4; ++r) So[(size_t)(16 * wv + 4 * fq + r) * 128 + 16 * slab + fr] = S[r];
    }
    __syncthreads();
}

__device__ __forceinline__ void gdn_finalize(Frame& F, int l) {
    bf16* MX = (bf16*)(F.ws + WS_X); const bf16* P = (const bf16*)(F.ws + WS_P); const float* SSQ = (const float*)(F.ws + WS_SSQ);
    const int nth = F.G * NTHR;
    for (int it = F.wg * NTHR + F.tid; it < MP * 64; it += nth) {
        const int row = it >> 6, hh = (it >> 4) & 3, ck = it & 15;
        const f32x4 s0 = *(const GAS f32x4*)(SSQ + (size_t)row * 32 + hh * 8), s1 = *(const GAS f32x4*)(SSQ + (size_t)row * 32 + hh * 8 + 4);
        const float rs = frsq(((s0.x + s0.y) + (s0.z + s0.w) + (s1.x + s1.y) + (s1.z + s1.w)) * (1.f / HD) + EPS);
        const v4u ov = *(const GAS v4u*)(MX + (size_t)row * DM + 512 + hh * HD + ck * 8), zv = *(const GAS v4u*)(P + (size_t)row * NPJ + PZ + hh * HD + ck * 8);
        const f32x4 w0 = *(const GAS f32x4*)(F.in[I_GNW] + l * HD + ck * 8), w1 = *(const GAS f32x4*)(F.in[I_GNW] + l * HD + ck * 8 + 4);
        float y[8];
        y[0] = bflo(ov.x) * rs * w0.x * siluf_(bflo(zv.x)); y[1] = bfhi(ov.x) * rs * w0.y * siluf_(bfhi(zv.x)); y[2] = bflo(ov.y) * rs * w0.z * siluf_(bflo(zv.y)); y[3] = bfhi(ov.y) * rs * w0.w * siluf_(bfhi(zv.y));
        y[4] = bflo(ov.z) * rs * w1.x * siluf_(bflo(zv.z)); y[5] = bfhi(ov.z) * rs * w1.y * siluf_(bfhi(zv.z)); y[6] = bflo(ov.w) * rs * w1.z * siluf_(bflo(zv.w)); y[7] = bfhi(ov.w) * rs * w1.w * siluf_(bfhi(zv.w));
        *(GAS bf16x8*)(MX + (size_t)row * DM + 512 + hh * HD + ck * 8) = pack8(y);
    }
}


__device__ __forceinline__ void gdn_sample_load(Frame& F, int l, int task, float (&S)[32]) {
    const int b = task >> 2, h = task & 3, j = F.tid & 127, rq = F.tid >> 7;
    const float* S0 = F.in[I_GS] + (size_t)((l * 128 + b) * 4 + h) * 16384 + (size_t)(32 * rq) * 128 + j;
#pragma unroll
    for (int ii = 0; ii < 32; ++ii) S[ii] = S0[ii * 128];
}
__device__ __forceinline__ void gdn_sample(Frame& F, int l, int task, float (&S)[32]) {
    LAS float* L = (LAS float*)F.lds;
    LAS float* RAW = L;
    LAS float* QS = L + 7 * 384;
    LAS float* KS = QS + 512; LAS float* VS = KS + 512; LAS float* OS = VS + 512;
    LAS float* RED = OS + 512;
    LAS float* NRM = RED + 512;
    int tid = F.tid; asm volatile("" : "+v"(tid)); const int lane = tid & 63, wv = tid >> 6;
    const int b = task >> 2, h = task & 3; const int m0 = MP + b * 4;
    const bf16* P = (const bf16*)(F.ws + WS_P); const float* AB = (const float*)(F.ws + WS_AB); bf16* MX = (bf16*)(F.ws + WS_X);
    const int j = tid & 127, rq = tid >> 7;
    float cwv[3][4], gA[4], gB[4]; float zv, gnw;
    const float galog = F.in[I_GALOG][l * 4 + h], dtb = F.in[I_GDTB][l * 4 + h];
    {
        const int tok = tid >> 7, ch = tid & 127;
#pragma unroll
        for (int ten = 0; ten < 3; ++ten)
#pragma unroll
            for (int jj = 0; jj < 4; ++jj) cwv[ten][jj] = F.in[I_GCW][(size_t)(l * 4 + jj) * 1536 + ten * 512 + h * HD + ch];
#pragma unroll
        for (int t = 0; t < 4; ++t) { gA[t] = AB[(size_t)(m0 + t) * 8 + h]; gB[t] = AB[(size_t)(m0 + t) * 8 + 4 + h]; }
        zv = bf2f(P[(size_t)(m0 + tok) * NPJ + PZ + h * HD + ch]); gnw = F.in[I_GNW][l * HD + ch];
    }
    {
        float rv[6];
#pragma unroll
        for (int k6 = 0; k6 < 6; ++k6) { const int idx = tid + k6 * NTHR; const int r = idx / 384, cc = idx % 384, ten = cc >> 7, ch = cc & 127;
            float v = 0.f;
            if (idx < 7 * 384) { if (r < 3) v = F.in[I_GC][(size_t)((l * 128 + b) * 3 + r) * 1536 + ten * 512 + h * HD + ch]; else v = bf2f(P[(size_t)(m0 + r - 3) * NPJ + PQ + ten * 512 + h * HD + ch]); }
            rv[k6] = v; }
#pragma unroll
        for (int k6 = 0; k6 < 6; ++k6) { const int idx = tid + k6 * NTHR; if (idx < 7 * 384) RAW[idx] = rv[k6]; }
    }
    __syncthreads();
    if (tid < 384) { const int ten = tid >> 7, ch = tid & 127;
#pragma unroll
        for (int j = 0; j < 3; ++j) F.out[O_SGC + (size_t)((l * 128 + b) * 3 + j) * 1536 + ten * 512 + h * HD + ch] = RAW[(4 + j) * 384 + tid]; }
    float cq, ck, cv;
    {
        const int tok = tid >> 7, ch = tid & 127; float r3[3];
#pragma unroll
        for (int ten = 0; ten < 3; ++ten) { float a = 0.f;
#pragma unroll
            for (int j = 0; j < 4; ++j) a += cwv[ten][j] * RAW[(tok + j) * 384 + ten * 128 + ch];
            r3[ten] = siluf_(a); }
        cq = r3[0]; ck = r3[1]; cv = r3[2];
        const float sq = wave_sum(cq * cq), sk = wave_sum(ck * ck);
        if (lane == 0) { NRM[wv * 4] = sq; NRM[wv * 4 + 1] = sk; }
    }
    __syncthreads();
    {
        const int tok = tid >> 7, ch = tid & 127;
        const float sq = NRM[(2 * tok) * 4] + NRM[(2 * tok + 1) * 4], sk = NRM[(2 * tok) * 4 + 1] + NRM[(2 * tok + 1) * 4 + 1];
        QS[tok * 128 + ch] = cq * frsq(sq + EPS) * 0.08838834764831845f; KS[tok * 128 + ch] = ck * frsq(sk + EPS); VS[tok * 128 + ch] = cv;
    }
    __syncthreads();
    float egv[4], bev[4];
    {
        const float al = -__expf(galog);
#pragma unroll
        for (int t = 0; t < 4; ++t) { const float a = gA[t], bb = gB[t]; egv[t] = __expf(al * softplus_fast(a + dtb)); bev[t] = frcp(1.0f + __expf(-bb)); }
    }
#pragma unroll
    for (int t = 0; t < 4; ++t) {
        const float eg = egv[t], be = bev[t];
        float part = 0.f;
#pragma unroll
        for (int ii = 0; ii < 32; ++ii) { S[ii] *= eg; part += S[ii] * KS[t * 128 + 32 * rq + ii]; }
        RED[rq * 128 + j] = part;
        __syncthreads();
        const float vn = be * (VS[t * 128 + j] - (RED[j] + RED[128 + j] + RED[256 + j] + RED[384 + j]));
        __syncthreads();
        part = 0.f;
#pragma unroll
        for (int ii = 0; ii < 32; ++ii) { S[ii] += KS[t * 128 + 32 * rq + ii] * vn; part += S[ii] * QS[t * 128 + 32 * rq + ii]; }
        RED[rq * 128 + j] = part;
        __syncthreads();
        if (rq == 0) OS[t * 128 + j] = RED[j] + RED[128 + j] + RED[256 + j] + RED[384 + j];
        __syncthreads();
    }
    float* So = F.out + O_SGS + (size_t)((l * 128 + b) * 4 + h) * 16384;
#pragma unroll
    for (int ii = 0; ii < 32; ++ii) So[(size_t)(32 * rq + ii) * 128 + j] = S[ii];
    {
        const int tok = tid >> 7, ch = tid & 127; const float o = OS[tok * 128 + ch];
        const float ss = wave_sum(o * o);
        if (lane == 0) NRM[wv * 4 + 2] = ss;
        __syncthreads();
        const float tot = NRM[(2 * tok) * 4 + 2] + NRM[(2 * tok + 1) * 4 + 2];
        MX[(size_t)(m0 + tok) * DM + 512 + h * HD + ch] = (bf16)f2bf(o * (frsq(tot * (1.f / HD) + EPS)) * gnw * siluf_(zv));
    }
    __syncthreads();
}

struct S5Par { float ar, ai; float bbr[16], bbi[16]; };
__device__ __forceinline__ void s5_params(Frame& F, int l, int g, int p, S5Par& q) {
    const float lr = fminf(F.in[I_LRE][(l * 16 + g) * 64 + p], -1e-4f), li = F.in[I_LIM][(l * 16 + g) * 64 + p];
    const float dt = expf(F.in[I_LDT][l * 16 + g]);
    const float mag = __expf(lr * dt), ph = li * dt; q.ar = mag * __cosf(ph); q.ai = mag * __sinf(ph);
    const float den = lr * lr + li * li;
    const float fr = ((q.ar - 1.0f) * lr + q.ai * li) / den, fi = (q.ai * lr - (q.ar - 1.0f) * li) / den;
    const float* br = F.in[I_BRE] + (size_t)((l * 16 + g) * 64 + p) * 16; const float* bi = F.in[I_BIM] + (size_t)((l * 16 + g) * 64 + p) * 16;
#pragma unroll
    for (int h4 = 0; h4 < 4; ++h4) { const f32x4 r = *(const GAS f32x4*)(br + 4 * h4), i = *(const GAS f32x4*)(bi + 4 * h4);
#pragma unroll
        for (int e = 0; e < 4; ++e) { q.bbr[4 * h4 + e] = fr * r[e] - fi * i[e]; q.bbi[4 * h4 + e] = fr * i[e] + fi * r[e]; } }
}
__device__ __forceinline__ void s5_stage_u(Frame& F, LAS float* U, int m0, int nrows) {
    const bf16* P = (const bf16*)(F.ws + WS_P);
    for (int idx = F.tid; idx < nrows * 32; idx += NTHR) { const int r = idx >> 5, ck = idx & 31;
        const v4u w = *(const GAS v4u*)(P + (size_t)(m0 + r) * NPJ + PU + ck * 8);
        *(LAS f32x4*)(U + r * 256 + ck * 8) = (f32x4){bflo(w.x), bfhi(w.x), bflo(w.y), bfhi(w.y)}; *(LAS f32x4*)(U + r * 256 + ck * 8 + 4) = (f32x4){bflo(w.z), bfhi(w.z), bflo(w.w), bfhi(w.w)}; }
}
__device__ __forceinline__ void s5_step(const S5Par& q, const LAS float* urow, float& xr, float& xi) {
    const f32x4 u0 = *(const LAS f32x4*)urow, u1 = *(const LAS f32x4*)(urow + 4), u2 = *(const LAS f32x4*)(urow + 8), u3 = *(const LAS f32x4*)(urow + 12);
    float br = 0.f, bi = 0.f;
#pragma unroll
    for (int e = 0; e < 4; ++e) { br += q.bbr[e] * u0[e]; bi += q.bbi[e] * u0[e]; br += q.bbr[4 + e] * u1[e]; bi += q.bbi[4 + e] * u1[e]; br += q.bbr[8 + e] * u2[e]; bi += q.bbi[8 + e] * u2[e]; br += q.bbr[12 + e] * u3[e]; bi += q.bbi[12 + e] * u3[e]; }
    const float nr = q.ar * xr - q.ai * xi + br, ni = q.ar * xi + q.ai * xr + bi; xr = nr; xi = ni;
}
__device__ __forceinline__ void s5_pass1(Frame& F, int l, int b, int c) {
    LAS float* U = (LAS float*)F.lds;
    int tid = F.tid; asm volatile("" : "+v"(tid)); const int lane = tid & 63, g0 = 2 * (tid >> 6);
    S5Par q0, q1; s5_params(F, l, g0, lane, q0); s5_params(F, l, g0 + 1, lane, q1);
    s5_stage_u(F, U, b * SEQ + c * 64, 64);
    __syncthreads();
    float* E = (float*)(F.ws + WS_S5E);
    float xr0 = 0.f, xi0 = 0.f, xr1 = 0.f, xi1 = 0.f;
#pragma unroll 4
    for (int t = 0; t < 64; ++t) { s5_step(q0, U + t * 256 + 16 * g0, xr0, xi0); s5_step(q1, U + t * 256 + 16 * g0 + 16, xr1, xi1); }
    E[(size_t)((b * 32 + c) * 16 + g0) * 128 + lane] = xr0; E[(size_t)((b * 32 + c) * 16 + g0) * 128 + 64 + lane] = xi0;
    E[(size_t)((b * 32 + c) * 16 + g0 + 1) * 128 + lane] = xr1; E[(size_t)((b * 32 + c) * 16 + g0 + 1) * 128 + 64 + lane] = xi1;
    __syncthreads();
}
constexpr int S5_U = 0, S5_XT = 65536, S5_YG = S5_XT + 8 * 16 * S256;
static_assert(S5_YG + 64 * S512 <= LDSCTL_OFF, "s5 lds");
template <bool SAMPLE>
__device__ __forceinline__ void s5_pass2(Frame& F, int l, int ua, int ub) {
    LAS unsigned char* L = F.lds; LAS float* U = (LAS float*)(L + S5_U); LAS unsigned char* XT = L + S5_XT + (F.tid >> 6) * (16 * S256); LAS unsigned char* YG = L + S5_YG;
    int tid = F.tid; asm volatile("" : "+v"(tid)); const int lane = tid & 63, wv = tid >> 6, fr = lane & 15, fq = lane >> 4;
    constexpr int NSUB = SAMPLE ? 1 : 4;
    const int m0 = SAMPLE ? MP + 4 * ua : ua * SEQ + ub * 64;
    constexpr int NTT = SAMPLE ? 4 : 16;
    S5Par qq[2]; bf16x8 cbb[2][4]; float dskk[2];
#pragma unroll
    for (int gi = 0; gi < 2; ++gi) {
        const int g = 2 * wv + gi; s5_params(F, l, g, lane, qq[gi]);
        bf16x8 (&cb)[4] = cbb[gi];
#pragma unroll
        for (int ks = 0; ks < 4; ++ks) { const float* src = F.in[ks < 2 ? I_CRE : I_CIM] + (size_t)((l * 16 + g) * 16 + fr) * 64 + 32 * (ks & 1) + 8 * fq;
            const f32x4 c0 = *(const GAS f32x4*)src, c1 = *(const GAS f32x4*)(src + 4); const float sg = ks < 2 ? 1.f : -1.f;
            float f[8] = {sg * c0.x, sg * c0.y, sg * c0.z, sg * c0.w, sg * c1.x, sg * c1.y, sg * c1.z, sg * c1.w}; cb[ks] = pack8(f); }
        dskk[gi] = F.in[I_S5D][l * 256 + 16 * g + fr];
    }
    s5_stage_u(F, U, m0, SAMPLE ? 4 : 64);
    __syncthreads();
    const float* E = (const float*)(F.ws + WS_S5E);
#pragma unroll
    for (int gi = 0; gi < 2; ++gi) {
        const int g = 2 * wv + gi; const S5Par& q = qq[gi]; const bf16x8 (&cb)[4] = cbb[gi];
        const float dsk = dskk[gi];
        float xr = 0.f, xi = 0.f;
        if (!SAMPLE) {
            float pr = q.ar, pi = q.ai;
#pragma unroll
            for (int s = 0; s < 6; ++s) { const float nr = pr * pr - pi * pi, ni = 2.f * pr * pi; pr = nr; pi = ni; }
            float er[31], ei[31];
            const float* Eb = E + (size_t)((ua * 32) * 16 + g) * 128 + lane; asm volatile("" : "+v"(Eb));
#pragma unroll
            for (int cc = 0; cc < 31; ++cc) { er[cc] = Eb[cc * 2048]; ei[cc] = Eb[cc * 2048 + 64]; }
#pragma unroll
            for (int cc = 0; cc < 31; ++cc) { const float nr = pr * xr - pi * xi + er[cc], ni = pr * xi + pi * xr + ei[cc]; xr = cc < ub ? nr : xr; xi = cc < ub ? ni : xi; }
        }
        for (int sub = 0; sub < NSUB; ++sub) {
#pragma unroll
            for (int tt = 0; tt < NTT; ++tt) {
                if (SAMPLE && (tt & 3) == 0) { const int bs = ua; xr = F.in[I_S5RE][(size_t)((l * 128 + bs) * 16 + g) * 64 + lane]; xi = F.in[I_S5IM][(size_t)((l * 128 + bs) * 16 + g) * 64 + lane]; }
                s5_step(q, U + (16 * sub + tt) * 256 + 16 * g, xr, xi);
                *(LAS bf16*)(XT + t256(tt, lane)) = (bf16)f2bf(xr); *(LAS bf16*)(XT + t256(tt, 64 + lane)) = (bf16)f2bf(xi);
                if (SAMPLE && (tt & 3) == 3) { const int bs = ua; F.out[O_SS5RE + (size_t)((l * 128 + bs) * 16 + g) * 64 + lane] = xr; F.out[O_SS5IM + (size_t)((l * 128 + bs) * 16 + g) * 64 + lane] = xi; }
            }
            f32x4 acc = (f32x4){0.f, 0.f, 0.f, 0.f};
#pragma unroll
            for (int ks = 0; ks < 4; ++ks) { const bf16x8 af = *(const LAS bf16x8*)(XT + t256(fr, 32 * ks + 8 * fq)); acc = MFMA16(af, cb[ks], acc); }
#pragma unroll
            for (int r = 0; r < 4; ++r) { const int t = 16 * sub + 4 * fq + r; if (SAMPLE && t >= 4) continue; const float y = acc[r] + dsk * U[t * 256 + 16 * g + fr];
                *(LAS bf16*)(YG + t512(t, 16 * g + fr)) = (bf16)f2bf(gelu_tanh(y)); }
            asm volatile("" ::: "memory");
        }
        if (!SAMPLE && ub == 31) { F.out[O_PS5RE + (size_t)((l * 8 + ua) * 16 + g) * 64 + lane] = xr; F.out[O_PS5IM + (size_t)((l * 8 + ua) * 16 + g) * 64 + lane] = xi; }
    }
    __syncthreads();
    {
        const bf16* WG = (const bf16*)(F.ws + WS_WGLU); bf16* MX = (bf16*)(F.ws + WS_X);
#pragma unroll 1
        for (int ni = 0; ni < 2; ++ni) {
            const int nt = 2 * wv + ni; bf16x8 bw[8];
#pragma unroll
            for (int ks = 0; ks < 8; ++ks) bw[ks] = __builtin_bit_cast(bf16x8, *(const GAS v4u*)(WG + (size_t)(16 * nt + fr) * 256 + 32 * ks + 8 * fq));
            const float bg = F.in[I_BGLU][l * 256 + 16 * nt + fr];
#pragma unroll 1
            for (int mi = 0; mi < NSUB; ++mi) {
                f32x4 acc = (f32x4){0.f, 0.f, 0.f, 0.f};
#pragma unroll
                for (int ks = 0; ks < 8; ++ks) { const bf16x8 af = *(const LAS bf16x8*)(YG + t512(16 * mi + fr, 32 * ks + 8 * fq)); acc = MFMA16(af, bw[ks], acc); }
#pragma unroll
                for (int r = 0; r < 4; ++r) { const int t = 16 * mi + 4 * fq + r; if (SAMPLE && t >= 4) continue; const float yg = bf2f(*(const LAS bf16*)(YG + t512(t, 16 * nt + fr)));
                    MX[(size_t)(m0 + t) * DM + 16 * nt + fr] = (bf16)f2bf(yg * sigmoidf_(acc[r] + bg)); }
            }
        }
    }
    __syncthreads();
}

constexpr int LR_RAW = 0, LR_XC = 73728, LR_AGG = 139264;
struct LruW { float wa[32], wx[32], ba, bx, c8, cb, cw[4]; };
__device__ __forceinline__ void lru_weights(Frame& F, int l, int j, LruW& w) {
    const int blk = j >> 5, jj = j & 31;
#pragma unroll
    for (int i = 0; i < 32; ++i) { w.wa[i] = F.in[I_LWA][(size_t)((l * 8 + blk) * 32 + i) * 32 + jj]; w.wx[i] = F.in[I_LWX][(size_t)((l * 8 + blk) * 32 + i) * 32 + jj]; }
    w.ba = F.in[I_LBA][l * 256 + j]; w.bx = F.in[I_LBX][l * 256 + j]; w.c8 = -8.0f * softplusf_(-F.in[I_LLAM][l * 256 + j]); w.cb = F.in[I_LCB][l * 256 + j];
#pragma unroll
    for (int k = 0; k < 4; ++k) w.cw[k] = F.in[I_LCW][(l * 4 + k) * 256 + j];
}
__device__ __forceinline__ void lru_gate(const LruW& w, const LAS float* xrow, float xown, bool reset, float& a, float& bt) {
    float ra = w.ba, rx = w.bx;
#pragma unroll
    for (int i4 = 0; i4 < 8; ++i4) { const f32x4 xv = *(const LAS f32x4*)(xrow + 4 * i4);
#pragma unroll
        for (int e = 0; e < 4; ++e) { ra += w.wa[4 * i4 + e] * xv[e]; rx += w.wx[4 * i4 + e] * xv[e]; } }
    const float r = sigmoidf_(ra), gi = sigmoidf_(rx);
    const float la = w.c8 * r; a = __expf(la);
    const float mult = reset ? 1.0f : __builtin_amdgcn_sqrtf(fmaxf(1.0f - a * a, 0.f));
    bt = mult * gi * xown;
}
template <int PASS>
__device__ __forceinline__ void lru_pass(Frame& F, int l, int b, int c) {
    LAS float* RAW = (LAS float*)(F.lds + LR_RAW); LAS float* XC = (LAS float*)(F.lds + LR_XC); LAS float* AGG = (LAS float*)(F.lds + LR_AGG);
    int tid = F.tid; asm volatile("" : "+v"(tid)); const int j = tid & 255, hh = tid >> 8; const int row0 = b * SEQ + c * 64;
    const bf16* P = (const bf16*)(F.ws + WS_P); bf16* MX = (bf16*)(F.ws + WS_X); float* LA = (float*)(F.ws + WS_LAGG);
    for (int idx = tid; idx < 67 * 32; idx += NTHR) { const int r = idx >> 5, ck = idx & 31, tt = c * 64 - 3 + r;
        v4u w = (v4u){0u, 0u, 0u, 0u}; if (tt >= 0) w = *(const GAS v4u*)(P + (size_t)(b * SEQ + tt) * NPJ + PXL + ck * 8);
        *(LAS f32x4*)(RAW + r * 256 + ck * 8) = (f32x4){bflo(w.x), bfhi(w.x), bflo(w.y), bfhi(w.y)}; *(LAS f32x4*)(RAW + r * 256 + ck * 8 + 4) = (f32x4){bflo(w.z), bfhi(w.z), bflo(w.w), bfhi(w.w)}; }
    __syncthreads();
    LruW w; lru_weights(F, l, j, w);
    for (int ii = 0; ii < 32; ++ii) { const int i = 32 * hh + ii;
        XC[i * 256 + j] = w.cb + w.cw[0] * RAW[i * 256 + j] + w.cw[1] * RAW[(i + 1) * 256 + j] + w.cw[2] * RAW[(i + 2) * 256 + j] + w.cw[3] * RAW[(i + 3) * 256 + j]; }
    __syncthreads();
    float A = 1.f, B = 0.f; float hl[32], ca[32];
#pragma unroll
    for (int ii = 0; ii < 32; ++ii) { const int i = 32 * hh + ii; float a, bt;
        lru_gate(w, XC + i * 256 + (j & ~31), XC[i * 256 + j], (c == 0 && i == 0), a, bt);
        B = a * B + bt; A *= a; if (PASS == 2) { hl[ii] = B; ca[ii] = A; }
        if (ii & 1) __builtin_amdgcn_sched_barrier(0); }
    if (hh == 0) { AGG[j] = A; AGG[256 + j] = B; }
    __syncthreads();
    if (PASS == 1) {
        if (hh == 1) { const float A0 = AGG[j], B0 = AGG[256 + j]; LA[(size_t)((b * 32 + c) * 2) * 256 + j] = A0 * A; LA[(size_t)((b * 32 + c) * 2 + 1) * 256 + j] = A * B0 + B; }
    } else {
        float H = 0.f;
        {
            float la[31], lb[31];
            const float* Lb = LA + (size_t)(b * 32 * 2) * 256 + j; asm volatile("" : "+v"(Lb));
#pragma unroll
            for (int cc = 0; cc < 31; ++cc) { la[cc] = Lb[cc * 512]; lb[cc] = Lb[cc * 512 + 256]; }
#pragma unroll
            for (int cc = 0; cc < 31; ++cc) { const float nh = la[cc] * H + lb[cc]; H = cc < c ? nh : H; }
        }
        if (hh == 1) H = AGG[j] * H + AGG[256 + j];
#pragma unroll
        for (int ii = 0; ii < 32; ++ii) { const int i = 32 * hh + ii; const float hv = hl[ii] + ca[ii] * H;
            const float gt = bf2f(P[(size_t)(row0 + i) * NPJ + PGL + j]);
            MX[(size_t)(row0 + i) * DM + 256 + j] = (bf16)f2bf(hv * gelu_tanh(gt));
            if (c == 31 && hh == 1 && ii == 31) F.out[O_PLRUH + (size_t)(l * 8 + b) * 256 + j] = hv; }
        if (c == 31 && hh == 0) {
#pragma unroll
            for (int k = 0; k < 3; ++k) F.out[O_PLRUC + (size_t)((l * 8 + b) * 3 + k) * 256 + j] = RAW[(64 + k) * 256 + j]; }
    }
    __syncthreads();
}
__device__ __forceinline__ void lru_sample(Frame& F, int l, int q) {
    LAS float* XC = (LAS float*)F.lds;
    int tid = F.tid; asm volatile("" : "+v"(tid)); const int j = tid & 255, hh = tid >> 8;
    const bf16* P = (const bf16*)(F.ws + WS_P); bf16* MX = (bf16*)(F.ws + WS_X);
    LruW w; const int bs = q;
    if (hh == 0) {
        lru_weights(F, l, j, w);
        float r[7];
#pragma unroll
        for (int k = 0; k < 3; ++k) r[k] = F.in[I_LRUC][(size_t)((l * 128 + bs) * 3 + k) * 256 + j];
#pragma unroll
        for (int t = 0; t < 4; ++t) r[3 + t] = bf2f(P[(size_t)(MP + bs * 4 + t) * NPJ + PXL + j]);
#pragma unroll
        for (int t = 0; t < 4; ++t) XC[t * 256 + j] = w.cb + w.cw[0] * r[t] + w.cw[1] * r[t + 1] + w.cw[2] * r[t + 2] + w.cw[3] * r[t + 3];
#pragma unroll
        for (int k = 0; k < 3; ++k) F.out[O_SLRUC + (size_t)((l * 128 + bs) * 3 + k) * 256 + j] = r[4 + k];
    }
    float H = 0.f, gtv[4] = {0.f, 0.f, 0.f, 0.f};
    if (hh == 0) {
        H = F.in[I_LRUH][(size_t)(l * 128 + bs) * 256 + j];
#pragma unroll
        for (int t = 0; t < 4; ++t) gtv[t] = bf2f(P[(size_t)(MP + bs * 4 + t) * NPJ + PGL + j]);
    }
    __syncthreads();
    if (hh == 0) {
#pragma unroll
        for (int t = 0; t < 4; ++t) { float a, bt;
            lru_gate(w, XC + t * 256 + (j & ~31), XC[t * 256 + j], false, a, bt); H = a * H + bt;
            const float gt = gtv[t];
            MX[(size_t)(MP + bs * 4 + t) * DM + 256 + j] = (bf16)f2bf(H * gelu_tanh(gt)); }
        F.out[O_SLRUH + (size_t)(l * 128 + bs) * 256 + j] = H;
    }
    __syncthreads();
}

constexpr int S5M_U = 0, S5M_XT = 64 * S512, S5M_YG = S5M_XT + 8 * 16 * S256;
static_assert(S5M_YG + 64 * S512 <= LDSCTL_OFF, "s5m lds");
__device__ __forceinline__ void cmul_acc(float ar, float ai, float br, float bi, float& cr, float& ci) { cr += ar * br - ai * bi; ci += ar * bi + ai * br; }
template <int MODE>
__device__ __forceinline__ void s5m_unit(Frame& F, int l, int ua, int ub) {
    LAS unsigned char* L = F.lds;
    int tid = F.tid; asm volatile("" : "+v"(tid)); const int lane = tid & 63, wv = tid >> 6, fr = lane & 15, fq = lane >> 4;
    LAS unsigned char* U16 = L + S5M_U; LAS unsigned char* XT = L + S5M_XT + wv * (16 * S256); LAS float* SCR = (LAS float*)XT; LAS unsigned char* YG = L + S5M_YG;
    constexpr bool SAMPLE = MODE == 3; constexpr int NSUB = SAMPLE ? 1 : 4;
    const int m0 = SAMPLE ? MP + 4 * ua : ua * SEQ + ub * 64;
    { const bf16* P = (const bf16*)(F.ws + WS_P); constexpr int nrows = SAMPLE ? 4 : 64; constexpr int NK = (nrows * 32 + NTHR - 1) / NTHR;
      v4u su[NK];
#pragma unroll
      for (int k = 0; k < NK; ++k) { const int idx = tid + k * NTHR; const int r = idx >> 5, ck = idx & 31; if (idx < nrows * 32) su[k] = *(const GAS v4u*)(P + (size_t)(m0 + r) * NPJ + PU + ck * 8); }
#pragma unroll
      for (int k = 0; k < NK; ++k) { const int idx = tid + k * NTHR; const int r = idx >> 5, ck = idx & 31; if (idx < nrows * 32) *(LAS v4u*)(U16 + r * S512 + ck * 16) = su[k]; } }
    __syncthreads();
    float* Eo = (float*)(F.ws + WS_S5E);
#pragma unroll 1
    for (int gi = 0; gi < 2; ++gi) {
        const int g = 2 * wv + gi;
        S5Par q; s5_params(F, l, g, lane, q);
        bf16x8 bfrag[8];
#pragma unroll
        for (int part = 0; part < 2; ++part) {
#pragma unroll
            for (int h4 = 0; h4 < 4; ++h4) *(LAS f32x4*)(SCR + lane * 16 + 4 * h4) = part == 0 ? (f32x4){q.bbr[4 * h4], q.bbr[4 * h4 + 1], q.bbr[4 * h4 + 2], q.bbr[4 * h4 + 3]} : (f32x4){q.bbi[4 * h4], q.bbi[4 * h4 + 1], q.bbi[4 * h4 + 2], q.bbi[4 * h4 + 3]};
#pragma unroll
            for (int nt = 0; nt < 4; ++nt) { const LAS float* src = SCR + (16 * nt + fr) * 16 + 8 * (fq & 1);
                const f32x4 v0 = *(const LAS f32x4*)src, v1 = *(const LAS f32x4*)(src + 4); float f[8] = {v0.x, v0.y, v0.z, v0.w, v1.x, v1.y, v1.z, v1.w};
                if (fq >= 2) {
#pragma unroll
                    for (int e = 0; e < 8; ++e) f[e] = f[e] - bf2f(f2bf(f[e]));
                }
                bfrag[4 * part + nt] = pack8(f); }
        }
        float l1r[4], l1i[4], xinr[4], xini[4];
        *(LAS f32x2_t*)(SCR + lane * 2) = (f32x2_t){q.ar, q.ai};
        if (MODE == 2) {
            float pr = q.ar, pi = q.ai;
#pragma unroll
            for (int s = 0; s < 6; ++s) { const float nr = pr * pr - pi * pi, ni = 2.f * pr * pi; pr = nr; pi = ni; }
            float er[31], ei[31];
            const float* Eb = Eo + (size_t)((ua * 32) * 16 + g) * 128 + lane; asm volatile("" : "+v"(Eb));
#pragma unroll
            for (int cc = 0; cc < 31; ++cc) { er[cc] = Eb[cc * 2048]; ei[cc] = Eb[cc * 2048 + 64]; }
            float xr = 0.f, xi = 0.f;
#pragma unroll
            for (int cc = 0; cc < 31; ++cc) { const float nr = pr * xr - pi * xi + er[cc], ni = pr * xi + pi * xr + ei[cc]; xr = cc < ub ? nr : xr; xi = cc < ub ? ni : xi; }
            *(LAS f32x2_t*)(SCR + 128 + lane * 2) = (f32x2_t){xr, xi};
        }
#pragma unroll
        for (int s = 0; s < 4; ++s) { const f32x2_t lv = *(const LAS f32x2_t*)(SCR + (16 * s + fr) * 2); l1r[s] = lv.x; l1i[s] = lv.y;
            if (MODE == 2) { const f32x2_t xv = *(const LAS f32x2_t*)(SCR + 128 + (16 * s + fr) * 2); xinr[s] = xv.x; xini[s] = xv.y; }
            else if (MODE == 3) { xinr[s] = F.in[I_S5RE][(size_t)((l * 128 + ua) * 16 + g) * 64 + 16 * s + fr]; xini[s] = F.in[I_S5IM][(size_t)((l * 128 + ua) * 16 + g) * 64 + 16 * s + fr]; }
            else { xinr[s] = 0.f; xini[s] = 0.f; } }
        float l2r[4], l2i[4], l3r[4], l3i[4], l4r[4], l4i[4], l8r[4], l8i[4], lpr[4], lpi[4];
#pragma unroll
        for (int s = 0; s < 4; ++s) {
            l2r[s] = l1r[s] * l1r[s] - l1i[s] * l1i[s]; l2i[s] = 2.f * l1r[s] * l1i[s];
            l3r[s] = l2r[s] * l1r[s] - l2i[s] * l1i[s]; l3i[s] = l2r[s] * l1i[s] + l2i[s] * l1r[s];
            l4r[s] = l2r[s] * l2r[s] - l2i[s] * l2i[s]; l4i[s] = 2.f * l2r[s] * l2i[s];
            l8r[s] = l4r[s] * l4r[s] - l4i[s] * l4i[s]; l8i[s] = 2.f * l4r[s] * l4i[s];
            const float l12r = l8r[s] * l4r[s] - l8i[s] * l4i[s], l12i = l8r[s] * l4i[s] + l8i[s] * l4r[s];
            lpr[s] = fq == 0 ? 1.f : fq == 1 ? l4r[s] : fq == 2 ? l8r[s] : l12r; lpi[s] = fq == 0 ? 0.f : fq == 1 ? l4i[s] : fq == 2 ? l8i[s] : l12i;
        }
        bf16x8 cb[4]; float dsk = 0.f;
        if (MODE != 1) {
#pragma unroll
            for (int ks = 0; ks < 4; ++ks) { const float* src = F.in[ks < 2 ? I_CRE : I_CIM] + (size_t)((l * 16 + g) * 16 + fr) * 64 + 32 * (ks & 1) + 8 * fq;
                const f32x4 c0 = *(const GAS f32x4*)src, c1 = *(const GAS f32x4*)(src + 4); const float sg = ks < 2 ? 1.f : -1.f;
                float f[8] = {sg * c0.x, sg * c0.y, sg * c0.z, sg * c0.w, sg * c1.x, sg * c1.y, sg * c1.z, sg * c1.w}; cb[ks] = pack8(f); }
            dsk = F.in[I_S5D][l * 256 + 16 * g + fr];
        }
#pragma unroll 1
        for (int sub = 0; sub < NSUB; ++sub) {
            const bf16x8 au = *(const LAS bf16x8*)(U16 + (16 * sub + fr) * S512 + (16 * g + 8 * (fq & 1)) * 2);
            f32x4 d[8];
#pragma unroll
            for (int nt = 0; nt < 8; ++nt) d[nt] = MFMA16(au, bfrag[nt], ((f32x4){0.f, 0.f, 0.f, 0.f}));
            float Lr[4][4], Li[4][4], Er[4], Ei[4];
#pragma unroll
            for (int s = 0; s < 4; ++s) {
                Lr[s][0] = d[s][0]; Li[s][0] = d[4 + s][0];
#pragma unroll
                for (int r = 1; r < 4; ++r) { Lr[s][r] = d[s][r]; Li[s][r] = d[4 + s][r]; cmul_acc(l1r[s], l1i[s], Lr[s][r - 1], Li[s][r - 1], Lr[s][r], Li[s][r]); }
                Er[s] = Lr[s][3]; Ei[s] = Li[s][3];
            }
            {
                float pr_[4], pi_[4];
#pragma unroll
                for (int s = 0; s < 4; ++s) { pr_[s] = __shfl_up(Er[s], 16); pi_[s] = __shfl_up(Ei[s], 16); }
#pragma unroll
                for (int s = 0; s < 4; ++s) { float ar_ = 0.f, ai_ = 0.f; cmul_acc(l4r[s], l4i[s], pr_[s], pi_[s], ar_, ai_); if (fq >= 1) { Er[s] += ar_; Ei[s] += ai_; } }
#pragma unroll
                for (int s = 0; s < 4; ++s) { pr_[s] = __shfl_up(Er[s], 32); pi_[s] = __shfl_up(Ei[s], 32); }
#pragma unroll
                for (int s = 0; s < 4; ++s) { float ar_ = 0.f, ai_ = 0.f; cmul_acc(l8r[s], l8i[s], pr_[s], pi_[s], ar_, ai_); if (fq >= 2) { Er[s] += ar_; Ei[s] += ai_; } }
#pragma unroll
                for (int s = 0; s < 4; ++s) { pr_[s] = __shfl_up(Er[s], 16); pi_[s] = __shfl_up(Ei[s], 16); }
#pragma unroll
                for (int s = 0; s < 4; ++s) { float xr = fq >= 1 ? pr_[s] : 0.f, xi = fq >= 1 ? pi_[s] : 0.f; cmul_acc(lpr[s], lpi[s], xinr[s], xini[s], xr, xi); Er[s] = xr; Ei[s] = xi; }
            }
#pragma unroll
            for (int s = 0; s < 4; ++s) {
                cmul_acc(l1r[s], l1i[s], Er[s], Ei[s], Lr[s][0], Li[s][0]); cmul_acc(l2r[s], l2i[s], Er[s], Ei[s], Lr[s][1], Li[s][1]);
                cmul_acc(l3r[s], l3i[s], Er[s], Ei[s], Lr[s][2], Li[s][2]); cmul_acc(l4r[s], l4i[s], Er[s], Ei[s], Lr[s][3], Li[s][3]);
            }
#pragma unroll
            for (int s = 0; s < 4; ++s) { xinr[s] = __shfl(Lr[s][3], fr + (SAMPLE ? 0 : 48)); xini[s] = __shfl(Li[s][3], fr + (SAMPLE ? 0 : 48)); }
            if (MODE != 1) {
#pragma unroll
                for (int s = 0; s < 4; ++s)
#pragma unroll
                    for (int r = 0; r < 4; ++r) { *(LAS bf16*)(XT + t256(4 * fq + r, 16 * s + fr)) = (bf16)f2bf(Lr[s][r]); *(LAS bf16*)(XT + t256(4 * fq + r, 64 + 16 * s + fr)) = (bf16)f2bf(Li[s][r]); }
                f32x4 acc = (f32x4){0.f, 0.f, 0.f, 0.f};
#pragma unroll
                for (int ks = 0; ks < 4; ++ks) { const bf16x8 af = *(const LAS bf16x8*)(XT + t256(fr, 32 * ks + 8 * fq)); acc = MFMA16(af, cb[ks], acc); }
#pragma unroll
                for (int r = 0; r < 4; ++r) { const int t = 16 * sub + 4 * fq + r; if (SAMPLE && t >= 4) continue;
                    const float y = acc[r] + dsk * bf2f(*(const LAS bf16*)(U16 + t * S512 + (16 * g + fr) * 2));
                    *(LAS bf16*)(YG + t512(t, 16 * g + fr)) = (bf16)f2bf(gelu_tanh(y)); }
                asm volatile("" ::: "memory");
            }
        }
        if (fq == 0) {
#pragma unroll
            for (int s = 0; s < 4; ++s) { const int p = 16 * s + fr;
                if (MODE == 1) { Eo[(size_t)((ua * 32 + ub) * 16 + g) * 128 + p] = xinr[s]; Eo[(size_t)((ua * 32 + ub) * 16 + g) * 128 + 64 + p] = xini[s]; }
                if (MODE == 2 && ub == 31) { F.out[O_PS5RE + (size_t)((l * 8 + ua) * 16 + g) * 64 + p] = xinr[s]; F.out[O_PS5IM + (size_t)((l * 8 + ua) * 16 + g) * 64 + p] = xini[s]; }
                if (MODE == 3) { F.out[O_SS5RE + (size_t)((l * 128 + ua) * 16 + g) * 64 + p] = xinr[s]; F.out[O_SS5IM + (size_t)((l * 128 + ua) * 16 + g) * 64 + p] = xini[s]; } }
        }
    }
    bf16x8 bwA[8], bwB[8]; float bgA = 0.f, bgB = 0.f;
    if (MODE != 1) {
        const bf16* WG = (const bf16*)(F.ws + WS_WGLU);
#pragma unroll
        for (int ks = 0; ks < 8; ++ks) { bwA[ks] = __builtin_bit_cast(bf16x8, *(const GAS v4u*)(WG + (size_t)(16 * (2 * wv) + fr) * 256 + 32 * ks + 8 * fq)); bwB[ks] = __builtin_bit_cast(bf16x8, *(const GAS v4u*)(WG + (size_t)(16 * (2 * wv + 1) + fr) * 256 + 32 * ks + 8 * fq)); }
        bgA = F.in[I_BGLU][l * 256 + 16 * (2 * wv) + fr]; bgB = F.in[I_BGLU][l * 256 + 16 * (2 * wv + 1) + fr];
    }
    __syncthreads();
    if (MODE != 1) {
        bf16* MX = (bf16*)(F.ws + WS_X);
        auto glu_block = [&](const bf16x8 (&bw)[8], const float bg, const int nt) {
#pragma unroll 1
            for (int mi = 0; mi < NSUB; ++mi) {
                f32x4 acc = (f32x4){0.f, 0.f, 0.f, 0.f};
#pragma unroll
                for (int ks = 0; ks < 8; ++ks) { const bf16x8 af = *(const LAS bf16x8*)(YG + t512(16 * mi + fr, 32 * ks + 8 * fq)); acc = MFMA16(af, bw[ks], acc); }
#pragma unroll
                for (int r = 0; r < 4; ++r) { const int t = 16 * mi + 4 * fq + r; if (SAMPLE && t >= 4) continue; const float yg = bf2f(*(const LAS bf16*)(YG + t512(t, 16 * nt + fr)));
                    MX[(size_t)(m0 + t) * DM + 16 * nt + fr] = (bf16)f2bf(yg * sigmoidf_(acc[r] + bg)); }
            }
        };
        glu_block(bwA, bgA, 2 * wv); glu_block(bwB, bgB, 2 * wv + 1);
        __syncthreads();
    }
}


constexpr int LM_RAW = 0, LM_XCB = 69632, LM_GT = LM_XCB + 64 * S512;
static_assert(LM_GT + 64 * S512 <= LDSCTL_OFF && 67 * 1024 <= LM_XCB, "lru mfma lds");
template <int PASS>
__device__ __forceinline__ void lrum_pass(Frame& F, int l, int b, int c) {
    LAS float* RAW = (LAS float*)(F.lds + LM_RAW); LAS unsigned char* XCB = F.lds + LM_XCB;
    int tid = F.tid; asm volatile("" : "+v"(tid)); const int lane = tid & 63, wv = tid >> 6, fr = lane & 15, fq = lane >> 4;
    const int row0 = b * SEQ + c * 64;
    const bf16* P = (const bf16*)(F.ws + WS_P); bf16* MX = (bf16*)(F.ws + WS_X); float* LA = (float*)(F.ws + WS_LAGG);
    {
        v4u sw[5], sg[4];
#pragma unroll
        for (int k5 = 0; k5 < 5; ++k5) { const int idx = tid + k5 * NTHR; const int r = idx >> 5, ck = idx & 31, tt = c * 64 - 3 + r;
            sw[k5] = (v4u){0u, 0u, 0u, 0u}; if (idx < 67 * 32 && tt >= 0) sw[k5] = *(const GAS v4u*)(P + (size_t)(b * SEQ + tt) * NPJ + PXL + ck * 8); }
        if (PASS == 2) {
#pragma unroll
            for (int k4 = 0; k4 < 4; ++k4) { const int idx = tid + k4 * NTHR; const int r = idx >> 5, ck = idx & 31; sg[k4] = *(const GAS v4u*)(P + (size_t)(row0 + r) * NPJ + PGL + ck * 8); }
        }
#pragma unroll
        for (int k5 = 0; k5 < 5; ++k5) { const int idx = tid + k5 * NTHR; const int r = idx >> 5, ck = idx & 31; const v4u w = sw[k5];
            if (idx < 67 * 32) { *(LAS f32x4*)(RAW + r * 256 + ck * 8) = (f32x4){bflo(w.x), bfhi(w.x), bflo(w.y), bfhi(w.y)}; *(LAS f32x4*)(RAW + r * 256 + ck * 8 + 4) = (f32x4){bflo(w.z), bfhi(w.z), bflo(w.w), bfhi(w.w)}; } }
        if (PASS == 2) {
#pragma unroll
            for (int k4 = 0; k4 < 4; ++k4) { const int idx = tid + k4 * NTHR; const int r = idx >> 5, ck = idx & 31; *(LAS v4u*)(F.lds + LM_GT + r * S512 + ck * 16) = sg[k4]; }
        }
    }
    bf16x8 wah[2], wal[2], wxh[2], wxl[2]; float ba[2], bx[2], c8[2];
#pragma unroll
    for (int nt = 0; nt < 2; ++nt) {
        const int jc = 16 * nt + fr; float fa[8], fx[8], ga[8], gx[8];
#pragma unroll
        for (int e = 0; e < 8; ++e) { fa[e] = F.in[I_LWA][(size_t)((l * 8 + wv) * 32 + 8 * fq + e) * 32 + jc]; fx[e] = F.in[I_LWX][(size_t)((l * 8 + wv) * 32 + 8 * fq + e) * 32 + jc]; }
        wah[nt] = pack8(fa); wxh[nt] = pack8(fx);
#pragma unroll
        for (int e = 0; e < 8; ++e) { ga[e] = fa[e] - bf2f(f2bf(fa[e])); gx[e] = fx[e] - bf2f(f2bf(fx[e])); }
        wal[nt] = pack8(ga); wxl[nt] = pack8(gx);
        const int j = 32 * wv + jc; ba[nt] = F.in[I_LBA][l * 256 + j]; bx[nt] = F.in[I_LBX][l * 256 + j]; c8[nt] = -8.0f * softplusf_(-F.in[I_LLAM][l * 256 + j]);
    }
    float Hin[2] = {0.f, 0.f};
    if (PASS == 2) {
        const int js = 32 * wv + 16 * (fq & 1) + fr; float H = 0.f;
        float la[31], lb[31];
        const float* Lb = LA + (size_t)(b * 32 * 2) * 256 + js; asm volatile("" : "+v"(Lb));
#pragma unroll
        for (int cc = 0; cc < 31; ++cc) { la[cc] = Lb[cc * 512]; lb[cc] = Lb[cc * 512 + 256]; }
#pragma unroll
        for (int cc = 0; cc < 31; ++cc) { const float nh = la[cc] * H + lb[cc]; H = cc < c ? nh : H; }
        Hin[0] = __shfl(H, fr); Hin[1] = __shfl(H, fr + 16);
    }
    float cw[4]; const float cb = F.in[I_LCB][l * 256 + (tid & 255)];
#pragma unroll
    for (int k = 0; k < 4; ++k) cw[k] = F.in[I_LCW][(l * 4 + k) * 256 + (tid & 255)];
    __syncthreads();
    {
        const int j = tid & 255, hh = tid >> 8; float xcv[32];
#pragma unroll
        for (int ii = 0; ii < 32; ++ii) { const int i = 32 * hh + ii; xcv[ii] = cb + cw[0] * RAW[i * 256 + j] + cw[1] * RAW[(i + 1) * 256 + j] + cw[2] * RAW[(i + 2) * 256 + j] + cw[3] * RAW[(i + 3) * 256 + j]; }
        __syncthreads();
#pragma unroll
        for (int ii = 0; ii < 32; ++ii) { const int i = 32 * hh + ii; RAW[i * 256 + j] = xcv[ii]; *(LAS bf16*)(XCB + i * S512 + j * 2) = (bf16)f2bf(xcv[ii]); }
    }
    __syncthreads();
    float At[2] = {1.f, 1.f}, Bt[2] = {0.f, 0.f};
#pragma unroll 1
    for (int sub = 0; sub < 4; ++sub) {
        const bf16x8 au = *(const LAS bf16x8*)(XCB + (16 * sub + fr) * S512 + (32 * wv + 8 * fq) * 2);
        unsigned short gt[2][4];
        if (PASS == 2) {
#pragma unroll
            for (int nt = 0; nt < 2; ++nt)
#pragma unroll
                for (int r = 0; r < 4; ++r) gt[nt][r] = *(const LAS unsigned short*)(F.lds + LM_GT + (16 * sub + 4 * fq + r) * S512 + (32 * wv + 16 * nt + fr) * 2);
        }
#pragma unroll
        for (int nt = 0; nt < 2; ++nt) {
            const f32x4 z = (f32x4){0.f, 0.f, 0.f, 0.f};
            f32x4 da = MFMA16(au, wah[nt], z); da = MFMA16(au, wal[nt], da);
            f32x4 dx = MFMA16(au, wxh[nt], z); dx = MFMA16(au, wxl[nt], dx);
            const int j = 32 * wv + 16 * nt + fr;
            float hl[4], ca[4]; float A = 1.f, B = 0.f;
#pragma unroll
            for (int r = 0; r < 4; ++r) { const int t = 16 * sub + 4 * fq + r;
                const float rr = sigmoidf_(da[r] + ba[nt]), gi = sigmoidf_(dx[r] + bx[nt]); const float a = __expf(c8[nt] * rr);
                const float mult = (c == 0 && t == 0) ? 1.0f : __builtin_amdgcn_sqrtf(fmaxf(1.0f - a * a, 0.f));
                const float bt = mult * gi * RAW[t * 256 + j];
                B = a * B + bt; A *= a; hl[r] = B; ca[r] = A; }
            float Ap = __shfl_up(A, 16), Bp = __shfl_up(B, 16); if (fq >= 1) { B = A * Bp + B; A = A * Ap; }
            Ap = __shfl_up(A, 32); Bp = __shfl_up(B, 32); if (fq >= 2) { B = A * Bp + B; A = A * Ap; }
            float Ae = __shfl_up(A, 16), Be = __shfl_up(B, 16); if (fq == 0) { Ae = 1.f; Be = 0.f; }
            const float As = __shfl(A, fr + 48), Bs = __shfl(B, fr + 48);
            if (PASS == 1) { Bt[nt] = As * Bt[nt] + Bs; At[nt] *= As; }
            else {
                const float Hs = Ae * Hin[nt] + Be;
#pragma unroll
                for (int r = 0; r < 4; ++r) { const float hv = hl[r] + ca[r] * Hs;
                    MX[(size_t)(row0 + 16 * sub + 4 * fq + r) * DM + 256 + j] = (bf16)f2bf(hv * gelu_tanh(bf2f(gt[nt][r]))); }
                Hin[nt] = As * Hin[nt] + Bs;
            }
        }
    }
    if (fq == 0) {
#pragma unroll
        for (int nt = 0; nt < 2; ++nt) { const int j = 32 * wv + 16 * nt + fr;
            if (PASS == 1) { LA[(size_t)((b * 32 + c) * 2) * 256 + j] = At[nt]; LA[(size_t)((b * 32 + c) * 2 + 1) * 256 + j] = Bt[nt]; }
            else if (c == 31) F.out[O_PLRUH + (size_t)(l * 8 + b) * 256 + j] = Hin[nt]; }
    }
    if (PASS == 2 && c == 31 && tid < 256) {
#pragma unroll
        for (int k = 0; k < 3; ++k) F.out[O_PLRUC + (size_t)((l * 8 + b) * 3 + k) * 256 + tid] = RAW[(64 + k) * 256 + tid]; }
    __syncthreads();
}
#ifndef MK_N_LAUNCHES
#define MK_N_LAUNCHES 1
#endif
constexpr int N_PHASES = 19;
struct Args { const float* in[37]; float* out; unsigned char* ws; int ph_lo, ph_hi; };
#if MK_N_LAUNCHES == 1
#define GRID_BAR() xcd_barrier(bar)
#else
#define GRID_BAR() do { } while (0)
#endif
#ifndef DUPM
#define DUPM 0
#endif
#define REP(bit) for (int rep_ = 0; rep_ < (((DUPM) >> (bit)) & 1 ? 2 : 1); ++rep_)
#ifndef PH_MASK
#define PH_MASK 0x3ff
#endif
#define IN(k) (lo <= (k) && (k) < hi)
#define INL(i) (((PH_MASK >> ((i) + 1)) & 1) && IN(pb + (i)))
#define OPQ() asm volatile("" : "+s"(F.wg), "+s"(F.G), "+s"(F.ws), "+s"(F.out), "+s"(l), "+s"(F.lds))
#ifndef BAR_TWICE
#define BAR_TWICE 0
#endif
#define SEAM(k) do { if (IN(k) && IN((k) + 1)) { GRID_BAR(); if (BAR_TWICE) GRID_BAR(); } } while (0)
#define X ((bf16*)(F.ws + WS_X))
#define P ((bf16*)(F.ws + WS_P))
#define BIG ((bf16*)(F.ws + WS_BIG))
#define AB ((float*)(F.ws + WS_AB))
#define Y (F.out + O_YP)
#define X1B ((float*)(F.ws + WS_BIG + 34 * MiB))
#define RSA ((float*)(F.ws + WS_CTL + 512 * 1024))
#define RSB ((float*)(F.ws + WS_CTL + 768 * 1024))
#define X2B Y
template <int LAYER>
__device__ __forceinline__ void layer_phases(Frame& F, const XcdBarrier& bar, const int lo, const int hi) {
    int l = LAYER;
#if defined(SEGREP) || defined(SEGPRE)
    int seg_n = 0;
#endif
        const int pb = 1 + 9 * l;
#if (defined(SEGREP) || defined(SEGPRE)) && SEG_LO == 0
        seg_start: asm volatile("" : "+v"(F.tid), "+v"(F.lane)); F.wave = __builtin_amdgcn_readfirstlane(F.tid >> 6);
#endif
        if (INL(0)) REP(1) { OPQ();
            pg8::Gemm g{(const bf16*)X2B, (const bf16*)(F.ws + WS_WIN), MT, NPJ, DM}; pg8::StaticOrder S; S.init(MT, NPJ, F.G, F.wg);
            pg8::EpiBf16Rs E{P, NPJ, RSA};
            pg8::gemm_phase<pg8::EpiBf16Rs, pg8::StaticOrder, true, true>(F.lds, g, S, E);
            if (LAYER == 0) convert_items<2 | 8>(F, l, ((MT / 256) * (NPJ / 256)) % F.G); else convert_items<8>(F, l, ((MT / 256) * (NPJ / 256)) % F.G);
        }
#if defined(SEGPRE) && SEG_HI == 0
        if (((SEGPRE >> LAYER) & 1) && seg_n < hi - (N_PHASES - 1)) { ++seg_n; if (SEGPRE_MODE == 1) xcd_barrier<true>(bar); else if (SEGPRE_MODE == 2) xcd_barrier<false>(bar); goto seg_start; }
#endif
        SEAM(pb + 0);
#if defined(SEGREP) && SEG_HI == 0
        if (((SEGREP >> LAYER) & 1) && seg_n < hi - (N_PHASES - 1)) { ++seg_n; if (0 == 8 && LAYER == 1) GRID_BAR(); goto seg_start; }
#endif
#if (defined(SEGREP) || defined(SEGPRE)) && SEG_LO == 1
        seg_start: asm volatile("" : "+v"(F.tid), "+v"(F.lane)); F.wave = __builtin_amdgcn_readfirstlane(F.tid >> 6);
#endif
        if (INL(1)) { OPQ();
            {
                int cw_head = -1; v4u pre[7]; float abn[2]; bool have = false; float SS[32];
                int ts = F.wg; const int NT = NB_S * GDH;
                if (ts < NT) gdn_sample_load(F, l, ts, SS);
                int k = 0;
                const int nun = NB_P * GDH * NCH / F.G;
                auto unit_of = [&](int kk) { return ((F.wg & 7) * GDH + (F.wg >> 6)) * NCH + ((F.wg >> 3) & 7) * 4 + kk; };
                for (; k < nun; ++k) { const int u = unit_of(k);
                    gdn_prep<0>(F, l, u, cw_head, pre, abn, have, k + 1 < nun ? unit_of(k + 1) : -1); have = true;
                    if ((k & 1) == 1 && ts < NT) { gdn_sample(F, l, ts, SS); ts += F.G; if (ts < NT) gdn_sample_load(F, l, ts, SS); }
                }
                while (ts < NT) { gdn_sample(F, l, ts, SS); ts += F.G; if (ts < NT) gdn_sample_load(F, l, ts, SS); }
            }
#ifdef GPC
            { int cw_head = -1; v4u pre[7]; float abn[2]; for (int u = F.wg; u < NB_P * GDH * NCH; u += F.G) { gdn_prep<GPC>(F, l, u, cw_head, pre, abn, false, -1); } __syncthreads(); }
#endif
            for (int u = F.wg; u < NB_P * 31; u += F.G) { REP(3) s5m_unit<1>(F, l, u / 31, u % 31); REP(4) lrum_pass<1>(F, l, u / 31, u % 31); }
            for (int q = F.wg; q < 2 * NB_S; q += F.G) REP(6) { if (q < NB_S) s5m_unit<3>(F, l, q, 0); else lru_sample(F, l, q - NB_S); }
        }
#if defined(SEGPRE) && SEG_HI == 1
        if (((SEGPRE >> LAYER) & 1) && seg_n < hi - (N_PHASES - 1)) { ++seg_n; if (SEGPRE_MODE == 1) xcd_barrier<true>(bar); else if (SEGPRE_MODE == 2) xcd_barrier<false>(bar); goto seg_start; }
#endif
        SEAM(pb + 1);
#if defined(SEGREP) && SEG_HI == 1
        if (((SEGREP >> LAYER) & 1) && seg_n < hi - (N_PHASES - 1)) { ++seg_n; if (1 == 8 && LAYER == 1) GRID_BAR(); goto seg_start; }
#endif
#if (defined(SEGREP) || defined(SEGPRE)) && SEG_LO == 2
        seg_start: asm volatile("" : "+v"(F.tid), "+v"(F.lane)); F.wave = __builtin_amdgcn_readfirstlane(F.tid >> 6);
#endif
        if (INL(2)) { OPQ();
            for (int t = F.wg; t < 256; t += F.G) gdn_chain<false>(F, l, t);
            for (int u = F.wg; u < NB_P * NCH; u += F.G) { REP(7) s5m_unit<2>(F, l, u >> 5, u & 31); REP(8) lrum_pass<2>(F, l, u >> 5, u & 31); }
        }
#if defined(SEGPRE) && SEG_HI == 2
        if (((SEGPRE >> LAYER) & 1) && seg_n < hi - (N_PHASES - 1)) { ++seg_n; if (SEGPRE_MODE == 1) xcd_barrier<true>(bar); else if (SEGPRE_MODE == 2) xcd_barrier<false>(bar); goto seg_start; }
#endif
        SEAM(pb + 2);
#if defined(SEGREP) && SEG_HI == 2
        if (((SEGREP >> LAYER) & 1) && seg_n < hi - (N_PHASES - 1)) { ++seg_n; if (2 == 8 && LAYER == 1) GRID_BAR(); goto seg_start; }
#endif
#if (defined(SEGREP) || defined(SEGPRE)) && SEG_LO == 3
        seg_start: asm volatile("" : "+v"(F.tid), "+v"(F.lane)); F.wave = __builtin_amdgcn_readfirstlane(F.tid >> 6);
#endif
        if (!HEADNORM_IN_GEMM && INL(3)) { OPQ();
            gdn_finalize(F, l);
        }
#if defined(SEGPRE) && SEG_HI == 3
        if (((SEGPRE >> LAYER) & 1) && seg_n < hi - (N_PHASES - 1)) { ++seg_n; if (SEGPRE_MODE == 1) xcd_barrier<true>(bar); else if (SEGPRE_MODE == 2) xcd_barrier<false>(bar); goto seg_start; }
#endif
#if !HEADNORM_IN_GEMM
        SEAM(pb + 3);
#endif
#if defined(SEGREP) && SEG_HI == 3
        if (((SEGREP >> LAYER) & 1) && seg_n < hi - (N_PHASES - 1)) { ++seg_n; if (3 == 8 && LAYER == 1) GRID_BAR(); goto seg_start; }
#endif
#if (defined(SEGREP) || defined(SEGPRE)) && SEG_LO == 4
        seg_start: asm volatile("" : "+v"(F.tid), "+v"(F.lane)); F.wave = __builtin_amdgcn_readfirstlane(F.tid >> 6);
#endif
        if (INL(4)) REP(9) { OPQ();
            pg8::Gemm g{X, (const bf16*)(F.ws + WS_WOUT), MP, DM, DM}; pg8::StaticOrder S; S.init(MP, DM, F.G, F.wg);
#if HEADNORM_IN_GEMM
            pg8::EpiBf16HeadNorm E{BIG, DM, (const float*)(F.ws + WS_SSQ), 1.f / HD, EPS};
            pg8::gemm_phase<pg8::EpiBf16HeadNorm, pg8::StaticOrder, true, true>(F.lds, g, S, E);
#else
            pg8::EpiBf16 E{BIG, DM, nullptr};
            pg8::gemm_phase<pg8::EpiBf16, pg8::StaticOrder, true, true>(F.lds, g, S, E);
#endif
            sample_gemm_lds(F, X, (const bf16*)(F.ws + WS_WOUT), DM, BIG);
        }
#if defined(SEGPRE) && SEG_HI == 4
        if (((SEGPRE >> LAYER) & 1) && seg_n < hi - (N_PHASES - 1)) { ++seg_n; if (SEGPRE_MODE == 1) xcd_barrier<true>(bar); else if (SEGPRE_MODE == 2) xcd_barrier<false>(bar); goto seg_start; }
#endif
        SEAM(pb + 4);
#if defined(SEGREP) && SEG_HI == 4
        if (((SEGREP >> LAYER) & 1) && seg_n < hi - (N_PHASES - 1)) { ++seg_n; if (4 == 8 && LAYER == 1) GRID_BAR(); goto seg_start; }
#endif
#if (defined(SEGREP) || defined(SEGPRE)) && SEG_LO == 5
        seg_start: asm volatile("" : "+v"(F.tid), "+v"(F.lane)); F.wave = __builtin_amdgcn_readfirstlane(F.tid >> 6);
#endif
        if (INL(5)) { OPQ();
            REP(13) row_pass<true, true>(F, X2B, nullptr, BIG, F.in[I_NMPOST] + l * DM, X1B, nullptr, RSB, nullptr, nullptr);
        }
#if defined(SEGPRE) && SEG_HI == 5
        if (((SEGPRE >> LAYER) & 1) && seg_n < hi - (N_PHASES - 1)) { ++seg_n; if (SEGPRE_MODE == 1) xcd_barrier<true>(bar); else if (SEGPRE_MODE == 2) xcd_barrier<false>(bar); goto seg_start; }
#endif
        SEAM(pb + 5);
#if defined(SEGREP) && SEG_HI == 5
        if (((SEGREP >> LAYER) & 1) && seg_n < hi - (N_PHASES - 1)) { ++seg_n; if (5 == 8 && LAYER == 1) GRID_BAR(); goto seg_start; }
#endif
#if (defined(SEGREP) || defined(SEGPRE)) && SEG_LO == 6
        seg_start: asm volatile("" : "+v"(F.tid), "+v"(F.lane)); F.wave = __builtin_amdgcn_readfirstlane(F.tid >> 6);
#endif
        if (INL(6)) REP(10) { OPQ();
            pg8::Gemm g{(const bf16*)X1B, (const bf16*)(F.ws + WS_WGU), MT, 2 * FF, DM}; pg8::StaticOrder S; S.init(MT, 2 * FF, F.G, F.wg);
            pg8::EpiSwiGLU E{P, FF, RSB};
            pg8::gemm_phase<pg8::EpiSwiGLU, pg8::StaticOrder, true, true>(F.lds, g, S, E);
            if (LAYER + 1 < DEPTH) convert_items<1 | 2>(F, l + 1, ((MT / 256) * (2 * FF / 256)) % F.G);
        }
#if defined(SEGPRE) && SEG_HI == 6
        if (((SEGPRE >> LAYER) & 1) && seg_n < hi - (N_PHASES - 1)) { ++seg_n; if (SEGPRE_MODE == 1) xcd_barrier<true>(bar); else if (SEGPRE_MODE == 2) xcd_barrier<false>(bar); goto seg_start; }
#endif
        SEAM(pb + 6);
#if defined(SEGREP) && SEG_HI == 6
        if (((SEGREP >> LAYER) & 1) && seg_n < hi - (N_PHASES - 1)) { ++seg_n; if (6 == 8 && LAYER == 1) GRID_BAR(); goto seg_start; }
#endif
#if (defined(SEGREP) || defined(SEGPRE)) && SEG_LO == 7
        seg_start: asm volatile("" : "+v"(F.tid), "+v"(F.lane)); F.wave = __builtin_amdgcn_readfirstlane(F.tid >> 6);
#endif
        if (INL(7)) REP(11) { OPQ();
            pg8::Gemm g{P, (const bf16*)(F.ws + WS_WDN), MP, DM, FF}; pg8::StaticOrder S; S.init(MP, DM, F.G, F.wg);
            pg8::EpiBf16 E{BIG, DM, nullptr};
            pg8::gemm_phase<pg8::EpiBf16, pg8::StaticOrder, true, true>(F.lds, g, S, E);
            sample_gemm_lds(F, P, (const bf16*)(F.ws + WS_WDN), FF, BIG);
        }
#if defined(SEGPRE) && SEG_HI == 7
        if (((SEGPRE >> LAYER) & 1) && seg_n < hi - (N_PHASES - 1)) { ++seg_n; if (SEGPRE_MODE == 1) xcd_barrier<true>(bar); else if (SEGPRE_MODE == 2) xcd_barrier<false>(bar); goto seg_start; }
#endif
        SEAM(pb + 7);
#if defined(SEGREP) && SEG_HI == 7
        if (((SEGREP >> LAYER) & 1) && seg_n < hi - (N_PHASES - 1)) { ++seg_n; if (7 == 8 && LAYER == 1) GRID_BAR(); goto seg_start; }
#endif
#if (defined(SEGREP) || defined(SEGPRE)) && SEG_LO == 8
        seg_start: asm volatile("" : "+v"(F.tid), "+v"(F.lane)); F.wave = __builtin_amdgcn_readfirstlane(F.tid >> 6);
#endif
        if (INL(8)) { OPQ();
            if (l + 1 < DEPTH) {
                convert_items<4 | 16>(F, l + 1, 0);
                row_pass<true, true>(F, X1B, nullptr, BIG, F.in[I_NFPOST] + l * DM, X2B, F.in[I_NMPRE] + (l + 1) * DM, RSA, F.in[I_WIN] + (size_t)(l + 1) * DM * INC, AB);
            } else row_pass<true, false>(F, X1B, nullptr, BIG, F.in[I_NFPOST] + l * DM, Y, nullptr, nullptr, nullptr, nullptr);
        }
#if defined(SEGPRE) && SEG_HI == 8
        if (((SEGPRE >> LAYER) & 1) && seg_n < hi - (N_PHASES - 1)) { ++seg_n; if (SEGPRE_MODE == 1) xcd_barrier<true>(bar); else if (SEGPRE_MODE == 2) xcd_barrier<false>(bar); goto seg_start; }
#endif
        SEAM(pb + 8);
#if defined(SEGREP) && SEG_HI == 8
        if (((SEGREP >> LAYER) & 1) && seg_n < hi - (N_PHASES - 1)) { ++seg_n; if (8 == 8 && LAYER == 1) GRID_BAR(); goto seg_start; }
#endif
    }
__global__ void __launch_bounds__(NTHR, 2) mega_fwd(Args args) {
    extern __shared__ __attribute__((aligned(16))) unsigned char lds[];
    Frame F;
    F.lds = (LAS unsigned char*)lds;
    F.tid = threadIdx.x; F.lane = F.tid & 63; F.wave = __builtin_amdgcn_readfirstlane(F.tid >> 6);
    F.G = gridDim.x; F.wg = blockIdx.x;
    F.in = args.in;
    F.out = args.out; F.ws = args.ws;
    volatile LAS unsigned* MISC = (volatile LAS unsigned*)(F.lds + LDSCTL_OFF);
    for (int u = F.tid; u < (LDS_BYTES - LDSCTL_OFF) / 4; u += NTHR) ((LAS unsigned*)(F.lds + LDSCTL_OFF))[u] = 0u;
    __syncthreads();
#if MK_N_LAUNCHES == 1
    XcdBarrier bar = xcd_barrier_post((unsigned*)(F.ws + WS_CTL) + CW_BAR, MISC + 8);
#else
    (void)MISC; XcdBarrier bar; bar.bar = nullptr; bar.x = 0; bar.st = nullptr;
#endif
    const int lo = args.ph_lo, hi = args.ph_hi;
#ifdef FULLREP
    for (int rep2 = 0; rep2 < args.ph_hi - (N_PHASES - FULLREP); ++rep2) {
        F.tid = threadIdx.x; asm volatile("" : "+v"(F.tid)); F.lane = F.tid & 63; F.wave = __builtin_amdgcn_readfirstlane(F.tid >> 6);
#endif
    if ((PH_MASK & 1) && IN(0)) REP(12) {
        convert_items<1 | 4 | 16>(F, 0, 0);
        row_pass<false, true>(F, F.in[I_XP], F.in[I_XS], nullptr, nullptr, X2B, F.in[I_NMPRE], RSA, F.in[I_WIN], AB);
    }
    SEAM(0);
    layer_phases<0>(F, bar, lo, hi);
    layer_phases<1>(F, bar, lo, hi);
#ifdef FULLREP
    GRID_BAR(); }
#endif
}

extern "C" void kernel_launch(void* const* d_in, const int* in_sizes, int n_in, void* d_out, int out_size, void* d_ws, size_t ws_size, hipStream_t stream) {
    static int grid = 0;
    if (grid == 0) {
        if (n_in != 37 || (size_t)out_size != O_END || ws_size < WS_OL + 16 * MiB) { fprintf(stderr, "kernel_launch: unexpected shapes: n_in %d out %d ws %zu\n", n_in, out_size, ws_size); grid = -1; return; }
        int dev = 0, cus = 0, per_cu = 0;
        if (hipGetDevice(&dev) != hipSuccess || hipDeviceGetAttribute(&cus, hipDeviceAttributeMultiprocessorCount, dev) != hipSuccess) { grid = -1; return; }
        if (hipFuncSetAttribute((const void*)mega_fwd, hipFuncAttributeMaxDynamicSharedMemorySize, LDS_BYTES) != hipSuccess) { fprintf(stderr, "kernel_launch: hipFuncSetAttribute failed\n"); grid = -1; return; }
        if (hipOccupancyMaxActiveBlocksPerMultiprocessor(&per_cu, (const void*)mega_fwd, NTHR, LDS_BYTES) != hipSuccess || per_cu < 1) { fprintf(stderr, "kernel_launch: occupancy query says %d blocks per CU\n", per_cu); (void)hipGetLastError(); per_cu = 1; }
        grid = cus;
        if (grid > 256) grid = 256;
        if (HEADNORM_IN_GEMM && grid != 256) { fprintf(stderr, "kernel_launch: %d compute units, this build needs 256 (one out-projection unit per workgroup)\n", cus); grid = -1; return; }
    }
    if (grid < 0) return;
    (void)hipMemsetAsync((char*)d_ws + WS_CTL, 0, CTL_ZERO_BYTES, stream);
    Args a{};
    for (int i = 0; i < 37; ++i) a.in[i] = (const float*)d_in[i];
    a.out = (float*)d_out; a.ws = (unsigned char*)d_ws;
#if MK_N_LAUNCHES == 1
    a.ph_lo = 0; a.ph_hi = N_PHASES;
    hipLaunchKernelGGL(mega_fwd, dim3(grid), dim3(NTHR), LDS_BYTES, stream, a);
#else
    for (int ph = 0; ph < N_PHASES; ++ph) { a.ph_lo = ph; a.ph_hi = ph + 1; hipLaunchKernelGGL(mega_fwd, dim3(grid), dim3(NTHR), LDS_BYTES, stream, a); }
#endif
}
```

```cpp
#include <hip/hip_runtime.h>
#include <cstdio>
#include <cstdint>
#include <cmath>
namespace pg8 {
#define PG8_LAS __attribute__((address_space(3)))
typedef unsigned short bf16_t;
typedef short bf16x8 __attribute__((ext_vector_type(8)));
typedef float f32x4 __attribute__((ext_vector_type(4)));
typedef unsigned u32x4 __attribute__((ext_vector_type(4)));
constexpr int BM = 256, BK = 64, HALF = 128, HTB = HALF * BK * 2  , STAGE_BYTES = 8 * HTB, NXCD = 8, WGM = 8;

__host__ __device__ __forceinline__ int lds_byte(int r, int c) { const int st = (r >> 4) * 2 + (c >> 5), rr = r & 15, cc = c & 31, ob = rr * 64 + cc * 2; return st * 1024 + (ob ^ (((ob >> 9) & 1) << 5)); }
__host__ __device__ __forceinline__ void stage_rc(int b, int& R, int& C) { const int st = b / 1024, sb = b % 1024, swz = sb ^ (((sb >> 9) & 1) << 5); R = (st >> 1) * 16 + swz / 64; C = (st & 1) * 32 + (swz % 64) / 2; }
__host__ __device__ __forceinline__ int perm32(int rho) { const int n = rho >> 4, i = rho & 15; return 8 * (i >> 2) + 4 * n + (i & 3); }

struct Unit { int pm, pn; };
struct Gemm { const bf16_t* A; const bf16_t* Bt; int M, N, K; };

struct StaticOrder {
    int nM, nN, nwg, G, c;
    __host__ __device__ void init(int M, int N, int G_, int c_) { nM = M / BM; nN = N / BM; nwg = nM * nN; G = G_; c = c_; }
    __host__ __device__ bool next(int i, Unit& u) const {
        const long L = (long)i * G + c; if (L >= nwg) return false;
        int wgid = (int)L; { const int q = nwg / NXCD, r = nwg % NXCD, xcd = wgid % NXCD, off = wgid / NXCD; wgid = (xcd < r ? xcd * (q + 1) : r * (q + 1) + (xcd - r) * q) + off; }
        const int nig = WGM * nN, gid = wgid / nig, fm = gid * WGM, gsz = (nM - fm) < WGM ? (nM - fm) : WGM;
        u.pm = fm + ((wgid % nig) % gsz); u.pn = (wgid % nig) / gsz; return true;
    }
    __device__ __forceinline__ void a_ready(const Unit&) const {}
    __device__ __forceinline__ void done(const Unit&) const {}
};


__device__ __forceinline__ unsigned cvt_pk_bf16(float lo, float hi) { unsigned r; asm volatile("v_cvt_pk_bf16_f32 %0, %1, %2" : "=v"(r) : "v"(lo), "v"(hi)); return r; }

template <bool WT>
__device__ __forceinline__ void st16(void* p, u32x4 v) {
    if constexpr (WT) asm volatile("global_store_dwordx4 %0, %1, off sc1\n\ts_nop 1" :: "v"(p), "v"(v) : "memory");
    else *(u32x4*)p = v;
}
struct EpiF32 {
    static constexpr bool PERM = false, AFTER_DRAIN = false, KSCALE = false;
    float* C; int ldc;
    template <bool WT>
    __device__ __forceinline__ void run(const f32x4 (&acc)[2][2][4][2], const Unit& u, int wr, int wc, int fr, int fq) const {
        const int row0 = u.pm * BM + wr * 64 + fr, col0 = u.pn * BM + wc * 32 + 4 * fq;
#pragma unroll
        for (int ai = 0; ai < 2; ++ai)
#pragma unroll
            for (int m = 0; m < 4; ++m) { float* rowp = C + (size_t)(row0 + ai * HALF + m * 16) * ldc + col0;
#pragma unroll
                for (int bj = 0; bj < 2; ++bj)
#pragma unroll
                    for (int n = 0; n < 2; ++n) *(f32x4*)(rowp + bj * HALF + n * 16) = acc[ai][bj][m][n]; }
    }
};
struct EpiBf16 {
    static constexpr bool PERM = true, AFTER_DRAIN = false, KSCALE = false;
    bf16_t* O; int ldc; const float* RS;
    template <bool WT>
    __device__ __forceinline__ void run(const f32x4 (&acc)[2][2][4][2], const Unit& u, int wr, int wc, int fr, int fq) const {
        const int row0 = u.pm * BM + wr * 64 + fr; const int col0 = u.pn * BM + wc * 32 + 8 * fq;
        float rsc[2][4];
#pragma unroll
        for (int ai = 0; ai < 2; ++ai)
#pragma unroll
            for (int m = 0; m < 4; ++m) rsc[ai][m] = RS ? RS[row0 + ai * HALF + m * 16] : 1.0f;
#pragma unroll
        for (int ai = 0; ai < 2; ++ai)
#pragma unroll
            for (int m = 0; m < 4; ++m) { bf16_t* rowp = O + (size_t)(row0 + ai * HALF + m * 16) * ldc + col0;
#pragma unroll
                for (int bj = 0; bj < 2; ++bj) { const f32x4 v0 = acc[ai][bj][m][0] * rsc[ai][m], v1 = acc[ai][bj][m][1] * rsc[ai][m];
                    u32x4 w; w.x = cvt_pk_bf16(v0[0], v0[1]); w.y = cvt_pk_bf16(v0[2], v0[3]); w.z = cvt_pk_bf16(v1[0], v1[1]); w.w = cvt_pk_bf16(v1[2], v1[3]);
                    st16<WT>(rowp + bj * HALF, w); } }
    }
};
struct EpiBf16HeadNorm {
    static constexpr bool PERM = true, AFTER_DRAIN = false, KSCALE = true;
    static constexpr int KT0 = 8, TAB = STAGE_BYTES;
    bf16_t* O; int ldc; const float* SSQ; float inv_n, eps;
    struct Pre { f32x4 v[8]; };
    __device__ __forceinline__ void setup_load(Pre& p, const Unit& u, int tid) const {
        const float* sp = SSQ + (size_t)(u.pm * BM + (tid & 255)) * 32;
#pragma unroll
        for (int i = 0; i < 8; ++i) p.v[i] = *(const f32x4*)(sp + 4 * i);
    }
    __device__ __forceinline__ void setup_store(const Pre& p, PG8_LAS unsigned char* lds, int tid) const {
        if (tid < 256) {
            float sq[4], rs[4];
#pragma unroll
            for (int h = 0; h < 4; ++h) { const f32x4 a = p.v[2 * h], b = p.v[2 * h + 1]; const float x = ((a.x + a.y) + (a.z + a.w) + (b.x + b.y) + (b.z + b.w)) * inv_n + eps; rs[h] = __builtin_amdgcn_rsqf(x); sq[h] = x * rs[h]; }
            PG8_LAS float* t = (PG8_LAS float*)(lds + TAB) + tid * 8;
            *(PG8_LAS f32x4*)t = (f32x4){sq[0], rs[0] * sq[1], rs[1] * sq[2], rs[2] * sq[3]}; t[4] = rs[3];
        }
    }
    __device__ __forceinline__ void scale(f32x4 (&acc)[2][2][4][2], PG8_LAS unsigned char* lds, int wr, int fr, int p) const {
        const PG8_LAS float* t = (const PG8_LAS float*)(lds + TAB) + (wr * 64 + fr) * 8 + p;
#pragma unroll
        for (int ai = 0; ai < 2; ++ai)
#pragma unroll
            for (int m = 0; m < 4; ++m) { const float f = t[(ai * HALF + m * 16) * 8];
#pragma unroll
                for (int bj = 0; bj < 2; ++bj)
#pragma unroll
                    for (int n = 0; n < 2; ++n) acc[ai][bj][m][n] = acc[ai][bj][m][n] * f; }
    }
    template <bool WT>
    __device__ __forceinline__ void run(const f32x4 (&acc)[2][2][4][2], const Unit& u, int wr, int wc, int fr, int fq) const { EpiBf16 e{O, ldc, nullptr}; e.template run<WT>(acc, u, wr, wc, fr, fq); }
};
struct EpiSwiGLU {
    static constexpr bool PERM = true, AFTER_DRAIN = false, KSCALE = false;
    bf16_t* O; int ldc; const float* RS;
    template <bool WT>
    __device__ __forceinline__ void run(const f32x4 (&acc)[2][2][4][2], const Unit& u, int wr, int wc, int fr, int fq) const {
        const int row0 = u.pm * BM + wr * 64 + fr; const int col0 = u.pn * HALF + wc * 32 + 8 * fq;
        float rsc[2][4];
#pragma unroll
        for (int ai = 0; ai < 2; ++ai)
#pragma unroll
            for (int m = 0; m < 4; ++m) rsc[ai][m] = RS[row0 + ai * HALF + m * 16];
#pragma unroll
        for (int ai = 0; ai < 2; ++ai)
#pragma unroll
            for (int m = 0; m < 4; ++m) { bf16_t* rowp = O + (size_t)(row0 + ai * HALF + m * 16) * ldc + col0;
                float o[8];
#pragma unroll
                for (int n = 0; n < 2; ++n)
#pragma unroll
                    for (int j = 0; j < 4; ++j) { const float g = acc[ai][0][m][n][j] * rsc[ai][m], up = acc[ai][1][m][n][j] * rsc[ai][m]; o[n * 4 + j] = g * up * __builtin_amdgcn_rcpf(1.0f + __expf(-g)); }
                u32x4 w; w.x = cvt_pk_bf16(o[0], o[1]); w.y = cvt_pk_bf16(o[2], o[3]); w.z = cvt_pk_bf16(o[4], o[5]); w.w = cvt_pk_bf16(o[6], o[7]);
                st16<WT>(rowp, w); }
    }
};

#ifndef PG8_LAST_WT
#define PG8_LAST_WT 0
#endif
template <class E, bool K = E::KSCALE> struct Epi_pre { typedef int type; };
template <class E> struct Epi_pre<E, true> { typedef typename E::Pre type; };
template <class Epi, class Sched, bool ALIGN_EPI = false, bool SP2 = false>
__device__ __forceinline__ void gemm_phase(PG8_LAS unsigned char* lds, const Gemm g, const Sched& S, const Epi& E) {
    int tid_ = threadIdx.x; asm volatile("" : "+v"(tid_));
    const int tid = tid_, wid = __builtin_amdgcn_readfirstlane(tid >> 6), lane = tid & 63, wr = wid >> 2, wc = wid & 3, fr = lane & 15, fq = lane >> 4;
    const int K = g.K, nt = K / BK;
    unsigned voffA[2], voffB[2];
#pragma unroll
    for (int i = 0; i < 2; ++i) { int R, C; stage_rc(tid * 16 + i * 8192, R, C); const int Rb = Epi::PERM ? ((R & ~31) + perm32(R & 31)) : R;
        voffA[i] = (unsigned)(R * K + C) * 2u; voffB[i] = (unsigned)(Rb * K + C) * 2u; }
    const size_t kstep = (size_t)(BK * 2);
    const size_t hstep = (size_t)HALF * K * 2;
    const size_t tstep = 2 * hstep;
    const unsigned ldsw = (unsigned)wid * 1024u;
    const int aoff = lds_byte(wr * 64 + fr, fq * 8), boff = lds_byte(wc * 32 + fr, fq * 8);
#define PG8_SA(b, h) (((b) * 2 + (h)) * HTB)
#define PG8_SB(b, h) ((4 + (b) * 2 + (h)) * HTB)
#define PG8_STAGE(bufoff, gbase, voff) do { _Pragma("unroll") for (int _i = 0; _i < 2; ++_i) \
        __builtin_amdgcn_global_load_lds((const unsigned*)((const char*)(gbase) + (voff)[_i]), (PG8_LAS unsigned*)(lds + (bufoff) + ldsw + _i * 8192), 16, 0, 0); } while (0)
#define PG8_LDA(dst, b, h) do { _Pragma("unroll") for (int m = 0; m < 4; ++m) _Pragma("unroll") for (int k = 0; k < 2; ++k) dst[m][k] = *(const PG8_LAS bf16x8*)(lds + PG8_SA(b, h) + aoff + m * 2048 + k * 1024); } while (0)
#define PG8_LDB(dst, b, h) do { _Pragma("unroll") for (int n = 0; n < 2; ++n) _Pragma("unroll") for (int k = 0; k < 2; ++k) dst[n][k] = *(const PG8_LAS bf16x8*)(lds + PG8_SB(b, h) + boff + n * 2048 + k * 1024); } while (0)
#define PG8_MMA(ai, bj, At, Bt) do { __builtin_amdgcn_s_setprio(1); _Pragma("unroll") for (int m = 0; m < 4; ++m) _Pragma("unroll") for (int n = 0; n < 2; ++n) _Pragma("unroll") for (int k = 0; k < 2; ++k) \
        acc[ai][bj][m][n] = __builtin_amdgcn_mfma_f32_16x16x32_bf16(Bt[n][k], At[m][k], acc[ai][bj][m][n], 0, 0, 0); __builtin_amdgcn_s_setprio(0); } while (0)
#define PG8_WAIT_V(n) asm volatile("s_waitcnt vmcnt(" #n ")" ::: "memory")
#define PG8_WAIT_L(n) asm volatile("s_waitcnt lgkmcnt(" #n ")" ::: "memory")
#define PG8_BAR __builtin_amdgcn_s_barrier()
#define PG8_SCHED __builtin_amdgcn_sched_barrier(0)
    Unit cur, nxt; int ui = 0;
    if (!S.next(0, cur)) return;
    f32x4 acc[2][2][4][2];
#pragma unroll
    for (int a = 0; a < 2; ++a)
#pragma unroll
        for (int b = 0; b < 2; ++b)
#pragma unroll
            for (int m = 0; m < 4; ++m)
#pragma unroll
                for (int n = 0; n < 2; ++n) acc[a][b][m][n] = (f32x4){0.f, 0.f, 0.f, 0.f};
    bf16x8 At[4][2], B0[2][2], B1[2][2];
    const char* cA = (const char*)g.A + (size_t)cur.pm * tstep; const char* cB = (const char*)g.Bt + (size_t)cur.pn * tstep;
    S.a_ready(cur);
    typename Epi_pre<Epi>::type epre;
    if constexpr (Epi::KSCALE) E.setup_load(epre, cur, tid);
    if constexpr (SP2) {
        PG8_STAGE(PG8_SB(0, 0), cB, voffB); PG8_STAGE(PG8_SB(0, 1), cB + hstep, voffB); PG8_STAGE(PG8_SA(0, 0), cA, voffA); PG8_STAGE(PG8_SA(0, 1), cA + hstep, voffA);
        if (wr == 1) PG8_BAR;
        PG8_WAIT_V(2); PG8_BAR;
        PG8_STAGE(PG8_SB(1, 0), cB + kstep, voffB); PG8_STAGE(PG8_SA(1, 0), cA + kstep, voffA); PG8_STAGE(PG8_SB(1, 1), cB + hstep + kstep, voffB);
        PG8_WAIT_V(6); PG8_BAR;
        if constexpr (Epi::KSCALE) E.setup_store(epre, lds, tid);
    } else {
        PG8_STAGE(PG8_SB(0, 0), cB, voffB); PG8_STAGE(PG8_SA(0, 0), cA, voffA); PG8_STAGE(PG8_SB(0, 1), cB + hstep, voffB); PG8_STAGE(PG8_SA(0, 1), cA + hstep, voffA);
        if (wr == 1) PG8_BAR;
        PG8_WAIT_V(4); PG8_BAR;
        PG8_STAGE(PG8_SB(1, 0), cB + kstep, voffB); PG8_STAGE(PG8_SA(1, 0), cA + kstep, voffA); PG8_STAGE(PG8_SB(1, 1), cB + hstep + kstep, voffB);
        PG8_WAIT_V(6); PG8_BAR;
    }
    for (;;) {
        const bool has_next = S.next(ui + 1, nxt);
        const char* nA = has_next ? (const char*)g.A + (size_t)nxt.pm * tstep : cA; const char* nB = has_next ? (const char*)g.Bt + (size_t)nxt.pn * tstep : cB;
        for (int t = 0; t < nt; t += 2) {
            const bool last = (t == nt - 2);
            const char* a1 = cA + (size_t)(t + 1) * kstep;
            const char* a2 = last ? nA : cA + (size_t)(t + 2) * kstep; const char* b2 = last ? nB : cB + (size_t)(t + 2) * kstep;
            const char* a3 = a2 + kstep; const char* b3 = b2 + kstep;
            if (last && has_next) S.a_ready(nxt);
            if constexpr (Epi::KSCALE) { if (t >= Epi::KT0) E.scale(acc, lds, wr, fr, (t - Epi::KT0) >> 1); }
            if constexpr (SP2) {
            PG8_LDB(B0, 0, 0); PG8_LDB(B1, 0, 1); PG8_SCHED; PG8_LDA(At, 0, 0); PG8_STAGE(PG8_SA(1, 1), a1 + hstep, voffA);
            PG8_WAIT_V(8); PG8_WAIT_L(0); PG8_BAR; PG8_MMA(0, 0, At, B0); PG8_MMA(0, 1, At, B1); PG8_BAR; PG8_SCHED;
            PG8_LDA(At, 0, 1); PG8_STAGE(PG8_SB(0, 0), b2, voffB); PG8_STAGE(PG8_SB(0, 1), b2 + hstep, voffB); PG8_STAGE(PG8_SA(0, 0), a2, voffA);
            PG8_WAIT_V(8); PG8_WAIT_L(0); PG8_BAR; PG8_MMA(1, 0, At, B0); PG8_MMA(1, 1, At, B1); PG8_BAR; PG8_SCHED;
            PG8_LDB(B0, 1, 0); PG8_LDB(B1, 1, 1); PG8_SCHED; PG8_LDA(At, 1, 0); PG8_STAGE(PG8_SA(0, 1), a2 + hstep, voffA);
            PG8_WAIT_V(8); PG8_WAIT_L(0); PG8_BAR; PG8_MMA(0, 0, At, B0); PG8_MMA(0, 1, At, B1); PG8_BAR; PG8_SCHED;
            PG8_LDA(At, 1, 1); PG8_STAGE(PG8_SB(1, 0), b3, voffB); PG8_STAGE(PG8_SB(1, 1), b3 + hstep, voffB); PG8_STAGE(PG8_SA(1, 0), a3, voffA);
            PG8_WAIT_V(8); PG8_WAIT_L(0); PG8_BAR; PG8_MMA(1, 0, At, B0); PG8_MMA(1, 1, At, B1); PG8_BAR; PG8_SCHED;
            } else {
            PG8_LDB(B0, 0, 0); PG8_SCHED; PG8_LDA(At, 0, 0); PG8_STAGE(PG8_SA(1, 1), a1 + hstep, voffA);
            PG8_WAIT_L(8); PG8_BAR; PG8_WAIT_L(0); PG8_MMA(0, 0, At, B0); PG8_BAR; PG8_SCHED;
            PG8_LDB(B1, 0, 1); PG8_STAGE(PG8_SB(0, 0), b2, voffB);
            PG8_BAR; PG8_WAIT_L(0); PG8_MMA(0, 1, At, B1); PG8_BAR;
            PG8_LDA(At, 0, 1); PG8_STAGE(PG8_SA(0, 0), a2, voffA);
            PG8_BAR; PG8_WAIT_L(0); PG8_MMA(1, 0, At, B0); PG8_BAR; PG8_SCHED;
            PG8_STAGE(PG8_SB(0, 1), b2 + hstep, voffB);
            PG8_WAIT_V(6); PG8_BAR; PG8_MMA(1, 1, At, B1); PG8_BAR;
            PG8_LDB(B0, 1, 0); PG8_SCHED; PG8_LDA(At, 1, 0); PG8_STAGE(PG8_SA(0, 1), a2 + hstep, voffA);
            PG8_WAIT_L(8); PG8_BAR; PG8_WAIT_L(0); PG8_MMA(0, 0, At, B0); PG8_BAR; PG8_SCHED;
            PG8_LDB(B1, 1, 1); PG8_STAGE(PG8_SB(1, 0), b3, voffB);
            PG8_BAR; PG8_WAIT_L(0); PG8_MMA(0, 1, At, B1); PG8_BAR;
            PG8_LDA(At, 1, 1); PG8_STAGE(PG8_SA(1, 0), a3, voffA);
            PG8_BAR; PG8_WAIT_L(0); PG8_MMA(1, 0, At, B0); PG8_BAR; PG8_SCHED;
            PG8_STAGE(PG8_SB(1, 1), b3 + hstep, voffB);
            PG8_WAIT_V(6); PG8_BAR; PG8_MMA(1, 1, At, B1); PG8_BAR;
            }
        }
        if constexpr (Epi::KSCALE) E.scale(acc, lds, wr, fr, 4);
        if constexpr (ALIGN_EPI) { if (wr == 0) PG8_BAR; }
        if constexpr (!Epi::AFTER_DRAIN) {
            if (PG8_LAST_WT && !has_next) E.template run<true>(acc, cur, wr, wc, fr, fq); else E.template run<false>(acc, cur, wr, wc, fr, fq);
            S.done(cur); }
        if (!has_next) break;
#pragma unroll
        for (int a = 0; a < 2; ++a)
#pragma unroll
            for (int b = 0; b < 2; ++b)
#pragma unroll
                for (int m = 0; m < 4; ++m)
#pragma unroll
                    for (int n = 0; n < 2; ++n) acc[a][b][m][n] = (f32x4){0.f, 0.f, 0.f, 0.f};
        cur = nxt; cA = nA; cB = nB; ++ui;
        if constexpr (ALIGN_EPI) { if (wr == 1) PG8_BAR; }
    }
    PG8_WAIT_V(0);
    if constexpr (!ALIGN_EPI) { if (wr == 0) PG8_BAR; }
    PG8_BAR;
    if constexpr (Epi::AFTER_DRAIN) { E.fused(acc, cur, wr, wc, fr, fq, lds, wid, lane); S.done(cur); }
#undef PG8_SA
#undef PG8_SB
#undef PG8_STAGE
#undef PG8_LDA
#undef PG8_LDB
#undef PG8_MMA
#undef PG8_WAIT_V
#undef PG8_WAIT_L
#undef PG8_BAR
#undef PG8_SCHED
}
}

constexpr int NWAVES = 8, NTHR = 512;
constexpr int DM = 1024, SEQ = 2048, NB_P = 8, MP = NB_P * SEQ, NB_S = 128, DSEQ = 4, MS = NB_S * DSEQ, MT = MP + MS;
constexpr int DEPTH = 2, INC = 2824, NPJ = 2816, FF = 2816, GDH = 4, HD = 128, NCH = SEQ / 64;
constexpr int PU = 0, PXL = 256, PGL = 512, PQ = 768, PK = 1280, PV = 1792, PZ = 2304;
constexpr float EPS = 1e-6f;
#ifndef HEADNORM_IN_GEMM
#define HEADNORM_IN_GEMM 1
#endif
constexpr size_t O_YP = 0, O_YS = O_YP + (size_t)MP * DM, O_PS5RE = O_YS + (size_t)MS * DM, O_PS5IM = O_PS5RE + 2 * 8 * 16 * 64, O_PLRUH = O_PS5IM + 2 * 8 * 16 * 64,
    O_PLRUC = O_PLRUH + 2 * 8 * 256, O_PGS = O_PLRUC + 2 * 8 * 3 * 256, O_PGC = O_PGS + (size_t)2 * 8 * 4 * 128 * 128, O_SS5RE = O_PGC + 2 * 8 * 3 * 1536,
    O_SS5IM = O_SS5RE + 2 * 128 * 16 * 64, O_SLRUH = O_SS5IM + 2 * 128 * 16 * 64, O_SLRUC = O_SLRUH + 2 * 128 * 256, O_SGS = O_SLRUC + 2 * 128 * 3 * 256,
    O_SGC = O_SGS + (size_t)2 * 128 * 4 * 128 * 128, O_END = O_SGC + (size_t)2 * 128 * 3 * 1536;
static_assert(O_END == 37216256, "output size");
constexpr size_t MiB = 1u << 20;
constexpr size_t WS_CTL = 0, CTL_ZERO_BYTES = 1 * MiB;
constexpr size_t WS_S5E = 1 * MiB;
constexpr size_t WS_LAGG = 3 * MiB;
constexpr size_t WS_AB = 3 * MiB + 512 * 1024;
constexpr size_t WS_EGL = 4 * MiB + 256 * 1024;
constexpr size_t WS_WIN = 5 * MiB;
constexpr size_t WS_WOUT = WS_WIN + (size_t)NPJ * DM * 2;
constexpr size_t WS_WGU = WS_WOUT + (size_t)DM * DM * 2;
constexpr size_t WS_WDN = WS_WGU + (size_t)2 * FF * DM * 2;
constexpr size_t WS_WGLU = WS_WDN + (size_t)DM * FF * 2;
constexpr size_t WS_X = 30 * MiB;
constexpr size_t WS_P = 63 * MiB;
constexpr size_t WS_BIG = 154 * MiB;
constexpr size_t WS_PP = WS_BIG, WS_RT = WS_BIG + 32 * MiB, WS_QT = WS_BIG + 64 * MiB, WS_END = WS_BIG + 80 * MiB;
static_assert(WS_WGLU + 256 * 256 * 2 <= WS_X && WS_X + (size_t)MT * DM * 2 <= WS_P && WS_P + (size_t)MT * NPJ * 2 <= WS_BIG && WS_BIG + (size_t)MT * DM * 4 <= WS_END && WS_END + (size_t)MP * 32 * 4 <= 256 * MiB, "ws map");
static_assert(WS_AB + (size_t)MT * 8 * 4 <= WS_EGL && WS_EGL + 4096 <= WS_WIN, "ws map 2");
constexpr size_t WS_SSQ = WS_END;
constexpr size_t WS_OL = WS_END + 2 * MiB;
constexpr size_t WS_DUMH = WS_END + 18 * MiB, WS_DUMF = WS_END + 19 * MiB;
static_assert(WS_DUMF + 2 * MiB <= 256 * MiB, "ws tail");
constexpr int CW_BAR = 4096;
constexpr int RING_BYTES = 131072, LDSCTL_OFF = 143360, LDS_BYTES = 147456;

#define GAS __attribute__((address_space(1)))
#define LAS __attribute__((address_space(3)))
typedef unsigned short bf16;
typedef unsigned v4u __attribute__((ext_vector_type(4)));
typedef unsigned v2u __attribute__((ext_vector_type(2)));
typedef float f32x4 __attribute__((ext_vector_type(4)));
typedef short bf16x8 __attribute__((ext_vector_type(8)));
#define LDS_WAIT() asm volatile("s_waitcnt lgkmcnt(0)" ::: "memory")
#define VM_WAIT() asm volatile("s_waitcnt vmcnt(0)" ::: "memory")
#define MFMA16(a, b, c) __builtin_amdgcn_mfma_f32_16x16x32_bf16(a, b, c, 0, 0, 0)
typedef float f32x2_t __attribute__((ext_vector_type(2))); typedef __bf16 bf16x2_t __attribute__((ext_vector_type(2)));
__device__ __forceinline__ unsigned pk2(float lo, float hi) { f32x2_t v = {lo, hi}; bf16x2_t b = __builtin_convertvector(v, bf16x2_t); return __builtin_bit_cast(unsigned, b); }
__device__ __forceinline__ unsigned f2bf(float f) { return pk2(f, f) & 0xffffu; }
__device__ __forceinline__ float bf2f(unsigned b) { return __builtin_bit_cast(float, b << 16); }
__device__ __forceinline__ float bflo(unsigned w) { return __builtin_bit_cast(float, w << 16); }
__device__ __forceinline__ float bfhi(unsigned w) { return __builtin_bit_cast(float, w & 0xffff0000u); }
__device__ __forceinline__ float frcp(float x) { return __builtin_amdgcn_rcpf(x); }
__device__ __forceinline__ float frsq(float x) { return __builtin_amdgcn_rsqf(x); }
__device__ __forceinline__ float sigmoidf_(float x) { return frcp(1.0f + __expf(-x)); }
__device__ __forceinline__ float siluf_(float x) { return x * frcp(1.0f + __expf(-x)); }
__device__ __forceinline__ float gelu_tanh(float x) { const float z = 0.7978845608028654f * (x + 0.044715f * x * x * x); return x * frcp(1.0f + __expf(-2.0f * z)); }
__device__ __forceinline__ float softplusf_(float x) { return x > 20.f ? x : log1pf(expf(x)); }
__device__ __forceinline__ float softplus_fast(float x) { return x > 20.f ? x : __logf(1.0f + __expf(x)); }
__device__ __forceinline__ float wave_sum(float v) {
#pragma unroll
    for (int o = 1; o < 64; o <<= 1) v += __shfl_xor(v, o);
    return v;
}
__device__ __forceinline__ bf16x8 pack8(const float* f) { v4u w; w.x = pk2(f[0], f[1]); w.y = pk2(f[2], f[3]); w.z = pk2(f[4], f[5]); w.w = pk2(f[6], f[7]); return __builtin_bit_cast(bf16x8, w); }
constexpr int S256 = 272, S128 = 144, S512 = 528;
__device__ __forceinline__ int t256(int row, int col) { return row * S256 + col * 2; }
__device__ __forceinline__ int t128(int row, int col) { return row * S128 + col * 2; }
__device__ __forceinline__ int t512(int row, int col) { return row * S512 + col * 2; }

#define XB_TMO      128
#define XB_XCNT(j)  (256  + 64 * (j))
#define XB_XSUB(j)  (1280 + 64 * (j))
#define XB_XGEN(j)  (2304 + 64 * (j))
#define XB_TOP      3328
#define XB_TOPGEN   3392
#define XCD_BAR_WORDS 3456
#define XB_SPIN_CAP (1u << 20)
__device__ __forceinline__ unsigned xb_ld(unsigned* p)              { return __hip_atomic_load(p, __ATOMIC_RELAXED, __HIP_MEMORY_SCOPE_AGENT); }
__device__ __forceinline__ unsigned xb_add(unsigned* p, unsigned v) { return __hip_atomic_fetch_add(p, v, __ATOMIC_RELAXED, __HIP_MEMORY_SCOPE_AGENT); }
__device__ __forceinline__ unsigned xb_xcc_id() { return (unsigned)__builtin_amdgcn_s_getreg((3 << 11) | 20) & 0xFu; }
#define XB_SPIN(cond, bar) do { unsigned _sp = 0; while (cond) { __builtin_amdgcn_s_sleep(1); \
    if ((++_sp & 255u) == 0u) { if (xb_ld(&(bar)[XB_TMO])) break; if (_sp > XB_SPIN_CAP) { atomicAdd(&(bar)[XB_TMO], 1u); break; } } } } while (0)
struct XcdBarrier { unsigned* bar; unsigned x; volatile LAS unsigned* st; };
__device__ __forceinline__ XcdBarrier xcd_barrier_post(unsigned* bar, volatile LAS unsigned* st) {
    XcdBarrier b; b.bar = bar; b.x = xb_xcc_id(); b.st = st;
    if (threadIdx.x == 0) (void)xb_add(&bar[XB_XCNT(b.x)], 1u);
    return b;
}
__device__ __forceinline__ void xcd_barrier_complete(unsigned* bar, unsigned x, unsigned& nloc, unsigned& nx) {
    const unsigned G = gridDim.x * gridDim.y * gridDim.z;
    unsigned sum, cnt, mine, sp = 0u;
    for (;;) {
        sum = 0u; cnt = 0u; mine = 0u;
#pragma unroll
        for (unsigned j = 0; j < 16; ++j) { const unsigned c = xb_ld(&bar[XB_XCNT(j)]); sum += c; cnt += (c > 0u) ? 1u : 0u; mine = (j == x) ? c : mine; }
        if (sum == G) break;
        __builtin_amdgcn_s_sleep(1);
        if ((++sp & 255u) == 0u) { if (xb_ld(&bar[XB_TMO])) break; if (sp > XB_SPIN_CAP) { atomicAdd(&bar[XB_TMO], 1u); break; } }
    }
    nloc = mine > 0u ? mine : 1u; nx = cnt > 0u ? cnt : 1u;
}
template <bool FENCED = true>
__device__ __forceinline__ void xcd_barrier(const XcdBarrier& b) {
    asm volatile("s_waitcnt vmcnt(0)" ::: "memory");
    __syncthreads();
    if (threadIdx.x == 0) {
        unsigned* bar = b.bar;
        __builtin_amdgcn_s_waitcnt(0);
        unsigned nloc = b.st[0], nx = b.st[1];
        if (nloc == 0u) { xcd_barrier_complete(bar, b.x, nloc, nx); b.st[0] = nloc; b.st[1] = nx; }
        const unsigned old = xb_add(&bar[XB_XSUB(b.x)], 1u);
        const unsigned gen = old / nloc;
        if (old + 1u == (gen + 1u) * nloc) {
            if (FENCED) __builtin_amdgcn_fence(__ATOMIC_RELEASE, "agent");
            asm volatile("s_waitcnt vmcnt(0)" ::: "memory");
            const unsigned og = xb_add(&bar[XB_TOP], 1u);
            const unsigned tg = og / nx;
            if (og + 1u == (tg + 1u) * nx) xb_add(&bar[XB_TOPGEN], 1u);
            else XB_SPIN(xb_ld(&bar[XB_TOPGEN]) == tg, bar);
            if (FENCED) __builtin_amdgcn_fence(__ATOMIC_ACQUIRE, "agent");
            xb_add(&bar[XB_XGEN(b.x)], 1u);
            asm volatile("s_waitcnt vmcnt(0)" ::: "memory");
        } else {
            XB_SPIN(xb_ld(&bar[XB_XGEN(b.x)]) == gen, bar);
            if (FENCED) __builtin_amdgcn_fence(__ATOMIC_ACQUIRE, "agent");
            asm volatile("s_waitcnt vmcnt(0)" ::: "memory");
        }
    }
    __syncthreads();
}

struct Frame {
    LAS unsigned char* lds;
    int tid, lane, wave, wg, G;
    const float* const* in;
    float* out; unsigned char* ws;
};
enum { I_XP = 0, I_XS, I_S5RE, I_S5IM, I_LRUH, I_LRUC, I_GS, I_GC, I_NMPRE, I_NMPOST, I_NFPRE, I_NFPOST, I_WIN, I_LRE, I_LIM, I_LDT, I_BRE, I_BIM, I_CRE, I_CIM, I_S5D, I_WGLU, I_BGLU,
       I_LCW, I_LCB, I_LWA, I_LBA, I_LWX, I_LBX, I_LLAM, I_GCW, I_GALOG, I_GDTB, I_GNW, I_WOUT, I_WGU, I_WDN };

__device__ __forceinline__ void transpose_item(const float* W, int ldw, int K, int k0, int c0, bf16* WT, int r0, LAS float* scr, int lane, const float* ksc = nullptr) {
    float tv[32];
#pragma unroll
    for (int i = 0; i < 32; ++i) tv[i] = W[(size_t)(k0 + 2 * i + (lane >> 5)) * ldw + c0 + (lane & 31)];
    if (ksc) {
#pragma unroll
        for (int i = 0; i < 32; ++i) tv[i] *= ksc[k0 + 2 * i + (lane >> 5)];
    }
#pragma unroll
    for (int i = 0; i < 32; ++i) scr[(2 * i + (lane >> 5)) * 33 + (lane & 31)] = tv[i];
    LDS_WAIT(); asm volatile("" ::: "memory");
    const int c = lane & 7;
#pragma unroll
    for (int j = 0; j < 4; ++j) { const int n = (lane >> 3) + 8 * j; const LAS float* s = scr + (8 * c) * 33 + n;
        v4u o; o.x = pk2(s[0 * 33], s[1 * 33]); o.y = pk2(s[2 * 33], s[3 * 33]); o.z = pk2(s[4 * 33], s[5 * 33]); o.w = pk2(s[6 * 33], s[7 * 33]);
        *(GAS v4u*)(WT + (size_t)(r0 + n) * K + k0 + 8 * c) = o; }
    LDS_WAIT(); asm volatile("" ::: "memory");
}
template <int MASK>
__device__ __forceinline__ void convert_items(Frame& F, int l, int wg0) {
    LAS float* scr = (LAS float*)(F.lds + F.wave * 16384);
    int lane = F.lane; asm volatile("" : "+v"(lane));
    const int gw = (F.wg - wg0) * NWAVES + F.wave, NGW = (F.G - wg0) * NWAVES;
    if (gw < 0) return;
    constexpr int I1 = (MASK & 1) ? 16 * 88 : 0, I2 = (MASK & 2) ? 16 * 32 : 0, I3 = (MASK & 4) ? 16 * 176 : 0, I4 = (MASK & 8) ? 44 * 32 : 0, I5 = (MASK & 16) ? 4 * 8 : 0, NIT = I1 + I2 + I3 + I4 + I5;
    unsigned char* ws = F.ws;
    for (int it = gw; it < NIT; it += NGW) {
        int r = it;
        if (r < I1) { const int kb = r / 88, nb = r % 88; transpose_item(F.in[I_WIN] + (size_t)l * DM * INC, INC, DM, 64 * kb, nb * 32 + (nb >= 72 ? 8 : 0), (bf16*)(ws + WS_WIN), nb * 32, scr, lane, F.in[I_NMPRE] + l * DM); continue; } r -= I1;
        if (r < I2) { const int kb = r / 32, nb = r % 32; transpose_item(F.in[I_WOUT] + (size_t)l * DM * DM, DM, DM, 64 * kb, nb * 32, (bf16*)(ws + WS_WOUT), nb * 32, scr, lane); continue; } r -= I2;
        if (r < I3) { const int kb = r / 176, nb = r % 176, tile = nb >> 3, wi = nb & 7; const int c0 = wi < 4 ? tile * 128 + wi * 32 : FF + tile * 128 + (wi - 4) * 32;
                      transpose_item(F.in[I_WGU] + (size_t)l * DM * 2 * FF, 2 * FF, DM, 64 * kb, c0, (bf16*)(ws + WS_WGU), nb * 32, scr, lane, F.in[I_NFPRE] + l * DM); continue; } r -= I3;
        if (r < I4) { const int kb = r / 32, nb = r % 32; transpose_item(F.in[I_WDN] + (size_t)l * FF * DM, DM, FF, 64 * kb, nb * 32, (bf16*)(ws + WS_WDN), nb * 32, scr, lane); continue; } r -= I4;
        if (r < I5) { const int kb = r / 8, nb = r % 8; transpose_item(F.in[I_WGLU] + (size_t)l * 256 * 256, 256, 256, 64 * kb, nb * 32, (bf16*)(ws + WS_WGLU), nb * 32, scr, lane); }
    }
}
constexpr size_t WS_DEP = 256 * 1024;
__device__ __forceinline__ unsigned* dep_word(Frame& F, int bank, int i) { return (unsigned*)(F.ws + WS_CTL + WS_DEP) + ((size_t)bank * 96 + i) * 64; }
__device__ __forceinline__ void dep_publish(Frame& F, unsigned* w0, unsigned* w1) {
    asm volatile("s_waitcnt vmcnt(0)" ::: "memory");
    __syncthreads();
    if (F.tid == 0) {
        __builtin_amdgcn_fence(__ATOMIC_RELEASE, "agent");
        asm volatile("s_waitcnt vmcnt(0)" ::: "memory");
        (void)xb_add(w0, 1u);
        if (w1) (void)xb_add(w1, 1u);
    }
}
__device__ __forceinline__ void dep_wait(Frame& F, unsigned* w0, unsigned n0, unsigned* w1, unsigned n1, unsigned* bar) {
    if (F.tid == 0) {
        XB_SPIN(xb_ld(w0) < n0, bar);
        if (w1) XB_SPIN(xb_ld(w1) < n1, bar);
        __builtin_amdgcn_fence(__ATOMIC_ACQUIRE, "agent");
        asm volatile("s_waitcnt vmcnt(0)" ::: "memory");
    }
    __syncthreads();
}
template <bool XIN_B, bool XOUT_B, bool LOCAL = false>
__device__ __forceinline__ void row_pass(Frame& F, const float* xp, const float* xs, const bf16* branch, const float* wb, float* xout, const float* wh, float* RS, const float* wab, float* AB, int lbase = 0, unsigned* sw = nullptr, unsigned sn = 0, unsigned* bar = nullptr) {
    int lane = F.lane; asm volatile("" : "+v"(lane));
    const int gw = F.wg * NWAVES + F.wave, NGW = F.G * NWAVES;
    f32x4 wbv[4], whv[4];
#pragma unroll
    for (int j = 0; j < 4; ++j) { wbv[j] = branch ? *(const GAS f32x4*)(wb + 4 * lane + 256 * j) : (f32x4){0.f, 0.f, 0.f, 0.f}; whv[j] = wh ? *(const GAS f32x4*)(wh + 4 * lane + 256 * j) : (f32x4){0.f, 0.f, 0.f, 0.f}; }
    LAS float* WL = (LAS float*)F.lds;
    if (wab) {
        f32x4 wl4[4];
#pragma unroll
        for (int k4 = 0; k4 < 4; ++k4) { const int i = F.tid + k4 * NTHR; const int k = i >> 1, hlf = i & 1; wl4[k4] = *(const GAS f32x4*)(wab + (size_t)k * INC + 2304 + hlf * 4); }
        __syncthreads();
#pragma unroll
        for (int k4 = 0; k4 < 4; ++k4) { const int i = F.tid + k4 * NTHR; const int k = i >> 1, hlf = i & 1; *(LAS f32x4*)(WL + k * 8 + hlf * 4) = wl4[k4]; }
        __syncthreads(); }
    const int nit = LOCAL ? (F.wave < 2 ? 9 : 8) : (MT - gw + NGW - 1) / NGW;
    for (int it = 0; it < nit; ++it) {
        const int m = LOCAL ? (it < 8 ? lbase + it : MP + 2 * F.wg + F.wave) : gw + it * NGW;
        if (LOCAL && it == 8) {
            XB_SPIN(xb_ld(sw) < sn, bar);
            __builtin_amdgcn_fence(__ATOMIC_ACQUIRE, "agent");
            asm volatile("s_waitcnt vmcnt(0)" ::: "memory");
        }
        f32x4 v[4];
        if (XIN_B) {
#pragma unroll
            for (int j = 0; j < 4; ++j) { const v2u w = *(const GAS v2u*)((const bf16*)xp + (size_t)m * DM + 4 * lane + 256 * j); v[j] = (f32x4){bflo(w.x), bfhi(w.x), bflo(w.y), bfhi(w.y)}; }
        } else {
            const float* xr = (xs && m >= MP) ? xs + (size_t)(m - MP) * DM : xp + (size_t)m * DM;
#pragma unroll
            for (int j = 0; j < 4; ++j) v[j] = *(const GAS f32x4*)(xr + 4 * lane + 256 * j);
        }
        if (branch) {
            f32x4 b[4]; float s = 0.f;
#pragma unroll
            for (int j = 0; j < 4; ++j) { const v2u bw = *(const GAS v2u*)(branch + (size_t)m * DM + 4 * lane + 256 * j); b[j] = (f32x4){bflo(bw.x), bfhi(bw.x), bflo(bw.y), bfhi(bw.y)}; s += (b[j].x * b[j].x + b[j].y * b[j].y) + (b[j].z * b[j].z + b[j].w * b[j].w); }
            const float rs = 1.0f / sqrtf(wave_sum(s) * (1.f / DM) + EPS);
#pragma unroll
            for (int j = 0; j < 4; ++j) v[j] = v[j] + b[j] * rs * wbv[j];
        }
        if (xout) {
#pragma unroll
            for (int j = 0; j < 4; ++j) {
                if (XOUT_B) { v2u o; o.x = pk2(v[j].x, v[j].y); o.y = pk2(v[j].z, v[j].w); *(GAS v2u*)((bf16*)xout + (size_t)m * DM + 4 * lane + 256 * j) = o; }
                else *(GAS f32x4*)(xout + (size_t)m * DM + 4 * lane + 256 * j) = v[j];
            }
        }
        if (RS) {
            float s = 0.f;
#pragma unroll
            for (int j = 0; j < 4; ++j) s += (v[j].x * v[j].x + v[j].y * v[j].y) + (v[j].z * v[j].z + v[j].w * v[j].w);
            const float rs = 1.0f / sqrtf(wave_sum(s) * (1.f / DM) + EPS);
            if (lane == 0) RS[m] = rs;
            if (wab) {
#pragma unroll
                for (int j = 0; j < 4; ++j) v[j] = v[j] * rs * whv[j];
            }
            if (wab) {
                float a8[8];
#pragma unroll
                for (int c = 0; c < 8; ++c) a8[c] = 0.f;
#pragma unroll
                for (int j = 0; j < 4; ++j)
#pragma unroll
                    for (int q = 0; q < 4; ++q) { const LAS float* wr = WL + (4 * lane + 256 * j + q) * 8; const f32x4 w0 = *(const LAS f32x4*)wr, w1 = *(const LAS f32x4*)(wr + 4); const float xv = v[j][q];
                        a8[0] += xv * w0.x; a8[1] += xv * w0.y; a8[2] += xv * w0.z; a8[3] += xv * w0.w; a8[4] += xv * w1.x; a8[5] += xv * w1.y; a8[6] += xv * w1.z; a8[7] += xv * w1.w; }
#pragma unroll
                for (int c = 0; c < 8; ++c) a8[c] = wave_sum(a8[c]);
                if (lane == 0) { *(GAS f32x4*)(AB + (size_t)m * 8) = (f32x4){a8[0], a8[1], a8[2], a8[3]}; *(GAS f32x4*)(AB + (size_t)m * 8 + 4) = (f32x4){a8[4], a8[5], a8[6], a8[7]}; }
            }
        }
    }
}

__device__ __forceinline__ void sample_gemm_f32(Frame& F, const bf16* A, const bf16* Bt, int K, bf16* C) {
    int tid = F.tid; asm volatile("" : "+v"(tid)); const int lane = tid & 63, wv = tid >> 6, fr = lane & 15, fq = lane >> 4;
    for (int t = F.wg; t < 256; t += F.G) {
        const int row0 = MP + 32 * (t >> 4) + 16 * (wv >> 2), col0 = 64 * (t & 15) + 16 * (wv & 3);
        const bf16* ap = A + (size_t)(row0 + fr) * K + 8 * fq; const bf16* bp = Bt + (size_t)(col0 + fr) * K + 8 * fq;
        f32x4 acc0 = (f32x4){0.f, 0.f, 0.f, 0.f}, acc1 = (f32x4){0.f, 0.f, 0.f, 0.f};
#pragma unroll 4
        for (int k = 0; k < K; k += 64) {
            const v4u a0 = *(const GAS v4u*)(ap + k), b0 = *(const GAS v4u*)(bp + k), a1 = *(const GAS v4u*)(ap + k + 32), b1 = *(const GAS v4u*)(bp + k + 32);
            acc0 = MFMA16(__builtin_bit_cast(bf16x8, a0), __builtin_bit_cast(bf16x8, b0), acc0); acc1 = MFMA16(__builtin_bit_cast(bf16x8, a1), __builtin_bit_cast(bf16x8, b1), acc1);
        }
#pragma unroll
        for (int r = 0; r < 4; ++r) C[(size_t)(row0 + 4 * fq + r) * DM + col0 + fr] = (bf16)f2bf(acc0[r] + acc1[r]);
    }
}

__device__ __forceinline__ void sample_gemm_lds(Frame& F, const bf16* A, const bf16* Bt, int K, bf16* C) {
    int tid = F.tid; asm volatile("" : "+v"(tid)); const int lane = tid & 63, wv = tid >> 6, fr = lane & 15, fq = lane >> 4;
    LAS unsigned char* L = F.lds;
    constexpr int SA = 32 * S512, SBUF = SA + 64 * S512;
    for (int t = F.wg; t < 256; t += F.G) {
        const int row0 = MP + 32 * (t >> 4), col0 = 64 * (t & 15);
        const int pr = tid >> 5, pc = (tid & 31) * 8;
        const bf16* ap = A + (size_t)(row0 + pr) * K + pc; const bf16* bp = Bt + (size_t)(col0 + pr) * K + pc;
        const size_t s16 = (size_t)16 * K;
        const int sa = pr * S512 + pc * 2, sb = SA + sa;
        v4u ra0 = *(const GAS v4u*)ap, ra1 = *(const GAS v4u*)(ap + s16);
        v4u rb0 = *(const GAS v4u*)bp, rb1 = *(const GAS v4u*)(bp + s16), rb2 = *(const GAS v4u*)(bp + 2 * s16), rb3 = *(const GAS v4u*)(bp + 3 * s16);
        *(LAS v4u*)(L + sa) = ra0; *(LAS v4u*)(L + sa + 16 * S512) = ra1;
        *(LAS v4u*)(L + sb) = rb0; *(LAS v4u*)(L + sb + 16 * S512) = rb1; *(LAS v4u*)(L + sb + 32 * S512) = rb2; *(LAS v4u*)(L + sb + 48 * S512) = rb3;
        __syncthreads();
        f32x4 acc = (f32x4){0.f, 0.f, 0.f, 0.f};
        const int nc = K >> 8;
        for (int kc = 0; kc < nc; ++kc) {
            const int cur = (kc & 1) * SBUF, nxt = ((kc + 1) & 1) * SBUF;
            if (kc + 1 < nc) { const int o = (kc + 1) * 256;
                ra0 = *(const GAS v4u*)(ap + o); ra1 = *(const GAS v4u*)(ap + s16 + o);
                rb0 = *(const GAS v4u*)(bp + o); rb1 = *(const GAS v4u*)(bp + s16 + o); rb2 = *(const GAS v4u*)(bp + 2 * s16 + o); rb3 = *(const GAS v4u*)(bp + 3 * s16 + o); }
#pragma unroll
            for (int ks = 0; ks < 8; ++ks) {
                const bf16x8 af = *(const LAS bf16x8*)(L + cur + (16 * (wv >> 2) + fr) * S512 + (32 * ks + 8 * fq) * 2);
                const bf16x8 bf = *(const LAS bf16x8*)(L + cur + SA + (16 * (wv & 3) + fr) * S512 + (32 * ks + 8 * fq) * 2);
                acc = MFMA16(af, bf, acc);
            }
            if (kc + 1 < nc) { *(LAS v4u*)(L + nxt + sa) = ra0; *(LAS v4u*)(L + nxt + sa + 16 * S512) = ra1;
                *(LAS v4u*)(L + nxt + sb) = rb0; *(LAS v4u*)(L + nxt + sb + 16 * S512) = rb1; *(LAS v4u*)(L + nxt + sb + 32 * S512) = rb2; *(LAS v4u*)(L + nxt + sb + 48 * S512) = rb3; }
            __syncthreads();
        }
#pragma unroll
        for (int r = 0; r < 4; ++r) C[(size_t)(row0 + 16 * (wv >> 2) + 4 * fq + r) * DM + col0 + 16 * (wv & 3) + fr] = (bf16)f2bf(acc[r]);
    }
}

constexpr int G_KN = 0, G_WKT = 0, G_QN = 18432, G_KT = G_QN + 64 * S256, G_VT = G_KT + 128 * S128, G_RAW = G_VT + 128 * S128, G_AT = G_RAW, G_T1 = G_AT + 64 * S128, G_T2 = G_T1 + 64 * S128, G_AF = G_T2 + 64 * S128, G_WVT = G_AF, G_VEC = G_RAW + 52544, G_CW = G_VEC + 1024;
constexpr int RAW_STRIDE = 784;
static_assert(G_RAW + 67 * RAW_STRIDE <= G_VEC && G_CW + 6144 <= LDSCTL_OFF && G_WVT + 128 * S128 <= G_VEC && 64 * S256 <= G_QN && 128 * S128 <= G_QN, "gdn prep lds");
__device__ __forceinline__ void gdn_raw_load(Frame& F, int u, int tid, v4u (&pre)[7], float (&abn)[2]) {
    const int c = u & 31, h = (u >> 5) & 3, b = u >> 7; const bf16* P = (const bf16*)(F.ws + WS_P);
    { const float* ABp = (const float*)(F.ws + WS_AB) + (size_t)(b * SEQ + c * 64 + (tid & 63)) * 8; abn[0] = ABp[h]; abn[1] = ABp[4 + h]; }
#pragma unroll
    for (int k7 = 0; k7 < 7; ++k7) { const int idx = tid + NTHR * k7; const int r = idx / 48, ck = idx % 48, ten = ck >> 4, c16 = ck & 15; const int tt = c * 64 - 3 + r;
        v4u val = (v4u){0u, 0u, 0u, 0u};
        if (idx < 67 * 48 && tt >= 0) val = *(const GAS v4u*)(P + (size_t)(b * SEQ + tt) * NPJ + PQ + ten * 512 + h * HD + c16 * 8);
        pre[k7] = val; }
}
template <int GP_CUT>
__device__ __forceinline__ void gdn_prep(Frame& F, int l, int u, int& cw_head, v4u (&pre)[7], float (&abn)[2], bool have_pre, int u_next) {
    LAS unsigned char* L = F.lds;
    int tid = F.tid; asm volatile("" : "+v"(tid)); const int lane = tid & 63, wv = tid >> 6;
    const int c = u & 31, h = (u >> 5) & 3, b = u >> 7;
    const int row0 = b * SEQ + c * 64;
    const bf16* P = (const bf16*)(F.ws + WS_P);
    const float* AB = (const float*)(F.ws + WS_AB);
    LAS float* VG = (LAS float*)(L + G_VEC); LAS float* VB = VG + 64; LAS float* VEG = VG + 128; LAS float* VEGL = VG + 192;
    const float galog = F.in[I_GALOG][l * 4 + h], gdtb = F.in[I_GDTB][l * 4 + h];
    if (h != cw_head) {
        for (int idx = tid; idx < 1536; idx += NTHR) { const int j = idx / 384, cc = idx % 384; ((LAS float*)(L + G_CW))[idx] = F.in[I_GCW][(size_t)(l * 4 + j) * 1536 + (cc >> 7) * 512 + h * HD + (cc & 127)]; }
        cw_head = h;
    }
    if (!have_pre) gdn_raw_load(F, u, tid, pre, abn);
#pragma unroll
    for (int k7 = 0; k7 < 7; ++k7) { const int idx = tid + NTHR * k7; if (idx < 67 * 48) { const int r = idx / 48, ck = idx % 48; *(LAS v4u*)(L + G_RAW + r * RAW_STRIDE + (ck >> 4) * 256 + (ck & 15) * 16) = pre[k7]; } }
    if (wv == 0) {
        const float a = abn[0], bb = abn[1];
        const float g = -__expf(galog) * softplus_fast(a + gdtb);
        const float be = frcp(1.0f + __expf(-bb));
        float Gc = g;
#pragma unroll
        for (int o = 1; o < 64; o <<= 1) { const float t = __shfl_up(Gc, o); if (lane >= o) Gc += t; }
        const float Gl = __shfl(Gc, 63);
        VG[lane] = Gc; VB[lane] = be; VEG[lane] = __expf(Gc); VEGL[lane] = __expf(Gl - Gc);
        if (lane == 0) ((float*)(F.ws + WS_EGL))[u] = __expf(Gl);
    }
    __syncthreads();
    if (u_next >= 0) gdn_raw_load(F, u_next, tid, pre, abn);
    if (c == 31 && tid < 384) {
        const int ten = tid >> 7, ch = tid & 127;
#pragma unroll
        for (int j = 0; j < 3; ++j) F.out[O_PGC + (size_t)((l * 8 + b) * 3 + j) * 1536 + ten * 512 + h * HD + ch] = bf2f(*(LAS bf16*)(L + G_RAW + (64 + j) * RAW_STRIDE + ten * 256 + ch * 2));
    }
    {
        const int i = tid >> 3, cg = tid & 7;
#pragma unroll 1
        for (int ten = 0; ten < 3; ++ten) {
            float acc[16];
#pragma unroll
            for (int e = 0; e < 16; ++e) acc[e] = 0.f;
#pragma unroll
            for (int j = 0; j < 4; ++j) {
                const v4u x0 = *(LAS v4u*)(L + G_RAW + (i + j) * RAW_STRIDE + ten * 256 + cg * 32), x1 = *(LAS v4u*)(L + G_RAW + (i + j) * RAW_STRIDE + ten * 256 + cg * 32 + 16);
                const LAS float* w = (const LAS float*)(L + G_CW) + j * 384 + ten * 128 + cg * 16;
                const f32x4 w0 = *(const LAS f32x4*)w, w1 = *(const LAS f32x4*)(w + 4), w2 = *(const LAS f32x4*)(w + 8), w3 = *(const LAS f32x4*)(w + 12);
                acc[0] += w0.x * bflo(x0.x); acc[1] += w0.y * bfhi(x0.x); acc[2] += w0.z * bflo(x0.y); acc[3] += w0.w * bfhi(x0.y);
                acc[4] += w1.x * bflo(x0.z); acc[5] += w1.y * bfhi(x0.z); acc[6] += w1.z * bflo(x0.w); acc[7] += w1.w * bfhi(x0.w);
                acc[8] += w2.x * bflo(x1.x); acc[9] += w2.y * bfhi(x1.x); acc[10] += w2.z * bflo(x1.y); acc[11] += w2.w * bfhi(x1.y);
                acc[12] += w3.x * bflo(x1.z); acc[13] += w3.y * bfhi(x1.z); acc[14] += w3.z * bflo(x1.w); acc[15] += w3.w * bfhi(x1.w);
            }
            float ss = 0.f;
#pragma unroll
            for (int e = 0; e < 16; ++e) { acc[e] = siluf_(acc[e]); ss += acc[e] * acc[e]; }
            ss += __shfl_xor(ss, 1); ss += __shfl_xor(ss, 2); ss += __shfl_xor(ss, 4);
            const float sc = ten == 2 ? 1.0f : frsq(ss + EPS) * (ten == 0 ? 0.08838834764831845f : 1.0f);
#pragma unroll
            for (int e = 0; e < 16; ++e) acc[e] *= sc;
            if (ten < 2) { const int base = ten == 0 ? G_QN : G_KN; *(LAS bf16x8*)(L + base + t256(i, cg * 16)) = pack8(acc); *(LAS bf16x8*)(L + base + t256(i, cg * 16 + 8)) = pack8(acc + 8); }
            if (ten > 0) { const int base = ten == 1 ? G_KT : G_VT;
#pragma unroll
                for (int e = 0; e < 16; ++e) *(LAS bf16*)(L + base + t128(cg * 16 + e, i)) = (bf16)f2bf(acc[e]); }
        }
    }
    __syncthreads();
    if constexpr (GP_CUT == 1) return;
    {
        const int prod = wv >> 2, mi = wv & 3, fr = lane & 15, fq = lane >> 4;
        bf16x8 a[4];
#pragma unroll
        for (int ks = 0; ks < 4; ++ks) a[ks] = *(LAS bf16x8*)(L + (prod ? G_QN : G_KN) + t256(16 * mi + fr, 32 * ks + 8 * fq));
#pragma unroll
        for (int nj = 0; nj < 4; ++nj) {
            f32x4 acc = (f32x4){0.f, 0.f, 0.f, 0.f};
            if (nj <= mi) {
#pragma unroll
                for (int ks = 0; ks < 4; ++ks) { const bf16x8 bb = *(LAS bf16x8*)(L + G_KN + t256(16 * nj + fr, 32 * ks + 8 * fq)); acc = MFMA16(a[ks], bb, acc); }
            }
            const int j = 16 * nj + fr; const float Gj = VG[j];
#pragma unroll
            for (int r = 0; r < 4; ++r) {
                const int i = 16 * mi + 4 * fq + r; const float Gi = VG[i];
                const float dec = (i >= j) ? __expf(Gi - Gj) : 0.f;
                if (prod == 0) { const float val = (i > j) ? acc[r] * VB[i] * dec : 0.f; *(LAS float*)(L + G_AF + (i * 64 + j) * 4) = val; }
                else { const float val = (i >= j) ? acc[r] * dec : 0.f; *(LAS bf16*)(L + G_AT + t128(i, j)) = (bf16)f2bf(val); }
            }
        }
    }
    __syncthreads();
    if constexpr (GP_CUT == 2) return;
    if (wv == 0) {
        const int q = lane >> 4, col = lane & 15; const LAS float* Ab = (const LAS float*)(L + G_AF) + (16 * q) * 64 + 16 * q;
        float t[16];
#pragma unroll
        for (int i = 0; i < 16; ++i) {
            float a0 = (col == i) ? 1.f : 0.f, a1 = 0.f, a2 = 0.f, a3 = 0.f;
#pragma unroll
            for (int j4 = 0; j4 < i; j4 += 4) { const f32x4 av = *(const LAS f32x4*)(Ab + i * 64 + j4);
                a0 -= av.x * t[j4]; if (j4 + 1 < i) a1 -= av.y * t[j4 + 1]; if (j4 + 2 < i) a2 -= av.z * t[j4 + 2]; if (j4 + 3 < i) a3 -= av.w * t[j4 + 3]; }
            t[i] = (a0 + a1) + (a2 + a3);
            if ((i & 3) == 3) asm volatile("" ::: "memory");
        }
        LAS float* Tb = (LAS float*)(L + G_AF) + (16 * q) * 64 + 16 * q;
#pragma unroll
        for (int i = 0; i < 16; ++i) Tb[i * 64 + col] = t[i];
    }
    __syncthreads();
    if (wv < 2) {
        LAS float* AF = (LAS float*)(L + G_AF) + (32 * wv) * 64 + 32 * wv; LAS float* X1 = (LAS float*)(L + G_T1) + 1024 + 256 * wv;
        const int fr = lane & 15, fq = lane >> 4;
        f32x4 acc = (f32x4){0.f, 0.f, 0.f, 0.f};
#pragma unroll
        for (int kk = 0; kk < 4; ++kk) { const float av = AF[(16 + fr) * 64 + 4 * kk + fq], bv = AF[(4 * kk + fq) * 64 + fr]; acc = __builtin_amdgcn_mfma_f32_16x16x4f32(av, bv, acc, 0, 0, 0); }
#pragma unroll
        for (int r = 0; r < 4; ++r) X1[(4 * fq + r) * 16 + fr] = acc[r];
        acc = (f32x4){0.f, 0.f, 0.f, 0.f};
#pragma unroll
        for (int kk = 0; kk < 4; ++kk) { const float av = AF[(16 + fr) * 64 + 16 + 4 * kk + fq], bv = X1[(4 * kk + fq) * 16 + fr]; acc = __builtin_amdgcn_mfma_f32_16x16x4f32(av, bv, acc, 0, 0, 0); }
#pragma unroll
        for (int r = 0; r < 4; ++r) AF[(16 + 4 * fq + r) * 64 + fr] = -acc[r];
    }
    __syncthreads();
    if constexpr (GP_CUT == 3) return;
    {
        LAS float* AF = (LAS float*)(L + G_AF); LAS float* XF = (LAS float*)(L + G_T1);
        const int mi2 = wv & 1, nj2 = (wv >> 1) & 1, fr = lane & 15, fq = lane >> 4;
        if (wv < 4) {
            f32x4 acc = (f32x4){0.f, 0.f, 0.f, 0.f};
#pragma unroll
            for (int kk = 0; kk < 8; ++kk) { const float av = AF[(32 + 16 * mi2 + fr) * 64 + 4 * kk + fq], bv = AF[(4 * kk + fq) * 64 + 16 * nj2 + fr]; acc = __builtin_amdgcn_mfma_f32_16x16x4f32(av, bv, acc, 0, 0, 0); }
#pragma unroll
            for (int r = 0; r < 4; ++r) XF[(16 * mi2 + 4 * fq + r) * 32 + 16 * nj2 + fr] = acc[r];
        }
        __syncthreads();
        if (wv < 4) {
            f32x4 acc = (f32x4){0.f, 0.f, 0.f, 0.f};
#pragma unroll
            for (int kk = 0; kk < 8; ++kk) { const float av = AF[(32 + 16 * mi2 + fr) * 64 + 32 + 4 * kk + fq], bv = XF[(4 * kk + fq) * 32 + 16 * nj2 + fr]; acc = __builtin_amdgcn_mfma_f32_16x16x4f32(av, bv, acc, 0, 0, 0); }
#pragma unroll
            for (int r = 0; r < 4; ++r) AF[(32 + 16 * mi2 + 4 * fq + r) * 64 + 16 * nj2 + fr] = -acc[r];
        }
        __syncthreads();
    }
    if constexpr (GP_CUT == 4) return;
    {
        const int i = tid >> 3, c8 = tid & 7; const LAS float* AF = (const LAS float*)(L + G_AF);
        const f32x4 t0 = *(const LAS f32x4*)(AF + i * 64 + 8 * c8), t1 = *(const LAS f32x4*)(AF + i * 64 + 8 * c8 + 4);
        float a1[8], a2[8];
#pragma unroll
        for (int e = 0; e < 8; ++e) { const float tv = e < 4 ? t0[e] : t1[e - 4]; const int j = 8 * c8 + e; a1[e] = tv * VB[j]; a2[e] = a1[e] * VEG[j]; }
        __syncthreads();
        *(LAS bf16x8*)(L + G_T1 + t128(i, 8 * c8)) = pack8(a1); *(LAS bf16x8*)(L + G_T2 + t128(i, 8 * c8)) = pack8(a2);
    }
    __syncthreads();
    if constexpr (GP_CUT == 5) return;
    {
        const int nd = wv, fr = lane & 15, fq = lane >> 4;
#pragma unroll
        for (int prod = 0; prod < 2; ++prod) {
            bf16x8 bfr[2];
#pragma unroll
            for (int ks = 0; ks < 2; ++ks) bfr[ks] = *(LAS bf16x8*)(L + (prod ? G_KT : G_VT) + t128(16 * nd + fr, 32 * ks + 8 * fq));
#pragma unroll
            for (int mi = 0; mi < 4; ++mi) {
                f32x4 acc = (f32x4){0.f, 0.f, 0.f, 0.f};
#pragma unroll
                for (int ks = 0; ks < 2; ++ks) { const bf16x8 af = *(LAS bf16x8*)(L + (prod ? G_T2 : G_T1) + t128(16 * mi + fr, 32 * ks + 8 * fq)); acc = MFMA16(af, bfr[ks], acc); }
                v2u o; o.x = pk2(acc[0], acc[1]); o.y = pk2(acc[2], acc[3]);
                *(LAS v2u*)(L + (prod ? G_WKT : G_WVT) + t128(16 * nd + fr, 16 * mi + 4 * fq)) = o;
            }
        }
    }
    __syncthreads();
    if constexpr (GP_CUT == 6) return;
    {
        const int nd = wv, fr = lane & 15, fq = lane >> 4;
        bf16x8 bk[2], bv[2];
#pragma unroll
        for (int ks = 0; ks < 2; ++ks) { bk[ks] = *(LAS bf16x8*)(L + G_WKT + t128(16 * nd + fr, 32 * ks + 8 * fq)); bv[ks] = *(LAS bf16x8*)(L + G_WVT + t128(16 * nd + fr, 32 * ks + 8 * fq)); }
        bf16* QT = (bf16*)(F.ws + WS_QT) + (size_t)u * 64 * 128; bf16* OL = (bf16*)(F.ws + WS_OL) + (size_t)u * 8192;
#pragma unroll
        for (int mi = 0; mi < 4; ++mi) {
            f32x4 ak = (f32x4){0.f, 0.f, 0.f, 0.f}, av = (f32x4){0.f, 0.f, 0.f, 0.f};
#pragma unroll
            for (int ks = 0; ks < 2; ++ks) { const bf16x8 af = *(LAS bf16x8*)(L + G_AT + t128(16 * mi + fr, 32 * ks + 8 * fq)); ak = MFMA16(af, bk[ks], ak); av = MFMA16(af, bv[ks], av); }
#pragma unroll
            for (int r = 0; r < 4; ++r) { const int i = 16 * mi + 4 * fq + r, d = 16 * nd + fr;
                const float qv = bf2f(*(LAS bf16*)(L + G_QN + t256(i, d)));
                QT[(((mi * 4 + (nd >> 1)) * 64) + (4 * fq + r) + 16 * (2 * (nd & 1) + (fr >> 3))) * 8 + (fr & 7)] = (bf16)f2bf(VEG[i] * qv - ak[r]);
                }
            { v2u o; o.x = pk2(av[0], av[1]); o.y = pk2(av[2], av[3]); *(GAS v2u*)(OL + ((nd * 4 + mi) * 64 + lane) * 4) = o; }
        }
    }
    if constexpr (GP_CUT == 7) return;
    {
        const int fr = lane & 15, fq = lane >> 4;
        bf16x8 kd[2];
#pragma unroll
        for (int ks = 0; ks < 2; ++ks) { const v4u raw = *(LAS v4u*)(L + G_KT + t128(16 * wv + fr, 32 * ks + 8 * fq)); const int i0 = 32 * ks + 8 * fq; float f[8];
            f[0] = bflo(raw.x) * VEGL[i0]; f[1] = bfhi(raw.x) * VEGL[i0 + 1]; f[2] = bflo(raw.y) * VEGL[i0 + 2]; f[3] = bfhi(raw.y) * VEGL[i0 + 3];
            f[4] = bflo(raw.z) * VEGL[i0 + 4]; f[5] = bfhi(raw.z) * VEGL[i0 + 5]; f[6] = bflo(raw.w) * VEGL[i0 + 6]; f[7] = bfhi(raw.w) * VEGL[i0 + 7]; kd[ks] = pack8(f); }
        bf16* PP = (bf16*)(F.ws + WS_PP) + (size_t)u * 128 * 128; bf16* RT = (bf16*)(F.ws + WS_RT) + (size_t)u * 128 * 128;
#pragma unroll 2
        for (int nd = 0; nd < 8; ++nd) {
            f32x4 ar = (f32x4){0.f, 0.f, 0.f, 0.f}, ap = (f32x4){0.f, 0.f, 0.f, 0.f};
#pragma unroll
            for (int ks = 0; ks < 2; ++ks) { const bf16x8 wvf = *(LAS bf16x8*)(L + G_WVT + t128(16 * nd + fr, 32 * ks + 8 * fq)), wkf = *(LAS bf16x8*)(L + G_WKT + t128(16 * nd + fr, 32 * ks + 8 * fq));
                ar = MFMA16(kd[ks], wvf, ar); ap = MFMA16(wkf, kd[ks], ap); }
            v2u o; o.x = pk2(ar[0], ar[1]); o.y = pk2(ar[2], ar[3]); *(GAS v2u*)(RT + (size_t)((nd * 8 + wv) * 64 + lane) * 4) = o;
            o.x = pk2(ap[0], ap[1]); o.y = pk2(ap[2], ap[3]); *(GAS v2u*)(PP + (size_t)(((wv * 4 + (nd >> 1)) * 64) + fr + 16 * (2 * (nd & 1) + (fq >> 1))) * 8 + 4 * (fq & 1)) = o;
        }
    }
    __syncthreads();
}

struct ChainSet { v4u ap[4], aq[4]; v2u rr, ol; float eg; };
constexpr int CH_O = 2 * 16 * S256, CH_S = CH_O + 32 * 4 * 512;
static_assert(CH_S + 32 * 4 * 64 <= LDSCTL_OFF, "chain lds");
struct ChainPtr { const bf16* pp; const bf16* qq; const bf16* rt; const bf16* ol; const float* egl; };
__device__ __forceinline__ void chain_load(ChainSet& s, const ChainPtr& p, int c, bool lowhalf) {
    const bf16* pp = p.pp + (size_t)c * 16384;
#pragma unroll
    for (int ks = 0; ks < 4; ++ks) s.ap[ks] = *(const GAS v4u*)(pp + 512 * ks);
    s.rr = *(const GAS v2u*)(p.rt + (size_t)c * 16384); s.eg = p.egl[c];
    if (lowhalf) {
        const bf16* qq = p.qq + (size_t)c * 8192;
#pragma unroll
        for (int ks = 0; ks < 4; ++ks) s.aq[ks] = *(const GAS v4u*)(qq + 512 * ks);
        s.ol = *(const GAS v2u*)(p.ol + (size_t)c * 8192);
    }
}
template <bool DRY>
__device__ __forceinline__ void gdn_chain(Frame& F, int l, int task) {
    LAS unsigned char* L = F.lds;
    int tid = F.tid; asm volatile("" : "+v"(tid)); const int lane = tid & 63, wv = tid >> 6, fr = lane & 15, fq = lane >> 4;
    const int xcd = task & 7, idx = task >> 3; const int chain = xcd * 4 + (idx >> 3), slab = idx & 7;
    const int b = chain >> 2, h = chain & 3;
    const bf16* PPb = (const bf16*)(F.ws + WS_PP) + (size_t)chain * 32 * 16384; bf16* RTb = (bf16*)(F.ws + WS_RT) + (size_t)chain * 32 * 16384;
    const bf16* QTb = (const bf16*)(F.ws + WS_QT) + (size_t)chain * 32 * 8192;
    bf16* OLb = (bf16*)(F.ws + WS_OL) + (size_t)chain * 32 * 8192;
    float* SSQ = (float*)(F.ws + WS_SSQ);
    const float* EGL = (const float*)(F.ws + WS_EGL) + chain * 32;
    const int row0h = b * SEQ;
    for (int i = F.tid; i < 2 * 16 * S256 / 4; i += NTHR) ((LAS unsigned*)L)[i] = 0u;
    __syncthreads();
    f32x4 S = (f32x4){0.f, 0.f, 0.f, 0.f};
    ChainSet cs[4];
    ChainPtr cp;
    cp.pp = PPb + (size_t)(wv * 4 * 64 + lane) * 8; cp.qq = QTb + (size_t)((wv & 3) * 4 * 64 + lane) * 8;
    cp.rt = RTb + (size_t)((slab * 8 + wv) * 64 + lane) * 4;
    cp.ol = OLb + ((slab * 4 + (wv & 3)) * 64 + lane) * 4; cp.egl = EGL;
    asm volatile("" : "+v"(cp.pp), "+v"(cp.qq), "+v"(cp.rt), "+v"(cp.ol));
    const bool lowhalf = wv < 4;
    chain_load(cs[0], cp, 0, lowhalf); chain_load(cs[1], cp, 1, lowhalf); chain_load(cs[2], cp, 2, lowhalf);
#pragma unroll 1
    for (int c0 = 0; c0 < NCH; c0 += 4) {
#pragma unroll
        for (int s = 0; s < 4; ++s) {
            const int c = c0 + s;
            chain_load(cs[(s + 3) & 3], cp, c + 3 < NCH ? c + 3 : NCH - 1, lowhalf);
            const ChainSet& q = cs[s];
            const LAS unsigned char* St = L + (s & 1) * (16 * S256);
            bf16x8 bs[4];
#pragma unroll
            for (int ks = 0; ks < 4; ++ks) bs[ks] = *(const LAS bf16x8*)(St + t256(fr, 32 * ks + 8 * fq));
            f32x4 acc = (f32x4){0.f, 0.f, 0.f, 0.f};
#pragma unroll
            for (int ks = 0; ks < 4; ++ks) acc = MFMA16(__builtin_bit_cast(bf16x8, q.ap[ks]), bs[ks], acc);
            if (lowhalf) {
                f32x4 ao = (f32x4){0.f, 0.f, 0.f, 0.f};
#pragma unroll
                for (int ks = 0; ks < 4; ++ks) ao = MFMA16(__builtin_bit_cast(bf16x8, q.aq[ks]), bs[ks], ao);
                const float o0 = ao[0] + bflo(q.ol.x), o1 = ao[1] + bfhi(q.ol.x), o2 = ao[2] + bflo(q.ol.y), o3 = ao[3] + bfhi(q.ol.y);
                v2u ov; ov.x = pk2(o0, o1); ov.y = pk2(o2, o3);
                f32x4 ss = (f32x4){o0 * o0, o1 * o1, o2 * o2, o3 * o3};
#pragma unroll
                for (int sh = 1; sh < 16; sh <<= 1) { ss[0] += __shfl_xor(ss[0], sh); ss[1] += __shfl_xor(ss[1], sh); ss[2] += __shfl_xor(ss[2], sh); ss[3] += __shfl_xor(ss[3], sh); }
                {
                    *(LAS v2u*)(L + CH_O + ((c * 4 + wv) * 64 + lane) * 8) = ov;
                    if (fr == 0) *(LAS f32x4*)(L + CH_S + ((c * 4 + wv) * 4 + fq) * 16) = ss;
                }
            }
            S[0] = q.eg * S[0] - acc[0] + bflo(q.rr.x); S[1] = q.eg * S[1] - acc[1] + bfhi(q.rr.x); S[2] = q.eg * S[2] - acc[2] + bflo(q.rr.y); S[3] = q.eg * S[3] - acc[3] + bfhi(q.rr.y);
            v2u o2; o2.x = pk2(S[0], S[1]); o2.y = pk2(S[2], S[3]);
            *(LAS v2u*)(L + ((s + 1) & 1) * (16 * S256) + t256(fr, 16 * wv + 4 * fq)) = o2;
            asm volatile("s_waitcnt lgkmcnt(0)" ::: "memory"); __builtin_amdgcn_s_barrier(); asm volatile("" ::: "memory");
        }
    }
    if (!DRY) {
        bf16* MXh = (bf16*)(F.ws + WS_X) + 512 + h * HD + 16 * slab;
#if HEADNORM_IN_GEMM
        const bf16* Zh = (const bf16*)(F.ws + WS_P) + PZ + h * HD + 16 * slab + 8 * (tid & 1);
        const float* gwp = F.in[I_GNW] + l * HD + 16 * slab + 8 * (tid & 1);
        const f32x4 w0 = *(const GAS f32x4*)gwp, w1 = *(const GAS f32x4*)(gwp + 4);
#endif
#if HEADNORM_IN_GEMM
        v4u zq[8];
#pragma unroll
        for (int k = 0; k < 8; ++k) { const int i = tid + k * NTHR; zq[k] = *(const GAS v4u*)(Zh + (size_t)(row0h + (i >> 7) * 64 + ((i >> 1) & 63)) * NPJ); }
#pragma unroll
        for (int k = 0; k < 8; ++k) { const int i = tid + k * NTHR; const int half = i & 1, rr = (i >> 1) & 63, cc = i >> 7; const int mi = rr >> 4, fq2 = (rr >> 2) & 3, r = rr & 3;
#else
        for (int i = tid; i < 32 * 64 * 2; i += NTHR) { const int half = i & 1, rr = (i >> 1) & 63, cc = i >> 7; const int mi = rr >> 4, fq2 = (rr >> 2) & 3, r = rr & 3;
#endif
            unsigned w[4];
#pragma unroll
            for (int e = 0; e < 4; ++e) { const int f0 = 8 * half + 2 * e;
                const unsigned lo = *(const LAS unsigned short*)(L + CH_O + ((cc * 4 + mi) * 64 + fq2 * 16 + f0) * 8 + r * 2), hi = *(const LAS unsigned short*)(L + CH_O + ((cc * 4 + mi) * 64 + fq2 * 16 + f0 + 1) * 8 + r * 2);
                w[e] = lo | (hi << 16); }
#if HEADNORM_IN_GEMM
            const v4u zv = zq[k];
            float y[8];
            y[0] = bflo(w[0]) * w0.x * siluf_(bflo(zv.x)); y[1] = bfhi(w[0]) * w0.y * siluf_(bfhi(zv.x)); y[2] = bflo(w[1]) * w0.z * siluf_(bflo(zv.y)); y[3] = bfhi(w[1]) * w0.w * siluf_(bfhi(zv.y));
            y[4] = bflo(w[2]) * w1.x * siluf_(bflo(zv.z)); y[5] = bfhi(w[2]) * w1.y * siluf_(bfhi(zv.z)); y[6] = bflo(w[3]) * w1.z * siluf_(bflo(zv.w)); y[7] = bfhi(w[3]) * w1.w * siluf_(bfhi(zv.w));
            *(GAS bf16x8*)(MXh + (size_t)(row0h + cc * 64 + rr) * DM + 8 * half) = pack8(y); }
#else
            *(GAS v4u*)(MXh + (size_t)(row0h + cc * 64 + rr) * DM + 8 * half) = (v4u){w[0], w[1], w[2], w[3]}; }
#endif
        for (int i = tid; i < 32 * 64; i += NTHR) { const int rr = i & 63, cc = i >> 6; const int mi = rr >> 4, fq2 = (rr >> 2) & 3, r = rr & 3;
            SSQ[(size_t)(row0h + cc * 64 + rr) * 32 + h * 8 + slab] = *(const LAS float*)(L + CH_S + ((cc * 4 + mi) * 4 + fq2) * 16 + r * 4); }
        float* So = F.out + O_PGS + (size_t)((l * 8 + b) * 4 + h) * 16384;
#pragma unroll
        for (int r = 0; r < 4; ++r) So[(size_t)(16 * wv + 4 * fq + r) * 128 + 16 * slab + fr] = S[r];
    }
    __syncthreads();
}

__device__ __forceinline__ void gdn_finalize(Frame& F, int l) {
    bf16* MX = (bf16*)(F.ws + WS_X); const bf16* P = (const bf16*)(F.ws + WS_P); const float* SSQ = (const float*)(F.ws + WS_SSQ);
    const int nth = F.G * NTHR;
    for (int it = F.wg * NTHR + F.tid; it < MP * 64; it += nth) {
        const int row = it >> 6, hh = (it >> 4) & 3, ck = it & 15;
        const f32x4 s0 = *(const GAS f32x4*)(SSQ + (size_t)row * 32 + hh * 8), s1 = *(const GAS f32x4*)(SSQ + (size_t)row * 32 + hh * 8 + 4);
        const float rs = frsq(((s0.x + s0.y) + (s0.z + s0.w) + (s1.x + s1.y) + (s1.z + s1.w)) * (1.f / HD) + EPS);
        const v4u ov = *(const GAS v4u*)(MX + (size_t)row * DM + 512 + hh * HD + ck * 8), zv = *(const GAS v4u*)(P + (size_t)row * NPJ + PZ + hh * HD + ck * 8);
        const f32x4 w0 = *(const GAS f32x4*)(F.in[I_GNW] + l * HD + ck * 8), w1 = *(const GAS f32x4*)(F.in[I_GNW] + l * HD + ck * 8 + 4);
        float y[8];
        y[0] = bflo(ov.x) * rs * w0.x * siluf_(bflo(zv.x)); y[1] = bfhi(ov.x) * rs * w0.y * siluf_(bfhi(zv.x)); y[2] = bflo(ov.y) * rs * w0.z * siluf_(bflo(zv.y)); y[3] = bfhi(ov.y) * rs * w0.w * siluf_(bfhi(zv.y));
        y[4] = bflo(ov.z) * rs * w1.x * siluf_(bflo(zv.z)); y[5] = bfhi(ov.z) * rs * w1.y * siluf_(bfhi(zv.z)); y[6] = bflo(ov.w) * rs * w1.z * siluf_(bflo(zv.w)); y[7] = bfhi(ov.w) * rs * w1.w * siluf_(bfhi(zv.w));
        *(GAS bf16x8*)(MX + (size_t)row * DM + 512 + hh * HD + ck * 8) = pack8(y);
    }
}


__device__ __forceinline__ void gdn_sample_load(Frame& F, int l, int task, float (&S)[32]) {
    const int b = task >> 2, h = task & 3, j = F.tid & 127, rq = F.tid >> 7;
    const float* S0 = F.in[I_GS] + (size_t)((l * 128 + b) * 4 + h) * 16384 + (size_t)(32 * rq) * 128 + j;
#pragma unroll
    for (int ii = 0; ii < 32; ++ii) S[ii] = S0[ii * 128];
}
__device__ __forceinline__ void gdn_sample(Frame& F, int l, int task, float (&S)[32]) {
    LAS float* L = (LAS float*)F.lds;
    LAS float* RAW = L;
    LAS float* QS = L + 7 * 384;
    LAS float* KS = QS + 512; LAS float* VS = KS + 512; LAS float* OS = VS + 512;
    LAS float* RED = OS + 512;
    LAS float* NRM = RED + 512;
    int tid = F.tid; asm volatile("" : "+v"(tid)); const int lane = tid & 63, wv = tid >> 6;
    const int b = task >> 2, h = task & 3; const int m0 = MP + b * 4;
    const bf16* P = (const bf16*)(F.ws + WS_P); const float* AB = (const float*)(F.ws + WS_AB); bf16* MX = (bf16*)(F.ws + WS_X);
    const int j = tid & 127, rq = tid >> 7;
    float cwv[3][4], gA[4], gB[4]; float zv, gnw;
    const float galog = F.in[I_GALOG][l * 4 + h], dtb = F.in[I_GDTB][l * 4 + h];
    {
        const int tok = tid >> 7, ch = tid & 127;
#pragma unroll
        for (int ten = 0; ten < 3; ++ten)
#pragma unroll
            for (int jj = 0; jj < 4; ++jj) cwv[ten][jj] = F.in[I_GCW][(size_t)(l * 4 + jj) * 1536 + ten * 512 + h * HD + ch];
#pragma unroll
        for (int t = 0; t < 4; ++t) { gA[t] = AB[(size_t)(m0 + t) * 8 + h]; gB[t] = AB[(size_t)(m0 + t) * 8 + 4 + h]; }
        zv = bf2f(P[(size_t)(m0 + tok) * NPJ + PZ + h * HD + ch]); gnw = F.in[I_GNW][l * HD + ch];
    }
    {
        float rv[6];
#pragma unroll
        for (int k6 = 0; k6 < 6; ++k6) { const int idx = tid + k6 * NTHR; const int r = idx / 384, cc = idx % 384, ten = cc >> 7, ch = cc & 127;
            float v = 0.f;
            if (idx < 7 * 384) { if (r < 3) v = F.in[I_GC][(size_t)((l * 128 + b) * 3 + r) * 1536 + ten * 512 + h * HD + ch]; else v = bf2f(P[(size_t)(m0 + r - 3) * NPJ + PQ + ten * 512 + h * HD + ch]); }
            rv[k6] = v; }
#pragma unroll
        for (int k6 = 0; k6 < 6; ++k6) { const int idx = tid + k6 * NTHR; if (idx < 7 * 384) RAW[idx] = rv[k6]; }
    }
    __syncthreads();
    if (tid < 384) { const int ten = tid >> 7, ch = tid & 127;
#pragma unroll
        for (int j = 0; j < 3; ++j) F.out[O_SGC + (size_t)((l * 128 + b) * 3 + j) * 1536 + ten * 512 + h * HD + ch] = RAW[(4 + j) * 384 + tid]; }
    float cq, ck, cv;
    {
        const int tok = tid >> 7, ch = tid & 127; float r3[3];
#pragma unroll
        for (int ten = 0; ten < 3; ++ten) { float a = 0.f;
#pragma unroll
            for (int j = 0; j < 4; ++j) a += cwv[ten][j] * RAW[(tok + j) * 384 + ten * 128 + ch];
            r3[ten] = siluf_(a); }
        cq = r3[0]; ck = r3[1]; cv = r3[2];
        const float sq = wave_sum(cq * cq), sk = wave_sum(ck * ck);
        if (lane == 0) { NRM[wv * 4] = sq; NRM[wv * 4 + 1] = sk; }
    }
    __syncthreads();
    {
        const int tok = tid >> 7, ch = tid & 127;
        const float sq = NRM[(2 * tok) * 4] + NRM[(2 * tok + 1) * 4], sk = NRM[(2 * tok) * 4 + 1] + NRM[(2 * tok + 1) * 4 + 1];
        QS[tok * 128 + ch] = cq * frsq(sq + EPS) * 0.08838834764831845f; KS[tok * 128 + ch] = ck * frsq(sk + EPS); VS[tok * 128 + ch] = cv;
    }
    __syncthreads();
    float egv[4], bev[4];
    {
        const float al = -__expf(galog);
#pragma unroll
        for (int t = 0; t < 4; ++t) { const float a = gA[t], bb = gB[t]; egv[t] = __expf(al * softplus_fast(a + dtb)); bev[t] = frcp(1.0f + __expf(-bb)); }
    }
#pragma unroll
    for (int t = 0; t < 4; ++t) {
        const float eg = egv[t], be = bev[t];
        float part = 0.f;
#pragma unroll
        for (int ii = 0; ii < 32; ++ii) { S[ii] *= eg; part += S[ii] * KS[t * 128 + 32 * rq + ii]; }
        RED[rq * 128 + j] = part;
        __syncthreads();
        const float vn = be * (VS[t * 128 + j] - (RED[j] + RED[128 + j] + RED[256 + j] + RED[384 + j]));
        __syncthreads();
        part = 0.f;
#pragma unroll
        for (int ii = 0; ii < 32; ++ii) { S[ii] += KS[t * 128 + 32 * rq + ii] * vn; part += S[ii] * QS[t * 128 + 32 * rq + ii]; }
        RED[rq * 128 + j] = part;
        __syncthreads();
        if (rq == 0) OS[t * 128 + j] = RED[j] + RED[128 + j] + RED[256 + j] + RED[384 + j];
        __syncthreads();
    }
    float* So = F.out + O_SGS + (size_t)((l * 128 + b) * 4 + h) * 16384;
#pragma unroll
    for (int ii = 0; ii < 32; ++ii) So[(size_t)(32 * rq + ii) * 128 + j] = S[ii];
    {
        const int tok = tid >> 7, ch = tid & 127; const float o = OS[tok * 128 + ch];
        const float ss = wave_sum(o * o);
        if (lane == 0) NRM[wv * 4 + 2] = ss;
        __syncthreads();
        const float tot = NRM[(2 * tok) * 4 + 2] + NRM[(2 * tok + 1) * 4 + 2];
        MX[(size_t)(m0 + tok) * DM + 512 + h * HD + ch] = (bf16)f2bf(o * (frsq(tot * (1.f / HD) + EPS)) * gnw * siluf_(zv));
    }
    __syncthreads();
}

struct S5Par { float ar, ai; float bbr[16], bbi[16]; };
__device__ __forceinline__ void s5_params(Frame& F, int l, int g, int p, S5Par& q) {
    const float lr = fminf(F.in[I_LRE][(l * 16 + g) * 64 + p], -1e-4f), li = F.in[I_LIM][(l * 16 + g) * 64 + p];
    const float dt = expf(F.in[I_LDT][l * 16 + g]);
    const float mag = __expf(lr * dt), ph = li * dt; q.ar = mag * __cosf(ph); q.ai = mag * __sinf(ph);
    const float den = lr * lr + li * li;
    const float fr = ((q.ar - 1.0f) * lr + q.ai * li) / den, fi = (q.ai * lr - (q.ar - 1.0f) * li) / den;
    const float* br = F.in[I_BRE] + (size_t)((l * 16 + g) * 64 + p) * 16; const float* bi = F.in[I_BIM] + (size_t)((l * 16 + g) * 64 + p) * 16;
#pragma unroll
    for (int h4 = 0; h4 < 4; ++h4) { const f32x4 r = *(const GAS f32x4*)(br + 4 * h4), i = *(const GAS f32x4*)(bi + 4 * h4);
#pragma unroll
        for (int e = 0; e < 4; ++e) { q.bbr[4 * h4 + e] = fr * r[e] - fi * i[e]; q.bbi[4 * h4 + e] = fr * i[e] + fi * r[e]; } }
}
__device__ __forceinline__ void s5_stage_u(Frame& F, LAS float* U, int m0, int nrows) {
    const bf16* P = (const bf16*)(F.ws + WS_P);
    for (int idx = F.tid; idx < nrows * 32; idx += NTHR) { const int r = idx >> 5, ck = idx & 31;
        const v4u w = *(const GAS v4u*)(P + (size_t)(m0 + r) * NPJ + PU + ck * 8);
        *(LAS f32x4*)(U + r * 256 + ck * 8) = (f32x4){bflo(w.x), bfhi(w.x), bflo(w.y), bfhi(w.y)}; *(LAS f32x4*)(U + r * 256 + ck * 8 + 4) = (f32x4){bflo(w.z), bfhi(w.z), bflo(w.w), bfhi(w.w)}; }
}
__device__ __forceinline__ void s5_step(const S5Par& q, const LAS float* urow, float& xr, float& xi) {
    const f32x4 u0 = *(const LAS f32x4*)urow, u1 = *(const LAS f32x4*)(urow + 4), u2 = *(const LAS f32x4*)(urow + 8), u3 = *(const LAS f32x4*)(urow + 12);
    float br = 0.f, bi = 0.f;
#pragma unroll
    for (int e = 0; e < 4; ++e) { br += q.bbr[e] * u0[e]; bi += q.bbi[e] * u0[e]; br += q.bbr[4 + e] * u1[e]; bi += q.bbi[4 + e] * u1[e]; br += q.bbr[8 + e] * u2[e]; bi += q.bbi[8 + e] * u2[e]; br += q.bbr[12 + e] * u3[e]; bi += q.bbi[12 + e] * u3[e]; }
    const float nr = q.ar * xr - q.ai * xi + br, ni = q.ar * xi + q.ai * xr + bi; xr = nr; xi = ni;
}
__device__ __forceinline__ void s5_pass1(Frame& F, int l, int b, int c) {
    LAS float* U = (LAS float*)F.lds;
    int tid = F.tid; asm volatile("" : "+v"(tid)); const int lane = tid & 63, g0 = 2 * (tid >> 6);
    S5Par q0, q1; s5_params(F, l, g0, lane, q0); s5_params(F, l, g0 + 1, lane, q1);
    s5_stage_u(F, U, b * SEQ + c * 64, 64);
    __syncthreads();
    float* E = (float*)(F.ws + WS_S5E);
    float xr0 = 0.f, xi0 = 0.f, xr1 = 0.f, xi1 = 0.f;
#pragma unroll 4
    for (int t = 0; t < 64; ++t) { s5_step(q0, U + t * 256 + 16 * g0, xr0, xi0); s5_step(q1, U + t * 256 + 16 * g0 + 16, xr1, xi1); }
    E[(size_t)((b * 32 + c) * 16 + g0) * 128 + lane] = xr0; E[(size_t)((b * 32 + c) * 16 + g0) * 128 + 64 + lane] = xi0;
    E[(size_t)((b * 32 + c) * 16 + g0 + 1) * 128 + lane] = xr1; E[(size_t)((b * 32 + c) * 16 + g0 + 1) * 128 + 64 + lane] = xi1;
    __syncthreads();
}
constexpr int S5_U = 0, S5_XT = 65536, S5_YG = S5_XT + 8 * 16 * S256;
static_assert(S5_YG + 64 * S512 <= LDSCTL_OFF, "s5 lds");
template <bool SAMPLE>
__device__ __forceinline__ void s5_pass2(Frame& F, int l, int ua, int ub) {
    LAS unsigned char* L = F.lds; LAS float* U = (LAS float*)(L + S5_U); LAS unsigned char* XT = L + S5_XT + (F.tid >> 6) * (16 * S256); LAS unsigned char* YG = L + S5_YG;
    int tid = F.tid; asm volatile("" : "+v"(tid)); const int lane = tid & 63, wv = tid >> 6, fr = lane & 15, fq = lane >> 4;
    constexpr int NSUB = SAMPLE ? 1 : 4;
    const int m0 = SAMPLE ? MP + 4 * ua : ua * SEQ + ub * 64;
    constexpr int NTT = SAMPLE ? 4 : 16;
    S5Par qq[2]; bf16x8 cbb[2][4]; float dskk[2];
#pragma unroll
    for (int gi = 0; gi < 2; ++gi) {
        const int g = 2 * wv + gi; s5_params(F, l, g, lane, qq[gi]);
        bf16x8 (&cb)[4] = cbb[gi];
#pragma unroll
        for (int ks = 0; ks < 4; ++ks) { const float* src = F.in[ks < 2 ? I_CRE : I_CIM] + (size_t)((l * 16 + g) * 16 + fr) * 64 + 32 * (ks & 1) + 8 * fq;
            const f32x4 c0 = *(const GAS f32x4*)src, c1 = *(const GAS f32x4*)(src + 4); const float sg = ks < 2 ? 1.f : -1.f;
            float f[8] = {sg * c0.x, sg * c0.y, sg * c0.z, sg * c0.w, sg * c1.x, sg * c1.y, sg * c1.z, sg * c1.w}; cb[ks] = pack8(f); }
        dskk[gi] = F.in[I_S5D][l * 256 + 16 * g + fr];
    }
    s5_stage_u(F, U, m0, SAMPLE ? 4 : 64);
    __syncthreads();
    const float* E = (const float*)(F.ws + WS_S5E);
#pragma unroll
    for (int gi = 0; gi < 2; ++gi) {
        const int g = 2 * wv + gi; const S5Par& q = qq[gi]; const bf16x8 (&cb)[4] = cbb[gi];
        const float dsk = dskk[gi];
        float xr = 0.f, xi = 0.f;
        if (!SAMPLE) {
            float pr = q.ar, pi = q.ai;
#pragma unroll
            for (int s = 0; s < 6; ++s) { const float nr = pr * pr - pi * pi, ni = 2.f * pr * pi; pr = nr; pi = ni; }
            float er[31], ei[31];
            const float* Eb = E + (size_t)((ua * 32) * 16 + g) * 128 + lane; asm volatile("" : "+v"(Eb));
#pragma unroll
            for (int cc = 0; cc < 31; ++cc) { er[cc] = Eb[cc * 2048]; ei[cc] = Eb[cc * 2048 + 64]; }
#pragma unroll
            for (int cc = 0; cc < 31; ++cc) { const float nr = pr * xr - pi * xi + er[cc], ni = pr * xi + pi * xr + ei[cc]; xr = cc < ub ? nr : xr; xi = cc < ub ? ni : xi; }
        }
        for (int sub = 0; sub < NSUB; ++sub) {
#pragma unroll
            for (int tt = 0; tt < NTT; ++tt) {
                if (SAMPLE && (tt & 3) == 0) { const int bs = ua; xr = F.in[I_S5RE][(size_t)((l * 128 + bs) * 16 + g) * 64 + lane]; xi = F.in[I_S5IM][(size_t)((l * 128 + bs) * 16 + g) * 64 + lane]; }
                s5_step(q, U + (16 * sub + tt) * 256 + 16 * g, xr, xi);
                *(LAS bf16*)(XT + t256(tt, lane)) = (bf16)f2bf(xr); *(LAS bf16*)(XT + t256(tt, 64 + lane)) = (bf16)f2bf(xi);
                if (SAMPLE && (tt & 3) == 3) { const int bs = ua; F.out[O_SS5RE + (size_t)((l * 128 + bs) * 16 + g) * 64 + lane] = xr; F.out[O_SS5IM + (size_t)((l * 128 + bs) * 16 + g) * 64 + lane] = xi; }
            }
            f32x4 acc = (f32x4){0.f, 0.f, 0.f, 0.f};
#pragma unroll
            for (int ks = 0; ks < 4; ++ks) { const bf16x8 af = *(const LAS bf16x8*)(XT + t256(fr, 32 * ks + 8 * fq)); acc = MFMA16(af, cb[ks], acc); }
#pragma unroll
            for (int r = 0; r < 4; ++r) { const int t = 16 * sub + 4 * fq + r; if (SAMPLE && t >= 4) continue; const float y = acc[r] + dsk * U[t * 256 + 16 * g + fr];
                *(LAS bf16*)(YG + t512(t, 16 * g + fr)) = (bf16)f2bf(gelu_tanh(y)); }
            asm volatile("" ::: "memory");
        }
        if (!SAMPLE && ub == 31) { F.out[O_PS5RE + (size_t)((l * 8 + ua) * 16 + g) * 64 + lane] = xr; F.out[O_PS5IM + (size_t)((l * 8 + ua) * 16 + g) * 64 + lane] = xi; }
    }
    __syncthreads();
    {
        const bf16* WG = (const bf16*)(F.ws + WS_WGLU); bf16* MX = (bf16*)(F.ws + WS_X);
#pragma unroll 1
        for (int ni = 0; ni < 2; ++ni) {
            const int nt = 2 * wv + ni; bf16x8 bw[8];
#pragma unroll
            for (int ks = 0; ks < 8; ++ks) bw[ks] = __builtin_bit_cast(bf16x8, *(const GAS v4u*)(WG + (size_t)(16 * nt + fr) * 256 + 32 * ks + 8 * fq));
            const float bg = F.in[I_BGLU][l * 256 + 16 * nt + fr];
#pragma unroll 1
            for (int mi = 0; mi < NSUB; ++mi) {
                f32x4 acc = (f32x4){0.f, 0.f, 0.f, 0.f};
#pragma unroll
                for (int ks = 0; ks < 8; ++ks) { const bf16x8 af = *(const LAS bf16x8*)(YG + t512(16 * mi + fr, 32 * ks + 8 * fq)); acc = MFMA16(af, bw[ks], acc); }
#pragma unroll
                for (int r = 0; r < 4; ++r) { const int t = 16 * mi + 4 * fq + r; if (SAMPLE && t >= 4) continue; const float yg = bf2f(*(const LAS bf16*)(YG + t512(t, 16 * nt + fr)));
                    MX[(size_t)(m0 + t) * DM + 16 * nt + fr] = (bf16)f2bf(yg * sigmoidf_(acc[r] + bg)); }
            }
        }
    }
    __syncthreads();
}

constexpr int LR_RAW = 0, LR_XC = 73728, LR_AGG = 139264;
struct LruW { float wa[32], wx[32], ba, bx, c8, cb, cw[4]; };
__device__ __forceinline__ void lru_weights(Frame& F, int l, int j, LruW& w) {
    const int blk = j >> 5, jj = j & 31;
#pragma unroll
    for (int i = 0; i < 32; ++i) { w.wa[i] = F.in[I_LWA][(size_t)((l * 8 + blk) * 32 + i) * 32 + jj]; w.wx[i] = F.in[I_LWX][(size_t)((l * 8 + blk) * 32 + i) * 32 + jj]; }
    w.ba = F.in[I_LBA][l * 256 + j]; w.bx = F.in[I_LBX][l * 256 + j]; w.c8 = -8.0f * softplusf_(-F.in[I_LLAM][l * 256 + j]); w.cb = F.in[I_LCB][l * 256 + j];
#pragma unroll
    for (int k = 0; k < 4; ++k) w.cw[k] = F.in[I_LCW][(l * 4 + k) * 256 + j];
}
__device__ __forceinline__ void lru_gate(const LruW& w, const LAS float* xrow, float xown, bool reset, float& a, float& bt) {
    float ra = w.ba, rx = w.bx;
#pragma unroll
    for (int i4 = 0; i4 < 8; ++i4) { const f32x4 xv = *(const LAS f32x4*)(xrow + 4 * i4);
#pragma unroll
        for (int e = 0; e < 4; ++e) { ra += w.wa[4 * i4 + e] * xv[e]; rx += w.wx[4 * i4 + e] * xv[e]; } }
    const float r = sigmoidf_(ra), gi = sigmoidf_(rx);
    const float la = w.c8 * r; a = __expf(la);
    const float mult = reset ? 1.0f : __builtin_amdgcn_sqrtf(fmaxf(1.0f - a * a, 0.f));
    bt = mult * gi * xown;
}
template <int PASS>
__device__ __forceinline__ void lru_pass(Frame& F, int l, int b, int c) {
    LAS float* RAW = (LAS float*)(F.lds + LR_RAW); LAS float* XC = (LAS float*)(F.lds + LR_XC); LAS float* AGG = (LAS float*)(F.lds + LR_AGG);
    int tid = F.tid; asm volatile("" : "+v"(tid)); const int j = tid & 255, hh = tid >> 8; const int row0 = b * SEQ + c * 64;
    const bf16* P = (const bf16*)(F.ws + WS_P); bf16* MX = (bf16*)(F.ws + WS_X); float* LA = (float*)(F.ws + WS_LAGG);
    for (int idx = tid; idx < 67 * 32; idx += NTHR) { const int r = idx >> 5, ck = idx & 31, tt = c * 64 - 3 + r;
        v4u w = (v4u){0u, 0u, 0u, 0u}; if (tt >= 0) w = *(const GAS v4u*)(P + (size_t)(b * SEQ + tt) * NPJ + PXL + ck * 8);
        *(LAS f32x4*)(RAW + r * 256 + ck * 8) = (f32x4){bflo(w.x), bfhi(w.x), bflo(w.y), bfhi(w.y)}; *(LAS f32x4*)(RAW + r * 256 + ck * 8 + 4) = (f32x4){bflo(w.z), bfhi(w.z), bflo(w.w), bfhi(w.w)}; }
    __syncthreads();
    LruW w; lru_weights(F, l, j, w);
    for (int ii = 0; ii < 32; ++ii) { const int i = 32 * hh + ii;
        XC[i * 256 + j] = w.cb + w.cw[0] * RAW[i * 256 + j] + w.cw[1] * RAW[(i + 1) * 256 + j] + w.cw[2] * RAW[(i + 2) * 256 + j] + w.cw[3] * RAW[(i + 3) * 256 + j]; }
    __syncthreads();
    float A = 1.f, B = 0.f; float hl[32], ca[32];
#pragma unroll
    for (int ii = 0; ii < 32; ++ii) { const int i = 32 * hh + ii; float a, bt;
        lru_gate(w, XC + i * 256 + (j & ~31), XC[i * 256 + j], (c == 0 && i == 0), a, bt);
        B = a * B + bt; A *= a; if (PASS == 2) { hl[ii] = B; ca[ii] = A; }
        if (ii & 1) __builtin_amdgcn_sched_barrier(0); }
    if (hh == 0) { AGG[j] = A; AGG[256 + j] = B; }
    __syncthreads();
    if (PASS == 1) {
        if (hh == 1) { const float A0 = AGG[j], B0 = AGG[256 + j]; LA[(size_t)((b * 32 + c) * 2) * 256 + j] = A0 * A; LA[(size_t)((b * 32 + c) * 2 + 1) * 256 + j] = A * B0 + B; }
    } else {
        float H = 0.f;
        {
            float la[31], lb[31];
            const float* Lb = LA + (size_t)(b * 32 * 2) * 256 + j; asm volatile("" : "+v"(Lb));
#pragma unroll
            for (int cc = 0; cc < 31; ++cc) { la[cc] = Lb[cc * 512]; lb[cc] = Lb[cc * 512 + 256]; }
#pragma unroll
            for (int cc = 0; cc < 31; ++cc) { const float nh = la[cc] * H + lb[cc]; H = cc < c ? nh : H; }
        }
        if (hh == 1) H = AGG[j] * H + AGG[256 + j];
#pragma unroll
        for (int ii = 0; ii < 32; ++ii) { const int i = 32 * hh + ii; const float hv = hl[ii] + ca[ii] * H;
            const float gt = bf2f(P[(size_t)(row0 + i) * NPJ + PGL + j]);
            MX[(size_t)(row0 + i) * DM + 256 + j] = (bf16)f2bf(hv * gelu_tanh(gt));
            if (c == 31 && hh == 1 && ii == 31) F.out[O_PLRUH + (size_t)(l * 8 + b) * 256 + j] = hv; }
        if (c == 31 && hh == 0) {
#pragma unroll
            for (int k = 0; k < 3; ++k) F.out[O_PLRUC + (size_t)((l * 8 + b) * 3 + k) * 256 + j] = RAW[(64 + k) * 256 + j]; }
    }
    __syncthreads();
}
__device__ __forceinline__ void lru_sample(Frame& F, int l, int q) {
    LAS float* XC = (LAS float*)F.lds;
    int tid = F.tid; asm volatile("" : "+v"(tid)); const int j = tid & 255, hh = tid >> 8;
    const bf16* P = (const bf16*)(F.ws + WS_P); bf16* MX = (bf16*)(F.ws + WS_X);
    LruW w; const int bs = q;
    if (hh == 0) {
        lru_weights(F, l, j, w);
        float r[7];
#pragma unroll
        for (int k = 0; k < 3; ++k) r[k] = F.in[I_LRUC][(size_t)((l * 128 + bs) * 3 + k) * 256 + j];
#pragma unroll
        for (int t = 0; t < 4; ++t) r[3 + t] = bf2f(P[(size_t)(MP + bs * 4 + t) * NPJ + PXL + j]);
#pragma unroll
        for (int t = 0; t < 4; ++t) XC[t * 256 + j] = w.cb + w.cw[0] * r[t] + w.cw[1] * r[t + 1] + w.cw[2] * r[t + 2] + w.cw[3] * r[t + 3];
#pragma unroll
        for (int k = 0; k < 3; ++k) F.out[O_SLRUC + (size_t)((l * 128 + bs) * 3 + k) * 256 + j] = r[4 + k];
    }
    float H = 0.f, gtv[4] = {0.f, 0.f, 0.f, 0.f};
    if (hh == 0) {
        H = F.in[I_LRUH][(size_t)(l * 128 + bs) * 256 + j];
#pragma unroll
        for (int t = 0; t < 4; ++t) gtv[t] = bf2f(P[(size_t)(MP + bs * 4 + t) * NPJ + PGL + j]);
    }
    __syncthreads();
    if (hh == 0) {
#pragma unroll
        for (int t = 0; t < 4; ++t) { float a, bt;
            lru_gate(w, XC + t * 256 + (j & ~31), XC[t * 256 + j], false, a, bt); H = a * H + bt;
            const float gt = gtv[t];
            MX[(size_t)(MP + bs * 4 + t) * DM + 256 + j] = (bf16)f2bf(H * gelu_tanh(gt)); }
        F.out[O_SLRUH + (size_t)(l * 128 + bs) * 256 + j] = H;
    }
    __syncthreads();
}

constexpr int S5M_U = 0, S5M_XT = 64 * S512, S5M_YG = S5M_XT + 8 * 16 * S256;
static_assert(S5M_YG + 64 * S512 <= LDSCTL_OFF, "s5m lds");
__device__ __forceinline__ void cmul_acc(float ar, float ai, float br, float bi, float& cr, float& ci) { cr += ar * br - ai * bi; ci += ar * bi + ai * br; }
template <int MODE>
__device__ __forceinline__ void s5m_unit(Frame& F, int l, int ua, int ub) {
    LAS unsigned char* L = F.lds;
    int tid = F.tid; asm volatile("" : "+v"(tid)); const int lane = tid & 63, wv = tid >> 6, fr = lane & 15, fq = lane >> 4;
    LAS unsigned char* U16 = L + S5M_U; LAS unsigned char* XT = L + S5M_XT + wv * (16 * S256); LAS float* SCR = (LAS float*)XT; LAS unsigned char* YG = L + S5M_YG;
    constexpr bool SAMPLE = MODE == 3; constexpr int NSUB = SAMPLE ? 1 : 4;
    const int m0 = SAMPLE ? MP + 4 * ua : ua * SEQ + ub * 64;
    { const bf16* P = (const bf16*)(F.ws + WS_P); constexpr int nrows = SAMPLE ? 4 : 64; constexpr int NK = (nrows * 32 + NTHR - 1) / NTHR;
      v4u su[NK];
#pragma unroll
      for (int k = 0; k < NK; ++k) { const int idx = tid + k * NTHR; const int r = idx >> 5, ck = idx & 31; if (idx < nrows * 32) su[k] = *(const GAS v4u*)(P + (size_t)(m0 + r) * NPJ + PU + ck * 8); }
#pragma unroll
      for (int k = 0; k < NK; ++k) { const int idx = tid + k * NTHR; const int r = idx >> 5, ck = idx & 31; if (idx < nrows * 32) *(LAS v4u*)(U16 + r * S512 + ck * 16) = su[k]; } }
    __syncthreads();
    float* Eo = (float*)(F.ws + WS_S5E);
#pragma unroll 1
    for (int gi = 0; gi < 2; ++gi) {
        const int g = 2 * wv + gi;
        S5Par q; s5_params(F, l, g, lane, q);
        bf16x8 bfrag[8];
#pragma unroll
        for (int part = 0; part < 2; ++part) {
#pragma unroll
            for (int h4 = 0; h4 < 4; ++h4) *(LAS f32x4*)(SCR + lane * 16 + 4 * h4) = part == 0 ? (f32x4){q.bbr[4 * h4], q.bbr[4 * h4 + 1], q.bbr[4 * h4 + 2], q.bbr[4 * h4 + 3]} : (f32x4){q.bbi[4 * h4], q.bbi[4 * h4 + 1], q.bbi[4 * h4 + 2], q.bbi[4 * h4 + 3]};
#pragma unroll
            for (int nt = 0; nt < 4; ++nt) { const LAS float* src = SCR + (16 * nt + fr) * 16 + 8 * (fq & 1);
                const f32x4 v0 = *(const LAS f32x4*)src, v1 = *(const LAS f32x4*)(src + 4); float f[8] = {v0.x, v0.y, v0.z, v0.w, v1.x, v1.y, v1.z, v1.w};
                if (fq >= 2) {
#pragma unroll
                    for (int e = 0; e < 8; ++e) f[e] = f[e] - bf2f(f2bf(f[e]));
                }
                bfrag[4 * part + nt] = pack8(f); }
        }
        float l1r[4], l1i[4], xinr[4], xini[4];
        *(LAS f32x2_t*)(SCR + lane * 2) = (f32x2_t){q.ar, q.ai};
        if (MODE == 2) {
            float pr = q.ar, pi = q.ai;
#pragma unroll
            for (int s = 0; s < 6; ++s) { const float nr = pr * pr - pi * pi, ni = 2.f * pr * pi; pr = nr; pi = ni; }
            float er[31], ei[31];
            const float* Eb = Eo + (size_t)((ua * 32) * 16 + g) * 128 + lane; asm volatile("" : "+v"(Eb));
#pragma unroll
            for (int cc = 0; cc < 31; ++cc) { er[cc] = Eb[cc * 2048]; ei[cc] = Eb[cc * 2048 + 64]; }
            float xr = 0.f, xi = 0.f;
#pragma unroll
            for (int cc = 0; cc < 31; ++cc) { const float nr = pr * xr - pi * xi + er[cc], ni = pr * xi + pi * xr + ei[cc]; xr = cc < ub ? nr : xr; xi = cc < ub ? ni : xi; }
            *(LAS f32x2_t*)(SCR + 128 + lane * 2) = (f32x2_t){xr, xi};
        }
#pragma unroll
        for (int s = 0; s < 4; ++s) { const f32x2_t lv = *(const LAS f32x2_t*)(SCR + (16 * s + fr) * 2); l1r[s] = lv.x; l1i[s] = lv.y;
            if (MODE == 2) { const f32x2_t xv = *(const LAS f32x2_t*)(SCR + 128 + (16 * s + fr) * 2); xinr[s] = xv.x; xini[s] = xv.y; }
            else if (MODE == 3) { xinr[s] = F.in[I_S5RE][(size_t)((l * 128 + ua) * 16 + g) * 64 + 16 * s + fr]; xini[s] = F.in[I_S5IM][(size_t)((l * 128 + ua) * 16 + g) * 64 + 16 * s + fr]; }
            else { xinr[s] = 0.f; xini[s] = 0.f; } }
        float l2r[4], l2i[4], l3r[4], l3i[4], l4r[4], l4i[4], l8r[4], l8i[4], lpr[4], lpi[4];
#pragma unroll
        for (int s = 0; s < 4; ++s) {
            l2r[s] = l1r[s] * l1r[s] - l1i[s] * l1i[s]; l2i[s] = 2.f * l1r[s] * l1i[s];
            l3r[s] = l2r[s] * l1r[s] - l2i[s] * l1i[s]; l3i[s] = l2r[s] * l1i[s] + l2i[s] * l1r[s];
            l4r[s] = l2r[s] * l2r[s] - l2i[s] * l2i[s]; l4i[s] = 2.f * l2r[s] * l2i[s];
            l8r[s] = l4r[s] * l4r[s] - l4i[s] * l4i[s]; l8i[s] = 2.f * l4r[s] * l4i[s];
            const float l12r = l8r[s] * l4r[s] - l8i[s] * l4i[s], l12i = l8r[s] * l4i[s] + l8i[s] * l4r[s];
            lpr[s] = fq == 0 ? 1.f : fq == 1 ? l4r[s] : fq == 2 ? l8r[s] : l12r; lpi[s] = fq == 0 ? 0.f : fq == 1 ? l4i[s] : fq == 2 ? l8i[s] : l12i;
        }
        bf16x8 cb[4]; float dsk = 0.f;
        if (MODE != 1) {
#pragma unroll
            for (int ks = 0; ks < 4; ++ks) { const float* src = F.in[ks < 2 ? I_CRE : I_CIM] + (size_t)((l * 16 + g) * 16 + fr) * 64 + 32 * (ks & 1) + 8 * fq;
                const f32x4 c0 = *(const GAS f32x4*)src, c1 = *(const GAS f32x4*)(src + 4); const float sg = ks < 2 ? 1.f : -1.f;
                float f[8] = {sg * c0.x, sg * c0.y, sg * c0.z, sg * c0.w, sg * c1.x, sg * c1.y, sg * c1.z, sg * c1.w}; cb[ks] = pack8(f); }
            dsk = F.in[I_S5D][l * 256 + 16 * g + fr];
        }
#pragma unroll 1
        for (int sub = 0; sub < NSUB; ++sub) {
            const bf16x8 au = *(const LAS bf16x8*)(U16 + (16 * sub + fr) * S512 + (16 * g + 8 * (fq & 1)) * 2);
            f32x4 d[8];
#pragma unroll
            for (int nt = 0; nt < 8; ++nt) d[nt] = MFMA16(au, bfrag[nt], ((f32x4){0.f, 0.f, 0.f, 0.f}));
            float Lr[4][4], Li[4][4], Er[4], Ei[4];
#pragma unroll
            for (int s = 0; s < 4; ++s) {
                Lr[s][0] = d[s][0]; Li[s][0] = d[4 + s][0];
#pragma unroll
                for (int r = 1; r < 4; ++r) { Lr[s][r] = d[s][r]; Li[s][r] = d[4 + s][r]; cmul_acc(l1r[s], l1i[s], Lr[s][r - 1], Li[s][r - 1], Lr[s][r], Li[s][r]); }
                Er[s] = Lr[s][3]; Ei[s] = Li[s][3];
            }
            {
                float pr_[4], pi_[4];
#pragma unroll
                for (int s = 0; s < 4; ++s) { pr_[s] = __shfl_up(Er[s], 16); pi_[s] = __shfl_up(Ei[s], 16); }
#pragma unroll
                for (int s = 0; s < 4; ++s) { float ar_ = 0.f, ai_ = 0.f; cmul_acc(l4r[s], l4i[s], pr_[s], pi_[s], ar_, ai_); if (fq >= 1) { Er[s] += ar_; Ei[s] += ai_; } }
#pragma unroll
                for (int s = 0; s < 4; ++s) { pr_[s] = __shfl_up(Er[s], 32); pi_[s] = __shfl_up(Ei[s], 32); }
#pragma unroll
                for (int s = 0; s < 4; ++s) { float ar_ = 0.f, ai_ = 0.f; cmul_acc(l8r[s], l8i[s], pr_[s], pi_[s], ar_, ai_); if (fq >= 2) { Er[s] += ar_; Ei[s] += ai_; } }
#pragma unroll
                for (int s = 0; s < 4; ++s) { pr_[s] = __shfl_up(Er[s], 16); pi_[s] = __shfl_up(Ei[s], 16); }
#pragma unroll
                for (int s = 0; s < 4; ++s) { float xr = fq >= 1 ? pr_[s] : 0.f, xi = fq >= 1 ? pi_[s] : 0.f; cmul_acc(lpr[s], lpi[s], xinr[s], xini[s], xr, xi); Er[s] = xr; Ei[s] = xi; }
            }
#pragma unroll
            for (int s = 0; s < 4; ++s) {
                cmul_acc(l1r[s], l1i[s], Er[s], Ei[s], Lr[s][0], Li[s][0]); cmul_acc(l2r[s], l2i[s], Er[s], Ei[s], Lr[s][1], Li[s][1]);
                cmul_acc(l3r[s], l3i[s], Er[s], Ei[s], Lr[s][2], Li[s][2]); cmul_acc(l4r[s], l4i[s], Er[s], Ei[s], Lr[s][3], Li[s][3]);
            }
#pragma unroll
            for (int s = 0; s < 4; ++s) { xinr[s] = __shfl(Lr[s][3], fr + (SAMPLE ? 0 : 48)); xini[s] = __shfl(Li[s][3], fr + (SAMPLE ? 0 : 48)); }
            if (MODE != 1) {
#pragma unroll
                for (int s = 0; s < 4; ++s)
#pragma unroll
                    for (int r = 0; r < 4; ++r) { *(LAS bf16*)(XT + t256(4 * fq + r, 16 * s + fr)) = (bf16)f2bf(Lr[s][r]); *(LAS bf16*)(XT + t256(4 * fq + r, 64 + 16 * s + fr)) = (bf16)f2bf(Li[s][r]); }
                f32x4 acc = (f32x4){0.f, 0.f, 0.f, 0.f};
#pragma unroll
                for (int ks = 0; ks < 4; ++ks) { const bf16x8 af = *(const LAS bf16x8*)(XT + t256(fr, 32 * ks + 8 * fq)); acc = MFMA16(af, cb[ks], acc); }
#pragma unroll
                for (int r = 0; r < 4; ++r) { const int t = 16 * sub + 4 * fq + r; if (SAMPLE && t >= 4) continue;
                    const float y = acc[r] + dsk * bf2f(*(const LAS bf16*)(U16 + t * S512 + (16 * g + fr) * 2));
                    *(LAS bf16*)(YG + t512(t, 16 * g + fr)) = (bf16)f2bf(gelu_tanh(y)); }
                asm volatile("" ::: "memory");
            }
        }
        if (fq == 0) {
#pragma unroll
            for (int s = 0; s < 4; ++s) { const int p = 16 * s + fr;
                if (MODE == 1) { Eo[(size_t)((ua * 32 + ub) * 16 + g) * 128 + p] = xinr[s]; Eo[(size_t)((ua * 32 + ub) * 16 + g) * 128 + 64 + p] = xini[s]; }
                if (MODE == 2 && ub == 31) { F.out[O_PS5RE + (size_t)((l * 8 + ua) * 16 + g) * 64 + p] = xinr[s]; F.out[O_PS5IM + (size_t)((l * 8 + ua) * 16 + g) * 64 + p] = xini[s]; }
                if (MODE == 3) { F.out[O_SS5RE + (size_t)((l * 128 + ua) * 16 + g) * 64 + p] = xinr[s]; F.out[O_SS5IM + (size_t)((l * 128 + ua) * 16 + g) * 64 + p] = xini[s]; } }
        }
    }
    bf16x8 bwA[8], bwB[8]; float bgA = 0.f, bgB = 0.f;
    if (MODE != 1) {
        const bf16* WG = (const bf16*)(F.ws + WS_WGLU);
#pragma unroll
        for (int ks = 0; ks < 8; ++ks) { bwA[ks] = __builtin_bit_cast(bf16x8, *(const GAS v4u*)(WG + (size_t)(16 * (2 * wv) + fr) * 256 + 32 * ks + 8 * fq)); bwB[ks] = __builtin_bit_cast(bf16x8, *(const GAS v4u*)(WG + (size_t)(16 * (2 * wv + 1) + fr) * 256 + 32 * ks + 8 * fq)); }
        bgA = F.in[I_BGLU][l * 256 + 16 * (2 * wv) + fr]; bgB = F.in[I_BGLU][l * 256 + 16 * (2 * wv + 1) + fr];
    }
    __syncthreads();
    if (MODE != 1) {
        bf16* MX = (bf16*)(F.ws + WS_X);
        auto glu_block = [&](const bf16x8 (&bw)[8], const float bg, const int nt) {
#pragma unroll 1
            for (int mi = 0; mi < NSUB; ++mi) {
                f32x4 acc = (f32x4){0.f, 0.f, 0.f, 0.f};
#pragma unroll
                for (int ks = 0; ks < 8; ++ks) { const bf16x8 af = *(const LAS bf16x8*)(YG + t512(16 * mi + fr, 32 * ks + 8 * fq)); acc = MFMA16(af, bw[ks], acc); }
#pragma unroll
                for (int r = 0; r < 4; ++r) { const int t = 16 * mi + 4 * fq + r; if (SAMPLE && t >= 4) continue; const float yg = bf2f(*(const LAS bf16*)(YG + t512(t, 16 * nt + fr)));
                    MX[(size_t)(m0 + t) * DM + 16 * nt + fr] = (bf16)f2bf(yg * sigmoidf_(acc[r] + bg)); }
            }
        };
        glu_block(bwA, bgA, 2 * wv); glu_block(bwB, bgB, 2 * wv + 1);
        __syncthreads();
    }
}


constexpr int LM_RAW = 0, LM_XCB = 69632, LM_GT = LM_XCB + 64 * S512;
static_assert(LM_GT + 64 * S512 <= LDSCTL_OFF && 67 * 1024 <= LM_XCB, "lru mfma lds");
template <int PASS>
__device__ __forceinline__ void lrum_pass(Frame& F, int l, int b, int c) {
    LAS float* RAW = (LAS float*)(F.lds + LM_RAW); LAS unsigned char* XCB = F.lds + LM_XCB;
    int tid = F.tid; asm volatile("" : "+v"(tid)); const int lane = tid & 63, wv = tid >> 6, fr = lane & 15, fq = lane >> 4;
    const int row0 = b * SEQ + c * 64;
    const bf16* P = (const bf16*)(F.ws + WS_P); bf16* MX = (bf16*)(F.ws + WS_X); float* LA = (float*)(F.ws + WS_LAGG);
    {
        v4u sw[5], sg[4];
#pragma unroll
        for (int k5 = 0; k5 < 5; ++k5) { const int idx = tid + k5 * NTHR; const int r = idx >> 5, ck = idx & 31, tt = c * 64 - 3 + r;
            sw[k5] = (v4u){0u, 0u, 0u, 0u}; if (idx < 67 * 32 && tt >= 0) sw[k5] = *(const GAS v4u*)(P + (size_t)(b * SEQ + tt) * NPJ + PXL + ck * 8); }
        if (PASS == 2) {
#pragma unroll
            for (int k4 = 0; k4 < 4; ++k4) { const int idx = tid + k4 * NTHR; const int r = idx >> 5, ck = idx & 31; sg[k4] = *(const GAS v4u*)(P + (size_t)(row0 + r) * NPJ + PGL + ck * 8); }
        }
#pragma unroll
        for (int k5 = 0; k5 < 5; ++k5) { const int idx = tid + k5 * NTHR; const int r = idx >> 5, ck = idx & 31; const v4u w = sw[k5];
            if (idx < 67 * 32) { *(LAS f32x4*)(RAW + r * 256 + ck * 8) = (f32x4){bflo(w.x), bfhi(w.x), bflo(w.y), bfhi(w.y)}; *(LAS f32x4*)(RAW + r * 256 + ck * 8 + 4) = (f32x4){bflo(w.z), bfhi(w.z), bflo(w.w), bfhi(w.w)}; } }
        if (PASS == 2) {
#pragma unroll
            for (int k4 = 0; k4 < 4; ++k4) { const int idx = tid + k4 * NTHR; const int r = idx >> 5, ck = idx & 31; *(LAS v4u*)(F.lds + LM_GT + r * S512 + ck * 16) = sg[k4]; }
        }
    }
    bf16x8 wah[2], wal[2], wxh[2], wxl[2]; float ba[2], bx[2], c8[2];
#pragma unroll
    for (int nt = 0; nt < 2; ++nt) {
        const int jc = 16 * nt + fr; float fa[8], fx[8], ga[8], gx[8];
#pragma unroll
        for (int e = 0; e < 8; ++e) { fa[e] = F.in[I_LWA][(size_t)((l * 8 + wv) * 32 + 8 * fq + e) * 32 + jc]; fx[e] = F.in[I_LWX][(size_t)((l * 8 + wv) * 32 + 8 * fq + e) * 32 + jc]; }
        wah[nt] = pack8(fa); wxh[nt] = pack8(fx);
#pragma unroll
        for (int e = 0; e < 8; ++e) { ga[e] = fa[e] - bf2f(f2bf(fa[e])); gx[e] = fx[e] - bf2f(f2bf(fx[e])); }
        wal[nt] = pack8(ga); wxl[nt] = pack8(gx);
        const int j = 32 * wv + jc; ba[nt] = F.in[I_LBA][l * 256 + j]; bx[nt] = F.in[I_LBX][l * 256 + j]; c8[nt] = -8.0f * softplusf_(-F.in[I_LLAM][l * 256 + j]);
    }
    float Hin[2] = {0.f, 0.f};
    if (PASS == 2) {
        const int js = 32 * wv + 16 * (fq & 1) + fr; float H = 0.f;
        float la[31], lb[31];
        const float* Lb = LA + (size_t)(b * 32 * 2) * 256 + js; asm volatile("" : "+v"(Lb));
#pragma unroll
        for (int cc = 0; cc < 31; ++cc) { la[cc] = Lb[cc * 512]; lb[cc] = Lb[cc * 512 + 256]; }
#pragma unroll
        for (int cc = 0; cc < 31; ++cc) { const float nh = la[cc] * H + lb[cc]; H = cc < c ? nh : H; }
        Hin[0] = __shfl(H, fr); Hin[1] = __shfl(H, fr + 16);
    }
    float cw[4]; const float cb = F.in[I_LCB][l * 256 + (tid & 255)];
#pragma unroll
    for (int k = 0; k < 4; ++k) cw[k] = F.in[I_LCW][(l * 4 + k) * 256 + (tid & 255)];
    __syncthreads();
    {
        const int j = tid & 255, hh = tid >> 8; float xcv[32];
#pragma unroll
        for (int ii = 0; ii < 32; ++ii) { const int i = 32 * hh + ii; xcv[ii] = cb + cw[0] * RAW[i * 256 + j] + cw[1] * RAW[(i + 1) * 256 + j] + cw[2] * RAW[(i + 2) * 256 + j] + cw[3] * RAW[(i + 3) * 256 + j]; }
        __syncthreads();
#pragma unroll
        for (int ii = 0; ii < 32; ++ii) { const int i = 32 * hh + ii; RAW[i * 256 + j] = xcv[ii]; *(LAS bf16*)(XCB + i * S512 + j * 2) = (bf16)f2bf(xcv[ii]); }
    }
    __syncthreads();
    float At[2] = {1.f, 1.f}, Bt[2] = {0.f, 0.f};
#pragma unroll 1
    for (int sub = 0; sub < 4; ++sub) {
        const bf16x8 au = *(const LAS bf16x8*)(XCB + (16 * sub + fr) * S512 + (32 * wv + 8 * fq) * 2);
        unsigned short gt[2][4];
        if (PASS == 2) {
#pragma unroll
            for (int nt = 0; nt < 2; ++nt)
#pragma unroll
                for (int r = 0; r < 4; ++r) gt[nt][r] = *(const LAS unsigned short*)(F.lds + LM_GT + (16 * sub + 4 * fq + r) * S512 + (32 * wv + 16 * nt + fr) * 2);
        }
#pragma unroll
        for (int nt = 0; nt < 2; ++nt) {
            const f32x4 z = (f32x4){0.f, 0.f, 0.f, 0.f};
            f32x4 da = MFMA16(au, wah[nt], z); da = MFMA16(au, wal[nt], da);
            f32x4 dx = MFMA16(au, wxh[nt], z); dx = MFMA16(au, wxl[nt], dx);
            const int j = 32 * wv + 16 * nt + fr;
            float hl[4], ca[4]; float A = 1.f, B = 0.f;
#pragma unroll
            for (int r = 0; r < 4; ++r) { const int t = 16 * sub + 4 * fq + r;
                const float rr = sigmoidf_(da[r] + ba[nt]), gi = sigmoidf_(dx[r] + bx[nt]); const float a = __expf(c8[nt] * rr);
                const float mult = (c == 0 && t == 0) ? 1.0f : __builtin_amdgcn_sqrtf(fmaxf(1.0f - a * a, 0.f));
                const float bt = mult * gi * RAW[t * 256 + j];
                B = a * B + bt; A *= a; hl[r] = B; ca[r] = A; }
            float Ap = __shfl_up(A, 16), Bp = __shfl_up(B, 16); if (fq >= 1) { B = A * Bp + B; A = A * Ap; }
            Ap = __shfl_up(A, 32); Bp = __shfl_up(B, 32); if (fq >= 2) { B = A * Bp + B; A = A * Ap; }
            float Ae = __shfl_up(A, 16), Be = __shfl_up(B, 16); if (fq == 0) { Ae = 1.f; Be = 0.f; }
            const float As = __shfl(A, fr + 48), Bs = __shfl(B, fr + 48);
            if (PASS == 1) { Bt[nt] = As * Bt[nt] + Bs; At[nt] *= As; }
            else {
                const float Hs = Ae * Hin[nt] + Be;
#pragma unroll
                for (int r = 0; r < 4; ++r) { const float hv = hl[r] + ca[r] * Hs;
                    MX[(size_t)(row0 + 16 * sub + 4 * fq + r) * DM + 256 + j] = (bf16)f2bf(hv * gelu_tanh(bf2f(gt[nt][r]))); }
                Hin[nt] = As * Hin[nt] + Bs;
            }
        }
    }
    if (fq == 0) {
#pragma unroll
        for (int nt = 0; nt < 2; ++nt) { const int j = 32 * wv + 16 * nt + fr;
            if (PASS == 1) { LA[(size_t)((b * 32 + c) * 2) * 256 + j] = At[nt]; LA[(size_t)((b * 32 + c) * 2 + 1) * 256 + j] = Bt[nt]; }
            else if (c == 31) F.out[O_PLRUH + (size_t)(l * 8 + b) * 256 + j] = Hin[nt]; }
    }
    if (PASS == 2 && c == 31 && tid < 256) {
#pragma unroll
        for (int k = 0; k < 3; ++k) F.out[O_PLRUC + (size_t)((l * 8 + b) * 3 + k) * 256 + tid] = RAW[(64 + k) * 256 + tid]; }
    __syncthreads();
}
#ifndef MK_N_LAUNCHES
#define MK_N_LAUNCHES 1
#endif
constexpr int N_PHASES = 19;
struct Args { const float* in[37]; float* out; unsigned char* ws; int ph_lo, ph_hi; };
#if MK_N_LAUNCHES == 1
#define GRID_BAR() xcd_barrier(bar)
#else
#define GRID_BAR() do { } while (0)
#endif
#ifndef DUPM
#define DUPM 0
#endif
#define REP(bit) for (int rep_ = 0; rep_ < (((DUPM) >> (bit)) & 1 ? 2 : 1); ++rep_)
#ifndef PH_MASK
#define PH_MASK 0x3ff
#endif
#define IN(k) (lo <= (k) && (k) < hi)
#define INL(i) (((PH_MASK >> ((i) + 1)) & 1) && IN(pb + (i)))
#define OPQ() asm volatile("" : "+s"(F.wg), "+s"(F.G), "+s"(F.ws), "+s"(F.out), "+s"(l), "+s"(F.lds))
#ifndef BAR_TWICE
#define BAR_TWICE 0
#endif
#define SEAM(k) do { if (IN(k) && IN((k) + 1)) { GRID_BAR(); if (BAR_TWICE) GRID_BAR(); } } while (0)
#define X ((bf16*)(F.ws + WS_X))
#define P ((bf16*)(F.ws + WS_P))
#define BIG ((bf16*)(F.ws + WS_BIG))
#define AB ((float*)(F.ws + WS_AB))
#define Y (F.out + O_YP)
#define X1B ((float*)(F.ws + WS_BIG + 34 * MiB))
#define RSA ((float*)(F.ws + WS_CTL + 512 * 1024))
#define RSB ((float*)(F.ws + WS_CTL + 768 * 1024))
#define X2B Y
template <int LAYER>
__device__ __forceinline__ void layer_phases(Frame& F, const XcdBarrier& bar, const int lo, const int hi) {
    int l = LAYER;
#if defined(SEGREP) || defined(SEGPRE)
    int seg_n = 0;
#endif
        const int pb = 1 + 9 * l;
#if (defined(SEGREP) || defined(SEGPRE)) && SEG_LO == 0
        seg_start: asm volatile("" : "+v"(F.tid), "+v"(F.lane)); F.wave = __builtin_amdgcn_readfirstlane(F.tid >> 6);
#endif
        if (INL(0)) REP(1) { OPQ();
            pg8::Gemm g{(const bf16*)X2B, (const bf16*)(F.ws + WS_WIN), MT, NPJ, DM}; pg8::StaticOrder S; S.init(MT, NPJ, F.G, F.wg);
            pg8::EpiBf16 E{P, NPJ, RSA};
            pg8::gemm_phase<pg8::EpiBf16, pg8::StaticOrder, true, true>(F.lds, g, S, E);
            if (LAYER == 0) convert_items<2 | 8>(F, l, ((MT / 256) * (NPJ / 256)) % F.G); else convert_items<8>(F, l, ((MT / 256) * (NPJ / 256)) % F.G);
        }
#if defined(SEGPRE) && SEG_HI == 0
        if (((SEGPRE >> LAYER) & 1) && seg_n < hi - (N_PHASES - 1)) { ++seg_n; if (SEGPRE_MODE == 1) xcd_barrier<true>(bar); else if (SEGPRE_MODE == 2) xcd_barrier<false>(bar); goto seg_start; }
#endif
        SEAM(pb + 0);
#if defined(SEGREP) && SEG_HI == 0
        if (((SEGREP >> LAYER) & 1) && seg_n < hi - (N_PHASES - 1)) { ++seg_n; if (0 == 8 && LAYER == 1) GRID_BAR(); goto seg_start; }
#endif
#if (defined(SEGREP) || defined(SEGPRE)) && SEG_LO == 1
        seg_start: asm volatile("" : "+v"(F.tid), "+v"(F.lane)); F.wave = __builtin_amdgcn_readfirstlane(F.tid >> 6);
#endif
        if (INL(1)) { OPQ();
            {
                int cw_head = -1; v4u pre[7]; float abn[2]; bool have = false; float SS[32];
                int ts = F.wg; const int NT = NB_S * GDH;
                if (ts < NT) gdn_sample_load(F, l, ts, SS);
                int k = 0;
                const int nun = NB_P * GDH * NCH / F.G;
                auto unit_of = [&](int kk) { return ((F.wg & 7) * GDH + (F.wg >> 6)) * NCH + ((F.wg >> 3) & 7) * 4 + kk; };
                for (; k < nun; ++k) { const int u = unit_of(k);
                    gdn_prep<0>(F, l, u, cw_head, pre, abn, have, k + 1 < nun ? unit_of(k + 1) : -1); have = true;
                    if (ts < NT) { gdn_sample(F, l, ts, SS); ts += F.G; if (ts < NT) gdn_sample_load(F, l, ts, SS); }
                }
                while (ts < NT) { gdn_sample(F, l, ts, SS); ts += F.G; if (ts < NT) gdn_sample_load(F, l, ts, SS); }
            }
#ifdef GPC
            { int cw_head = -1; v4u pre[7]; float abn[2]; for (int u = F.wg; u < NB_P * GDH * NCH; u += F.G) { gdn_prep<GPC>(F, l, u, cw_head, pre, abn, false, -1); } __syncthreads(); }
#endif
            for (int u = F.wg; u < NB_P * 31; u += F.G) { REP(3) s5m_unit<1>(F, l, u / 31, u % 31); REP(4) lrum_pass<1>(F, l, u / 31, u % 31); }
            for (int q = F.wg; q < 2 * NB_S; q += F.G) REP(6) { if (q < NB_S) s5m_unit<3>(F, l, q, 0); else lru_sample(F, l, q - NB_S); }
        }
#if defined(SEGPRE) && SEG_HI == 1
        if (((SEGPRE >> LAYER) & 1) && seg_n < hi - (N_PHASES - 1)) { ++seg_n; if (SEGPRE_MODE == 1) xcd_barrier<true>(bar); else if (SEGPRE_MODE == 2) xcd_barrier<false>(bar); goto seg_start; }
#endif
        SEAM(pb + 1);
#if defined(SEGREP) && SEG_HI == 1
        if (((SEGREP >> LAYER) & 1) && seg_n < hi - (N_PHASES - 1)) { ++seg_n; if (1 == 8 && LAYER == 1) GRID_BAR(); goto seg_start; }
#endif
#if (defined(SEGREP) || defined(SEGPRE)) && SEG_LO == 2
        seg_start: asm volatile("" : "+v"(F.tid), "+v"(F.lane)); F.wave = __builtin_amdgcn_readfirstlane(F.tid >> 6);
#endif
        if (INL(2)) { OPQ();
            for (int t = F.wg; t < 256; t += F.G) gdn_chain<false>(F, l, t);
            for (int u = F.wg; u < NB_P * NCH; u += F.G) { REP(7) s5m_unit<2>(F, l, u >> 5, u & 31); REP(8) lrum_pass<2>(F, l, u >> 5, u & 31); }
        }
#if defined(SEGPRE) && SEG_HI == 2
        if (((SEGPRE >> LAYER) & 1) && seg_n < hi - (N_PHASES - 1)) { ++seg_n; if (SEGPRE_MODE == 1) xcd_barrier<true>(bar); else if (SEGPRE_MODE == 2) xcd_barrier<false>(bar); goto seg_start; }
#endif
        SEAM(pb + 2);
#if defined(SEGREP) && SEG_HI == 2
        if (((SEGREP >> LAYER) & 1) && seg_n < hi - (N_PHASES - 1)) { ++seg_n; if (2 == 8 && LAYER == 1) GRID_BAR(); goto seg_start; }
#endif
#if (defined(SEGREP) || defined(SEGPRE)) && SEG_LO == 3
        seg_start: asm volatile("" : "+v"(F.tid), "+v"(F.lane)); F.wave = __builtin_amdgcn_readfirstlane(F.tid >> 6);
#endif
        if (!HEADNORM_IN_GEMM && INL(3)) { OPQ();
            gdn_finalize(F, l);
        }
#if defined(SEGPRE) && SEG_HI == 3
        if (((SEGPRE >> LAYER) & 1) && seg_n < hi - (N_PHASES - 1)) { ++seg_n; if (SEGPRE_MODE == 1) xcd_barrier<true>(bar); else if (SEGPRE_MODE == 2) xcd_barrier<false>(bar); goto seg_start; }
#endif
#if !HEADNORM_IN_GEMM
        SEAM(pb + 3);
#endif
#if defined(SEGREP) && SEG_HI == 3
        if (((SEGREP >> LAYER) & 1) && seg_n < hi - (N_PHASES - 1)) { ++seg_n; if (3 == 8 && LAYER == 1) GRID_BAR(); goto seg_start; }
#endif
#if (defined(SEGREP) || defined(SEGPRE)) && SEG_LO == 4
        seg_start: asm volatile("" : "+v"(F.tid), "+v"(F.lane)); F.wave = __builtin_amdgcn_readfirstlane(F.tid >> 6);
#endif
        if (INL(4)) REP(9) { OPQ();
            pg8::Gemm g{X, (const bf16*)(F.ws + WS_WOUT), MP, DM, DM}; pg8::StaticOrder S; S.init(MP, DM, F.G, F.wg);
#if HEADNORM_IN_GEMM
            pg8::EpiBf16HeadNorm E{BIG, DM, (const float*)(F.ws + WS_SSQ), 1.f / HD, EPS};
            pg8::gemm_phase<pg8::EpiBf16HeadNorm, pg8::StaticOrder, true, true>(F.lds, g, S, E);
#else
            pg8::EpiBf16 E{BIG, DM, nullptr};
            pg8::gemm_phase<pg8::EpiBf16, pg8::StaticOrder, true, true>(F.lds, g, S, E);
#endif
            sample_gemm_lds(F, X, (const bf16*)(F.ws + WS_WOUT), DM, BIG);
        }
#if defined(SEGPRE) && SEG_HI == 4
        if (((SEGPRE >> LAYER) & 1) && seg_n < hi - (N_PHASES - 1)) { ++seg_n; if (SEGPRE_MODE == 1) xcd_barrier<true>(bar); else if (SEGPRE_MODE == 2) xcd_barrier<false>(bar); goto seg_start; }
#endif
        SEAM(pb + 4);
#if defined(SEGREP) && SEG_HI == 4
        if (((SEGREP >> LAYER) & 1) && seg_n < hi - (N_PHASES - 1)) { ++seg_n; if (4 == 8 && LAYER == 1) GRID_BAR(); goto seg_start; }
#endif
#if (defined(SEGREP) || defined(SEGPRE)) && SEG_LO == 5
        seg_start: asm volatile("" : "+v"(F.tid), "+v"(F.lane)); F.wave = __builtin_amdgcn_readfirstlane(F.tid >> 6);
#endif
        if (INL(5)) { OPQ();
            REP(13) row_pass<true, true>(F, X2B, nullptr, BIG, F.in[I_NMPOST] + l * DM, X1B, nullptr, RSB, nullptr, nullptr);
        }
#if defined(SEGPRE) && SEG_HI == 5
        if (((SEGPRE >> LAYER) & 1) && seg_n < hi - (N_PHASES - 1)) { ++seg_n; if (SEGPRE_MODE == 1) xcd_barrier<true>(bar); else if (SEGPRE_MODE == 2) xcd_barrier<false>(bar); goto seg_start; }
#endif
        SEAM(pb + 5);
#if defined(SEGREP) && SEG_HI == 5
        if (((SEGREP >> LAYER) & 1) && seg_n < hi - (N_PHASES - 1)) { ++seg_n; if (5 == 8 && LAYER == 1) GRID_BAR(); goto seg_start; }
#endif
#if (defined(SEGREP) || defined(SEGPRE)) && SEG_LO == 6
        seg_start: asm volatile("" : "+v"(F.tid), "+v"(F.lane)); F.wave = __builtin_amdgcn_readfirstlane(F.tid >> 6);
#endif
        if (INL(6)) REP(10) { OPQ();
            pg8::Gemm g{(const bf16*)X1B, (const bf16*)(F.ws + WS_WGU), MT, 2 * FF, DM}; pg8::StaticOrder S; S.init(MT, 2 * FF, F.G, F.wg);
            pg8::EpiSwiGLU E{P, FF, RSB};
            pg8::gemm_phase<pg8::EpiSwiGLU, pg8::StaticOrder, true, true>(F.lds, g, S, E);
            if (LAYER + 1 < DEPTH) convert_items<1 | 2>(F, l + 1, ((MT / 256) * (2 * FF / 256)) % F.G);
        }
#if defined(SEGPRE) && SEG_HI == 6
        if (((SEGPRE >> LAYER) & 1) && seg_n < hi - (N_PHASES - 1)) { ++seg_n; if (SEGPRE_MODE == 1) xcd_barrier<true>(bar); else if (SEGPRE_MODE == 2) xcd_barrier<false>(bar); goto seg_start; }
#endif
        SEAM(pb + 6);
#if defined(SEGREP) && SEG_HI == 6
        if (((SEGREP >> LAYER) & 1) && seg_n < hi - (N_PHASES - 1)) { ++seg_n; if (6 == 8 && LAYER == 1) GRID_BAR(); goto seg_start; }
#endif
#if (defined(SEGREP) || defined(SEGPRE)) && SEG_LO == 7
        seg_start: asm volatile("" : "+v"(F.tid), "+v"(F.lane)); F.wave = __builtin_amdgcn_readfirstlane(F.tid >> 6);
#endif
        if (INL(7)) REP(11) { OPQ();
            pg8::Gemm g{P, (const bf16*)(F.ws + WS_WDN), MP, DM, FF}; pg8::StaticOrder S; S.init(MP, DM, F.G, F.wg);
            pg8::EpiBf16 E{BIG, DM, nullptr};
            pg8::gemm_phase<pg8::EpiBf16, pg8::StaticOrder, true, true>(F.lds, g, S, E);
            sample_gemm_lds(F, P, (const bf16*)(F.ws + WS_WDN), FF, BIG);
        }
#if defined(SEGPRE) && SEG_HI == 7
        if (((SEGPRE >> LAYER) & 1) && seg_n < hi - (N_PHASES - 1)) { ++seg_n; if (SEGPRE_MODE == 1) xcd_barrier<true>(bar); else if (SEGPRE_MODE == 2) xcd_barrier<false>(bar); goto seg_start; }
#endif
        SEAM(pb + 7);
#if defined(SEGREP) && SEG_HI == 7
        if (((SEGREP >> LAYER) & 1) && seg_n < hi - (N_PHASES - 1)) { ++seg_n; if (7 == 8 && LAYER == 1) GRID_BAR(); goto seg_start; }
#endif
#if (defined(SEGREP) || defined(SEGPRE)) && SEG_LO == 8
        seg_start: asm volatile("" : "+v"(F.tid), "+v"(F.lane)); F.wave = __builtin_amdgcn_readfirstlane(F.tid >> 6);
#endif
        if (INL(8)) { OPQ();
            if (l + 1 < DEPTH) {
                convert_items<4 | 16>(F, l + 1, 0);
                row_pass<true, true>(F, X1B, nullptr, BIG, F.in[I_NFPOST] + l * DM, X2B, F.in[I_NMPRE] + (l + 1) * DM, RSA, F.in[I_WIN] + (size_t)(l + 1) * DM * INC, AB);
            } else row_pass<true, false>(F, X1B, nullptr, BIG, F.in[I_NFPOST] + l * DM, Y, nullptr, nullptr, nullptr, nullptr);
        }
#if defined(SEGPRE) && SEG_HI == 8
        if (((SEGPRE >> LAYER) & 1) && seg_n < hi - (N_PHASES - 1)) { ++seg_n; if (SEGPRE_MODE == 1) xcd_barrier<true>(bar); else if (SEGPRE_MODE == 2) xcd_barrier<false>(bar); goto seg_start; }
#endif
        SEAM(pb + 8);
#if defined(SEGREP) && SEG_HI == 8
        if (((SEGREP >> LAYER) & 1) && seg_n < hi - (N_PHASES - 1)) { ++seg_n; if (8 == 8 && LAYER == 1) GRID_BAR(); goto seg_start; }
#endif
    }
__global__ void __launch_bounds__(NTHR, 2) mega_fwd(Args args) {
    extern __shared__ __attribute__((aligned(16))) unsigned char lds[];
    Frame F;
    F.lds = (LAS unsigned char*)lds;
    F.tid = threadIdx.x; F.lane = F.tid & 63; F.wave = __builtin_amdgcn_readfirstlane(F.tid >> 6);
    F.G = gridDim.x; F.wg = blockIdx.x;
    F.in = args.in;
    F.out = args.out; F.ws = args.ws;
    volatile LAS unsigned* MISC = (volatile LAS unsigned*)(F.lds + LDSCTL_OFF);
    for (int u = F.tid; u < (LDS_BYTES - LDSCTL_OFF) / 4; u += NTHR) ((LAS unsigned*)(F.lds + LDSCTL_OFF))[u] = 0u;
    __syncthreads();
#if MK_N_LAUNCHES == 1
    XcdBarrier bar = xcd_barrier_post((unsigned*)(F.ws + WS_CTL) + CW_BAR, MISC + 8);
#else
    (void)MISC; XcdBarrier bar; bar.bar = nullptr; bar.x = 0; bar.st = nullptr;
#endif
    const int lo = args.ph_lo, hi = args.ph_hi;
#ifdef FULLREP
    for (int rep2 = 0; rep2 < args.ph_hi - (N_PHASES - FULLREP); ++rep2) {
        F.tid = threadIdx.x; asm volatile("" : "+v"(F.tid)); F.lane = F.tid & 63; F.wave = __builtin_amdgcn_readfirstlane(F.tid >> 6);
#endif
    if ((PH_MASK & 1) && IN(0)) REP(12) {
        convert_items<1 | 4 | 16>(F, 0, 0);
        row_pass<false, true>(F, F.in[I_XP], F.in[I_XS], nullptr, nullptr, X2B, F.in[I_NMPRE], RSA, F.in[I_WIN], AB);
    }
    SEAM(0);
    layer_phases<0>(F, bar, lo, hi);
    layer_phases<1>(F, bar, lo, hi);
#ifdef FULLREP
    GRID_BAR(); }
#endif
}

extern "C" void kernel_launch(void* const* d_in, const int* in_sizes, int n_in, void* d_out, int out_size, void* d_ws, size_t ws_size, hipStream_t stream) {
    static int grid = 0;
    if (grid == 0) {
        if (n_in != 37 || (size_t)out_size != O_END || ws_size < WS_OL + 16 * MiB) { fprintf(stderr, "kernel_launch: unexpected shapes: n_in %d out %d ws %zu\n", n_in, out_size, ws_size); grid = -1; return; }
        int dev = 0, cus = 0, per_cu = 0;
        if (hipGetDevice(&dev) != hipSuccess || hipDeviceGetAttribute(&cus, hipDeviceAttributeMultiprocessorCount, dev) != hipSuccess) { grid = -1; return; }
        if (hipFuncSetAttribute((const void*)mega_fwd, hipFuncAttributeMaxDynamicSharedMemorySize, LDS_BYTES) != hipSuccess) { fprintf(stderr, "kernel_launch: hipFuncSetAttribute failed\n"); grid = -1; return; }
        if (hipOccupancyMaxActiveBlocksPerMultiprocessor(&per_cu, (const void*)mega_fwd, NTHR, LDS_BYTES) != hipSuccess || per_cu < 1) { fprintf(stderr, "kernel_launch: occupancy query says %d blocks per CU\n", per_cu); (void)hipGetLastError(); per_cu = 1; }
        grid = cus;
        if (grid > 256) grid = 256;
        if (HEADNORM_IN_GEMM && grid != 256) { fprintf(stderr, "kernel_launch: %d compute units, this build needs 256 (one out-projection unit per workgroup)\n", cus); grid = -1; return; }
    }
    if (grid < 0) return;
    (void)hipMemsetAsync((char*)d_ws + WS_CTL, 0, CTL_ZERO_BYTES, stream);
    Args a{};
    for (int i = 0; i < 37; ++i) a.in[i] = (const float*)d_in[i];
    a.out = (float*)d_out; a.ws = (unsigned char*)d_ws;
#if MK_N_LAUNCHES == 1
    a.ph_lo = 0; a.ph_hi = N_PHASES;
    hipLaunchKernelGGL(mega_fwd, dim3(grid), dim3(NTHR), LDS_BYTES, stream, a);
#else
    for (int ph = 0; ph < N_PHASES; ++ph) { a.ph_lo = ph; a.ph_hi = ph + 1; hipLaunchKernelGGL(mega_fwd, dim3(grid), dim3(NTHR), LDS_BYTES, stream, a); }
#endif
}
```

```cpp
#include <hip/hip_runtime.h>
#include <cstdio>
#include <cstdint>
#include <cmath>
namespace pg8 {
#define PG8_LAS __attribute__((address_space(3)))
typedef unsigned short bf16_t;
typedef short bf16x8 __attribute__((ext_vector_type(8)));
typedef float f32x4 __attribute__((ext_vector_type(4)));
typedef unsigned u32x4 __attribute__((ext_vector_type(4)));
constexpr int BM = 256, BK = 64, HALF = 128, HTB = HALF * BK * 2  , STAGE_BYTES = 8 * HTB, NXCD = 8, WGM = 8;

__host__ __device__ __forceinline__ int lds_byte(int r, int c) { const int st = (r >> 4) * 2 + (c >> 5), rr = r & 15, cc = c & 31, ob = rr * 64 + cc * 2; return st * 1024 + (ob ^ (((ob >> 9) & 1) << 5)); }
__host__ __device__ __forceinline__ void stage_rc(int b, int& R, int& C) { const int st = b / 1024, sb = b % 1024, swz = sb ^ (((sb >> 9) & 1) << 5); R = (st >> 1) * 16 + swz / 64; C = (st & 1) * 32 + (swz % 64) / 2; }
__host__ __device__ __forceinline__ int perm32(int rho) { const int n = rho >> 4, i = rho & 15; return 8 * (i >> 2) + 4 * n + (i & 3); }

struct Unit { int pm, pn; };
struct Gemm { const bf16_t* A; const bf16_t* Bt; int M, N, K; };

struct StaticOrder {
    int nM, nN, nwg, G, c;
    __host__ __device__ void init(int M, int N, int G_, int c_) { nM = M / BM; nN = N / BM; nwg = nM * nN; G = G_; c = c_; }
    __host__ __device__ bool next(int i, Unit& u) const {
        const long L = (long)i * G + c; if (L >= nwg) return false;
        int wgid = (int)L; { const int q = nwg / NXCD, r = nwg % NXCD, xcd = wgid % NXCD, off = wgid / NXCD; wgid = (xcd < r ? xcd * (q + 1) : r * (q + 1) + (xcd - r) * q) + off; }
        const int nig = WGM * nN, gid = wgid / nig, fm = gid * WGM, gsz = (nM - fm) < WGM ? (nM - fm) : WGM;
        u.pm = fm + ((wgid % nig) % gsz); u.pn = (wgid % nig) / gsz; return true;
    }
    __device__ __forceinline__ void a_ready(const Unit&) const {}
    __device__ __forceinline__ void done(const Unit&) const {}
};


__device__ __forceinline__ unsigned cvt_pk_bf16(float lo, float hi) { unsigned r; asm volatile("v_cvt_pk_bf16_f32 %0, %1, %2" : "=v"(r) : "v"(lo), "v"(hi)); return r; }

template <bool WT>
__device__ __forceinline__ void st16(void* p, u32x4 v) {
    if constexpr (WT) asm volatile("global_store_dwordx4 %0, %1, off sc1\n\ts_nop 1" :: "v"(p), "v"(v) : "memory");
    else *(u32x4*)p = v;
}
struct EpiF32 {
    static constexpr bool PERM = false, AFTER_DRAIN = false, KSCALE = false;
    float* C; int ldc;
    template <bool WT>
    __device__ __forceinline__ void run(const f32x4 (&acc)[2][2][4][2], const Unit& u, int wr, int wc, int fr, int fq) const {
        const int row0 = u.pm * BM + wr * 64 + fr, col0 = u.pn * BM + wc * 32 + 4 * fq;
#pragma unroll
        for (int ai = 0; ai < 2; ++ai)
#pragma unroll
            for (int m = 0; m < 4; ++m) { float* rowp = C + (size_t)(row0 + ai * HALF + m * 16) * ldc + col0;
#pragma unroll
                for (int bj = 0; bj < 2; ++bj)
#pragma unroll
                    for (int n = 0; n < 2; ++n) *(f32x4*)(rowp + bj * HALF + n * 16) = acc[ai][bj][m][n]; }
    }
};
struct EpiBf16 {
    static constexpr bool PERM = true, AFTER_DRAIN = false, KSCALE = false;
    bf16_t* O; int ldc; const float* RS;
    template <bool WT>
    __device__ __forceinline__ void run(const f32x4 (&acc)[2][2][4][2], const Unit& u, int wr, int wc, int fr, int fq) const {
        const int row0 = u.pm * BM + wr * 64 + fr; const int col0 = u.pn * BM + wc * 32 + 8 * fq;
        float rsc[2][4];
#pragma unroll
        for (int ai = 0; ai < 2; ++ai)
#pragma unroll
            for (int m = 0; m < 4; ++m) rsc[ai][m] = RS ? RS[row0 + ai * HALF + m * 16] : 1.0f;
#pragma unroll
        for (int ai = 0; ai < 2; ++ai)
#pragma unroll
            for (int m = 0; m < 4; ++m) { bf16_t* rowp = O + (size_t)(row0 + ai * HALF + m * 16) * ldc + col0;
#pragma unroll
                for (int bj = 0; bj < 2; ++bj) { const f32x4 v0 = acc[ai][bj][m][0] * rsc[ai][m], v1 = acc[ai][bj][m][1] * rsc[ai][m];
                    u32x4 w; w.x = cvt_pk_bf16(v0[0], v0[1]); w.y = cvt_pk_bf16(v0[2], v0[3]); w.z = cvt_pk_bf16(v1[0], v1[1]); w.w = cvt_pk_bf16(v1[2], v1[3]);
                    st16<WT>(rowp + bj * HALF, w); } }
    }
};
struct EpiBf16HeadNorm {
    static constexpr bool PERM = true, AFTER_DRAIN = false, KSCALE = true;
    static constexpr int KT0 = 8, TAB = STAGE_BYTES;
    bf16_t* O; int ldc; const float* SSQ; float inv_n, eps;
    struct Pre { f32x4 v[8]; };
    __device__ __forceinline__ void setup_load(Pre& p, const Unit& u, int tid) const {
        const float* sp = SSQ + (size_t)(u.pm * BM + (tid & 255)) * 32;
#pragma unroll
        for (int i = 0; i < 8; ++i) p.v[i] = *(const f32x4*)(sp + 4 * i);
    }
    __device__ __forceinline__ void setup_store(const Pre& p, PG8_LAS unsigned char* lds, int tid) const {
        if (tid < 256) {
            float sq[4], rs[4];
#pragma unroll
            for (int h = 0; h < 4; ++h) { const f32x4 a = p.v[2 * h], b = p.v[2 * h + 1]; const float x = ((a.x + a.y) + (a.z + a.w) + (b.x + b.y) + (b.z + b.w)) * inv_n + eps; rs[h] = __builtin_amdgcn_rsqf(x); sq[h] = x * rs[h]; }
            PG8_LAS float* t = (PG8_LAS float*)(lds + TAB) + tid * 8;
            *(PG8_LAS f32x4*)t = (f32x4){sq[0], rs[0] * sq[1], rs[1] * sq[2], rs[2] * sq[3]}; t[4] = rs[3];
        }
    }
    __device__ __forceinline__ void scale(f32x4 (&acc)[2][2][4][2], PG8_LAS unsigned char* lds, int wr, int fr, int p) const {
        const PG8_LAS float* t = (const PG8_LAS float*)(lds + TAB) + (wr * 64 + fr) * 8 + p;
#pragma unroll
        for (int ai = 0; ai < 2; ++ai)
#pragma unroll
            for (int m = 0; m < 4; ++m) { const float f = t[(ai * HALF + m * 16) * 8];
#pragma unroll
                for (int bj = 0; bj < 2; ++bj)
#pragma unroll
                    for (int n = 0; n < 2; ++n) acc[ai][bj][m][n] = acc[ai][bj][m][n] * f; }
    }
    template <bool WT>
    __device__ __forceinline__ void run(const f32x4 (&acc)[2][2][4][2], const Unit& u, int wr, int wc, int fr, int fq) const { EpiBf16 e{O, ldc, nullptr}; e.template run<WT>(acc, u, wr, wc, fr, fq); }
};
struct EpiSwiGLU {
    static constexpr bool PERM = true, AFTER_DRAIN = false, KSCALE = false;
    bf16_t* O; int ldc; const float* RS;
    template <bool WT>
    __device__ __forceinline__ void run(const f32x4 (&acc)[2][2][4][2], const Unit& u, int wr, int wc, int fr, int fq) const {
        const int row0 = u.pm * BM + wr * 64 + fr; const int col0 = u.pn * HALF + wc * 32 + 8 * fq;
        float rsc[2][4];
#pragma unroll
        for (int ai = 0; ai < 2; ++ai)
#pragma unroll
            for (int m = 0; m < 4; ++m) rsc[ai][m] = RS[row0 + ai * HALF + m * 16];
#pragma unroll
        for (int ai = 0; ai < 2; ++ai)
#pragma unroll
            for (int m = 0; m < 4; ++m) { bf16_t* rowp = O + (size_t)(row0 + ai * HALF + m * 16) * ldc + col0;
                float o[8];
#pragma unroll
                for (int n = 0; n < 2; ++n)
#pragma unroll
                    for (int j = 0; j < 4; ++j) { const float g = acc[ai][0][m][n][j] * rsc[ai][m], up = acc[ai][1][m][n][j] * rsc[ai][m]; o[n * 4 + j] = g * up * __builtin_amdgcn_rcpf(1.0f + __expf(-g)); }
                u32x4 w; w.x = cvt_pk_bf16(o[0], o[1]); w.y = cvt_pk_bf16(o[2], o[3]); w.z = cvt_pk_bf16(o[4], o[5]); w.w = cvt_pk_bf16(o[6], o[7]);
                st16<WT>(rowp, w); }
    }
};

#ifndef PG8_LAST_WT
#define PG8_LAST_WT 0
#endif
template <class E, bool K = E::KSCALE> struct Epi_pre { typedef int type; };
template <class E> struct Epi_pre<E, true> { typedef typename E::Pre type; };
template <class Epi, class Sched, bool ALIGN_EPI = false, bool SP2 = false>
__device__ __forceinline__ void gemm_phase(PG8_LAS unsigned char* lds, const Gemm g, const Sched& S, const Epi& E) {
    int tid_ = threadIdx.x; asm volatile("" : "+v"(tid_));
    const int tid = tid_, wid = __builtin_amdgcn_readfirstlane(tid >> 6), lane = tid & 63, wr = wid >> 2, wc = wid & 3, fr = lane & 15, fq = lane >> 4;
    const int K = g.K, nt = K / BK;
    unsigned voffA[2], voffB[2];
#pragma unroll
    for (int i = 0; i < 2; ++i) { int R, C; stage_rc(tid * 16 + i * 8192, R, C); const int Rb = Epi::PERM ? ((R & ~31) + perm32(R & 31)) : R;
        voffA[i] = (unsigned)(R * K + C) * 2u; voffB[i] = (unsigned)(Rb * K + C) * 2u; }
    const size_t kstep = (size_t)(BK * 2);
    const size_t hstep = (size_t)HALF * K * 2;
    const size_t tstep = 2 * hstep;
    const unsigned ldsw = (unsigned)wid * 1024u;
    const int aoff = lds_byte(wr * 64 + fr, fq * 8), boff = lds_byte(wc * 32 + fr, fq * 8);
#define PG8_SA(b, h) (((b) * 2 + (h)) * HTB)
#define PG8_SB(b, h) ((4 + (b) * 2 + (h)) * HTB)
#define PG8_STAGE(bufoff, gbase, voff) do { _Pragma("unroll") for (int _i = 0; _i < 2; ++_i) \
        __builtin_amdgcn_global_load_lds((const unsigned*)((const char*)(gbase) + (voff)[_i]), (PG8_LAS unsigned*)(lds + (bufoff) + ldsw + _i * 8192), 16, 0, 0); } while (0)
#define PG8_LDA(dst, b, h) do { _Pragma("unroll") for (int m = 0; m < 4; ++m) _Pragma("unroll") for (int k = 0; k < 2; ++k) dst[m][k] = *(const PG8_LAS bf16x8*)(lds + PG8_SA(b, h) + aoff + m * 2048 + k * 1024); } while (0)
#define PG8_LDB(dst, b, h) do { _Pragma("unroll") for (int n = 0; n < 2; ++n) _Pragma("unroll") for (int k = 0; k < 2; ++k) dst[n][k] = *(const PG8_LAS bf16x8*)(lds + PG8_SB(b, h) + boff + n * 2048 + k * 1024); } while (0)
#define PG8_MMA(ai, bj, At, Bt) do { __builtin_amdgcn_s_setprio(1); _Pragma("unroll") for (int m = 0; m < 4; ++m) _Pragma("unroll") for (int n = 0; n < 2; ++n) _Pragma("unroll") for (int k = 0; k < 2; ++k) \
        acc[ai][bj][m][n] = __builtin_amdgcn_mfma_f32_16x16x32_bf16(Bt[n][k], At[m][k], acc[ai][bj][m][n], 0, 0, 0); __builtin_amdgcn_s_setprio(0); } while (0)
#define PG8_WAIT_V(n) asm volatile("s_waitcnt vmcnt(" #n ")" ::: "memory")
#define PG8_WAIT_L(n) asm volatile("s_waitcnt lgkmcnt(" #n ")" ::: "memory")
#define PG8_BAR __builtin_amdgcn_s_barrier()
#define PG8_SCHED __builtin_amdgcn_sched_barrier(0)
    Unit cur, nxt; int ui = 0;
    if (!S.next(0, cur)) return;
    f32x4 acc[2][2][4][2];
#pragma unroll
    for (int a = 0; a < 2; ++a)
#pragma unroll
        for (int b = 0; b < 2; ++b)
#pragma unroll
            for (int m = 0; m < 4; ++m)
#pragma unroll
                for (int n = 0; n < 2; ++n) acc[a][b][m][n] = (f32x4){0.f, 0.f, 0.f, 0.f};
    bf16x8 At[4][2], B0[2][2], B1[2][2];
    const char* cA = (const char*)g.A + (size_t)cur.pm * tstep; const char* cB = (const char*)g.Bt + (size_t)cur.pn * tstep;
    S.a_ready(cur);
    typename Epi_pre<Epi>::type epre;
    if constexpr (Epi::KSCALE) E.setup_load(epre, cur, tid);
    if constexpr (SP2) {
        PG8_STAGE(PG8_SB(0, 0), cB, voffB); PG8_STAGE(PG8_SB(0, 1), cB + hstep, voffB); PG8_STAGE(PG8_SA(0, 0), cA, voffA); PG8_STAGE(PG8_SA(0, 1), cA + hstep, voffA);
        if (wr == 1) PG8_BAR;
        PG8_WAIT_V(2); PG8_BAR;
        PG8_STAGE(PG8_SB(1, 0), cB + kstep, voffB); PG8_STAGE(PG8_SA(1, 0), cA + kstep, voffA); PG8_STAGE(PG8_SB(1, 1), cB + hstep + kstep, voffB);
        PG8_WAIT_V(6); PG8_BAR;
        if constexpr (Epi::KSCALE) E.setup_store(epre, lds, tid);
    } else {
        PG8_STAGE(PG8_SB(0, 0), cB, voffB); PG8_STAGE(PG8_SA(0, 0), cA, voffA); PG8_STAGE(PG8_SB(0, 1), cB + hstep, voffB); PG8_STAGE(PG8_SA(0, 1), cA + hstep, voffA);
        if (wr == 1) PG8_BAR;
        PG8_WAIT_V(4); PG8_BAR;
        PG8_STAGE(PG8_SB(1, 0), cB + kstep, voffB); PG8_STAGE(PG8_SA(1, 0), cA + kstep, voffA); PG8_STAGE(PG8_SB(1, 1), cB + hstep + kstep, voffB);
        PG8_WAIT_V(6); PG8_BAR;
    }
    for (;;) {
        const bool has_next = S.next(ui + 1, nxt);
        const char* nA = has_next ? (const char*)g.A + (size_t)nxt.pm * tstep : cA; const char* nB = has_next ? (const char*)g.Bt + (size_t)nxt.pn * tstep : cB;
        for (int t = 0; t < nt; t += 2) {
            const bool last = (t == nt - 2);
            const char* a1 = cA + (size_t)(t + 1) * kstep;
            const char* a2 = last ? nA : cA + (size_t)(t + 2) * kstep; const char* b2 = last ? nB : cB + (size_t)(t + 2) * kstep;
            const char* a3 = a2 + kstep; const char* b3 = b2 + kstep;
            if (last && has_next) S.a_ready(nxt);
            if constexpr (Epi::KSCALE) { if (t >= Epi::KT0) E.scale(acc, lds, wr, fr, (t - Epi::KT0) >> 1); }
            if constexpr (SP2) {
            PG8_LDB(B0, 0, 0); PG8_LDB(B1, 0, 1); PG8_SCHED; PG8_LDA(At, 0, 0); PG8_STAGE(PG8_SA(1, 1), a1 + hstep, voffA);
            PG8_WAIT_V(8); PG8_WAIT_L(0); PG8_BAR; PG8_MMA(0, 0, At, B0); PG8_MMA(0, 1, At, B1); PG8_BAR; PG8_SCHED;
            PG8_LDA(At, 0, 1); PG8_STAGE(PG8_SB(0, 0), b2, voffB); PG8_STAGE(PG8_SB(0, 1), b2 + hstep, voffB); PG8_STAGE(PG8_SA(0, 0), a2, voffA);
            PG8_WAIT_V(8); PG8_WAIT_L(0); PG8_BAR; PG8_MMA(1, 0, At, B0); PG8_MMA(1, 1, At, B1); PG8_BAR; PG8_SCHED;
            PG8_LDB(B0, 1, 0); PG8_LDB(B1, 1, 1); PG8_SCHED; PG8_LDA(At, 1, 0); PG8_STAGE(PG8_SA(0, 1), a2 + hstep, voffA);
            PG8_WAIT_V(8); PG8_WAIT_L(0); PG8_BAR; PG8_MMA(0, 0, At, B0); PG8_MMA(0, 1, At, B1); PG8_BAR; PG8_SCHED;
            PG8_LDA(At, 1, 1); PG8_STAGE(PG8_SB(1, 0), b3, voffB); PG8_STAGE(PG8_SB(1, 1), b3 + hstep, voffB); PG8_STAGE(PG8_SA(1, 0), a3, voffA);
            PG8_WAIT_V(8); PG8_WAIT_L(0); PG8_BAR; PG8_MMA(1, 0, At, B0); PG8_MMA(1, 1, At, B1); PG8_BAR; PG8_SCHED;
            } else {
            PG8_LDB(B0, 0, 0); PG8_SCHED; PG8_LDA(At, 0, 0); PG8_STAGE(PG8_SA(1, 1), a1 + hstep, voffA);
            PG8_WAIT_L(8); PG8_BAR; PG8_WAIT_L(0); PG8_MMA(0, 0, At, B0); PG8_BAR; PG8_SCHED;
            PG8_LDB(B1, 0, 1); PG8_STAGE(PG8_SB(0, 0), b2, voffB);
            PG8_BAR; PG8_WAIT_L(0); PG8_MMA(0, 1, At, B1); PG8_BAR;
            PG8_LDA(At, 0, 1); PG8_STAGE(PG8_SA(0, 0), a2, voffA);
            PG8_BAR; PG8_WAIT_L(0); PG8_MMA(1, 0, At, B0); PG8_BAR; PG8_SCHED;
            PG8_STAGE(PG8_SB(0, 1), b2 + hstep, voffB);
            PG8_WAIT_V(6); PG8_BAR; PG8_MMA(1, 1, At, B1); PG8_BAR;
            PG8_LDB(B0, 1, 0); PG8_SCHED; PG8_LDA(At, 1, 0); PG8_STAGE(PG8_SA(0, 1), a2 + hstep, voffA);
            PG8_WAIT_L(8); PG8_BAR; PG8_WAIT_L(0); PG8_MMA(0, 0, At, B0); PG8_BAR; PG8_SCHED;
            PG8_LDB(B1, 1, 1); PG8_STAGE(PG8_SB(1, 0), b3, voffB);
            PG8_BAR; PG8_WAIT_L(0); PG8_MMA(0, 1, At, B1); PG8_BAR;
            PG8_LDA(At, 1, 1); PG8_STAGE(PG8_SA(1, 0), a3, voffA);
            PG8_BAR; PG8_WAIT_L(0); PG8_MMA(1, 0, At, B0); PG8_BAR; PG8_SCHED;
            PG8_STAGE(PG8_SB(1, 1), b3 + hstep, voffB);
            PG8_WAIT_V(6); PG8_BAR; PG8_MMA(1, 1, At, B1); PG8_BAR;
            }
        }
        if constexpr (Epi::KSCALE) E.scale(acc, lds, wr, fr, 4);
        if constexpr (ALIGN_EPI) { if (wr == 0) PG8_BAR; }
        if constexpr (!Epi::AFTER_DRAIN) {
            if (PG8_LAST_WT && !has_next) E.template run<true>(acc, cur, wr, wc, fr, fq); else E.template run<false>(acc, cur, wr, wc, fr, fq);
            S.done(cur); }
        if (!has_next) break;
#pragma unroll
        for (int a = 0; a < 2; ++a)
#pragma unroll
            for (int b = 0; b < 2; ++b)
#pragma unroll
                for (int m = 0; m < 4; ++m)
#pragma unroll
                    for (int n = 0; n < 2; ++n) acc[a][b][m][n] = (f32x4){0.f, 0.f, 0.f, 0.f};
        cur = nxt; cA = nA; cB = nB; ++ui;
        if constexpr (ALIGN_EPI) { if (wr == 1) PG8_BAR; }
    }
    PG8_WAIT_V(0);
    if constexpr (!ALIGN_EPI) { if (wr == 0) PG8_BAR; }
    PG8_BAR;
    if constexpr (Epi::AFTER_DRAIN) { E.fused(acc, cur, wr, wc, fr, fq, lds, wid, lane); S.done(cur); }
#undef PG8_SA
#undef PG8_SB
#undef PG8_STAGE
#undef PG8_LDA
#undef PG8_LDB
#undef PG8_MMA
#undef PG8_WAIT_V
#undef PG8_WAIT_L
#undef PG8_BAR
#undef PG8_SCHED
}
}

constexpr int NWAVES = 8, NTHR = 512;
constexpr int DM = 1024, SEQ = 2048, NB_P = 8, MP = NB_P * SEQ, NB_S = 128, DSEQ = 4, MS = NB_S * DSEQ, MT = MP + MS;
constexpr int DEPTH = 2, INC = 2824, NPJ = 2816, FF = 2816, GDH = 4, HD = 128, NCH = SEQ / 64;
constexpr int PU = 0, PXL = 256, PGL = 512, PQ = 768, PK = 1280, PV = 1792, PZ = 2304;
constexpr float EPS = 1e-6f;
#ifndef HEADNORM_IN_GEMM
#define HEADNORM_IN_GEMM 1
#endif
constexpr size_t O_YP = 0, O_YS = O_YP + (size_t)MP * DM, O_PS5RE = O_YS + (size_t)MS * DM, O_PS5IM = O_PS5RE + 2 * 8 * 16 * 64, O_PLRUH = O_PS5IM + 2 * 8 * 16 * 64,
    O_PLRUC = O_PLRUH + 2 * 8 * 256, O_PGS = O_PLRUC + 2 * 8 * 3 * 256, O_PGC = O_PGS + (size_t)2 * 8 * 4 * 128 * 128, O_SS5RE = O_PGC + 2 * 8 * 3 * 1536,
    O_SS5IM = O_SS5RE + 2 * 128 * 16 * 64, O_SLRUH = O_SS5IM + 2 * 128 * 16 * 64, O_SLRUC = O_SLRUH + 2 * 128 * 256, O_SGS = O_SLRUC + 2 * 128 * 3 * 256,
    O_SGC = O_SGS + (size_t)2 * 128 * 4 * 128 * 128, O_END = O_SGC + (size_t)2 * 128 * 3 * 1536;
static_assert(O_END == 37216256, "output size");
constexpr size_t MiB = 1u << 20;
constexpr size_t WS_CTL = 0, CTL_ZERO_BYTES = 1 * MiB;
constexpr size_t WS_S5E = 1 * MiB;
constexpr size_t WS_LAGG = 3 * MiB;
constexpr size_t WS_AB = 3 * MiB + 512 * 1024;
constexpr size_t WS_EGL = 4 * MiB + 256 * 1024;
constexpr size_t WS_WIN = 5 * MiB;
constexpr size_t WS_WOUT = WS_WIN + (size_t)NPJ * DM * 2;
constexpr size_t WS_WGU = WS_WOUT + (size_t)DM * DM * 2;
constexpr size_t WS_WDN = WS_WGU + (size_t)2 * FF * DM * 2;
constexpr size_t WS_WGLU = WS_WDN + (size_t)DM * FF * 2;
constexpr size_t WS_X = 30 * MiB;
constexpr size_t WS_P = 63 * MiB;
constexpr size_t WS_BIG = 154 * MiB;
constexpr size_t WS_PP = WS_BIG, WS_RT = WS_BIG + 32 * MiB, WS_QT = WS_BIG + 64 * MiB, WS_END = WS_BIG + 80 * MiB;
static_assert(WS_WGLU + 256 * 256 * 2 <= WS_X && WS_X + (size_t)MT * DM * 2 <= WS_P && WS_P + (size_t)MT * NPJ * 2 <= WS_BIG && WS_BIG + (size_t)MT * DM * 4 <= WS_END && WS_END + (size_t)MP * 32 * 4 <= 256 * MiB, "ws map");
static_assert(WS_AB + (size_t)MT * 8 * 4 <= WS_EGL && WS_EGL + 4096 <= WS_WIN, "ws map 2");
constexpr size_t WS_SSQ = WS_END;
constexpr size_t WS_OL = WS_END + 2 * MiB;
constexpr size_t WS_DUMH = WS_END + 18 * MiB, WS_DUMF = WS_END + 19 * MiB;
static_assert(WS_DUMF + 2 * MiB <= 256 * MiB, "ws tail");
constexpr int CW_BAR = 4096;
constexpr int RING_BYTES = 131072, LDSCTL_OFF = 143360, LDS_BYTES = 147456;

#define GAS __attribute__((address_space(1)))
#define LAS __attribute__((address_space(3)))
typedef unsigned short bf16;
typedef unsigned v4u __attribute__((ext_vector_type(4)));
typedef unsigned v2u __attribute__((ext_vector_type(2)));
typedef float f32x4 __attribute__((ext_vector_type(4)));
typedef short bf16x8 __attribute__((ext_vector_type(8)));
#define LDS_WAIT() asm volatile("s_waitcnt lgkmcnt(0)" ::: "memory")
#define VM_WAIT() asm volatile("s_waitcnt vmcnt(0)" ::: "memory")
#define MFMA16(a, b, c) __builtin_amdgcn_mfma_f32_16x16x32_bf16(a, b, c, 0, 0, 0)
typedef float f32x2_t __attribute__((ext_vector_type(2))); typedef __bf16 bf16x2_t __attribute__((ext_vector_type(2)));
__device__ __forceinline__ unsigned pk2(float lo, float hi) { f32x2_t v = {lo, hi}; bf16x2_t b = __builtin_convertvector(v, bf16x2_t); return __builtin_bit_cast(unsigned, b); }
__device__ __forceinline__ unsigned f2bf(float f) { return pk2(f, f) & 0xffffu; }
__device__ __forceinline__ float bf2f(unsigned b) { return __builtin_bit_cast(float, b << 16); }
__device__ __forceinline__ float bflo(unsigned w) { return __builtin_bit_cast(float, w << 16); }
__device__ __forceinline__ float bfhi(unsigned w) { return __builtin_bit_cast(float, w & 0xffff0000u); }
__device__ __forceinline__ float frcp(float x) { return __builtin_amdgcn_rcpf(x); }
__device__ __forceinline__ float frsq(float x) { return __builtin_amdgcn_rsqf(x); }
__device__ __forceinline__ float sigmoidf_(float x) { return frcp(1.0f + __expf(-x)); }
__device__ __forceinline__ float siluf_(float x) { return x * frcp(1.0f + __expf(-x)); }
__device__ __forceinline__ float gelu_tanh(float x) { const float z = 0.7978845608028654f * (x + 0.044715f * x * x * x); return x * frcp(1.0f + __expf(-2.0f * z)); }
__device__ __forceinline__ float softplusf_(float x) { return x > 20.f ? x : log1pf(expf(x)); }
__device__ __forceinline__ float softplus_fast(float x) { return x > 20.f ? x : __logf(1.0f + __expf(x)); }
__device__ __forceinline__ float wave_sum(float v) {
#pragma unroll
    for (int o = 1; o < 64; o <<= 1) v += __shfl_xor(v, o);
    return v;
}
__device__ __forceinline__ bf16x8 pack8(const float* f) { v4u w; w.x = pk2(f[0], f[1]); w.y = pk2(f[2], f[3]); w.z = pk2(f[4], f[5]); w.w = pk2(f[6], f[7]); return __builtin_bit_cast(bf16x8, w); }
constexpr int S256 = 272, S128 = 144, S512 = 528;
__device__ __forceinline__ int t256(int row, int col) { return row * S256 + col * 2; }
__device__ __forceinline__ int t128(int row, int col) { return row * S128 + col * 2; }
__device__ __forceinline__ int t512(int row, int col) { return row * S512 + col * 2; }

#define XB_TMO      128
#define XB_XCNT(j)  (256  + 64 * (j))
#define XB_XSUB(j)  (1280 + 64 * (j))
#define XB_XGEN(j)  (2304 + 64 * (j))
#define XB_TOP      3328
#define XB_TOPGEN   3392
#define XCD_BAR_WORDS 3456
#define XB_SPIN_CAP (1u << 20)
__device__ __forceinline__ unsigned xb_ld(unsigned* p)              { return __hip_atomic_load(p, __ATOMIC_RELAXED, __HIP_MEMORY_SCOPE_AGENT); }
__device__ __forceinline__ unsigned xb_add(unsigned* p, unsigned v) { return __hip_atomic_fetch_add(p, v, __ATOMIC_RELAXED, __HIP_MEMORY_SCOPE_AGENT); }
__device__ __forceinline__ unsigned xb_xcc_id() { return (unsigned)__builtin_amdgcn_s_getreg((3 << 11) | 20) & 0xFu; }
#define XB_SPIN(cond, bar) do { unsigned _sp = 0; while (cond) { __builtin_amdgcn_s_sleep(1); \
    if ((++_sp & 255u) == 0u) { if (xb_ld(&(bar)[XB_TMO])) break; if (_sp > XB_SPIN_CAP) { atomicAdd(&(bar)[XB_TMO], 1u); break; } } } } while (0)
struct XcdBarrier { unsigned* bar; unsigned x; volatile LAS unsigned* st; };
__device__ __forceinline__ XcdBarrier xcd_barrier_post(unsigned* bar, volatile LAS unsigned* st) {
    XcdBarrier b; b.bar = bar; b.x = xb_xcc_id(); b.st = st;
    if (threadIdx.x == 0) (void)xb_add(&bar[XB_XCNT(b.x)], 1u);
    return b;
}
__device__ __forceinline__ void xcd_barrier_complete(unsigned* bar, unsigned x, unsigned& nloc, unsigned& nx) {
    const unsigned G = gridDim.x * gridDim.y * gridDim.z;
    unsigned sum, cnt, mine, sp = 0u;
    for (;;) {
        sum = 0u; cnt = 0u; mine = 0u;
#pragma unroll
        for (unsigned j = 0; j < 16; ++j) { const unsigned c = xb_ld(&bar[XB_XCNT(j)]); sum += c; cnt += (c > 0u) ? 1u : 0u; mine = (j == x) ? c : mine; }
        if (sum == G) break;
        __builtin_amdgcn_s_sleep(1);
        if ((++sp & 255u) == 0u) { if (xb_ld(&bar[XB_TMO])) break; if (sp > XB_SPIN_CAP) { atomicAdd(&bar[XB_TMO], 1u); break; } }
    }
    nloc = mine > 0u ? mine : 1u; nx = cnt > 0u ? cnt : 1u;
}
template <bool FENCED = true>
__device__ __forceinline__ void xcd_barrier(const XcdBarrier& b) {
    asm volatile("s_waitcnt vmcnt(0)" ::: "memory");
    __syncthreads();
    if (threadIdx.x == 0) {
        unsigned* bar = b.bar;
        __builtin_amdgcn_s_waitcnt(0);
        unsigned nloc = b.st[0], nx = b.st[1];
        if (nloc == 0u) { xcd_barrier_complete(bar, b.x, nloc, nx); b.st[0] = nloc; b.st[1] = nx; }
        const unsigned old = xb_add(&bar[XB_XSUB(b.x)], 1u);
        const unsigned gen = old / nloc;
        if (old + 1u == (gen + 1u) * nloc) {
            if (FENCED) __builtin_amdgcn_fence(__ATOMIC_RELEASE, "agent");
            asm volatile("s_waitcnt vmcnt(0)" ::: "memory");
            const unsigned og = xb_add(&bar[XB_TOP], 1u);
            const unsigned tg = og / nx;
            if (og + 1u == (tg + 1u) * nx) xb_add(&bar[XB_TOPGEN], 1u);
            else XB_SPIN(xb_ld(&bar[XB_TOPGEN]) == tg, bar);
            if (FENCED) __builtin_amdgcn_fence(__ATOMIC_ACQUIRE, "agent");
            xb_add(&bar[XB_XGEN(b.x)], 1u);
            asm volatile("s_waitcnt vmcnt(0)" ::: "memory");
        } else {
            XB_SPIN(xb_ld(&bar[XB_XGEN(b.x)]) == gen, bar);
            if (FENCED) __builtin_amdgcn_fence(__ATOMIC_ACQUIRE, "agent");
            asm volatile("s_waitcnt vmcnt(0)" ::: "memory");
        }
    }
    __syncthreads();
}

struct Frame {
    LAS unsigned char* lds;
    int tid, lane, wave, wg, G;
    const float* const* in;
    float* out; unsigned char* ws;
};
enum { I_XP = 0, I_XS, I_S5RE, I_S5IM, I_LRUH, I_LRUC, I_GS, I_GC, I_NMPRE, I_NMPOST, I_NFPRE, I_NFPOST, I_WIN, I_LRE, I_LIM, I_LDT, I_BRE, I_BIM, I_CRE, I_CIM, I_S5D, I_WGLU, I_BGLU,
       I_LCW, I_LCB, I_LWA, I_LBA, I_LWX, I_LBX, I_LLAM, I_GCW, I_GALOG, I_GDTB, I_GNW, I_WOUT, I_WGU, I_WDN };

__device__ __forceinline__ void transpose_item(const float* W, int ldw, int K, int k0, int c0, bf16* WT, int r0, LAS float* scr, int lane, const float* ksc = nullptr) {
    float tv[32];
#pragma unroll
    for (int i = 0; i < 32; ++i) tv[i] = W[(size_t)(k0 + 2 * i + (lane >> 5)) * ldw + c0 + (lane & 31)];
    if (ksc) {
#pragma unroll
        for (int i = 0; i < 32; ++i) tv[i] *= ksc[k0 + 2 * i + (lane >> 5)];
    }
#pragma unroll
    for (int i = 0; i < 32; ++i) scr[(2 * i + (lane >> 5)) * 33 + (lane & 31)] = tv[i];
    LDS_WAIT(); asm volatile("" ::: "memory");
    const int c = lane & 7;
#pragma unroll
    for (int j = 0; j < 4; ++j) { const int n = (lane >> 3) + 8 * j; const LAS float* s = scr + (8 * c) * 33 + n;
        v4u o; o.x = pk2(s[0 * 33], s[1 * 33]); o.y = pk2(s[2 * 33], s[3 * 33]); o.z = pk2(s[4 * 33], s[5 * 33]); o.w = pk2(s[6 * 33], s[7 * 33]);
        *(GAS v4u*)(WT + (size_t)(r0 + n) * K + k0 + 8 * c) = o; }
    LDS_WAIT(); asm volatile("" ::: "memory");
}
template <int MASK>
__device__ __forceinline__ void convert_items(Frame& F, int l, int wg0) {
    LAS float* scr = (LAS float*)(F.lds + F.wave * 16384);
    int lane = F.lane; asm volatile("" : "+v"(lane));
    const int gw = (F.wg - wg0) * NWAVES + F.wave, NGW = (F.G - wg0) * NWAVES;
    if (gw < 0) return;
    constexpr int I1 = (MASK & 1) ? 16 * 88 : 0, I2 = (MASK & 2) ? 16 * 32 : 0, I3 = (MASK & 4) ? 16 * 176 : 0, I4 = (MASK & 8) ? 44 * 32 : 0, I5 = (MASK & 16) ? 4 * 8 : 0, NIT = I1 + I2 + I3 + I4 + I5;
    unsigned char* ws = F.ws;
    for (int it = gw; it < NIT; it += NGW) {
        int r = it;
        if (r < I1) { const int kb = r / 88, nb = r % 88; transpose_item(F.in[I_WIN] + (size_t)l * DM * INC, INC, DM, 64 * kb, nb * 32 + (nb >= 72 ? 8 : 0), (bf16*)(ws + WS_WIN), nb * 32, scr, lane, F.in[I_NMPRE] + l * DM); continue; } r -= I1;
        if (r < I2) { const int kb = r / 32, nb = r % 32; transpose_item(F.in[I_WOUT] + (size_t)l * DM * DM, DM, DM, 64 * kb, nb * 32, (bf16*)(ws + WS_WOUT), nb * 32, scr, lane); continue; } r -= I2;
        if (r < I3) { const int kb = r / 176, nb = r % 176, tile = nb >> 3, wi = nb & 7; const int c0 = wi < 4 ? tile * 128 + wi * 32 : FF + tile * 128 + (wi - 4) * 32;
                      transpose_item(F.in[I_WGU] + (size_t)l * DM * 2 * FF, 2 * FF, DM, 64 * kb, c0, (bf16*)(ws + WS_WGU), nb * 32, scr, lane, F.in[I_NFPRE] + l * DM); continue; } r -= I3;
        if (r < I4) { const int kb = r / 32, nb = r % 32; transpose_item(F.in[I_WDN] + (size_t)l * FF * DM, DM, FF, 64 * kb, nb * 32, (bf16*)(ws + WS_WDN), nb * 32, scr, lane); continue; } r -= I4;
        if (r < I5) { const int kb = r / 8, nb = r % 8; transpose_item(F.in[I_WGLU] + (size_t)l * 256 * 256, 256, 256, 64 * kb, nb * 32, (bf16*)(ws + WS_WGLU), nb * 32, scr, lane); }
    }
}
constexpr size_t WS_DEP = 256 * 1024;
__device__ __forceinline__ unsigned* dep_word(Frame& F, int bank, int i) { return (unsigned*)(F.ws + WS_CTL + WS_DEP) + ((size_t)bank * 96 + i) * 64; }
__device__ __forceinline__ void dep_publish(Frame& F, unsigned* w0, unsigned* w1) {
    asm volatile("s_waitcnt vmcnt(0)" ::: "memory");
    __syncthreads();
    if (F.tid == 0) {
        __builtin_amdgcn_fence(__ATOMIC_RELEASE, "agent");
        asm volatile("s_waitcnt vmcnt(0)" ::: "memory");
        (void)xb_add(w0, 1u);
        if (w1) (void)xb_add(w1, 1u);
    }
}
__device__ __forceinline__ void dep_wait(Frame& F, unsigned* w0, unsigned n0, unsigned* w1, unsigned n1, unsigned* bar) {
    if (F.tid == 0) {
        XB_SPIN(xb_ld(w0) < n0, bar);
        if (w1) XB_SPIN(xb_ld(w1) < n1, bar);
        __builtin_amdgcn_fence(__ATOMIC_ACQUIRE, "agent");
        asm volatile("s_waitcnt vmcnt(0)" ::: "memory");
    }
    __syncthreads();
}
template <bool XIN_B, bool XOUT_B, bool LOCAL = false>
__device__ __forceinline__ void row_pass(Frame& F, const float* xp, const float* xs, const bf16* branch, const float* wb, float* xout, const float* wh, float* RS, const float* wab, float* AB, int lbase = 0, unsigned* sw = nullptr, unsigned sn = 0, unsigned* bar = nullptr) {
    int lane = F.lane; asm volatile("" : "+v"(lane));
    const int gw = F.wg * NWAVES + F.wave, NGW = F.G * NWAVES;
    f32x4 wbv[4], whv[4];
#pragma unroll
    for (int j = 0; j < 4; ++j) { wbv[j] = branch ? *(const GAS f32x4*)(wb + 4 * lane + 256 * j) : (f32x4){0.f, 0.f, 0.f, 0.f}; whv[j] = wh ? *(const GAS f32x4*)(wh + 4 * lane + 256 * j) : (f32x4){0.f, 0.f, 0.f, 0.f}; }
    LAS float* WL = (LAS float*)F.lds;
    if (wab) {
        f32x4 wl4[4];
#pragma unroll
        for (int k4 = 0; k4 < 4; ++k4) { const int i = F.tid + k4 * NTHR; const int k = i >> 1, hlf = i & 1; wl4[k4] = *(const GAS f32x4*)(wab + (size_t)k * INC + 2304 + hlf * 4); }
        __syncthreads();
#pragma unroll
        for (int k4 = 0; k4 < 4; ++k4) { const int i = F.tid + k4 * NTHR; const int k = i >> 1, hlf = i & 1; *(LAS f32x4*)(WL + k * 8 + hlf * 4) = wl4[k4]; }
        __syncthreads(); }
    const int nit = LOCAL ? (F.wave < 2 ? 9 : 8) : (MT - gw + NGW - 1) / NGW;
    for (int it = 0; it < nit; ++it) {
        const int m = LOCAL ? (it < 8 ? lbase + it : MP + 2 * F.wg + F.wave) : gw + it * NGW;
        if (LOCAL && it == 8) {
            XB_SPIN(xb_ld(sw) < sn, bar);
            __builtin_amdgcn_fence(__ATOMIC_ACQUIRE, "agent");
            asm volatile("s_waitcnt vmcnt(0)" ::: "memory");
        }
        f32x4 v[4];
        if (XIN_B) {
#pragma unroll
            for (int j = 0; j < 4; ++j) { const v2u w = *(const GAS v2u*)((const bf16*)xp + (size_t)m * DM + 4 * lane + 256 * j); v[j] = (f32x4){bflo(w.x), bfhi(w.x), bflo(w.y), bfhi(w.y)}; }
        } else {
            const float* xr = (xs && m >= MP) ? xs + (size_t)(m - MP) * DM : xp + (size_t)m * DM;
#pragma unroll
            for (int j = 0; j < 4; ++j) v[j] = *(const GAS f32x4*)(xr + 4 * lane + 256 * j);
        }
        if (branch) {
            f32x4 b[4]; float s = 0.f;
#pragma unroll
            for (int j = 0; j < 4; ++j) { const v2u bw = *(const GAS v2u*)(branch + (size_t)m * DM + 4 * lane + 256 * j); b[j] = (f32x4){bflo(bw.x), bfhi(bw.x), bflo(bw.y), bfhi(bw.y)}; s += (b[j].x * b[j].x + b[j].y * b[j].y) + (b[j].z * b[j].z + b[j].w * b[j].w); }
            const float rs = 1.0f / sqrtf(wave_sum(s) * (1.f / DM) + EPS);
#pragma unroll
            for (int j = 0; j < 4; ++j) v[j] = v[j] + b[j] * rs * wbv[j];
        }
        if (xout) {
#pragma unroll
            for (int j = 0; j < 4; ++j) {
                if (XOUT_B) { v2u o; o.x = pk2(v[j].x, v[j].y); o.y = pk2(v[j].z, v[j].w); *(GAS v2u*)((bf16*)xout + (size_t)m * DM + 4 * lane + 256 * j) = o; }
                else *(GAS f32x4*)(xout + (size_t)m * DM + 4 * lane + 256 * j) = v[j];
            }
        }
        if (RS) {
            float s = 0.f;
#pragma unroll
            for (int j = 0; j < 4; ++j) s += (v[j].x * v[j].x + v[j].y * v[j].y) + (v[j].z * v[j].z + v[j].w * v[j].w);
            const float rs = 1.0f / sqrtf(wave_sum(s) * (1.f / DM) + EPS);
            if (lane == 0) RS[m] = rs;
            if (wab) {
#pragma unroll
                for (int j = 0; j < 4; ++j) v[j] = v[j] * rs * whv[j];
            }
            if (wab) {
                float a8[8];
#pragma unroll
                for (int c = 0; c < 8; ++c) a8[c] = 0.f;
#pragma unroll
                for (int j = 0; j < 4; ++j)
#pragma unroll
                    for (int q = 0; q < 4; ++q) { const LAS float* wr = WL + (4 * lane + 256 * j + q) * 8; const f32x4 w0 = *(const LAS f32x4*)wr, w1 = *(const LAS f32x4*)(wr + 4); const float xv = v[j][q];
                        a8[0] += xv * w0.x; a8[1] += xv * w0.y; a8[2] += xv * w0.z; a8[3] += xv * w0.w; a8[4] += xv * w1.x; a8[5] += xv * w1.y; a8[6] += xv * w1.z; a8[7] += xv * w1.w; }
#pragma unroll
                for (int c = 0; c < 8; ++c) a8[c] = wave_sum(a8[c]);
                if (lane == 0) { *(GAS f32x4*)(AB + (size_t)m * 8) = (f32x4){a8[0], a8[1], a8[2], a8[3]}; *(GAS f32x4*)(AB + (size_t)m * 8 + 4) = (f32x4){a8[4], a8[5], a8[6], a8[7]}; }
            }
        }
    }
}

__device__ __forceinline__ void sample_gemm_f32(Frame& F, const bf16* A, const bf16* Bt, int K, bf16* C) {
    int tid = F.tid; asm volatile("" : "+v"(tid)); const int lane = tid & 63, wv = tid >> 6, fr = lane & 15, fq = lane >> 4;
    for (int t = F.wg; t < 256; t += F.G) {
        const int row0 = MP + 32 * (t >> 4) + 16 * (wv >> 2), col0 = 64 * (t & 15) + 16 * (wv & 3);
        const bf16* ap = A + (size_t)(row0 + fr) * K + 8 * fq; const bf16* bp = Bt + (size_t)(col0 + fr) * K + 8 * fq;
        f32x4 acc0 = (f32x4){0.f, 0.f, 0.f, 0.f}, acc1 = (f32x4){0.f, 0.f, 0.f, 0.f};
#pragma unroll 4
        for (int k = 0; k < K; k += 64) {
            const v4u a0 = *(const GAS v4u*)(ap + k), b0 = *(const GAS v4u*)(bp + k), a1 = *(const GAS v4u*)(ap + k + 32), b1 = *(const GAS v4u*)(bp + k + 32);
            acc0 = MFMA16(__builtin_bit_cast(bf16x8, a0), __builtin_bit_cast(bf16x8, b0), acc0); acc1 = MFMA16(__builtin_bit_cast(bf16x8, a1), __builtin_bit_cast(bf16x8, b1), acc1);
        }
#pragma unroll
        for (int r = 0; r < 4; ++r) C[(size_t)(row0 + 4 * fq + r) * DM + col0 + fr] = (bf16)f2bf(acc0[r] + acc1[r]);
    }
}

__device__ __forceinline__ void sample_gemm_lds(Frame& F, const bf16* A, const bf16* Bt, int K, bf16* C) {
    int tid = F.tid; asm volatile("" : "+v"(tid)); const int lane = tid & 63, wv = tid >> 6, fr = lane & 15, fq = lane >> 4;
    LAS unsigned char* L = F.lds;
    constexpr int SA = 32 * S512, SBUF = SA + 64 * S512;
    for (int t = F.wg; t < 256; t += F.G) {
        const int row0 = MP + 32 * (t >> 4), col0 = 64 * (t & 15);
        const int pr = tid >> 5, pc = (tid & 31) * 8;
        const bf16* ap = A + (size_t)(row0 + pr) * K + pc; const bf16* bp = Bt + (size_t)(col0 + pr) * K + pc;
        const size_t s16 = (size_t)16 * K;
        const int sa = pr * S512 + pc * 2, sb = SA + sa;
        v4u ra0 = *(const GAS v4u*)ap, ra1 = *(const GAS v4u*)(ap + s16);
        v4u rb0 = *(const GAS v4u*)bp, rb1 = *(const GAS v4u*)(bp + s16), rb2 = *(const GAS v4u*)(bp + 2 * s16), rb3 = *(const GAS v4u*)(bp + 3 * s16);
        *(LAS v4u*)(L + sa) = ra0; *(LAS v4u*)(L + sa + 16 * S512) = ra1;
        *(LAS v4u*)(L + sb) = rb0; *(LAS v4u*)(L + sb + 16 * S512) = rb1; *(LAS v4u*)(L + sb + 32 * S512) = rb2; *(LAS v4u*)(L + sb + 48 * S512) = rb3;
        __syncthreads();
        f32x4 acc = (f32x4){0.f, 0.f, 0.f, 0.f};
        const int nc = K >> 8;
        for (int kc = 0; kc < nc; ++kc) {
            const int cur = (kc & 1) * SBUF, nxt = ((kc + 1) & 1) * SBUF;
            if (kc + 1 < nc) { const int o = (kc + 1) * 256;
                ra0 = *(const GAS v4u*)(ap + o); ra1 = *(const GAS v4u*)(ap + s16 + o);
                rb0 = *(const GAS v4u*)(bp + o); rb1 = *(const GAS v4u*)(bp + s16 + o); rb2 = *(const GAS v4u*)(bp + 2 * s16 + o); rb3 = *(const GAS v4u*)(bp + 3 * s16 + o); }
#pragma unroll
            for (int ks = 0; ks < 8; ++ks) {
                const bf16x8 af = *(const LAS bf16x8*)(L + cur + (16 * (wv >> 2) + fr) * S512 + (32 * ks + 8 * fq) * 2);
                const bf16x8 bf = *(const LAS bf16x8*)(L + cur + SA + (16 * (wv & 3) + fr) * S512 + (32 * ks + 8 * fq) * 2);
                acc = MFMA16(af, bf, acc);
            }
            if (kc + 1 < nc) { *(LAS v4u*)(L + nxt + sa) = ra0; *(LAS v4u*)(L + nxt + sa + 16 * S512) = ra1;
                *(LAS v4u*)(L + nxt + sb) = rb0; *(LAS v4u*)(L + nxt + sb + 16 * S512) = rb1; *(LAS v4u*)(L + nxt + sb + 32 * S512) = rb2; *(LAS v4u*)(L + nxt + sb + 48 * S512) = rb3; }
            __syncthreads();
        }
#pragma unroll
        for (int r = 0; r < 4; ++r) C[(size_t)(row0 + 16 * (wv >> 2) + 4 * fq + r) * DM + col0 + 16 * (wv & 3) + fr] = (bf16)f2bf(acc[r]);
    }
}

constexpr int G_KN = 0, G_WKT = 0, G_QN = 18432, G_KT = G_QN + 64 * S256, G_VT = G_KT + 128 * S128, G_RAW = G_VT + 128 * S128, G_AT = G_RAW, G_T1 = G_AT + 64 * S128, G_T2 = G_T1 + 64 * S128, G_AF = G_T2 + 64 * S128, G_WVT = G_AF, G_VEC = G_RAW + 52544, G_CW = G_VEC + 1024;
constexpr int RAW_STRIDE = 784;
static_assert(G_RAW + 67 * RAW_STRIDE <= G_VEC && G_CW + 6144 <= LDSCTL_OFF && G_WVT + 128 * S128 <= G_VEC && 64 * S256 <= G_QN && 128 * S128 <= G_QN, "gdn prep lds");
__device__ __forceinline__ void gdn_raw_load(Frame& F, int u, int tid, v4u (&pre)[7], float (&abn)[2]) {
    const int c = u & 31, h = (u >> 5) & 3, b = u >> 7; const bf16* P = (const bf16*)(F.ws + WS_P);
    { const float* ABp = (const float*)(F.ws + WS_AB) + (size_t)(b * SEQ + c * 64 + (tid & 63)) * 8; abn[0] = ABp[h]; abn[1] = ABp[4 + h]; }
#pragma unroll
    for (int k7 = 0; k7 < 7; ++k7) { const int idx = tid + NTHR * k7; const int r = idx / 48, ck = idx % 48, ten = ck >> 4, c16 = ck & 15; const int tt = c * 64 - 3 + r;
        v4u val = (v4u){0u, 0u, 0u, 0u};
        if (idx < 67 * 48 && tt >= 0) val = *(const GAS v4u*)(P + (size_t)(b * SEQ + tt) * NPJ + PQ + ten * 512 + h * HD + c16 * 8);
        pre[k7] = val; }
}
template <int GP_CUT>
__device__ __forceinline__ void gdn_prep(Frame& F, int l, int u, int& cw_head, v4u (&pre)[7], float (&abn)[2], bool have_pre, int u_next) {
    LAS unsigned char* L = F.lds;
    int tid = F.tid; asm volatile("" : "+v"(tid)); const int lane = tid & 63, wv = tid >> 6;
    const int c = u & 31, h = (u >> 5) & 3, b = u >> 7;
    const int row0 = b * SEQ + c * 64;
    const bf16* P = (const bf16*)(F.ws + WS_P);
    const float* AB = (const float*)(F.ws + WS_AB);
    LAS float* VG = (LAS float*)(L + G_VEC); LAS float* VB = VG + 64; LAS float* VEG = VG + 128; LAS float* VEGL = VG + 192;
    const float galog = F.in[I_GALOG][l * 4 + h], gdtb = F.in[I_GDTB][l * 4 + h];
    if (h != cw_head) {
        for (int idx = tid; idx < 1536; idx += NTHR) { const int j = idx / 384, cc = idx % 384; ((LAS float*)(L + G_CW))[idx] = F.in[I_GCW][(size_t)(l * 4 + j) * 1536 + (cc >> 7) * 512 + h * HD + (cc & 127)]; }
        cw_head = h;
    }
    if (!have_pre) gdn_raw_load(F, u, tid, pre, abn);
#pragma unroll
    for (int k7 = 0; k7 < 7; ++k7) { const int idx = tid + NTHR * k7; if (idx < 67 * 48) { const int r = idx / 48, ck = idx % 48; *(LAS v4u*)(L + G_RAW + r * RAW_STRIDE + (ck >> 4) * 256 + (ck & 15) * 16) = pre[k7]; } }
    if (wv == 0) {
        const float a = abn[0], bb = abn[1];
        const float g = -__expf(galog) * softplus_fast(a + gdtb);
        const float be = frcp(1.0f + __expf(-bb));
        float Gc = g;
#pragma unroll
        for (int o = 1; o < 64; o <<= 1) { const float t = __shfl_up(Gc, o); if (lane >= o) Gc += t; }
        const float Gl = __shfl(Gc, 63);
        VG[lane] = Gc; VB[lane] = be; VEG[lane] = __expf(Gc); VEGL[lane] = __expf(Gl - Gc);
        if (lane == 0) ((float*)(F.ws + WS_EGL))[u] = __expf(Gl);
    }
    __syncthreads();
    if (u_next >= 0) gdn_raw_load(F, u_next, tid, pre, abn);
    if (c == 31 && tid < 384) {
        const int ten = tid >> 7, ch = tid & 127;
#pragma unroll
        for (int j = 0; j < 3; ++j) F.out[O_PGC + (size_t)((l * 8 + b) * 3 + j) * 1536 + ten * 512 + h * HD + ch] = bf2f(*(LAS bf16*)(L + G_RAW + (64 + j) * RAW_STRIDE + ten * 256 + ch * 2));
    }
    {
        const int i = tid >> 3, cg = tid & 7;
#pragma unroll 1
        for (int ten = 0; ten < 3; ++ten) {
            float acc[16];
#pragma unroll
            for (int e = 0; e < 16; ++e) acc[e] = 0.f;
#pragma unroll
            for (int j = 0; j < 4; ++j) {
                const v4u x0 = *(LAS v4u*)(L + G_RAW + (i + j) * RAW_STRIDE + ten * 256 + cg * 32), x1 = *(LAS v4u*)(L + G_RAW + (i + j) * RAW_STRIDE + ten * 256 + cg * 32 + 16);
                const LAS float* w = (const LAS float*)(L + G_CW) + j * 384 + ten * 128 + cg * 16;
                const f32x4 w0 = *(const LAS f32x4*)w, w1 = *(const LAS f32x4*)(w + 4), w2 = *(const LAS f32x4*)(w + 8), w3 = *(const LAS f32x4*)(w + 12);
                acc[0] += w0.x * bflo(x0.x); acc[1] += w0.y * bfhi(x0.x); acc[2] += w0.z * bflo(x0.y); acc[3] += w0.w * bfhi(x0.y);
                acc[4] += w1.x * bflo(x0.z); acc[5] += w1.y * bfhi(x0.z); acc[6] += w1.z * bflo(x0.w); acc[7] += w1.w * bfhi(x0.w);
                acc[8] += w2.x * bflo(x1.x); acc[9] += w2.y * bfhi(x1.x); acc[10] += w2.z * bflo(x1.y); acc[11] += w2.w * bfhi(x1.y);
                acc[12] += w3.x * bflo(x1.z); acc[13] += w3.y * bfhi(x1.z); acc[14] += w3.z * bflo(x1.w); acc[15] += w3.w * bfhi(x1.w);
            }
            float ss = 0.f;
#pragma unroll
            for (int e = 0; e < 16; ++e) { acc[e] = siluf_(acc[e]); ss += acc[e] * acc[e]; }
            ss += __shfl_xor(ss, 1); ss += __shfl_xor(ss, 2); ss += __shfl_xor(ss, 4);
            const float sc = ten == 2 ? 1.0f : frsq(ss + EPS) * (ten == 0 ? 0.08838834764831845f : 1.0f);
#pragma unroll
            for (int e = 0; e < 16; ++e) acc[e] *= sc;
            if (ten < 2) { const int base = ten == 0 ? G_QN : G_KN; *(LAS bf16x8*)(L + base + t256(i, cg * 16)) = pack8(acc); *(LAS bf16x8*)(L + base + t256(i, cg * 16 + 8)) = pack8(acc + 8); }
            if (ten > 0) { const int base = ten == 1 ? G_KT : G_VT;
#pragma unroll
                for (int e = 0; e < 16; ++e) *(LAS bf16*)(L + base + t128(cg * 16 + e, i)) = (bf16)f2bf(acc[e]); }
        }
    }
    __syncthreads();
    if constexpr (GP_CUT == 1) return;
    {
        const int prod = wv >> 2, mi = wv & 3, fr = lane & 15, fq = lane >> 4;
        bf16x8 a[4];
#pragma unroll
        for (int ks = 0; ks < 4; ++ks) a[ks] = *(LAS bf16x8*)(L + (prod ? G_QN : G_KN) + t256(16 * mi + fr, 32 * ks + 8 * fq));
#pragma unroll
        for (int nj = 0; nj < 4; ++nj) {
            f32x4 acc = (f32x4){0.f, 0.f, 0.f, 0.f};
            if (nj <= mi) {
#pragma unroll
                for (int ks = 0; ks < 4; ++ks) { const bf16x8 bb = *(LAS bf16x8*)(L + G_KN + t256(16 * nj + fr, 32 * ks + 8 * fq)); acc = MFMA16(a[ks], bb, acc); }
            }
            const int j = 16 * nj + fr; const float Gj = VG[j];
#pragma unroll
            for (int r = 0; r < 4; ++r) {
                const int i = 16 * mi + 4 * fq + r; const float Gi = VG[i];
                const float dec = (i >= j) ? __expf(Gi - Gj) : 0.f;
                if (prod == 0) { const float val = (i > j) ? acc[r] * VB[i] * dec : 0.f; *(LAS float*)(L + G_AF + (i * 64 + j) * 4) = val; }
                else { const float val = (i >= j) ? acc[r] * dec : 0.f; *(LAS bf16*)(L + G_AT + t128(i, j)) = (bf16)f2bf(val); }
            }
        }
    }
    __syncthreads();
    if constexpr (GP_CUT == 2) return;
    if (wv == 0) {
        const int q = lane >> 4, col = lane & 15; const LAS float* Ab = (const LAS float*)(L + G_AF) + (16 * q) * 64 + 16 * q;
        float t[16];
#pragma unroll
        for (int i = 0; i < 16; ++i) {
            float a0 = (col == i) ? 1.f : 0.f, a1 = 0.f, a2 = 0.f, a3 = 0.f;
#pragma unroll
            for (int j4 = 0; j4 < i; j4 += 4) { const f32x4 av = *(const LAS f32x4*)(Ab + i * 64 + j4);
                a0 -= av.x * t[j4]; if (j4 + 1 < i) a1 -= av.y * t[j4 + 1]; if (j4 + 2 < i) a2 -= av.z * t[j4 + 2]; if (j4 + 3 < i) a3 -= av.w * t[j4 + 3]; }
            t[i] = (a0 + a1) + (a2 + a3);
            if ((i & 3) == 3) asm volatile("" ::: "memory");
        }
        LAS float* Tb = (LAS float*)(L + G_AF) + (16 * q) * 64 + 16 * q;
#pragma unroll
        for (int i = 0; i < 16; ++i) Tb[i * 64 + col] = t[i];
    }
    __syncthreads();
    if (wv < 2) {
        LAS float* AF = (LAS float*)(L + G_AF) + (32 * wv) * 64 + 32 * wv; LAS float* X1 = (LAS float*)(L + G_T1) + 1024 + 256 * wv;
        const int fr = lane & 15, fq = lane >> 4;
        f32x4 acc = (f32x4){0.f, 0.f, 0.f, 0.f};
#pragma unroll
        for (int kk = 0; kk < 4; ++kk) { const float av = AF[(16 + fr) * 64 + 4 * kk + fq], bv = AF[(4 * kk + fq) * 64 + fr]; acc = __builtin_amdgcn_mfma_f32_16x16x4f32(av, bv, acc, 0, 0, 0); }
#pragma unroll
        for (int r = 0; r < 4; ++r) X1[(4 * fq + r) * 16 + fr] = acc[r];
        acc = (f32x4){0.f, 0.f, 0.f, 0.f};
#pragma unroll
        for (int kk = 0; kk < 4; ++kk) { const float av = AF[(16 + fr) * 64 + 16 + 4 * kk + fq], bv = X1[(4 * kk + fq) * 16 + fr]; acc = __builtin_amdgcn_mfma_f32_16x16x4f32(av, bv, acc, 0, 0, 0); }
#pragma unroll
        for (int r = 0; r < 4; ++r) AF[(16 + 4 * fq + r) * 64 + fr] = -acc[r];
    }
    __syncthreads();
    if constexpr (GP_CUT == 3) return;
    {
        LAS float* AF = (LAS float*)(L + G_AF); LAS float* XF = (LAS float*)(L + G_T1);
        const int mi2 = wv & 1, nj2 = (wv >> 1) & 1, fr = lane & 15, fq = lane >> 4;
        if (wv < 4) {
            f32x4 acc = (f32x4){0.f, 0.f, 0.f, 0.f};
#pragma unroll
            for (int kk = 0; kk < 8; ++kk) { const float av = AF[(32 + 16 * mi2 + fr) * 64 + 4 * kk + fq], bv = AF[(4 * kk + fq) * 64 + 16 * nj2 + fr]; acc = __builtin_amdgcn_mfma_f32_16x16x4f32(av, bv, acc, 0, 0, 0); }
#pragma unroll
            for (int r = 0; r < 4; ++r) XF[(16 * mi2 + 4 * fq + r) * 32 + 16 * nj2 + fr] = acc[r];
        }
        __syncthreads();
        if (wv < 4) {
            f32x4 acc = (f32x4){0.f, 0.f, 0.f, 0.f};
#pragma unroll
            for (int kk = 0; kk < 8; ++kk) { const float av = AF[(32 + 16 * mi2 + fr) * 64 + 32 + 4 * kk + fq], bv = XF[(4 * kk + fq) * 32 + 16 * nj2 + fr]; acc = __builtin_amdgcn_mfma_f32_16x16x4f32(av, bv, acc, 0, 0, 0); }
#pragma unroll
            for (int r = 0; r < 4; ++r) AF[(32 + 16 * mi2 + 4 * fq + r) * 64 + 16 * nj2 + fr] = -acc[r];
        }
        __syncthreads();
    }
    if constexpr (GP_CUT == 4) return;
    {
        const int i = tid >> 3, c8 = tid & 7; const LAS float* AF = (const LAS float*)(L + G_AF);
        const f32x4 t0 = *(const LAS f32x4*)(AF + i * 64 + 8 * c8), t1 = *(const LAS f32x4*)(AF + i * 64 + 8 * c8 + 4);
        float a1[8], a2[8];
#pragma unroll
        for (int e = 0; e < 8; ++e) { const float tv = e < 4 ? t0[e] : t1[e - 4]; const int j = 8 * c8 + e; a1[e] = tv * VB[j]; a2[e] = a1[e] * VEG[j]; }
        __syncthreads();
        *(LAS bf16x8*)(L + G_T1 + t128(i, 8 * c8)) = pack8(a1); *(LAS bf16x8*)(L + G_T2 + t128(i, 8 * c8)) = pack8(a2);
    }
    __syncthreads();
    if constexpr (GP_CUT == 5) return;
    {
        const int nd = wv, fr = lane & 15, fq = lane >> 4;
#pragma unroll
        for (int prod = 0; prod < 2; ++prod) {
            bf16x8 bfr[2];
#pragma unroll
            for (int ks = 0; ks < 2; ++ks) bfr[ks] = *(LAS bf16x8*)(L + (prod ? G_KT : G_VT) + t128(16 * nd + fr, 32 * ks + 8 * fq));
#pragma unroll
            for (int mi = 0; mi < 4; ++mi) {
                f32x4 acc = (f32x4){0.f, 0.f, 0.f, 0.f};
#pragma unroll
                for (int ks = 0; ks < 2; ++ks) { const bf16x8 af = *(LAS bf16x8*)(L + (prod ? G_T2 : G_T1) + t128(16 * mi + fr, 32 * ks + 8 * fq)); acc = MFMA16(af, bfr[ks], acc); }
                v2u o; o.x = pk2(acc[0], acc[1]); o.y = pk2(acc[2], acc[3]);
                *(LAS v2u*)(L + (prod ? G_WKT : G_WVT) + t128(16 * nd + fr, 16 * mi + 4 * fq)) = o;
            }
        }
    }
    __syncthreads();
    if constexpr (GP_CUT == 6) return;
    {
        const int nd = wv, fr = lane & 15, fq = lane >> 4;
        bf16x8 bk[2], bv[2];
#pragma unroll
        for (int ks = 0; ks < 2; ++ks) { bk[ks] = *(LAS bf16x8*)(L + G_WKT + t128(16 * nd + fr, 32 * ks + 8 * fq)); bv[ks] = *(LAS bf16x8*)(L + G_WVT + t128(16 * nd + fr, 32 * ks + 8 * fq)); }
        bf16* QT = (bf16*)(F.ws + WS_QT) + (size_t)u * 64 * 128; bf16* OL = (bf16*)(F.ws + WS_OL) + (size_t)u * 8192;
#pragma unroll
        for (int mi = 0; mi < 4; ++mi) {
            f32x4 ak = (f32x4){0.f, 0.f, 0.f, 0.f}, av = (f32x4){0.f, 0.f, 0.f, 0.f};
#pragma unroll
            for (int ks = 0; ks < 2; ++ks) { const bf16x8 af = *(LAS bf16x8*)(L + G_AT + t128(16 * mi + fr, 32 * ks + 8 * fq)); ak = MFMA16(af, bk[ks], ak); av = MFMA16(af, bv[ks], av); }
#pragma unroll
            for (int r = 0; r < 4; ++r) { const int i = 16 * mi + 4 * fq + r, d = 16 * nd + fr;
                const float qv = bf2f(*(LAS bf16*)(L + G_QN + t256(i, d)));
                QT[(((mi * 4 + (nd >> 1)) * 64) + (4 * fq + r) + 16 * (2 * (nd & 1) + (fr >> 3))) * 8 + (fr & 7)] = (bf16)f2bf(VEG[i] * qv - ak[r]);
                }
            { v2u o; o.x = pk2(av[0], av[1]); o.y = pk2(av[2], av[3]); *(GAS v2u*)(OL + ((nd * 4 + mi) * 64 + lane) * 4) = o; }
        }
    }
    if constexpr (GP_CUT == 7) return;
    {
        const int fr = lane & 15, fq = lane >> 4;
        bf16x8 kd[2];
#pragma unroll
        for (int ks = 0; ks < 2; ++ks) { const v4u raw = *(LAS v4u*)(L + G_KT + t128(16 * wv + fr, 32 * ks + 8 * fq)); const int i0 = 32 * ks + 8 * fq; float f[8];
            f[0] = bflo(raw.x) * VEGL[i0]; f[1] = bfhi(raw.x) * VEGL[i0 + 1]; f[2] = bflo(raw.y) * VEGL[i0 + 2]; f[3] = bfhi(raw.y) * VEGL[i0 + 3];
            f[4] = bflo(raw.z) * VEGL[i0 + 4]; f[5] = bfhi(raw.z) * VEGL[i0 + 5]; f[6] = bflo(raw.w) * VEGL[i0 + 6]; f[7] = bfhi(raw.w) * VEGL[i0 + 7]; kd[ks] = pack8(f); }
        bf16* PP = (bf16*)(F.ws + WS_PP) + (size_t)u * 128 * 128; bf16* RT = (bf16*)(F.ws + WS_RT) + (size_t)u * 128 * 128;
#pragma unroll 2
        for (int nd = 0; nd < 8; ++nd) {
            f32x4 ar = (f32x4){0.f, 0.f, 0.f, 0.f}, ap = (f32x4){0.f, 0.f, 0.f, 0.f};
#pragma unroll
            for (int ks = 0; ks < 2; ++ks) { const bf16x8 wvf = *(LAS bf16x8*)(L + G_WVT + t128(16 * nd + fr, 32 * ks + 8 * fq)), wkf = *(LAS bf16x8*)(L + G_WKT + t128(16 * nd + fr, 32 * ks + 8 * fq));
                ar = MFMA16(kd[ks], wvf, ar); ap = MFMA16(wkf, kd[ks], ap); }
            v2u o; o.x = pk2(ar[0], ar[1]); o.y = pk2(ar[2], ar[3]); *(GAS v2u*)(RT + (size_t)((nd * 8 + wv) * 64 + lane) * 4) = o;
            o.x = pk2(ap[0], ap[1]); o.y = pk2(ap[2], ap[3]); *(GAS v2u*)(PP + (size_t)(((wv * 4 + (nd >> 1)) * 64) + fr + 16 * (2 * (nd & 1) + (fq >> 1))) * 8 + 4 * (fq & 1)) = o;
        }
    }
    __syncthreads();
}

struct ChainSet { v4u ap[4], aq[4]; v2u rr, ol; float eg; };
constexpr int CH_O = 2 * 16 * S256, CH_S = CH_O + 32 * 4 * 512;
static_assert(CH_S + 32 * 4 * 64 <= LDSCTL_OFF, "chain lds");
struct ChainPtr { const bf16* pp; const bf16* qq; const bf16* rt; const bf16* ol; const float* egl; };
__device__ __forceinline__ void chain_load(ChainSet& s, const ChainPtr& p, int c, bool lowhalf) {
    const bf16* pp = p.pp + (size_t)c * 16384;
#pragma unroll
    for (int ks = 0; ks < 4; ++ks) s.ap[ks] = *(const GAS v4u*)(pp + 512 * ks);
    s.rr = *(const GAS v2u*)(p.rt + (size_t)c * 16384); s.eg = p.egl[c];
    if (lowhalf) {
        const bf16* qq = p.qq + (size_t)c * 8192;
#pragma unroll
        for (int ks = 0; ks < 4; ++ks) s.aq[ks] = *(const GAS v4u*)(qq + 512 * ks);
        s.ol = *(const GAS v2u*)(p.ol + (size_t)c * 8192);
    }
}
template <bool DRY>
__device__ __forceinline__ void gdn_chain(Frame& F, int l, int task) {
    LAS unsigned char* L = F.lds;
    int tid = F.tid; asm volatile("" : "+v"(tid)); const int lane = tid & 63, wv = tid >> 6, fr = lane & 15, fq = lane >> 4;
    const int xcd = task & 7, idx = task >> 3; const int chain = xcd * 4 + (idx >> 3), slab = idx & 7;
    const int b = chain >> 2, h = chain & 3;
    const bf16* PPb = (const bf16*)(F.ws + WS_PP) + (size_t)chain * 32 * 16384; bf16* RTb = (bf16*)(F.ws + WS_RT) + (size_t)chain * 32 * 16384;
    const bf16* QTb = (const bf16*)(F.ws + WS_QT) + (size_t)chain * 32 * 8192;
    bf16* OLb = (bf16*)(F.ws + WS_OL) + (size_t)chain * 32 * 8192;
    float* SSQ = (float*)(F.ws + WS_SSQ);
    const float* EGL = (const float*)(F.ws + WS_EGL) + chain * 32;
    const int row0h = b * SEQ;
    for (int i = F.tid; i < 2 * 16 * S256 / 4; i += NTHR) ((LAS unsigned*)L)[i] = 0u;
    __syncthreads();
    f32x4 S = (f32x4){0.f, 0.f, 0.f, 0.f};
    ChainSet cs[4];
    ChainPtr cp;
    cp.pp = PPb + (size_t)(wv * 4 * 64 + lane) * 8; cp.qq = QTb + (size_t)((wv & 3) * 4 * 64 + lane) * 8;
    cp.rt = RTb + (size_t)((slab * 8 + wv) * 64 + lane) * 4;
    cp.ol = OLb + ((slab * 4 + (wv & 3)) * 64 + lane) * 4; cp.egl = EGL;
    asm volatile("" : "+v"(cp.pp), "+v"(cp.qq), "+v"(cp.rt), "+v"(cp.ol));
    const bool lowhalf = wv < 4;
    chain_load(cs[0], cp, 0, lowhalf); chain_load(cs[1], cp, 1, lowhalf); chain_load(cs[2], cp, 2, lowhalf);
#pragma unroll 1
    for (int c0 = 0; c0 < NCH; c0 += 4) {
#pragma unroll
        for (int s = 0; s < 4; ++s) {
            const int c = c0 + s;
            chain_load(cs[(s + 3) & 3], cp, c + 3 < NCH ? c + 3 : NCH - 1, lowhalf);
            const ChainSet& q = cs[s];
            const LAS unsigned char* St = L + (s & 1) * (16 * S256);
            bf16x8 bs[4];
#pragma unroll
            for (int ks = 0; ks < 4; ++ks) bs[ks] = *(const LAS bf16x8*)(St + t256(fr, 32 * ks + 8 * fq));
            f32x4 acc = (f32x4){0.f, 0.f, 0.f, 0.f};
#pragma unroll
            for (int ks = 0; ks < 4; ++ks) acc = MFMA16(__builtin_bit_cast(bf16x8, q.ap[ks]), bs[ks], acc);
            if (lowhalf) {
                f32x4 ao = (f32x4){0.f, 0.f, 0.f, 0.f};
#pragma unroll
                for (int ks = 0; ks < 4; ++ks) ao = MFMA16(__builtin_bit_cast(bf16x8, q.aq[ks]), bs[ks], ao);
                const float o0 = ao[0] + bflo(q.ol.x), o1 = ao[1] + bfhi(q.ol.x), o2 = ao[2] + bflo(q.ol.y), o3 = ao[3] + bfhi(q.ol.y);
                v2u ov; ov.x = pk2(o0, o1); ov.y = pk2(o2, o3);
                f32x4 ss = (f32x4){o0 * o0, o1 * o1, o2 * o2, o3 * o3};
#pragma unroll
                for (int sh = 1; sh < 16; sh <<= 1) { ss[0] += __shfl_xor(ss[0], sh); ss[1] += __shfl_xor(ss[1], sh); ss[2] += __shfl_xor(ss[2], sh); ss[3] += __shfl_xor(ss[3], sh); }
                {
                    *(LAS v2u*)(L + CH_O + ((c * 4 + wv) * 64 + lane) * 8) = ov;
                    if (fr == 0) *(LAS f32x4*)(L + CH_S + ((c * 4 + wv) * 4 + fq) * 16) = ss;
                }
            }
            S[0] = q.eg * S[0] - acc[0] + bflo(q.rr.x); S[1] = q.eg * S[1] - acc[1] + bfhi(q.rr.x); S[2] = q.eg * S[2] - acc[2] + bflo(q.rr.y); S[3] = q.eg * S[3] - acc[3] + bfhi(q.rr.y);
            v2u o2; o2.x = pk2(S[0], S[1]); o2.y = pk2(S[2], S[3]);
            *(LAS v2u*)(L + ((s + 1) & 1) * (16 * S256) + t256(fr, 16 * wv + 4 * fq)) = o2;
            asm volatile("s_waitcnt lgkmcnt(0)" ::: "memory"); __builtin_amdgcn_s_barrier(); asm volatile("" ::: "memory");
        }
    }
    if (!DRY) {
        bf16* MXh = (bf16*)(F.ws + WS_X) + 512 + h * HD + 16 * slab;
#if HEADNORM_IN_GEMM
        const bf16* Zh = (const bf16*)(F.ws + WS_P) + PZ + h * HD + 16 * slab + 8 * (tid & 1);
        const float* gwp = F.in[I_GNW] + l * HD + 16 * slab + 8 * (tid & 1);
        const f32x4 w0 = *(const GAS f32x4*)gwp, w1 = *(const GAS f32x4*)(gwp + 4);
#endif
#if HEADNORM_IN_GEMM
        v4u zq[8];
#pragma unroll
        for (int k = 0; k < 8; ++k) { const int i = tid + k * NTHR; zq[k] = *(const GAS v4u*)(Zh + (size_t)(row0h + (i >> 7) * 64 + ((i >> 1) & 63)) * NPJ); }
#pragma unroll
        for (int k = 0; k < 8; ++k) { const int i = tid + k * NTHR; const int half = i & 1, rr = (i >> 1) & 63, cc = i >> 7; const int mi = rr >> 4, fq2 = (rr >> 2) & 3, r = rr & 3;
#else
        for (int i = tid; i < 32 * 64 * 2; i += NTHR) { const int half = i & 1, rr = (i >> 1) & 63, cc = i >> 7; const int mi = rr >> 4, fq2 = (rr >> 2) & 3, r = rr & 3;
#endif
            unsigned w[4];
#pragma unroll
            for (int e = 0; e < 4; ++e) { const int f0 = 8 * half + 2 * e;
                const unsigned lo = *(const LAS unsigned short*)(L + CH_O + ((cc * 4 + mi) * 64 + fq2 * 16 + f0) * 8 + r * 2), hi = *(const LAS unsigned short*)(L + CH_O + ((cc * 4 + mi) * 64 + fq2 * 16 + f0 + 1) * 8 + r * 2);
                w[e] = lo | (hi << 16); }
#if HEADNORM_IN_GEMM
            const v4u zv = zq[k];
            float y[8];
            y[0] = bflo(w[0]) * w0.x * siluf_(bflo(zv.x)); y[1] = bfhi(w[0]) * w0.y * siluf_(bfhi(zv.x)); y[2] = bflo(w[1]) * w0.z * siluf_(bflo(zv.y)); y[3] = bfhi(w[1]) * w0.w * siluf_(bfhi(zv.y));
            y[4] = bflo(w[2]) * w1.x * siluf_(bflo(zv.z)); y[5] = bfhi(w[2]) * w1.y * siluf_(bfhi(zv.z)); y[6] = bflo(w[3]) * w1.z * siluf_(bflo(zv.w)); y[7] = bfhi(w[3]) * w1.w * siluf_(bfhi(zv.w));
            *(GAS bf16x8*)(MXh + (size_t)(row0h + cc * 64 + rr) * DM + 8 * half) = pack8(y); }
#else
            *(GAS v4u*)(MXh + (size_t)(row0h + cc * 64 + rr) * DM + 8 * half) = (v4u){w[0], w[1], w[2], w[3]}; }
#endif
        for (int i = tid; i < 32 * 64; i += NTHR) { const int rr = i & 63, cc = i >> 6; const int mi = rr >> 4, fq2 = (rr >> 2) & 3, r = rr & 3;
            SSQ[(size_t)(row0h + cc * 64 + rr) * 32 + h * 8 + slab] = *(const LAS float*)(L + CH_S + ((cc * 4 + mi) * 4 + fq2) * 16 + r * 4); }
        float* So = F.out + O_PGS + (size_t)((l * 8 + b) * 4 + h) * 16384;
#pragma unroll
        for (int r = 0; r < 4; ++r) So[(size_t)(16 * wv + 4 * fq + r) * 128 + 16 * slab + fr] = S[r];
    }
    __syncthreads();
}

__device__ __forceinline__ void gdn_finalize(Frame& F, int l) {
    bf16* MX = (bf16*)(F.ws + WS_X); const bf16* P = (const bf16*)(F.ws + WS_P); const float* SSQ = (const float*)(F.ws + WS_SSQ);
    const int nth = F.G * NTHR;
    for (int it = F.wg * NTHR + F.tid; it < MP * 64; it += nth) {
        const int row = it >> 6, hh = (it >> 4) & 3, ck = it & 15;
        const f32x4 s0 = *(const GAS f32x4*)(SSQ + (size_t)row * 32 + hh * 8), s1 = *(const GAS f32x4*)(SSQ + (size_t)row * 32 + hh * 8 + 4);
        const float rs = frsq(((s0.x + s0.y) + (s0.z + s0.w) + (s1.x + s1.y) + (s1.z + s1.w)) * (1.f / HD) + EPS);
        const v4u ov = *(const GAS v4u*)(MX + (size_t)row * DM + 512 + hh * HD + ck * 8), zv = *(const GAS v4u*)(P + (size_t)row * NPJ + PZ + hh * HD + ck * 8);
        const f32x4 w0 = *(const GAS f32x4*)(F.in[I_GNW] + l * HD + ck * 8), w1 = *(const GAS f32x4*)(F.in[I_GNW] + l * HD + ck * 8 + 4);
        float y[8];
        y[0] = bflo(ov.x) * rs * w0.x * siluf_(bflo(zv.x)); y[1] = bfhi(ov.x) * rs * w0.y * siluf_(bfhi(zv.x)); y[2] = bflo(ov.y) * rs * w0.z * siluf_(bflo(zv.y)); y[3] = bfhi(ov.y) * rs * w0.w * siluf_(bfhi(zv.y));
        y[4] = bflo(ov.z) * rs * w1.x * siluf_(bflo(zv.z)); y[5] = bfhi(ov.z) * rs * w1.y * siluf_(bfhi(zv.z)); y[6] = bflo(ov.w) * rs * w1.z * siluf_(bflo(zv.w)); y[7] = bfhi(ov.w) * rs * w1.w * siluf_(bfhi(zv.w));
        *(GAS bf16x8*)(MX + (size_t)row * DM + 512 + hh * HD + ck * 8) = pack8(y);
    }
}


__device__ __forceinline__ void gdn_sample_load(Frame& F, int l, int task, float (&S)[32]) {
    const int b = task >> 2, h = task & 3, j = F.tid & 127, rq = F.tid >> 7;
    const float* S0 = F.in[I_GS] + (size_t)((l * 128 + b) * 4 + h) * 16384 + (size_t)(32 * rq) * 128 + j;
#pragma unroll
    for (int ii = 0; ii < 32; ++ii) S[ii] = S0[ii * 128];
}
__device__ __forceinline__ void gdn_sample(Frame& F, int l, int task, float (&S)[32]) {
    LAS float* L = (LAS float*)F.lds;
    LAS float* RAW = L;
    LAS float* QS = L + 7 * 384;
    LAS float* KS = QS + 512; LAS float* VS = KS + 512; LAS float* OS = VS + 512;
    LAS float* RED = OS + 512;
    LAS float* NRM = RED + 512;
    int tid = F.tid; asm volatile("" : "+v"(tid)); const int lane = tid & 63, wv = tid >> 6;
    const int b = task >> 2, h = task & 3; const int m0 = MP + b * 4;
    const bf16* P = (const bf16*)(F.ws + WS_P); const float* AB = (const float*)(F.ws + WS_AB); bf16* MX = (bf16*)(F.ws + WS_X);
    const int j = tid & 127, rq = tid >> 7;
    float cwv[3][4], gA[4], gB[4]; float zv, gnw;
    const float galog = F.in[I_GALOG][l * 4 + h], dtb = F.in[I_GDTB][l * 4 + h];
    {
        const int tok = tid >> 7, ch = tid & 127;
#pragma unroll
        for (int ten = 0; ten < 3; ++ten)
#pragma unroll
            for (int jj = 0; jj < 4; ++jj) cwv[ten][jj] = F.in[I_GCW][(size_t)(l * 4 + jj) * 1536 + ten * 512 + h * HD + ch];
#pragma unroll
        for (int t = 0; t < 4; ++t) { gA[t] = AB[(size_t)(m0 + t) * 8 + h]; gB[t] = AB[(size_t)(m0 + t) * 8 + 4 + h]; }
        zv = bf2f(P[(size_t)(m0 + tok) * NPJ + PZ + h * HD + ch]); gnw = F.in[I_GNW][l * HD + ch];
    }
    {
        float rv[6];
#pragma unroll
        for (int k6 = 0; k6 < 6; ++k6) { const int idx = tid + k6 * NTHR; const int r = idx / 384, cc = idx % 384, ten = cc >> 7, ch = cc & 127;
            float v = 0.f;
            if (idx < 7 * 384) { if (r < 3) v = F.in[I_GC][(size_t)((l * 128 + b) * 3 + r) * 1536 + ten * 512 + h * HD + ch]; else v = bf2f(P[(size_t)(m0 + r - 3) * NPJ + PQ + ten * 512 + h * HD + ch]); }
            rv[k6] = v; }
#pragma unroll
        for (int k6 = 0; k6 < 6; ++k6) { const int idx = tid + k6 * NTHR; if (idx < 7 * 384) RAW[idx] = rv[k6]; }
    }
    __syncthreads();
    if (tid < 384) { const int ten = tid >> 7, ch = tid & 127;
#pragma unroll
        for (int j = 0; j < 3; ++j) F.out[O_SGC + (size_t)((l * 128 + b) * 3 + j) * 1536 + ten * 512 + h * HD + ch] = RAW[(4 + j) * 384 + tid]; }
    float cq, ck, cv;
    {
        const int tok = tid >> 7, ch = tid & 127; float r3[3];
#pragma unroll
        for (int ten = 0; ten < 3; ++ten) { float a = 0.f;
#pragma unroll
            for (int j = 0; j < 4; ++j) a += cwv[ten][j] * RAW[(tok + j) * 384 + ten * 128 + ch];
            r3[ten] = siluf_(a); }
        cq = r3[0]; ck = r3[1]; cv = r3[2];
        const float sq = wave_sum(cq * cq), sk = wave_sum(ck * ck);
        if (lane == 0) { NRM[wv * 4] = sq; NRM[wv * 4 + 1] = sk; }
    }
    __syncthreads();
    {
        const int tok = tid >> 7, ch = tid & 127;
        const float sq = NRM[(2 * tok) * 4] + NRM[(2 * tok + 1) * 4], sk = NRM[(2 * tok) * 4 + 1] + NRM[(2 * tok + 1) * 4 + 1];
        QS[tok * 128 + ch] = cq * frsq(sq + EPS) * 0.08838834764831845f; KS[tok * 128 + ch] = ck * frsq(sk + EPS); VS[tok * 128 + ch] = cv;
    }
    __syncthreads();
    float egv[4], bev[4];
    {
        const float al = -__expf(galog);
#pragma unroll
        for (int t = 0; t < 4; ++t) { const float a = gA[t], bb = gB[t]; egv[t] = __expf(al * softplus_fast(a + dtb)); bev[t] = frcp(1.0f + __expf(-bb)); }
    }
#pragma unroll
    for (int t = 0; t < 4; ++t) {
        const float eg = egv[t], be = bev[t];
        float part = 0.f;
#pragma unroll
        for (int ii = 0; ii < 32; ++ii) { S[ii] *= eg; part += S[ii] * KS[t * 128 + 32 * rq + ii]; }
        RED[rq * 128 + j] = part;
        __syncthreads();
        const float vn = be * (VS[t * 128 + j] - (RED[j] + RED[128 + j] + RED[256 + j] + RED[384 + j]));
        __syncthreads();
        part = 0.f;
#pragma unroll
        for (int ii = 0; ii < 32; ++ii) { S[ii] += KS[t * 128 + 32 * rq + ii] * vn; part += S[ii] * QS[t * 128 + 32 * rq + ii]; }
        RED[rq * 128 + j] = part;
        __syncthreads();
        if (rq == 0) OS[t * 128 + j] = RED[j] + RED[128 + j] + RED[256 + j] + RED[384 + j];
        __syncthreads();
    }
    float* So = F.out + O_SGS + (size_t)((l * 128 + b) * 4 + h) * 16384;
#pragma unroll
    for (int ii = 0; ii < 32; ++ii) So[(size_t)(32 * rq + ii) * 128 + j] = S[ii];
    {
        const int tok = tid >> 7, ch = tid & 127; const float o = OS[tok * 128 + ch];
        const float ss = wave_sum(o * o);
        if (lane == 0) NRM[wv * 4 + 2] = ss;
        __syncthreads();
        const float tot = NRM[(2 * tok) * 4 + 2] + NRM[(2 * tok + 1) * 4 + 2];
        MX[(size_t)(m0 + tok) * DM + 512 + h * HD + ch] = (bf16)f2bf(o * (frsq(tot * (1.f / HD) + EPS)) * gnw * siluf_(zv));
    }
    __syncthreads();
}

struct S5Par { float ar, ai; float bbr[16], bbi[16]; };
__device__ __forceinline__ void s5_params(Frame& F, int l, int g, int p, S5Par& q) {
    const float lr = fminf(F.in[I_LRE][(l * 16 + g) * 64 + p], -1e-4f), li = F.in[I_LIM][(l * 16 + g) * 64 + p];
    const float dt = expf(F.in[I_LDT][l * 16 + g]);
    const float mag = __expf(lr * dt), ph = li * dt; q.ar = mag * __cosf(ph); q.ai = mag * __sinf(ph);
    const float den = lr * lr + li * li;
    const float fr = ((q.ar - 1.0f) * lr + q.ai * li) / den, fi = (q.ai * lr - (q.ar - 1.0f) * li) / den;
    const float* br = F.in[I_BRE] + (size_t)((l * 16 + g) * 64 + p) * 16; const float* bi = F.in[I_BIM] + (size_t)((l * 16 + g) * 64 + p) * 16;
#pragma unroll
    for (int h4 = 0; h4 < 4; ++h4) { const f32x4 r = *(const GAS f32x4*)(br + 4 * h4), i = *(const GAS f32x4*)(bi + 4 * h4);
#pragma unroll
        for (int e = 0; e < 4; ++e) { q.bbr[4 * h4 + e] = fr * r[e] - fi * i[e]; q.bbi[4 * h4 + e] = fr * i[e] + fi * r[e]; } }
}
__device__ __forceinline__ void s5_stage_u(Frame& F, LAS float* U, int m0, int nrows) {
    const bf16* P = (const bf16*)(F.ws + WS_P);
    for (int idx = F.tid; idx < nrows * 32; idx += NTHR) { const int r = idx >> 5, ck = idx & 31;
        const v4u w = *(const GAS v4u*)(P + (size_t)(m0 + r) * NPJ + PU + ck * 8);
        *(LAS f32x4*)(U + r * 256 + ck * 8) = (f32x4){bflo(w.x), bfhi(w.x), bflo(w.y), bfhi(w.y)}; *(LAS f32x4*)(U + r * 256 + ck * 8 + 4) = (f32x4){bflo(w.z), bfhi(w.z), bflo(w.w), bfhi(w.w)}; }
}
__device__ __forceinline__ void s5_step(const S5Par& q, const LAS float* urow, float& xr, float& xi) {
    const f32x4 u0 = *(const LAS f32x4*)urow, u1 = *(const LAS f32x4*)(urow + 4), u2 = *(const LAS f32x4*)(urow + 8), u3 = *(const LAS f32x4*)(urow + 12);
    float br = 0.f, bi = 0.f;
#pragma unroll
    for (int e = 0; e < 4; ++e) { br += q.bbr[e] * u0[e]; bi += q.bbi[e] * u0[e]; br += q.bbr[4 + e] * u1[e]; bi += q.bbi[4 + e] * u1[e]; br += q.bbr[8 + e] * u2[e]; bi += q.bbi[8 + e] * u2[e]; br += q.bbr[12 + e] * u3[e]; bi += q.bbi[12 + e] * u3[e]; }
    const float nr = q.ar * xr - q.ai * xi + br, ni = q.ar * xi + q.ai * xr + bi; xr = nr; xi = ni;
}
__device__ __forceinline__ void s5_pass1(Frame& F, int l, int b, int c) {
    LAS float* U = (LAS float*)F.lds;
    int tid = F.tid; asm volatile("" : "+v"(tid)); const int lane = tid & 63, g0 = 2 * (tid >> 6);
    S5Par q0, q1; s5_params(F, l, g0, lane, q0); s5_params(F, l, g0 + 1, lane, q1);
    s5_stage_u(F, U, b * SEQ + c * 64, 64);
    __syncthreads();
    float* E = (float*)(F.ws + WS_S5E);
    float xr0 = 0.f, xi0 = 0.f, xr1 = 0.f, xi1 = 0.f;
#pragma unroll 4
    for (int t = 0; t < 64; ++t) { s5_step(q0, U + t * 256 + 16 * g0, xr0, xi0); s5_step(q1, U + t * 256 + 16 * g0 + 16, xr1, xi1); }
    E[(size_t)((b * 32 + c) * 16 + g0) * 128 + lane] = xr0; E[(size_t)((b * 32 + c) * 16 + g0) * 128 + 64 + lane] = xi0;
    E[(size_t)((b * 32 + c) * 16 + g0 + 1) * 128 + lane] = xr1; E[(size_t)((b * 32 + c) * 16 + g0 + 1) * 128 + 64 + lane] = xi1;
    __syncthreads();
}
constexpr int S5_U = 0, S5_XT = 65536, S5_YG = S5_XT + 8 * 16 * S256;
static_assert(S5_YG + 64 * S512 <= LDSCTL_OFF, "s5 lds");
template <bool SAMPLE>
__device__ __forceinline__ void s5_pass2(Frame& F, int l, int ua, int ub) {
    LAS unsigned char* L = F.lds; LAS float* U = (LAS float*)(L + S5_U); LAS unsigned char* XT = L + S5_XT + (F.tid >> 6) * (16 * S256); LAS unsigned char* YG = L + S5_YG;
    int tid = F.tid; asm volatile("" : "+v"(tid)); const int lane = tid & 63, wv = tid >> 6, fr = lane & 15, fq = lane >> 4;
    constexpr int NSUB = SAMPLE ? 1 : 4;
    const int m0 = SAMPLE ? MP + 4 * ua : ua * SEQ + ub * 64;
    constexpr int NTT = SAMPLE ? 4 : 16;
    S5Par qq[2]; bf16x8 cbb[2][4]; float dskk[2];
#pragma unroll
    for (int gi = 0; gi < 2; ++gi) {
        const int g = 2 * wv + gi; s5_params(F, l, g, lane, qq[gi]);
        bf16x8 (&cb)[4] = cbb[gi];
#pragma unroll
        for (int ks = 0; ks < 4; ++ks) { const float* src = F.in[ks < 2 ? I_CRE : I_CIM] + (size_t)((l * 16 + g) * 16 + fr) * 64 + 32 * (ks & 1) + 8 * fq;
            const f32x4 c0 = *(const GAS f32x4*)src, c1 = *(const GAS f32x4*)(src + 4); const float sg = ks < 2 ? 1.f : -1.f;
            float f[8] = {sg * c0.x, sg * c0.y, sg * c0.z, sg * c0.w, sg * c1.x, sg * c1.y, sg * c1.z, sg * c1.w}; cb[ks] = pack8(f); }
        dskk[gi] = F.in[I_S5D][l * 256 + 16 * g + fr];
    }
    s5_stage_u(F, U, m0, SAMPLE ? 4 : 64);
    __syncthreads();
    const float* E = (const float*)(F.ws + WS_S5E);
#pragma unroll
    for (int gi = 0; gi < 2; ++gi) {
        const int g = 2 * wv + gi; const S5Par& q = qq[gi]; const bf16x8 (&cb)[4] = cbb[gi];
        const float dsk = dskk[gi];
        float xr = 0.f, xi = 0.f;
        if (!SAMPLE) {
            float pr = q.ar, pi = q.ai;
#pragma unroll
            for (int s = 0; s < 6; ++s) { const float nr = pr * pr - pi * pi, ni = 2.f * pr * pi; pr = nr; pi = ni; }
            float er[31], ei[31];
            const float* Eb = E + (size_t)((ua * 32) * 16 + g) * 128 + lane; asm volatile("" : "+v"(Eb));
#pragma unroll
            for (int cc = 0; cc < 31; ++cc) { er[cc] = Eb[cc * 2048]; ei[cc] = Eb[cc * 2048 + 64]; }
#pragma unroll
            for (int cc = 0; cc < 31; ++cc) { const float nr = pr * xr - pi * xi + er[cc], ni = pr * xi + pi * xr + ei[cc]; xr = cc < ub ? nr : xr; xi = cc < ub ? ni : xi; }
        }
        for (int sub = 0; sub < NSUB; ++sub) {
#pragma unroll
            for (int tt = 0; tt < NTT; ++tt) {
                if (SAMPLE && (tt & 3) == 0) { const int bs = ua; xr = F.in[I_S5RE][(size_t)((l * 128 + bs) * 16 + g) * 64 + lane]; xi = F.in[I_S5IM][(size_t)((l * 128 + bs) * 16 + g) * 64 + lane]; }
                s5_step(q, U + (16 * sub + tt) * 256 + 16 * g, xr, xi);
                *(LAS bf16*)(XT + t256(tt, lane)) = (bf16)f2bf(xr); *(LAS bf16*)(XT + t256(tt, 64 + lane)) = (bf16)f2bf(xi);
                if (SAMPLE && (tt & 3) == 3) { const int bs = ua; F.out[O_SS5RE + (size_t)((l * 128 + bs) * 16 + g) * 64 + lane] = xr; F.out[O_SS5IM + (size_t)((l * 128 + bs) * 16 + g) * 64 + lane] = xi; }
            }
            f32x4 acc = (f32x4){0.f, 0.f, 0.f, 0.f};
#pragma unroll
            for (int ks = 0; ks < 4; ++ks) { const bf16x8 af = *(const LAS bf16x8*)(XT + t256(fr, 32 * ks + 8 * fq)); acc = MFMA16(af, cb[ks], acc); }
#pragma unroll
            for (int r = 0; r < 4; ++r) { const int t = 16 * sub + 4 * fq + r; if (SAMPLE && t >= 4) continue; const float y = acc[r] + dsk * U[t * 256 + 16 * g + fr];
                *(LAS bf16*)(YG + t512(t, 16 * g + fr)) = (bf16)f2bf(gelu_tanh(y)); }
            asm volatile("" ::: "memory");
        }
        if (!SAMPLE && ub == 31) { F.out[O_PS5RE + (size_t)((l * 8 + ua) * 16 + g) * 64 + lane] = xr; F.out[O_PS5IM + (size_t)((l * 8 + ua) * 16 + g) * 64 + lane] = xi; }
    }
    __syncthreads();
    {
        const bf16* WG = (const bf16*)(F.ws + WS_WGLU); bf16* MX = (bf16*)(F.ws + WS_X);
#pragma unroll 1
        for (int ni = 0; ni < 2; ++ni) {
            const int nt = 2 * wv + ni; bf16x8 bw[8];
#pragma unroll
            for (int ks = 0; ks < 8; ++ks) bw[ks] = __builtin_bit_cast(bf16x8, *(const GAS v4u*)(WG + (size_t)(16 * nt + fr) * 256 + 32 * ks + 8 * fq));
            const float bg = F.in[I_BGLU][l * 256 + 16 * nt + fr];
#pragma unroll 1
            for (int mi = 0; mi < NSUB; ++mi) {
                f32x4 acc = (f32x4){0.f, 0.f, 0.f, 0.f};
#pragma unroll
                for (int ks = 0; ks < 8; ++ks) { const bf16x8 af = *(const LAS bf16x8*)(YG + t512(16 * mi + fr, 32 * ks + 8 * fq)); acc = MFMA16(af, bw[ks], acc); }
#pragma unroll
                for (int r = 0; r < 4; ++r) { const int t = 16 * mi + 4 * fq + r; if (SAMPLE && t >= 4) continue; const float yg = bf2f(*(const LAS bf16*)(YG + t512(t, 16 * nt + fr)));
                    MX[(size_t)(m0 + t) * DM + 16 * nt + fr] = (bf16)f2bf(yg * sigmoidf_(acc[r] + bg)); }
            }
        }
    }
    __syncthreads();
}

constexpr int LR_RAW = 0, LR_XC = 73728, LR_AGG = 139264;
struct LruW { float wa[32], wx[32], ba, bx, c8, cb, cw[4]; };
__device__ __forceinline__ void lru_weights(Frame& F, int l, int j, LruW& w) {
    const int blk = j >> 5, jj = j & 31;
#pragma unroll
    for (int i = 0; i < 32; ++i) { w.wa[i] = F.in[I_LWA][(size_t)((l * 8 + blk) * 32 + i) * 32 + jj]; w.wx[i] = F.in[I_LWX][(size_t)((l * 8 + blk) * 32 + i) * 32 + jj]; }
    w.ba = F.in[I_LBA][l * 256 + j]; w.bx = F.in[I_LBX][l * 256 + j]; w.c8 = -8.0f * softplusf_(-F.in[I_LLAM][l * 256 + j]); w.cb = F.in[I_LCB][l * 256 + j];
#pragma unroll
    for (int k = 0; k < 4; ++k) w.cw[k] = F.in[I_LCW][(l * 4 + k) * 256 + j];
}
__device__ __forceinline__ void lru_gate(const LruW& w, const LAS float* xrow, float xown, bool reset, float& a, float& bt) {
    float ra = w.ba, rx = w.bx;
#pragma unroll
    for (int i4 = 0; i4 < 8; ++i4) { const f32x4 xv = *(const LAS f32x4*)(xrow + 4 * i4);
#pragma unroll
        for (int e = 0; e < 4; ++e) { ra += w.wa[4 * i4 + e] * xv[e]; rx += w.wx[4 * i4 + e] * xv[e]; } }
    const float r = sigmoidf_(ra), gi = sigmoidf_(rx);
    const float la = w.c8 * r; a = __expf(la);
    const float mult = reset ? 1.0f : __builtin_amdgcn_sqrtf(fmaxf(1.0f - a * a, 0.f));
    bt = mult * gi * xown;
}
template <int PASS>
__device__ __forceinline__ void lru_pass(Frame& F, int l, int b, int c) {
    LAS float* RAW = (LAS float*)(F.lds + LR_RAW); LAS float* XC = (LAS float*)(F.lds + LR_XC); LAS float* AGG = (LAS float*)(F.lds + LR_AGG);
    int tid = F.tid; asm volatile("" : "+v"(tid)); const int j = tid & 255, hh = tid >> 8; const int row0 = b * SEQ + c * 64;
    const bf16* P = (const bf16*)(F.ws + WS_P); bf16* MX = (bf16*)(F.ws + WS_X); float* LA = (float*)(F.ws + WS_LAGG);
    for (int idx = tid; idx < 67 * 32; idx += NTHR) { const int r = idx >> 5, ck = idx & 31, tt = c * 64 - 3 + r;
        v4u w = (v4u){0u, 0u, 0u, 0u}; if (tt >= 0) w = *(const GAS v4u*)(P + (size_t)(b * SEQ + tt) * NPJ + PXL + ck * 8);
        *(LAS f32x4*)(RAW + r * 256 + ck * 8) = (f32x4){bflo(w.x), bfhi(w.x), bflo(w.y), bfhi(w.y)}; *(LAS f32x4*)(RAW + r * 256 + ck * 8 + 4) = (f32x4){bflo(w.z), bfhi(w.z), bflo(w.w), bfhi(w.w)}; }
    __syncthreads();
    LruW w; lru_weights(F, l, j, w);
    for (int ii = 0; ii < 32; ++ii) { const int i = 32 * hh + ii;
        XC[i * 256 + j] = w.cb + w.cw[0] * RAW[i * 256 + j] + w.cw[1] * RAW[(i + 1) * 256 + j] + w.cw[2] * RAW[(i + 2) * 256 + j] + w.cw[3] * RAW[(i + 3) * 256 + j]; }
    __syncthreads();
    float A = 1.f, B = 0.f; float hl[32], ca[32];
#pragma unroll
    for (int ii = 0; ii < 32; ++ii) { const int i = 32 * hh + ii; float a, bt;
        lru_gate(w, XC + i * 256 + (j & ~31), XC[i * 256 + j], (c == 0 && i == 0), a, bt);
        B = a * B + bt; A *= a; if (PASS == 2) { hl[ii] = B; ca[ii] = A; }
        if (ii & 1) __builtin_amdgcn_sched_barrier(0); }
    if (hh == 0) { AGG[j] = A; AGG[256 + j] = B; }
    __syncthreads();
    if (PASS == 1) {
        if (hh == 1) { const float A0 = AGG[j], B0 = AGG[256 + j]; LA[(size_t)((b * 32 + c) * 2) * 256 + j] = A0 * A; LA[(size_t)((b * 32 + c) * 2 + 1) * 256 + j] = A * B0 + B; }
    } else {
        float H = 0.f;
        {
            float la[31], lb[31];
            const float* Lb = LA + (size_t)(b * 32 * 2) * 256 + j; asm volatile("" : "+v"(Lb));
#pragma unroll
            for (int cc = 0; cc < 31; ++cc) { la[cc] = Lb[cc * 512]; lb[cc] = Lb[cc * 512 + 256]; }
#pragma unroll
            for (int cc = 0; cc < 31; ++cc) { const float nh = la[cc] * H + lb[cc]; H = cc < c ? nh : H; }
        }
        if (hh == 1) H = AGG[j] * H + AGG[256 + j];
#pragma unroll
        for (int ii = 0; ii < 32; ++ii) { const int i = 32 * hh + ii; const float hv = hl[ii] + ca[ii] * H;
            const float gt = bf2f(P[(size_t)(row0 + i) * NPJ + PGL + j]);
            MX[(size_t)(row0 + i) * DM + 256 + j] = (bf16)f2bf(hv * gelu_tanh(gt));
            if (c == 31 && hh == 1 && ii == 31) F.out[O_PLRUH + (size_t)(l * 8 + b) * 256 + j] = hv; }
        if (c == 31 && hh == 0) {
#pragma unroll
            for (int k = 0; k < 3; ++k) F.out[O_PLRUC + (size_t)((l * 8 + b) * 3 + k) * 256 + j] = RAW[(64 + k) * 256 + j]; }
    }
    __syncthreads();
}
__device__ __forceinline__ void lru_sample(Frame& F, int l, int q) {
    LAS float* XC = (LAS float*)F.lds;
    int tid = F.tid; asm volatile("" : "+v"(tid)); const int j = tid & 255, hh = tid >> 8;
    const bf16* P = (const bf16*)(F.ws + WS_P); bf16* MX = (bf16*)(F.ws + WS_X);
    LruW w; const int bs = q;
    if (hh == 0) {
        lru_weights(F, l, j, w);
        float r[7];
#pragma unroll
        for (int k = 0; k < 3; ++k) r[k] = F.in[I_LRUC][(size_t)((l * 128 + bs) * 3 + k) * 256 + j];
#pragma unroll
        for (int t = 0; t < 4; ++t) r[3 + t] = bf2f(P[(size_t)(MP + bs * 4 + t) * NPJ + PXL + j]);
#pragma unroll
        for (int t = 0; t < 4; ++t) XC[t * 256 + j] = w.cb + w.cw[0] * r[t] + w.cw[1] * r[t + 1] + w.cw[2] * r[t + 2] + w.cw[3] * r[t + 3];
#pragma unroll
        for (int k = 0; k < 3; ++k) F.out[O_SLRUC + (size_t)((l * 128 + bs) * 3 + k) * 256 + j] = r[4 + k];
    }
    float H = 0.f, gtv[4] = {0.f, 0.f, 0.f, 0.f};
    if (hh == 0) {
        H = F.in[I_LRUH][(size_t)(l * 128 + bs) * 256 + j];
#pragma unroll
        for (int t = 0; t < 4; ++t) gtv[t] = bf2f(P[(size_t)(MP + bs * 4 + t) * NPJ + PGL + j]);
    }
    __syncthreads();
    if (hh == 0) {
#pragma unroll
        for (int t = 0; t < 4; ++t) { float a, bt;
            lru_gate(w, XC + t * 256 + (j & ~31), XC[t * 256 + j], false, a, bt); H = a * H + bt;
            const float gt = gtv[t];
            MX[(size_t)(MP + bs * 4 + t) * DM + 256 + j] = (bf16)f2bf(H * gelu_tanh(gt)); }
        F.out[O_SLRUH + (size_t)(l * 128 + bs) * 256 + j] = H;
    }
    __syncthreads();
}

constexpr int S5M_U = 0, S5M_XT = 64 * S512, S5M_YG = S5M_XT + 8 * 16 * S256;
static_assert(S5M_YG + 64 * S512 <= LDSCTL_OFF, "s5m lds");
__device__ __forceinline__ void cmul_acc(float ar, float ai, float br, float bi, float& cr, float& ci) { cr += ar * br - ai * bi; ci += ar * bi + ai * br; }
struct S5Stage { v4u su[4]; };
__device__ __forceinline__ void s5m_stage_load(Frame& F, int m0, S5Stage& st) {
    const bf16* P = (const bf16*)(F.ws + WS_P);
#pragma unroll
    for (int k = 0; k < 4; ++k) { const int idx = F.tid + k * NTHR; const int r = idx >> 5, ck = idx & 31; st.su[k] = *(const GAS v4u*)(P + (size_t)(m0 + r) * NPJ + PU + ck * 8); }
}
struct NoHook { __device__ __forceinline__ void operator()() const {} };
template <int MODE, bool PRE = false, class Hook = NoHook>
__device__ __forceinline__ void s5m_unit(Frame& F, int l, int ua, int ub, const S5Stage* pre = nullptr, const Hook& hook = Hook()) {
    LAS unsigned char* L = F.lds;
    int tid = F.tid; asm volatile("" : "+v"(tid)); const int lane = tid & 63, wv = tid >> 6, fr = lane & 15, fq = lane >> 4;
    LAS unsigned char* U16 = L + S5M_U; LAS unsigned char* XT = L + S5M_XT + wv * (16 * S256); LAS float* SCR = (LAS float*)XT; LAS unsigned char* YG = L + S5M_YG;
    constexpr bool SAMPLE = MODE == 3; constexpr int NSUB = SAMPLE ? 1 : 4;
    const int m0 = SAMPLE ? MP + 4 * ua : ua * SEQ + ub * 64;
    { const bf16* P = (const bf16*)(F.ws + WS_P); constexpr int nrows = SAMPLE ? 4 : 64; constexpr int NK = (nrows * 32 + NTHR - 1) / NTHR;
      v4u su[NK];
#pragma unroll
      for (int k = 0; k < NK; ++k) { const int idx = tid + k * NTHR; const int r = idx >> 5, ck = idx & 31; if (PRE) su[k] = pre->su[k]; else if (idx < nrows * 32) su[k] = *(const GAS v4u*)(P + (size_t)(m0 + r) * NPJ + PU + ck * 8); }
#pragma unroll
      for (int k = 0; k < NK; ++k) { const int idx = tid + k * NTHR; const int r = idx >> 5, ck = idx & 31; if (idx < nrows * 32) *(LAS v4u*)(U16 + r * S512 + ck * 16) = su[k]; } }
    __syncthreads();
    float* Eo = (float*)(F.ws + WS_S5E);
#pragma unroll 1
    for (int gi = 0; gi < 2; ++gi) {
        const int g = 2 * wv + gi;
        S5Par q; s5_params(F, l, g, lane, q);
        bf16x8 bfrag[8];
#pragma unroll
        for (int part = 0; part < 2; ++part) {
#pragma unroll
            for (int h4 = 0; h4 < 4; ++h4) *(LAS f32x4*)(SCR + lane * 16 + 4 * h4) = part == 0 ? (f32x4){q.bbr[4 * h4], q.bbr[4 * h4 + 1], q.bbr[4 * h4 + 2], q.bbr[4 * h4 + 3]} : (f32x4){q.bbi[4 * h4], q.bbi[4 * h4 + 1], q.bbi[4 * h4 + 2], q.bbi[4 * h4 + 3]};
#pragma unroll
            for (int nt = 0; nt < 4; ++nt) { const LAS float* src = SCR + (16 * nt + fr) * 16 + 8 * (fq & 1);
                const f32x4 v0 = *(const LAS f32x4*)src, v1 = *(const LAS f32x4*)(src + 4); float f[8] = {v0.x, v0.y, v0.z, v0.w, v1.x, v1.y, v1.z, v1.w};
                if (fq >= 2) {
#pragma unroll
                    for (int e = 0; e < 8; ++e) f[e] = f[e] - bf2f(f2bf(f[e]));
                }
                bfrag[4 * part + nt] = pack8(f); }
        }
        float l1r[4], l1i[4], xinr[4], xini[4];
        *(LAS f32x2_t*)(SCR + lane * 2) = (f32x2_t){q.ar, q.ai};
        if (MODE == 2) {
            float pr = q.ar, pi = q.ai;
#pragma unroll
            for (int s = 0; s < 6; ++s) { const float nr = pr * pr - pi * pi, ni = 2.f * pr * pi; pr = nr; pi = ni; }
            float er[31], ei[31];
            const float* Eb = Eo + (size_t)((ua * 32) * 16 + g) * 128 + lane; asm volatile("" : "+v"(Eb));
#pragma unroll
            for (int cc = 0; cc < 31; ++cc) { er[cc] = Eb[cc * 2048]; ei[cc] = Eb[cc * 2048 + 64]; }
            float xr = 0.f, xi = 0.f;
#pragma unroll
            for (int cc = 0; cc < 31; ++cc) { const float nr = pr * xr - pi * xi + er[cc], ni = pr * xi + pi * xr + ei[cc]; xr = cc < ub ? nr : xr; xi = cc < ub ? ni : xi; }
            *(LAS f32x2_t*)(SCR + 128 + lane * 2) = (f32x2_t){xr, xi};
        }
#pragma unroll
        for (int s = 0; s < 4; ++s) { const f32x2_t lv = *(const LAS f32x2_t*)(SCR + (16 * s + fr) * 2); l1r[s] = lv.x; l1i[s] = lv.y;
            if (MODE == 2) { const f32x2_t xv = *(const LAS f32x2_t*)(SCR + 128 + (16 * s + fr) * 2); xinr[s] = xv.x; xini[s] = xv.y; }
            else if (MODE == 3) { xinr[s] = F.in[I_S5RE][(size_t)((l * 128 + ua) * 16 + g) * 64 + 16 * s + fr]; xini[s] = F.in[I_S5IM][(size_t)((l * 128 + ua) * 16 + g) * 64 + 16 * s + fr]; }
            else { xinr[s] = 0.f; xini[s] = 0.f; } }
        float l2r[4], l2i[4], l3r[4], l3i[4], l4r[4], l4i[4], l8r[4], l8i[4], lpr[4], lpi[4];
#pragma unroll
        for (int s = 0; s < 4; ++s) {
            l2r[s] = l1r[s] * l1r[s] - l1i[s] * l1i[s]; l2i[s] = 2.f * l1r[s] * l1i[s];
            l3r[s] = l2r[s] * l1r[s] - l2i[s] * l1i[s]; l3i[s] = l2r[s] * l1i[s] + l2i[s] * l1r[s];
            l4r[s] = l2r[s] * l2r[s] - l2i[s] * l2i[s]; l4i[s] = 2.f * l2r[s] * l2i[s];
            l8r[s] = l4r[s] * l4r[s] - l4i[s] * l4i[s]; l8i[s] = 2.f * l4r[s] * l4i[s];
            const float l12r = l8r[s] * l4r[s] - l8i[s] * l4i[s], l12i = l8r[s] * l4i[s] + l8i[s] * l4r[s];
            lpr[s] = fq == 0 ? 1.f : fq == 1 ? l4r[s] : fq == 2 ? l8r[s] : l12r; lpi[s] = fq == 0 ? 0.f : fq == 1 ? l4i[s] : fq == 2 ? l8i[s] : l12i;
        }
        bf16x8 cb[4]; float dsk = 0.f;
        if (MODE != 1) {
#pragma unroll
            for (int ks = 0; ks < 4; ++ks) { const float* src = F.in[ks < 2 ? I_CRE : I_CIM] + (size_t)((l * 16 + g) * 16 + fr) * 64 + 32 * (ks & 1) + 8 * fq;
                const f32x4 c0 = *(const GAS f32x4*)src, c1 = *(const GAS f32x4*)(src + 4); const float sg = ks < 2 ? 1.f : -1.f;
                float f[8] = {sg * c0.x, sg * c0.y, sg * c0.z, sg * c0.w, sg * c1.x, sg * c1.y, sg * c1.z, sg * c1.w}; cb[ks] = pack8(f); }
            dsk = F.in[I_S5D][l * 256 + 16 * g + fr];
        }
#pragma unroll 1
        for (int sub = 0; sub < NSUB; ++sub) {
            const bf16x8 au = *(const LAS bf16x8*)(U16 + (16 * sub + fr) * S512 + (16 * g + 8 * (fq & 1)) * 2);
            f32x4 d[8];
#pragma unroll
            for (int nt = 0; nt < 8; ++nt) d[nt] = MFMA16(au, bfrag[nt], ((f32x4){0.f, 0.f, 0.f, 0.f}));
            float Lr[4][4], Li[4][4], Er[4], Ei[4];
#pragma unroll
            for (int s = 0; s < 4; ++s) {
                Lr[s][0] = d[s][0]; Li[s][0] = d[4 + s][0];
#pragma unroll
                for (int r = 1; r < 4; ++r) { Lr[s][r] = d[s][r]; Li[s][r] = d[4 + s][r]; cmul_acc(l1r[s], l1i[s], Lr[s][r - 1], Li[s][r - 1], Lr[s][r], Li[s][r]); }
                Er[s] = Lr[s][3]; Ei[s] = Li[s][3];
            }
            {
                float pr_[4], pi_[4];
#pragma unroll
                for (int s = 0; s < 4; ++s) { pr_[s] = __shfl_up(Er[s], 16); pi_[s] = __shfl_up(Ei[s], 16); }
#pragma unroll
                for (int s = 0; s < 4; ++s) { float ar_ = 0.f, ai_ = 0.f; cmul_acc(l4r[s], l4i[s], pr_[s], pi_[s], ar_, ai_); if (fq >= 1) { Er[s] += ar_; Ei[s] += ai_; } }
#pragma unroll
                for (int s = 0; s < 4; ++s) { pr_[s] = __shfl_up(Er[s], 32); pi_[s] = __shfl_up(Ei[s], 32); }
#pragma unroll
                for (int s = 0; s < 4; ++s) { float ar_ = 0.f, ai_ = 0.f; cmul_acc(l8r[s], l8i[s], pr_[s], pi_[s], ar_, ai_); if (fq >= 2) { Er[s] += ar_; Ei[s] += ai_; } }
#pragma unroll
                for (int s = 0; s < 4; ++s) { pr_[s] = __shfl_up(Er[s], 16); pi_[s] = __shfl_up(Ei[s], 16); }
#pragma unroll
                for (int s = 0; s < 4; ++s) { float xr = fq >= 1 ? pr_[s] : 0.f, xi = fq >= 1 ? pi_[s] : 0.f; cmul_acc(lpr[s], lpi[s], xinr[s], xini[s], xr, xi); Er[s] = xr; Ei[s] = xi; }
            }
#pragma unroll
            for (int s = 0; s < 4; ++s) {
                cmul_acc(l1r[s], l1i[s], Er[s], Ei[s], Lr[s][0], Li[s][0]); cmul_acc(l2r[s], l2i[s], Er[s], Ei[s], Lr[s][1], Li[s][1]);
                cmul_acc(l3r[s], l3i[s], Er[s], Ei[s], Lr[s][2], Li[s][2]); cmul_acc(l4r[s], l4i[s], Er[s], Ei[s], Lr[s][3], Li[s][3]);
            }
#pragma unroll
            for (int s = 0; s < 4; ++s) { xinr[s] = __shfl(Lr[s][3], fr + (SAMPLE ? 0 : 48)); xini[s] = __shfl(Li[s][3], fr + (SAMPLE ? 0 : 48)); }
            if (MODE != 1) {
#pragma unroll
                for (int s = 0; s < 4; ++s)
#pragma unroll
                    for (int r = 0; r < 4; ++r) { *(LAS bf16*)(XT + t256(4 * fq + r, 16 * s + fr)) = (bf16)f2bf(Lr[s][r]); *(LAS bf16*)(XT + t256(4 * fq + r, 64 + 16 * s + fr)) = (bf16)f2bf(Li[s][r]); }
                f32x4 acc = (f32x4){0.f, 0.f, 0.f, 0.f};
#pragma unroll
                for (int ks = 0; ks < 4; ++ks) { const bf16x8 af = *(const LAS bf16x8*)(XT + t256(fr, 32 * ks + 8 * fq)); acc = MFMA16(af, cb[ks], acc); }
#pragma unroll
                for (int r = 0; r < 4; ++r) { const int t = 16 * sub + 4 * fq + r; if (SAMPLE && t >= 4) continue;
                    const float y = acc[r] + dsk * bf2f(*(const LAS bf16*)(U16 + t * S512 + (16 * g + fr) * 2));
                    *(LAS bf16*)(YG + t512(t, 16 * g + fr)) = (bf16)f2bf(gelu_tanh(y)); }
                asm volatile("" ::: "memory");
            }
        }
        if (MODE == 1 && gi == 0) hook();
        if (fq == 0) {
#pragma unroll
            for (int s = 0; s < 4; ++s) { const int p = 16 * s + fr;
                if (MODE == 1) { Eo[(size_t)((ua * 32 + ub) * 16 + g) * 128 + p] = xinr[s]; Eo[(size_t)((ua * 32 + ub) * 16 + g) * 128 + 64 + p] = xini[s]; }
                if (MODE == 2 && ub == 31) { F.out[O_PS5RE + (size_t)((l * 8 + ua) * 16 + g) * 64 + p] = xinr[s]; F.out[O_PS5IM + (size_t)((l * 8 + ua) * 16 + g) * 64 + p] = xini[s]; }
                if (MODE == 3) { F.out[O_SS5RE + (size_t)((l * 128 + ua) * 16 + g) * 64 + p] = xinr[s]; F.out[O_SS5IM + (size_t)((l * 128 + ua) * 16 + g) * 64 + p] = xini[s]; } }
        }
    }
    if (MODE != 1) hook();
    bf16x8 bwA[8], bwB[8]; float bgA = 0.f, bgB = 0.f;
    if (MODE != 1) {
        const bf16* WG = (const bf16*)(F.ws + WS_WGLU);
#pragma unroll
        for (int ks = 0; ks < 8; ++ks) { bwA[ks] = __builtin_bit_cast(bf16x8, *(const GAS v4u*)(WG + (size_t)(16 * (2 * wv) + fr) * 256 + 32 * ks + 8 * fq)); bwB[ks] = __builtin_bit_cast(bf16x8, *(const GAS v4u*)(WG + (size_t)(16 * (2 * wv + 1) + fr) * 256 + 32 * ks + 8 * fq)); }
        bgA = F.in[I_BGLU][l * 256 + 16 * (2 * wv) + fr]; bgB = F.in[I_BGLU][l * 256 + 16 * (2 * wv + 1) + fr];
    }
    __syncthreads();
    if (MODE != 1) {
        bf16* MX = (bf16*)(F.ws + WS_X);
        auto glu_block = [&](const bf16x8 (&bw)[8], const float bg, const int nt) {
#pragma unroll 1
            for (int mi = 0; mi < NSUB; ++mi) {
                f32x4 acc = (f32x4){0.f, 0.f, 0.f, 0.f};
#pragma unroll
                for (int ks = 0; ks < 8; ++ks) { const bf16x8 af = *(const LAS bf16x8*)(YG + t512(16 * mi + fr, 32 * ks + 8 * fq)); acc = MFMA16(af, bw[ks], acc); }
#pragma unroll
                for (int r = 0; r < 4; ++r) { const int t = 16 * mi + 4 * fq + r; if (SAMPLE && t >= 4) continue; const float yg = bf2f(*(const LAS bf16*)(YG + t512(t, 16 * nt + fr)));
                    MX[(size_t)(m0 + t) * DM + 16 * nt + fr] = (bf16)f2bf(yg * sigmoidf_(acc[r] + bg)); }
            }
        };
        glu_block(bwA, bgA, 2 * wv); glu_block(bwB, bgB, 2 * wv + 1);
        __syncthreads();
    }
}


constexpr int LM_RAW = 0, LM_XCB = 69632, LM_GT = LM_XCB + 64 * S512;
static_assert(LM_GT + 64 * S512 <= LDSCTL_OFF && 67 * 1024 <= LM_XCB, "lru mfma lds");
struct LruStage { v4u sw[5], sg[4]; };
template <int PASS>
__device__ __forceinline__ void lrum_stage_load(Frame& F, int b, int c, LruStage& st) {
    const bf16* P = (const bf16*)(F.ws + WS_P); const int row0 = b * SEQ + c * 64;
#pragma unroll
    for (int k5 = 0; k5 < 5; ++k5) { const int idx = F.tid + k5 * NTHR; const int r = idx >> 5, ck = idx & 31, tt = c * 64 - 3 + r;
        st.sw[k5] = (v4u){0u, 0u, 0u, 0u}; if (idx < 67 * 32 && tt >= 0) st.sw[k5] = *(const GAS v4u*)(P + (size_t)(b * SEQ + tt) * NPJ + PXL + ck * 8); }
    if (PASS == 2) {
#pragma unroll
        for (int k4 = 0; k4 < 4; ++k4) { const int idx = F.tid + k4 * NTHR; const int r = idx >> 5, ck = idx & 31; st.sg[k4] = *(const GAS v4u*)(P + (size_t)(row0 + r) * NPJ + PGL + ck * 8); }
    }
}
template <int PASS, bool PRE = false>
__device__ __forceinline__ void lrum_pass(Frame& F, int l, int b, int c, const LruStage* pre = nullptr) {
    LAS float* RAW = (LAS float*)(F.lds + LM_RAW); LAS unsigned char* XCB = F.lds + LM_XCB;
    int tid = F.tid; asm volatile("" : "+v"(tid)); const int lane = tid & 63, wv = tid >> 6, fr = lane & 15, fq = lane >> 4;
    const int row0 = b * SEQ + c * 64;
    const bf16* P = (const bf16*)(F.ws + WS_P); bf16* MX = (bf16*)(F.ws + WS_X); float* LA = (float*)(F.ws + WS_LAGG);
    {
        v4u sw[5], sg[4];
        if (PRE) {
#pragma unroll
            for (int k5 = 0; k5 < 5; ++k5) sw[k5] = pre->sw[k5];
            if (PASS == 2) {
#pragma unroll
                for (int k4 = 0; k4 < 4; ++k4) sg[k4] = pre->sg[k4];
            }
        } else {
#pragma unroll
        for (int k5 = 0; k5 < 5; ++k5) { const int idx = tid + k5 * NTHR; const int r = idx >> 5, ck = idx & 31, tt = c * 64 - 3 + r;
            sw[k5] = (v4u){0u, 0u, 0u, 0u}; if (idx < 67 * 32 && tt >= 0) sw[k5] = *(const GAS v4u*)(P + (size_t)(b * SEQ + tt) * NPJ + PXL + ck * 8); }
        if (PASS == 2) {
#pragma unroll
            for (int k4 = 0; k4 < 4; ++k4) { const int idx = tid + k4 * NTHR; const int r = idx >> 5, ck = idx & 31; sg[k4] = *(const GAS v4u*)(P + (size_t)(row0 + r) * NPJ + PGL + ck * 8); }
        }
        }
#pragma unroll
        for (int k5 = 0; k5 < 5; ++k5) { const int idx = tid + k5 * NTHR; const int r = idx >> 5, ck = idx & 31; const v4u w = sw[k5];
            if (idx < 67 * 32) { *(LAS f32x4*)(RAW + r * 256 + ck * 8) = (f32x4){bflo(w.x), bfhi(w.x), bflo(w.y), bfhi(w.y)}; *(LAS f32x4*)(RAW + r * 256 + ck * 8 + 4) = (f32x4){bflo(w.z), bfhi(w.z), bflo(w.w), bfhi(w.w)}; } }
        if (PASS == 2) {
#pragma unroll
            for (int k4 = 0; k4 < 4; ++k4) { const int idx = tid + k4 * NTHR; const int r = idx >> 5, ck = idx & 31; *(LAS v4u*)(F.lds + LM_GT + r * S512 + ck * 16) = sg[k4]; }
        }
    }
    bf16x8 wah[2], wal[2], wxh[2], wxl[2]; float ba[2], bx[2], c8[2];
#pragma unroll
    for (int nt = 0; nt < 2; ++nt) {
        const int jc = 16 * nt + fr; float fa[8], fx[8], ga[8], gx[8];
#pragma unroll
        for (int e = 0; e < 8; ++e) { fa[e] = F.in[I_LWA][(size_t)((l * 8 + wv) * 32 + 8 * fq + e) * 32 + jc]; fx[e] = F.in[I_LWX][(size_t)((l * 8 + wv) * 32 + 8 * fq + e) * 32 + jc]; }
        wah[nt] = pack8(fa); wxh[nt] = pack8(fx);
#pragma unroll
        for (int e = 0; e < 8; ++e) { ga[e] = fa[e] - bf2f(f2bf(fa[e])); gx[e] = fx[e] - bf2f(f2bf(fx[e])); }
        wal[nt] = pack8(ga); wxl[nt] = pack8(gx);
        const int j = 32 * wv + jc; ba[nt] = F.in[I_LBA][l * 256 + j]; bx[nt] = F.in[I_LBX][l * 256 + j]; c8[nt] = -8.0f * softplusf_(-F.in[I_LLAM][l * 256 + j]);
    }
    float Hin[2] = {0.f, 0.f};
    if (PASS == 2) {
        const int js = 32 * wv + 16 * (fq & 1) + fr; float H = 0.f;
        float la[31], lb[31];
        const float* Lb = LA + (size_t)(b * 32 * 2) * 256 + js; asm volatile("" : "+v"(Lb));
#pragma unroll
        for (int cc = 0; cc < 31; ++cc) { la[cc] = Lb[cc * 512]; lb[cc] = Lb[cc * 512 + 256]; }
#pragma unroll
        for (int cc = 0; cc < 31; ++cc) { const float nh = la[cc] * H + lb[cc]; H = cc < c ? nh : H; }
        Hin[0] = __shfl(H, fr); Hin[1] = __shfl(H, fr + 16);
    }
    float cw[4]; const float cb = F.in[I_LCB][l * 256 + (tid & 255)];
#pragma unroll
    for (int k = 0; k < 4; ++k) cw[k] = F.in[I_LCW][(l * 4 + k) * 256 + (tid & 255)];
    __syncthreads();
    {
        const int j = tid & 255, hh = tid >> 8; float xcv[32];
#pragma unroll
        for (int ii = 0; ii < 32; ++ii) { const int i = 32 * hh + ii; xcv[ii] = cb + cw[0] * RAW[i * 256 + j] + cw[1] * RAW[(i + 1) * 256 + j] + cw[2] * RAW[(i + 2) * 256 + j] + cw[3] * RAW[(i + 3) * 256 + j]; }
        __syncthreads();
#pragma unroll
        for (int ii = 0; ii < 32; ++ii) { const int i = 32 * hh + ii; RAW[i * 256 + j] = xcv[ii]; *(LAS bf16*)(XCB + i * S512 + j * 2) = (bf16)f2bf(xcv[ii]); }
    }
    __syncthreads();
    float At[2] = {1.f, 1.f}, Bt[2] = {0.f, 0.f};
#pragma unroll 1
    for (int sub = 0; sub < 4; ++sub) {
        const bf16x8 au = *(const LAS bf16x8*)(XCB + (16 * sub + fr) * S512 + (32 * wv + 8 * fq) * 2);
        unsigned short gt[2][4];
        if (PASS == 2) {
#pragma unroll
            for (int nt = 0; nt < 2; ++nt)
#pragma unroll
                for (int r = 0; r < 4; ++r) gt[nt][r] = *(const LAS unsigned short*)(F.lds + LM_GT + (16 * sub + 4 * fq + r) * S512 + (32 * wv + 16 * nt + fr) * 2);
        }
#pragma unroll
        for (int nt = 0; nt < 2; ++nt) {
            const f32x4 z = (f32x4){0.f, 0.f, 0.f, 0.f};
            f32x4 da = MFMA16(au, wah[nt], z); da = MFMA16(au, wal[nt], da);
            f32x4 dx = MFMA16(au, wxh[nt], z); dx = MFMA16(au, wxl[nt], dx);
            const int j = 32 * wv + 16 * nt + fr;
            float hl[4], ca[4]; float A = 1.f, B = 0.f;
#pragma unroll
            for (int r = 0; r < 4; ++r) { const int t = 16 * sub + 4 * fq + r;
                const float rr = sigmoidf_(da[r] + ba[nt]), gi = sigmoidf_(dx[r] + bx[nt]); const float a = __expf(c8[nt] * rr);
                const float mult = (c == 0 && t == 0) ? 1.0f : __builtin_amdgcn_sqrtf(fmaxf(1.0f - a * a, 0.f));
                const float bt = mult * gi * RAW[t * 256 + j];
                B = a * B + bt; A *= a; hl[r] = B; ca[r] = A; }
            float Ap = __shfl_up(A, 16), Bp = __shfl_up(B, 16); if (fq >= 1) { B = A * Bp + B; A = A * Ap; }
            Ap = __shfl_up(A, 32); Bp = __shfl_up(B, 32); if (fq >= 2) { B = A * Bp + B; A = A * Ap; }
            float Ae = __shfl_up(A, 16), Be = __shfl_up(B, 16); if (fq == 0) { Ae = 1.f; Be = 0.f; }
            const float As = __shfl(A, fr + 48), Bs = __shfl(B, fr + 48);
            if (PASS == 1) { Bt[nt] = As * Bt[nt] + Bs; At[nt] *= As; }
            else {
                const float Hs = Ae * Hin[nt] + Be;
#pragma unroll
                for (int r = 0; r < 4; ++r) { const float hv = hl[r] + ca[r] * Hs;
                    MX[(size_t)(row0 + 16 * sub + 4 * fq + r) * DM + 256 + j] = (bf16)f2bf(hv * gelu_tanh(bf2f(gt[nt][r]))); }
                Hin[nt] = As * Hin[nt] + Bs;
            }
        }
    }
    if (fq == 0) {
#pragma unroll
        for (int nt = 0; nt < 2; ++nt) { const int j = 32 * wv + 16 * nt + fr;
            if (PASS == 1) { LA[(size_t)((b * 32 + c) * 2) * 256 + j] = At[nt]; LA[(size_t)((b * 32 + c) * 2 + 1) * 256 + j] = Bt[nt]; }
            else if (c == 31) F.out[O_PLRUH + (size_t)(l * 8 + b) * 256 + j] = Hin[nt]; }
    }
    if (PASS == 2 && c == 31 && tid < 256) {
#pragma unroll
        for (int k = 0; k < 3; ++k) F.out[O_PLRUC + (size_t)((l * 8 + b) * 3 + k) * 256 + tid] = RAW[(64 + k) * 256 + tid]; }
    __syncthreads();
}
#ifndef MK_N_LAUNCHES
#define MK_N_LAUNCHES 1
#endif
constexpr int N_PHASES = 19;
#ifndef STAGE_AHEAD
#define STAGE_AHEAD 1
#endif
struct Args { const float* in[37]; float* out; unsigned char* ws; int ph_lo, ph_hi; };
#if MK_N_LAUNCHES == 1
#define GRID_BAR() xcd_barrier(bar)
#else
#define GRID_BAR() do { } while (0)
#endif
#ifndef DUPM
#define DUPM 0
#endif
#define REP(bit) for (int rep_ = 0; rep_ < (((DUPM) >> (bit)) & 1 ? 2 : 1); ++rep_)
#ifndef PH_MASK
#define PH_MASK 0x3ff
#endif
#define IN(k) (lo <= (k) && (k) < hi)
#define INL(i) (((PH_MASK >> ((i) + 1)) & 1) && IN(pb + (i)))
#define OPQ() asm volatile("" : "+s"(F.wg), "+s"(F.G), "+s"(F.ws), "+s"(F.out), "+s"(l), "+s"(F.lds))
#ifndef BAR_TWICE
#define BAR_TWICE 0
#endif
#define SEAM(k) do { if (IN(k) && IN((k) + 1)) { GRID_BAR(); if (BAR_TWICE) GRID_BAR(); } } while (0)
#define X ((bf16*)(F.ws + WS_X))
#define P ((bf16*)(F.ws + WS_P))
#define BIG ((bf16*)(F.ws + WS_BIG))
#define AB ((float*)(F.ws + WS_AB))
#define Y (F.out + O_YP)
#define X1B ((float*)(F.ws + WS_BIG + 34 * MiB))
#define RSA ((float*)(F.ws + WS_CTL + 512 * 1024))
#define RSB ((float*)(F.ws + WS_CTL + 768 * 1024))
#define X2B Y
template <int LAYER>
__device__ __forceinline__ void layer_phases(Frame& F, const XcdBarrier& bar, const int lo, const int hi) {
    int l = LAYER;
#if defined(SEGREP) || defined(SEGPRE)
    int seg_n = 0;
#endif
        const int pb = 1 + 9 * l;
#if (defined(SEGREP) || defined(SEGPRE)) && SEG_LO == 0
        seg_start: asm volatile("" : "+v"(F.tid), "+v"(F.lane)); F.wave = __builtin_amdgcn_readfirstlane(F.tid >> 6);
#endif
        if (INL(0)) REP(1) { OPQ();
            pg8::Gemm g{(const bf16*)X2B, (const bf16*)(F.ws + WS_WIN), MT, NPJ, DM}; pg8::StaticOrder S; S.init(MT, NPJ, F.G, F.wg);
            pg8::EpiBf16 E{P, NPJ, RSA};
            pg8::gemm_phase<pg8::EpiBf16, pg8::StaticOrder, true, true>(F.lds, g, S, E);
            if (LAYER == 0) convert_items<2 | 8>(F, l, ((MT / 256) * (NPJ / 256)) % F.G); else convert_items<8>(F, l, ((MT / 256) * (NPJ / 256)) % F.G);
        }
#if defined(SEGPRE) && SEG_HI == 0
        if (((SEGPRE >> LAYER) & 1) && seg_n < hi - (N_PHASES - 1)) { ++seg_n; if (SEGPRE_MODE == 1) xcd_barrier<true>(bar); else if (SEGPRE_MODE == 2) xcd_barrier<false>(bar); goto seg_start; }
#endif
        SEAM(pb + 0);
#if defined(SEGREP) && SEG_HI == 0
        if (((SEGREP >> LAYER) & 1) && seg_n < hi - (N_PHASES - 1)) { ++seg_n; if (0 == 8 && LAYER == 1) GRID_BAR(); goto seg_start; }
#endif
#if (defined(SEGREP) || defined(SEGPRE)) && SEG_LO == 1
        seg_start: asm volatile("" : "+v"(F.tid), "+v"(F.lane)); F.wave = __builtin_amdgcn_readfirstlane(F.tid >> 6);
#endif
        if (INL(1)) { OPQ();
            {
                int cw_head = -1; v4u pre[7]; float abn[2]; bool have = false; float SS[32];
                int ts = F.wg; const int NT = NB_S * GDH;
                if (ts < NT) gdn_sample_load(F, l, ts, SS);
                int k = 0;
                const int nun = NB_P * GDH * NCH / F.G;
                auto unit_of = [&](int kk) { return ((F.wg & 7) * GDH + (F.wg >> 6)) * NCH + ((F.wg >> 3) & 7) * 4 + kk; };
                for (; k < nun; ++k) { const int u = unit_of(k);
                    gdn_prep<0>(F, l, u, cw_head, pre, abn, have, k + 1 < nun ? unit_of(k + 1) : -1); have = true;
                    if (ts < NT) { gdn_sample(F, l, ts, SS); ts += F.G; if (ts < NT) gdn_sample_load(F, l, ts, SS); }
                }
                while (ts < NT) { gdn_sample(F, l, ts, SS); ts += F.G; if (ts < NT) gdn_sample_load(F, l, ts, SS); }
            }
#ifdef GPC
            { int cw_head = -1; v4u pre[7]; float abn[2]; for (int u = F.wg; u < NB_P * GDH * NCH; u += F.G) { gdn_prep<GPC>(F, l, u, cw_head, pre, abn, false, -1); } __syncthreads(); }
#endif
            for (int u = F.wg; u < NB_P * 31; u += F.G) { REP(3) s5m_unit<1>(F, l, u / 31, u % 31); REP(4) lrum_pass<1>(F, l, u / 31, u % 31); }
            for (int q = F.wg; q < 2 * NB_S; q += F.G) REP(6) { if (q < NB_S) s5m_unit<3>(F, l, q, 0); else lru_sample(F, l, q - NB_S); }
        }
#if defined(SEGPRE) && SEG_HI == 1
        if (((SEGPRE >> LAYER) & 1) && seg_n < hi - (N_PHASES - 1)) { ++seg_n; if (SEGPRE_MODE == 1) xcd_barrier<true>(bar); else if (SEGPRE_MODE == 2) xcd_barrier<false>(bar); goto seg_start; }
#endif
        SEAM(pb + 1);
#if defined(SEGREP) && SEG_HI == 1
        if (((SEGREP >> LAYER) & 1) && seg_n < hi - (N_PHASES - 1)) { ++seg_n; if (1 == 8 && LAYER == 1) GRID_BAR(); goto seg_start; }
#endif
#if (defined(SEGREP) || defined(SEGPRE)) && SEG_LO == 2
        seg_start: asm volatile("" : "+v"(F.tid), "+v"(F.lane)); F.wave = __builtin_amdgcn_readfirstlane(F.tid >> 6);
#endif
        if (INL(2)) { OPQ();
#if STAGE_AHEAD
            {
                const int u = F.wg; S5Stage s5s; LruStage lrs;
                s5m_stage_load(F, (u >> 5) * SEQ + (u & 31) * 64, s5s);
                gdn_chain<false>(F, l, F.wg);
                auto hook = [&]() { lrum_stage_load<2>(F, u >> 5, u & 31, lrs); };
                s5m_unit<2, true>(F, l, u >> 5, u & 31, &s5s, hook);
                lrum_pass<2, true>(F, l, u >> 5, u & 31, &lrs);
            }
#else
            for (int t = F.wg; t < 256; t += F.G) gdn_chain<false>(F, l, t);
            for (int u = F.wg; u < NB_P * NCH; u += F.G) { REP(7) s5m_unit<2>(F, l, u >> 5, u & 31); REP(8) lrum_pass<2>(F, l, u >> 5, u & 31); }
#endif
        }
#if defined(SEGPRE) && SEG_HI == 2
        if (((SEGPRE >> LAYER) & 1) && seg_n < hi - (N_PHASES - 1)) { ++seg_n; if (SEGPRE_MODE == 1) xcd_barrier<true>(bar); else if (SEGPRE_MODE == 2) xcd_barrier<false>(bar); goto seg_start; }
#endif
        SEAM(pb + 2);
#if defined(SEGREP) && SEG_HI == 2
        if (((SEGREP >> LAYER) & 1) && seg_n < hi - (N_PHASES - 1)) { ++seg_n; if (2 == 8 && LAYER == 1) GRID_BAR(); goto seg_start; }
#endif
#if (defined(SEGREP) || defined(SEGPRE)) && SEG_LO == 3
        seg_start: asm volatile("" : "+v"(F.tid), "+v"(F.lane)); F.wave = __builtin_amdgcn_readfirstlane(F.tid >> 6);
#endif
        if (!HEADNORM_IN_GEMM && INL(3)) { OPQ();
            gdn_finalize(F, l);
        }
#if defined(SEGPRE) && SEG_HI == 3
        if (((SEGPRE >> LAYER) & 1) && seg_n < hi - (N_PHASES - 1)) { ++seg_n; if (SEGPRE_MODE == 1) xcd_barrier<true>(bar); else if (SEGPRE_MODE == 2) xcd_barrier<false>(bar); goto seg_start; }
#endif
#if !HEADNORM_IN_GEMM
        SEAM(pb + 3);
#endif
#if defined(SEGREP) && SEG_HI == 3
        if (((SEGREP >> LAYER) & 1) && seg_n < hi - (N_PHASES - 1)) { ++seg_n; if (3 == 8 && LAYER == 1) GRID_BAR(); goto seg_start; }
#endif
#if (defined(SEGREP) || defined(SEGPRE)) && SEG_LO == 4
        seg_start: asm volatile("" : "+v"(F.tid), "+v"(F.lane)); F.wave = __builtin_amdgcn_readfirstlane(F.tid >> 6);
#endif
        if (INL(4)) REP(9) { OPQ();
            pg8::Gemm g{X, (const bf16*)(F.ws + WS_WOUT), MP, DM, DM}; pg8::StaticOrder S; S.init(MP, DM, F.G, F.wg);
#if HEADNORM_IN_GEMM
            pg8::EpiBf16HeadNorm E{BIG, DM, (const float*)(F.ws + WS_SSQ), 1.f / HD, EPS};
            pg8::gemm_phase<pg8::EpiBf16HeadNorm, pg8::StaticOrder, true, true>(F.lds, g, S, E);
#else
            pg8::EpiBf16 E{BIG, DM, nullptr};
            pg8::gemm_phase<pg8::EpiBf16, pg8::StaticOrder, true, true>(F.lds, g, S, E);
#endif
            sample_gemm_lds(F, X, (const bf16*)(F.ws + WS_WOUT), DM, BIG);
        }
#if defined(SEGPRE) && SEG_HI == 4
        if (((SEGPRE >> LAYER) & 1) && seg_n < hi - (N_PHASES - 1)) { ++seg_n; if (SEGPRE_MODE == 1) xcd_barrier<true>(bar); else if (SEGPRE_MODE == 2) xcd_barrier<false>(bar); goto seg_start; }
#endif
        SEAM(pb + 4);
#if defined(SEGREP) && SEG_HI == 4
        if (((SEGREP >> LAYER) & 1) && seg_n < hi - (N_PHASES - 1)) { ++seg_n; if (4 == 8 && LAYER == 1) GRID_BAR(); goto seg_start; }
#endif
#if (defined(SEGREP) || defined(SEGPRE)) && SEG_LO == 5
        seg_start: asm volatile("" : "+v"(F.tid), "+v"(F.lane)); F.wave = __builtin_amdgcn_readfirstlane(F.tid >> 6);
#endif
        if (INL(5)) { OPQ();
            REP(13) row_pass<true, true>(F, X2B, nullptr, BIG, F.in[I_NMPOST] + l * DM, X1B, nullptr, RSB, nullptr, nullptr);
        }
#if defined(SEGPRE) && SEG_HI == 5
        if (((SEGPRE >> LAYER) & 1) && seg_n < hi - (N_PHASES - 1)) { ++seg_n; if (SEGPRE_MODE == 1) xcd_barrier<true>(bar); else if (SEGPRE_MODE == 2) xcd_barrier<false>(bar); goto seg_start; }
#endif
        SEAM(pb + 5);
#if defined(SEGREP) && SEG_HI == 5
        if (((SEGREP >> LAYER) & 1) && seg_n < hi - (N_PHASES - 1)) { ++seg_n; if (5 == 8 && LAYER == 1) GRID_BAR(); goto seg_start; }
#endif
#if (defined(SEGREP) || defined(SEGPRE)) && SEG_LO == 6
        seg_start: asm volatile("" : "+v"(F.tid), "+v"(F.lane)); F.wave = __builtin_amdgcn_readfirstlane(F.tid >> 6);
#endif
        if (INL(6)) REP(10) { OPQ();
            pg8::Gemm g{(const bf16*)X1B, (const bf16*)(F.ws + WS_WGU), MT, 2 * FF, DM}; pg8::StaticOrder S; S.init(MT, 2 * FF, F.G, F.wg);
            pg8::EpiSwiGLU E{P, FF, RSB};
            pg8::gemm_phase<pg8::EpiSwiGLU, pg8::StaticOrder, true, true>(F.lds, g, S, E);
            if (LAYER + 1 < DEPTH) convert_items<1 | 2>(F, l + 1, ((MT / 256) * (2 * FF / 256)) % F.G);
        }
#if defined(SEGPRE) && SEG_HI == 6
        if (((SEGPRE >> LAYER) & 1) && seg_n < hi - (N_PHASES - 1)) { ++seg_n; if (SEGPRE_MODE == 1) xcd_barrier<true>(bar); else if (SEGPRE_MODE == 2) xcd_barrier<false>(bar); goto seg_start; }
#endif
        SEAM(pb + 6);
#if defined(SEGREP) && SEG_HI == 6
        if (((SEGREP >> LAYER) & 1) && seg_n < hi - (N_PHASES - 1)) { ++seg_n; if (6 == 8 && LAYER == 1) GRID_BAR(); goto seg_start; }
#endif
#if (defined(SEGREP) || defined(SEGPRE)) && SEG_LO == 7
        seg_start: asm volatile("" : "+v"(F.tid), "+v"(F.lane)); F.wave = __builtin_amdgcn_readfirstlane(F.tid >> 6);
#endif
        if (INL(7)) REP(11) { OPQ();
            pg8::Gemm g{P, (const bf16*)(F.ws + WS_WDN), MP, DM, FF}; pg8::StaticOrder S; S.init(MP, DM, F.G, F.wg);
            pg8::EpiBf16 E{BIG, DM, nullptr};
            pg8::gemm_phase<pg8::EpiBf16, pg8::StaticOrder, true, true>(F.lds, g, S, E);
            sample_gemm_lds(F, P, (const bf16*)(F.ws + WS_WDN), FF, BIG);
        }
#if defined(SEGPRE) && SEG_HI == 7
        if (((SEGPRE >> LAYER) & 1) && seg_n < hi - (N_PHASES - 1)) { ++seg_n; if (SEGPRE_MODE == 1) xcd_barrier<true>(bar); else if (SEGPRE_MODE == 2) xcd_barrier<false>(bar); goto seg_start; }
#endif
        SEAM(pb + 7);
#if defined(SEGREP) && SEG_HI == 7
        if (((SEGREP >> LAYER) & 1) && seg_n < hi - (N_PHASES - 1)) { ++seg_n; if (7 == 8 && LAYER == 1) GRID_BAR(); goto seg_start; }
#endif
#if (defined(SEGREP) || defined(SEGPRE)) && SEG_LO == 8
        seg_start: asm volatile("" : "+v"(F.tid), "+v"(F.lane)); F.wave = __builtin_amdgcn_readfirstlane(F.tid >> 6);
#endif
        if (INL(8)) { OPQ();
            if (l + 1 < DEPTH) {
                convert_items<4 | 16>(F, l + 1, 0);
                row_pass<true, true>(F, X1B, nullptr, BIG, F.in[I_NFPOST] + l * DM, X2B, F.in[I_NMPRE] + (l + 1) * DM, RSA, F.in[I_WIN] + (size_t)(l + 1) * DM * INC, AB);
            } else row_pass<true, false>(F, X1B, nullptr, BIG, F.in[I_NFPOST] + l * DM, Y, nullptr, nullptr, nullptr, nullptr);
        }
#if defined(SEGPRE) && SEG_HI == 8
        if (((SEGPRE >> LAYER) & 1) && seg_n < hi - (N_PHASES - 1)) { ++seg_n; if (SEGPRE_MODE == 1) xcd_barrier<true>(bar); else if (SEGPRE_MODE == 2) xcd_barrier<false>(bar); goto seg_start; }
#endif
        SEAM(pb + 8);
#if defined(SEGREP) && SEG_HI == 8
        if (((SEGREP >> LAYER) & 1) && seg_n < hi - (N_PHASES - 1)) { ++seg_n; if (8 == 8 && LAYER == 1) GRID_BAR(); goto seg_start; }
#endif
    }
__global__ void __launch_bounds__(NTHR, 2) mega_fwd(Args args) {
    extern __shared__ __attribute__((aligned(16))) unsigned char lds[];
    Frame F;
    F.lds = (LAS unsigned char*)lds;
    F.tid = threadIdx.x; F.lane = F.tid & 63; F.wave = __builtin_amdgcn_readfirstlane(F.tid >> 6);
    F.G = gridDim.x; F.wg = blockIdx.x;
    F.in = args.in;
    F.out = args.out; F.ws = args.ws;
    volatile LAS unsigned* MISC = (volatile LAS unsigned*)(F.lds + LDSCTL_OFF);
    for (int u = F.tid; u < (LDS_BYTES - LDSCTL_OFF) / 4; u += NTHR) ((LAS unsigned*)(F.lds + LDSCTL_OFF))[u] = 0u;
    __syncthreads();
#if MK_N_LAUNCHES == 1
    XcdBarrier bar = xcd_barrier_post((unsigned*)(F.ws + WS_CTL) + CW_BAR, MISC + 8);
#else
    (void)MISC; XcdBarrier bar; bar.bar = nullptr; bar.x = 0; bar.st = nullptr;
#endif
    const int lo = args.ph_lo, hi = args.ph_hi;
#ifdef FULLREP
    for (int rep2 = 0; rep2 < args.ph_hi - (N_PHASES - FULLREP); ++rep2) {
        F.tid = threadIdx.x; asm volatile("" : "+v"(F.tid)); F.lane = F.tid & 63; F.wave = __builtin_amdgcn_readfirstlane(F.tid >> 6);
#endif
    if ((PH_MASK & 1) && IN(0)) REP(12) {
        convert_items<1 | 4 | 16>(F, 0, 0);
        row_pass<false, true>(F, F.in[I_XP], F.in[I_XS], nullptr, nullptr, X2B, F.in[I_NMPRE], RSA, F.in[I_WIN], AB);
    }
    SEAM(0);
    layer_phases<0>(F, bar, lo, hi);
    layer_phases<1>(F, bar, lo, hi);
#ifdef FULLREP
    GRID_BAR(); }
#endif
}

extern "C" void kernel_launch(void* const* d_in, const int* in_sizes, int n_in, void* d_out, int out_size, void* d_ws, size_t ws_size, hipStream_t stream) {
    static int grid = 0;
    if (grid == 0) {
        if (n_in != 37 || (size_t)out_size != O_END || ws_size < WS_OL + 16 * MiB) { fprintf(stderr, "kernel_launch: unexpected shapes: n_in %d out %d ws %zu\n", n_in, out_size, ws_size); grid = -1; return; }
        int dev = 0, cus = 0, per_cu = 0;
        if (hipGetDevice(&dev) != hipSuccess || hipDeviceGetAttribute(&cus, hipDeviceAttributeMultiprocessorCount, dev) != hipSuccess) { grid = -1; return; }
        if (hipFuncSetAttribute((const void*)mega_fwd, hipFuncAttributeMaxDynamicSharedMemorySize, LDS_BYTES) != hipSuccess) { fprintf(stderr, "kernel_launch: hipFuncSetAttribute failed\n"); grid = -1; return; }
        if (hipOccupancyMaxActiveBlocksPerMultiprocessor(&per_cu, (const void*)mega_fwd, NTHR, LDS_BYTES) != hipSuccess || per_cu < 1) { fprintf(stderr, "kernel_launch: occupancy query says %d blocks per CU\n", per_cu); (void)hipGetLastError(); per_cu = 1; }
        grid = cus;
        if (grid > 256) grid = 256;
        if (HEADNORM_IN_GEMM && grid != 256) { fprintf(stderr, "kernel_launch: %d compute units, this build needs 256 (one out-projection unit per workgroup)\n", cus); grid = -1; return; }
    }
    if (grid < 0) return;
    (void)hipMemsetAsync((char*)d_ws + WS_CTL, 0, CTL_ZERO_BYTES, stream);
    Args a{};
    for (int i = 0; i < 37; ++i) a.in[i] = (const float*)d_in[i];
    a.out = (float*)d_out; a.ws = (unsigned char*)d_ws;
#if MK_N_LAUNCHES == 1
    a.ph_lo = 0; a.ph_hi = N_PHASES;
    hipLaunchKernelGGL(mega_fwd, dim3(grid), dim3(NTHR), LDS_BYTES, stream, a);
#else
    for (int ph = 0; ph < N_PHASES; ++ph) { a.ph_lo = ph; a.ph_hi = ph + 1; hipLaunchKernelGGL(mega_fwd, dim3(grid), dim3(NTHR), LDS_BYTES, stream, a); }
#endif
}
```

```cpp
#include <hip/hip_runtime.h>
#include <cstdio>
#include <cstdint>
#include <cmath>
namespace pg8 {
#define PG8_LAS __attribute__((address_space(3)))
typedef unsigned short bf16_t;
typedef short bf16x8 __attribute__((ext_vector_type(8)));
typedef float f32x4 __attribute__((ext_vector_type(4)));
typedef unsigned u32x4 __attribute__((ext_vector_type(4)));
constexpr int BM = 256, BK = 64, HALF = 128, HTB = HALF * BK * 2  , STAGE_BYTES = 8 * HTB, NXCD = 8, WGM = 8;

__host__ __device__ __forceinline__ int lds_byte(int r, int c) { const int st = (r >> 4) * 2 + (c >> 5), rr = r & 15, cc = c & 31, ob = rr * 64 + cc * 2; return st * 1024 + (ob ^ (((ob >> 9) & 1) << 5)); }
__host__ __device__ __forceinline__ void stage_rc(int b, int& R, int& C) { const int st = b / 1024, sb = b % 1024, swz = sb ^ (((sb >> 9) & 1) << 5); R = (st >> 1) * 16 + swz / 64; C = (st & 1) * 32 + (swz % 64) / 2; }
__host__ __device__ __forceinline__ int perm32(int rho) { const int n = rho >> 4, i = rho & 15; return 8 * (i >> 2) + 4 * n + (i & 3); }

struct Unit { int pm, pn; };
struct Gemm { const bf16_t* A; const bf16_t* Bt; int M, N, K; };

struct StaticOrder {
    int nM, nN, nwg, G, c;
    __host__ __device__ void init(int M, int N, int G_, int c_) { nM = M / BM; nN = N / BM; nwg = nM * nN; G = G_; c = c_; }
    __host__ __device__ bool next(int i, Unit& u) const {
        const long L = (long)i * G + c; if (L >= nwg) return false;
        int wgid = (int)L; { const int q = nwg / NXCD, r = nwg % NXCD, xcd = wgid % NXCD, off = wgid / NXCD; wgid = (xcd < r ? xcd * (q + 1) : r * (q + 1) + (xcd - r) * q) + off; }
        const int nig = WGM * nN, gid = wgid / nig, fm = gid * WGM, gsz = (nM - fm) < WGM ? (nM - fm) : WGM;
        u.pm = fm + ((wgid % nig) % gsz); u.pn = (wgid % nig) / gsz; return true;
    }
    __device__ __forceinline__ void a_ready(const Unit&) const {}
    __device__ __forceinline__ void done(const Unit&) const {}
};


__device__ __forceinline__ unsigned cvt_pk_bf16(float lo, float hi) { unsigned r; asm volatile("v_cvt_pk_bf16_f32 %0, %1, %2" : "=v"(r) : "v"(lo), "v"(hi)); return r; }

template <bool WT>
__device__ __forceinline__ void st16(void* p, u32x4 v) {
    if constexpr (WT) asm volatile("global_store_dwordx4 %0, %1, off sc1\n\ts_nop 1" :: "v"(p), "v"(v) : "memory");
    else *(u32x4*)p = v;
}
struct EpiF32 {
    static constexpr bool PERM = false, AFTER_DRAIN = false, KSCALE = false;
    float* C; int ldc;
    template <bool WT>
    __device__ __forceinline__ void run(const f32x4 (&acc)[2][2][4][2], const Unit& u, int wr, int wc, int fr, int fq) const {
        const int row0 = u.pm * BM + wr * 64 + fr, col0 = u.pn * BM + wc * 32 + 4 * fq;
#pragma unroll
        for (int ai = 0; ai < 2; ++ai)
#pragma unroll
            for (int m = 0; m < 4; ++m) { float* rowp = C + (size_t)(row0 + ai * HALF + m * 16) * ldc + col0;
#pragma unroll
                for (int bj = 0; bj < 2; ++bj)
#pragma unroll
                    for (int n = 0; n < 2; ++n) *(f32x4*)(rowp + bj * HALF + n * 16) = acc[ai][bj][m][n]; }
    }
};
struct EpiBf16 {
    static constexpr bool PERM = true, AFTER_DRAIN = false, KSCALE = false;
    bf16_t* O; int ldc; const float* RS;
    template <bool WT>
    __device__ __forceinline__ void run(const f32x4 (&acc)[2][2][4][2], const Unit& u, int wr, int wc, int fr, int fq) const {
        const int row0 = u.pm * BM + wr * 64 + fr; const int col0 = u.pn * BM + wc * 32 + 8 * fq;
        float rsc[2][4];
#pragma unroll
        for (int ai = 0; ai < 2; ++ai)
#pragma unroll
            for (int m = 0; m < 4; ++m) rsc[ai][m] = RS ? RS[row0 + ai * HALF + m * 16] : 1.0f;
#pragma unroll
        for (int ai = 0; ai < 2; ++ai)
#pragma unroll
            for (int m = 0; m < 4; ++m) { bf16_t* rowp = O + (size_t)(row0 + ai * HALF + m * 16) * ldc + col0;
#pragma unroll
                for (int bj = 0; bj < 2; ++bj) { const f32x4 v0 = acc[ai][bj][m][0] * rsc[ai][m], v1 = acc[ai][bj][m][1] * rsc[ai][m];
                    u32x4 w; w.x = cvt_pk_bf16(v0[0], v0[1]); w.y = cvt_pk_bf16(v0[2], v0[3]); w.z = cvt_pk_bf16(v1[0], v1[1]); w.w = cvt_pk_bf16(v1[2], v1[3]);
                    st16<WT>(rowp + bj * HALF, w); } }
    }
};
struct EpiBf16HeadNorm {
    static constexpr bool PERM = true, AFTER_DRAIN = false, KSCALE = true;
    static constexpr int KT0 = 8, TAB = STAGE_BYTES;
    bf16_t* O; int ldc; const float* SSQ; float inv_n, eps;
    struct Pre { f32x4 v[8]; };
    __device__ __forceinline__ void setup_load(Pre& p, const Unit& u, int tid) const {
        const float* sp = SSQ + (size_t)(u.pm * BM + (tid & 255)) * 32;
#pragma unroll
        for (int i = 0; i < 8; ++i) p.v[i] = *(const f32x4*)(sp + 4 * i);
    }
    __device__ __forceinline__ void setup_store(const Pre& p, PG8_LAS unsigned char* lds, int tid) const {
        if (tid < 256) {
            float sq[4], rs[4];
#pragma unroll
            for (int h = 0; h < 4; ++h) { const f32x4 a = p.v[2 * h], b = p.v[2 * h + 1]; const float x = ((a.x + a.y) + (a.z + a.w) + (b.x + b.y) + (b.z + b.w)) * inv_n + eps; rs[h] = __builtin_amdgcn_rsqf(x); sq[h] = x * rs[h]; }
            PG8_LAS float* t = (PG8_LAS float*)(lds + TAB) + tid * 8;
            *(PG8_LAS f32x4*)t = (f32x4){sq[0], rs[0] * sq[1], rs[1] * sq[2], rs[2] * sq[3]}; t[4] = rs[3];
        }
    }
    __device__ __forceinline__ void scale(f32x4 (&acc)[2][2][4][2], PG8_LAS unsigned char* lds, int wr, int fr, int p) const {
        const PG8_LAS float* t = (const PG8_LAS float*)(lds + TAB) + (wr * 64 + fr) * 8 + p;
#pragma unroll
        for (int ai = 0; ai < 2; ++ai)
#pragma unroll
            for (int m = 0; m < 4; ++m) { const float f = t[(ai * HALF + m * 16) * 8];
#pragma unroll
                for (int bj = 0; bj < 2; ++bj)
#pragma unroll
                    for (int n = 0; n < 2; ++n) acc[ai][bj][m][n] = acc[ai][bj][m][n] * f; }
    }
    template <bool WT>
    __device__ __forceinline__ void run(const f32x4 (&acc)[2][2][4][2], const Unit& u, int wr, int wc, int fr, int fq) const { EpiBf16 e{O, ldc, nullptr}; e.template run<WT>(acc, u, wr, wc, fr, fq); }
};
struct EpiSwiGLU {
    static constexpr bool PERM = true, AFTER_DRAIN = false, KSCALE = false;
    bf16_t* O; int ldc; const float* RS;
    template <bool WT>
    __device__ __forceinline__ void run(const f32x4 (&acc)[2][2][4][2], const Unit& u, int wr, int wc, int fr, int fq) const {
        const int row0 = u.pm * BM + wr * 64 + fr; const int col0 = u.pn * HALF + wc * 32 + 8 * fq;
        float rsc[2][4];
#pragma unroll
        for (int ai = 0; ai < 2; ++ai)
#pragma unroll
            for (int m = 0; m < 4; ++m) rsc[ai][m] = RS[row0 + ai * HALF + m * 16];
#pragma unroll
        for (int ai = 0; ai < 2; ++ai)
#pragma unroll
            for (int m = 0; m < 4; ++m) { bf16_t* rowp = O + (size_t)(row0 + ai * HALF + m * 16) * ldc + col0;
                float o[8];
#pragma unroll
                for (int n = 0; n < 2; ++n)
#pragma unroll
                    for (int j = 0; j < 4; ++j) { const float g = acc[ai][0][m][n][j] * rsc[ai][m], up = acc[ai][1][m][n][j] * rsc[ai][m]; o[n * 4 + j] = g * up * __builtin_amdgcn_rcpf(1.0f + __expf(-g)); }
                u32x4 w; w.x = cvt_pk_bf16(o[0], o[1]); w.y = cvt_pk_bf16(o[2], o[3]); w.z = cvt_pk_bf16(o[4], o[5]); w.w = cvt_pk_bf16(o[6], o[7]);
                st16<WT>(rowp, w); }
    }
};

#ifndef PG8_LAST_WT
#define PG8_LAST_WT 0
#endif
template <class E, bool K = E::KSCALE> struct Epi_pre { typedef int type; };
template <class E> struct Epi_pre<E, true> { typedef typename E::Pre type; };
template <class Epi, class Sched, bool ALIGN_EPI = false, bool SP2 = false>
__device__ __forceinline__ void gemm_phase(PG8_LAS unsigned char* lds, const Gemm g, const Sched& S, const Epi& E) {
    int tid_ = threadIdx.x; asm volatile("" : "+v"(tid_));
    const int tid = tid_, wid = __builtin_amdgcn_readfirstlane(tid >> 6), lane = tid & 63, wr = wid >> 2, wc = wid & 3, fr = lane & 15, fq = lane >> 4;
    const int K = g.K, nt = K / BK;
    unsigned voffA[2], voffB[2];
#pragma unroll
    for (int i = 0; i < 2; ++i) { int R, C; stage_rc(tid * 16 + i * 8192, R, C); const int Rb = Epi::PERM ? ((R & ~31) + perm32(R & 31)) : R;
        voffA[i] = (unsigned)(R * K + C) * 2u; voffB[i] = (unsigned)(Rb * K + C) * 2u; }
    const size_t kstep = (size_t)(BK * 2);
    const size_t hstep = (size_t)HALF * K * 2;
    const size_t tstep = 2 * hstep;
    const unsigned ldsw = (unsigned)wid * 1024u;
    const int aoff = lds_byte(wr * 64 + fr, fq * 8), boff = lds_byte(wc * 32 + fr, fq * 8);
#define PG8_SA(b, h) (((b) * 2 + (h)) * HTB)
#define PG8_SB(b, h) ((4 + (b) * 2 + (h)) * HTB)
#define PG8_STAGE(bufoff, gbase, voff) do { _Pragma("unroll") for (int _i = 0; _i < 2; ++_i) \
        __builtin_amdgcn_global_load_lds((const unsigned*)((const char*)(gbase) + (voff)[_i]), (PG8_LAS unsigned*)(lds + (bufoff) + ldsw + _i * 8192), 16, 0, 0); } while (0)
#define PG8_LDA(dst, b, h) do { _Pragma("unroll") for (int m = 0; m < 4; ++m) _Pragma("unroll") for (int k = 0; k < 2; ++k) dst[m][k] = *(const PG8_LAS bf16x8*)(lds + PG8_SA(b, h) + aoff + m * 2048 + k * 1024); } while (0)
#define PG8_LDB(dst, b, h) do { _Pragma("unroll") for (int n = 0; n < 2; ++n) _Pragma("unroll") for (int k = 0; k < 2; ++k) dst[n][k] = *(const PG8_LAS bf16x8*)(lds + PG8_SB(b, h) + boff + n * 2048 + k * 1024); } while (0)
#define PG8_MMA(ai, bj, At, Bt) do { __builtin_amdgcn_s_setprio(1); _Pragma("unroll") for (int m = 0; m < 4; ++m) _Pragma("unroll") for (int n = 0; n < 2; ++n) _Pragma("unroll") for (int k = 0; k < 2; ++k) \
        acc[ai][bj][m][n] = __builtin_amdgcn_mfma_f32_16x16x32_bf16(Bt[n][k], At[m][k], acc[ai][bj][m][n], 0, 0, 0); __builtin_amdgcn_s_setprio(0); } while (0)
#define PG8_WAIT_V(n) asm volatile("s_waitcnt vmcnt(" #n ")" ::: "memory")
#define PG8_WAIT_L(n) asm volatile("s_waitcnt lgkmcnt(" #n ")" ::: "memory")
#define PG8_BAR __builtin_amdgcn_s_barrier()
#define PG8_SCHED __builtin_amdgcn_sched_barrier(0)
    Unit cur, nxt; int ui = 0;
    if (!S.next(0, cur)) return;
    f32x4 acc[2][2][4][2];
#pragma unroll
    for (int a = 0; a < 2; ++a)
#pragma unroll
        for (int b = 0; b < 2; ++b)
#pragma unroll
            for (int m = 0; m < 4; ++m)
#pragma unroll
                for (int n = 0; n < 2; ++n) acc[a][b][m][n] = (f32x4){0.f, 0.f, 0.f, 0.f};
    bf16x8 At[4][2], B0[2][2], B1[2][2];
    const char* cA = (const char*)g.A + (size_t)cur.pm * tstep; const char* cB = (const char*)g.Bt + (size_t)cur.pn * tstep;
    S.a_ready(cur);
    typename Epi_pre<Epi>::type epre;
    if constexpr (Epi::KSCALE) E.setup_load(epre, cur, tid);
    if constexpr (SP2) {
        PG8_STAGE(PG8_SB(0, 0), cB, voffB); PG8_STAGE(PG8_SB(0, 1), cB + hstep, voffB); PG8_STAGE(PG8_SA(0, 0), cA, voffA); PG8_STAGE(PG8_SA(0, 1), cA + hstep, voffA);
        if (wr == 1) PG8_BAR;
        PG8_WAIT_V(2); PG8_BAR;
        PG8_STAGE(PG8_SB(1, 0), cB + kstep, voffB); PG8_STAGE(PG8_SA(1, 0), cA + kstep, voffA); PG8_STAGE(PG8_SB(1, 1), cB + hstep + kstep, voffB);
        PG8_WAIT_V(6); PG8_BAR;
        if constexpr (Epi::KSCALE) E.setup_store(epre, lds, tid);
    } else {
        PG8_STAGE(PG8_SB(0, 0), cB, voffB); PG8_STAGE(PG8_SA(0, 0), cA, voffA); PG8_STAGE(PG8_SB(0, 1), cB + hstep, voffB); PG8_STAGE(PG8_SA(0, 1), cA + hstep, voffA);
        if (wr == 1) PG8_BAR;
        PG8_WAIT_V(4); PG8_BAR;
        PG8_STAGE(PG8_SB(1, 0), cB + kstep, voffB); PG8_STAGE(PG8_SA(1, 0), cA + kstep, voffA); PG8_STAGE(PG8_SB(1, 1), cB + hstep + kstep, voffB);
        PG8_WAIT_V(6); PG8_BAR;
    }
    for (;;) {
        const bool has_next = S.next(ui + 1, nxt);
        const char* nA = has_next ? (const char*)g.A + (size_t)nxt.pm * tstep : cA; const char* nB = has_next ? (const char*)g.Bt + (size_t)nxt.pn * tstep : cB;
        for (int t = 0; t < nt; t += 2) {
            const bool last = (t == nt - 2);
            const char* a1 = cA + (size_t)(t + 1) * kstep;
            const char* a2 = last ? nA : cA + (size_t)(t + 2) * kstep; const char* b2 = last ? nB : cB + (size_t)(t + 2) * kstep;
            const char* a3 = a2 + kstep; const char* b3 = b2 + kstep;
            if (last && has_next) S.a_ready(nxt);
            if constexpr (Epi::KSCALE) { if (t >= Epi::KT0) E.scale(acc, lds, wr, fr, (t - Epi::KT0) >> 1); }
            if constexpr (SP2) {
            PG8_LDB(B0, 0, 0); PG8_LDB(B1, 0, 1); PG8_SCHED; PG8_LDA(At, 0, 0); PG8_STAGE(PG8_SA(1, 1), a1 + hstep, voffA);
            PG8_WAIT_V(8); PG8_WAIT_L(0); PG8_BAR; PG8_MMA(0, 0, At, B0); PG8_MMA(0, 1, At, B1); PG8_BAR; PG8_SCHED;
            PG8_LDA(At, 0, 1); PG8_STAGE(PG8_SB(0, 0), b2, voffB); PG8_STAGE(PG8_SB(0, 1), b2 + hstep, voffB); PG8_STAGE(PG8_SA(0, 0), a2, voffA);
            PG8_WAIT_V(8); PG8_WAIT_L(0); PG8_BAR; PG8_MMA(1, 0, At, B0); PG8_MMA(1, 1, At, B1); PG8_BAR; PG8_SCHED;
            PG8_LDB(B0, 1, 0); PG8_LDB(B1, 1, 1); PG8_SCHED; PG8_LDA(At, 1, 0); PG8_STAGE(PG8_SA(0, 1), a2 + hstep, voffA);
            PG8_WAIT_V(8); PG8_WAIT_L(0); PG8_BAR; PG8_MMA(0, 0, At, B0); PG8_MMA(0, 1, At, B1); PG8_BAR; PG8_SCHED;
            PG8_LDA(At, 1, 1); PG8_STAGE(PG8_SB(1, 0), b3, voffB); PG8_STAGE(PG8_SB(1, 1), b3 + hstep, voffB); PG8_STAGE(PG8_SA(1, 0), a3, voffA);
            PG8_WAIT_V(8); PG8_WAIT_L(0); PG8_BAR; PG8_MMA(1, 0, At, B0); PG8_MMA(1, 1, At, B1); PG8_BAR; PG8_SCHED;
            } else {
            PG8_LDB(B0, 0, 0); PG8_SCHED; PG8_LDA(At, 0, 0); PG8_STAGE(PG8_SA(1, 1), a1 + hstep, voffA);
            PG8_WAIT_L(8); PG8_BAR; PG8_WAIT_L(0); PG8_MMA(0, 0, At, B0); PG8_BAR; PG8_SCHED;
            PG8_LDB(B1, 0, 1); PG8_STAGE(PG8_SB(0, 0), b2, voffB);
            PG8_BAR; PG8_WAIT_L(0); PG8_MMA(0, 1, At, B1); PG8_BAR;
            PG8_LDA(At, 0, 1); PG8_STAGE(PG8_SA(0, 0), a2, voffA);
            PG8_BAR; PG8_WAIT_L(0); PG8_MMA(1, 0, At, B0); PG8_BAR; PG8_SCHED;
            PG8_STAGE(PG8_SB(0, 1), b2 + hstep, voffB);
            PG8_WAIT_V(6); PG8_BAR; PG8_MMA(1, 1, At, B1); PG8_BAR;
            PG8_LDB(B0, 1, 0); PG8_SCHED; PG8_LDA(At, 1, 0); PG8_STAGE(PG8_SA(0, 1), a2 + hstep, voffA);
            PG8_WAIT_L(8); PG8_BAR; PG8_WAIT_L(0); PG8_MMA(0, 0, At, B0); PG8_BAR; PG8_SCHED;
            PG8_LDB(B1, 1, 1); PG8_STAGE(PG8_SB(1, 0), b3, voffB);
            PG8_BAR; PG8_WAIT_L(0); PG8_MMA(0, 1, At, B1); PG8_BAR;
            PG8_LDA(At, 1, 1); PG8_STAGE(PG8_SA(1, 0), a3, voffA);
            PG8_BAR; PG8_WAIT_L(0); PG8_MMA(1, 0, At, B0); PG8_BAR; PG8_SCHED;
            PG8_STAGE(PG8_SB(1, 1), b3 + hstep, voffB);
            PG8_WAIT_V(6); PG8_BAR; PG8_MMA(1, 1, At, B1); PG8_BAR;
            }
        }
        if constexpr (Epi::KSCALE) E.scale(acc, lds, wr, fr, 4);
        if constexpr (ALIGN_EPI) { if (wr == 0) PG8_BAR; }
        if constexpr (!Epi::AFTER_DRAIN) {
            if (PG8_LAST_WT && !has_next) E.template run<true>(acc, cur, wr, wc, fr, fq); else E.template run<false>(acc, cur, wr, wc, fr, fq);
            S.done(cur); }
        if (!has_next) break;
#pragma unroll
        for (int a = 0; a < 2; ++a)
#pragma unroll
            for (int b = 0; b < 2; ++b)
#pragma unroll
                for (int m = 0; m < 4; ++m)
#pragma unroll
                    for (int n = 0; n < 2; ++n) acc[a][b][m][n] = (f32x4){0.f, 0.f, 0.f, 0.f};
        cur = nxt; cA = nA; cB = nB; ++ui;
        if constexpr (ALIGN_EPI) { if (wr == 1) PG8_BAR; }
    }
    PG8_WAIT_V(0);
    if constexpr (!ALIGN_EPI) { if (wr == 0) PG8_BAR; }
    PG8_BAR;
    if constexpr (Epi::AFTER_DRAIN) { E.fused(acc, cur, wr, wc, fr, fq, lds, wid, lane); S.done(cur); }
#undef PG8_SA
#undef PG8_SB
#undef PG8_STAGE
#undef PG8_LDA
#undef PG8_LDB
#undef PG8_MMA
#undef PG8_WAIT_V
#undef PG8_WAIT_L
#undef PG8_BAR
#undef PG8_SCHED
}
}

constexpr int NWAVES = 8, NTHR = 512;
constexpr int DM = 1024, SEQ = 2048, NB_P = 8, MP = NB_P * SEQ, NB_S = 128, DSEQ = 4, MS = NB_S * DSEQ, MT = MP + MS;
constexpr int DEPTH = 2, INC = 2824, NPJ = 2816, FF = 2816, GDH = 4, HD = 128, NCH = SEQ / 64;
constexpr int PU = 0, PXL = 256, PGL = 512, PQ = 768, PK = 1280, PV = 1792, PZ = 2304;
constexpr float EPS = 1e-6f;
#ifndef HEADNORM_IN_GEMM
#define HEADNORM_IN_GEMM 1
#endif
constexpr size_t O_YP = 0, O_YS = O_YP + (size_t)MP * DM, O_PS5RE = O_YS + (size_t)MS * DM, O_PS5IM = O_PS5RE + 2 * 8 * 16 * 64, O_PLRUH = O_PS5IM + 2 * 8 * 16 * 64,
    O_PLRUC = O_PLRUH + 2 * 8 * 256, O_PGS = O_PLRUC + 2 * 8 * 3 * 256, O_PGC = O_PGS + (size_t)2 * 8 * 4 * 128 * 128, O_SS5RE = O_PGC + 2 * 8 * 3 * 1536,
    O_SS5IM = O_SS5RE + 2 * 128 * 16 * 64, O_SLRUH = O_SS5IM + 2 * 128 * 16 * 64, O_SLRUC = O_SLRUH + 2 * 128 * 256, O_SGS = O_SLRUC + 2 * 128 * 3 * 256,
    O_SGC = O_SGS + (size_t)2 * 128 * 4 * 128 * 128, O_END = O_SGC + (size_t)2 * 128 * 3 * 1536;
static_assert(O_END == 37216256, "output size");
constexpr size_t MiB = 1u << 20;
constexpr size_t WS_CTL = 0, CTL_ZERO_BYTES = 1 * MiB;
constexpr size_t WS_S5E = 1 * MiB;
constexpr size_t WS_LAGG = 3 * MiB;
constexpr size_t WS_AB = 3 * MiB + 512 * 1024;
constexpr size_t WS_EGL = 4 * MiB + 256 * 1024;
constexpr size_t WS_WIN = 5 * MiB;
constexpr size_t WS_WOUT = WS_WIN + (size_t)NPJ * DM * 2;
constexpr size_t WS_WGU = WS_WOUT + (size_t)DM * DM * 2;
constexpr size_t WS_WDN = WS_WGU + (size_t)2 * FF * DM * 2;
constexpr size_t WS_WGLU = WS_WDN + (size_t)DM * FF * 2;
constexpr size_t WS_X = 30 * MiB;
constexpr size_t WS_P = 63 * MiB;
constexpr size_t WS_BIG = 154 * MiB;
constexpr size_t WS_PP = WS_BIG, WS_RT = WS_BIG + 32 * MiB, WS_QT = WS_BIG + 64 * MiB, WS_END = WS_BIG + 80 * MiB;
static_assert(WS_WGLU + 256 * 256 * 2 <= WS_X && WS_X + (size_t)MT * DM * 2 <= WS_P && WS_P + (size_t)MT * NPJ * 2 <= WS_BIG && WS_BIG + (size_t)MT * DM * 4 <= WS_END && WS_END + (size_t)MP * 32 * 4 <= 256 * MiB, "ws map");
static_assert(WS_AB + (size_t)MT * 8 * 4 <= WS_EGL && WS_EGL + 4096 <= WS_WIN, "ws map 2");
constexpr size_t WS_SSQ = WS_END;
constexpr size_t WS_OL = WS_END + 2 * MiB;
constexpr size_t WS_DUMH = WS_END + 18 * MiB, WS_DUMF = WS_END + 19 * MiB;
static_assert(WS_DUMF + 2 * MiB <= 256 * MiB, "ws tail");
constexpr int CW_BAR = 4096;
constexpr int RING_BYTES = 131072, LDSCTL_OFF = 143360, LDS_BYTES = 147456;

#define GAS __attribute__((address_space(1)))
#define LAS __attribute__((address_space(3)))
typedef unsigned short bf16;
typedef unsigned v4u __attribute__((ext_vector_type(4)));
typedef unsigned v2u __attribute__((ext_vector_type(2)));
typedef float f32x4 __attribute__((ext_vector_type(4)));
typedef short bf16x8 __attribute__((ext_vector_type(8)));
#define LDS_WAIT() asm volatile("s_waitcnt lgkmcnt(0)" ::: "memory")
#define VM_WAIT() asm volatile("s_waitcnt vmcnt(0)" ::: "memory")
#define MFMA16(a, b, c) __builtin_amdgcn_mfma_f32_16x16x32_bf16(a, b, c, 0, 0, 0)
typedef float f32x2_t __attribute__((ext_vector_type(2))); typedef __bf16 bf16x2_t __attribute__((ext_vector_type(2)));
__device__ __forceinline__ unsigned pk2(float lo, float hi) { f32x2_t v = {lo, hi}; bf16x2_t b = __builtin_convertvector(v, bf16x2_t); return __builtin_bit_cast(unsigned, b); }
__device__ __forceinline__ unsigned f2bf(float f) { return pk2(f, f) & 0xffffu; }
__device__ __forceinline__ float bf2f(unsigned b) { return __builtin_bit_cast(float, b << 16); }
__device__ __forceinline__ float bflo(unsigned w) { return __builtin_bit_cast(float, w << 16); }
__device__ __forceinline__ float bfhi(unsigned w) { return __builtin_bit_cast(float, w & 0xffff0000u); }
__device__ __forceinline__ float frcp(float x) { return __builtin_amdgcn_rcpf(x); }
__device__ __forceinline__ float frsq(float x) { return __builtin_amdgcn_rsqf(x); }
__device__ __forceinline__ float sigmoidf_(float x) { return frcp(1.0f + __expf(-x)); }
__device__ __forceinline__ float siluf_(float x) { return x * frcp(1.0f + __expf(-x)); }
__device__ __forceinline__ float gelu_tanh(float x) { const float z = 0.7978845608028654f * (x + 0.044715f * x * x * x); return x * frcp(1.0f + __expf(-2.0f * z)); }
__device__ __forceinline__ float softplusf_(float x) { return x > 20.f ? x : log1pf(expf(x)); }
__device__ __forceinline__ float softplus_fast(float x) { return x > 20.f ? x : __logf(1.0f + __expf(x)); }
__device__ __forceinline__ float wave_sum(float v) {
#pragma unroll
    for (int o = 1; o < 64; o <<= 1) v += __shfl_xor(v, o);
    return v;
}
__device__ __forceinline__ bf16x8 pack8(const float* f) { v4u w; w.x = pk2(f[0], f[1]); w.y = pk2(f[2], f[3]); w.z = pk2(f[4], f[5]); w.w = pk2(f[6], f[7]); return __builtin_bit_cast(bf16x8, w); }
constexpr int S256 = 272, S128 = 144, S512 = 528;
__device__ __forceinline__ int t256(int row, int col) { return row * S256 + col * 2; }
__device__ __forceinline__ int t128(int row, int col) { return row * S128 + col * 2; }
__device__ __forceinline__ int t512(int row, int col) { return row * S512 + col * 2; }

#define XB_TMO      128
#define XB_XCNT(j)  (256  + 64 * (j))
#define XB_XSUB(j)  (1280 + 64 * (j))
#define XB_XGEN(j)  (2304 + 64 * (j))
#define XB_TOP      3328
#define XB_TOPGEN   3392
#define XCD_BAR_WORDS 3456
#define XB_SPIN_CAP (1u << 20)
__device__ __forceinline__ unsigned xb_ld(unsigned* p)              { return __hip_atomic_load(p, __ATOMIC_RELAXED, __HIP_MEMORY_SCOPE_AGENT); }
__device__ __forceinline__ unsigned xb_add(unsigned* p, unsigned v) { return __hip_atomic_fetch_add(p, v, __ATOMIC_RELAXED, __HIP_MEMORY_SCOPE_AGENT); }
__device__ __forceinline__ unsigned xb_xcc_id() { return (unsigned)__builtin_amdgcn_s_getreg((3 << 11) | 20) & 0xFu; }
#define XB_SPIN(cond, bar) do { unsigned _sp = 0; while (cond) { __builtin_amdgcn_s_sleep(1); \
    if ((++_sp & 255u) == 0u) { if (xb_ld(&(bar)[XB_TMO])) break; if (_sp > XB_SPIN_CAP) { atomicAdd(&(bar)[XB_TMO], 1u); break; } } } } while (0)
struct XcdBarrier { unsigned* bar; unsigned x; volatile LAS unsigned* st; };
__device__ __forceinline__ XcdBarrier xcd_barrier_post(unsigned* bar, volatile LAS unsigned* st) {
    XcdBarrier b; b.bar = bar; b.x = xb_xcc_id(); b.st = st;
    if (threadIdx.x == 0) (void)xb_add(&bar[XB_XCNT(b.x)], 1u);
    return b;
}
__device__ __forceinline__ void xcd_barrier_complete(unsigned* bar, unsigned x, unsigned& nloc, unsigned& nx) {
    const unsigned G = gridDim.x * gridDim.y * gridDim.z;
    unsigned sum, cnt, mine, sp = 0u;
    for (;;) {
        sum = 0u; cnt = 0u; mine = 0u;
#pragma unroll
        for (unsigned j = 0; j < 16; ++j) { const unsigned c = xb_ld(&bar[XB_XCNT(j)]); sum += c; cnt += (c > 0u) ? 1u : 0u; mine = (j == x) ? c : mine; }
        if (sum == G) break;
        __builtin_amdgcn_s_sleep(1);
        if ((++sp & 255u) == 0u) { if (xb_ld(&bar[XB_TMO])) break; if (sp > XB_SPIN_CAP) { atomicAdd(&bar[XB_TMO], 1u); break; } }
    }
    nloc = mine > 0u ? mine : 1u; nx = cnt > 0u ? cnt : 1u;
}
template <bool FENCED = true>
__device__ __forceinline__ void xcd_barrier(const XcdBarrier& b) {
    asm volatile("s_waitcnt vmcnt(0)" ::: "memory");
    __syncthreads();
    if (threadIdx.x == 0) {
        unsigned* bar = b.bar;
        __builtin_amdgcn_s_waitcnt(0);
        unsigned nloc = b.st[0], nx = b.st[1];
        if (nloc == 0u) { xcd_barrier_complete(bar, b.x, nloc, nx); b.st[0] = nloc; b.st[1] = nx; }
        const unsigned old = xb_add(&bar[XB_XSUB(b.x)], 1u);
        const unsigned gen = old / nloc;
        if (old + 1u == (gen + 1u) * nloc) {
            if (FENCED) __builtin_amdgcn_fence(__ATOMIC_RELEASE, "agent");
            asm volatile("s_waitcnt vmcnt(0)" ::: "memory");
            const unsigned og = xb_add(&bar[XB_TOP], 1u);
            const unsigned tg = og / nx;
            if (og + 1u == (tg + 1u) * nx) xb_add(&bar[XB_TOPGEN], 1u);
            else XB_SPIN(xb_ld(&bar[XB_TOPGEN]) == tg, bar);
            if (FENCED) __builtin_amdgcn_fence(__ATOMIC_ACQUIRE, "agent");
            xb_add(&bar[XB_XGEN(b.x)], 1u);
            asm volatile("s_waitcnt vmcnt(0)" ::: "memory");
        } else {
            XB_SPIN(xb_ld(&bar[XB_XGEN(b.x)]) == gen, bar);
            if (FENCED) __builtin_amdgcn_fence(__ATOMIC_ACQUIRE, "agent");
            asm volatile("s_waitcnt vmcnt(0)" ::: "memory");
        }
    }
    __syncthreads();
}

struct Frame {
    LAS unsigned char* lds;
    int tid, lane, wave, wg, G;
    const float* const* in;
    float* out; unsigned char* ws;
};
enum { I_XP = 0, I_XS, I_S5RE, I_S5IM, I_LRUH, I_LRUC, I_GS, I_GC, I_NMPRE, I_NMPOST, I_NFPRE, I_NFPOST, I_WIN, I_LRE, I_LIM, I_LDT, I_BRE, I_BIM, I_CRE, I_CIM, I_S5D, I_WGLU, I_BGLU,
       I_LCW, I_LCB, I_LWA, I_LBA, I_LWX, I_LBX, I_LLAM, I_GCW, I_GALOG, I_GDTB, I_GNW, I_WOUT, I_WGU, I_WDN };

__device__ __forceinline__ void transpose_item(const float* W, int ldw, int K, int k0, int c0, bf16* WT, int r0, LAS float* scr, int lane, const float* ksc = nullptr) {
    float tv[32];
#pragma unroll
    for (int i = 0; i < 32; ++i) tv[i] = W[(size_t)(k0 + 2 * i + (lane >> 5)) * ldw + c0 + (lane & 31)];
    if (ksc) {
#pragma unroll
        for (int i = 0; i < 32; ++i) tv[i] *= ksc[k0 + 2 * i + (lane >> 5)];
    }
#pragma unroll
    for (int i = 0; i < 32; ++i) scr[(2 * i + (lane >> 5)) * 33 + (lane & 31)] = tv[i];
    LDS_WAIT(); asm volatile("" ::: "memory");
    const int c = lane & 7;
#pragma unroll
    for (int j = 0; j < 4; ++j) { const int n = (lane >> 3) + 8 * j; const LAS float* s = scr + (8 * c) * 33 + n;
        v4u o; o.x = pk2(s[0 * 33], s[1 * 33]); o.y = pk2(s[2 * 33], s[3 * 33]); o.z = pk2(s[4 * 33], s[5 * 33]); o.w = pk2(s[6 * 33], s[7 * 33]);
        *(GAS v4u*)(WT + (size_t)(r0 + n) * K + k0 + 8 * c) = o; }
    LDS_WAIT(); asm volatile("" ::: "memory");
}
template <int MASK>
__device__ __forceinline__ void convert_items(Frame& F, int l, int wg0) {
    LAS float* scr = (LAS float*)(F.lds + F.wave * 16384);
    int lane = F.lane; asm volatile("" : "+v"(lane));
    const int gw = (F.wg - wg0) * NWAVES + F.wave, NGW = (F.G - wg0) * NWAVES;
    if (gw < 0) return;
    constexpr int I1 = (MASK & 1) ? 16 * 88 : 0, I2 = (MASK & 2) ? 16 * 32 : 0, I3 = (MASK & 4) ? 16 * 176 : 0, I4 = (MASK & 8) ? 44 * 32 : 0, I5 = (MASK & 16) ? 4 * 8 : 0, NIT = I1 + I2 + I3 + I4 + I5;
    unsigned char* ws = F.ws;
    for (int it = gw; it < NIT; it += NGW) {
        int r = it;
        if (r < I1) { const int kb = r / 88, nb = r % 88; transpose_item(F.in[I_WIN] + (size_t)l * DM * INC, INC, DM, 64 * kb, nb * 32 + (nb >= 72 ? 8 : 0), (bf16*)(ws + WS_WIN), nb * 32, scr, lane, F.in[I_NMPRE] + l * DM); continue; } r -= I1;
        if (r < I2) { const int kb = r / 32, nb = r % 32; transpose_item(F.in[I_WOUT] + (size_t)l * DM * DM, DM, DM, 64 * kb, nb * 32, (bf16*)(ws + WS_WOUT), nb * 32, scr, lane); continue; } r -= I2;
        if (r < I3) { const int kb = r / 176, nb = r % 176, tile = nb >> 3, wi = nb & 7; const int c0 = wi < 4 ? tile * 128 + wi * 32 : FF + tile * 128 + (wi - 4) * 32;
                      transpose_item(F.in[I_WGU] + (size_t)l * DM * 2 * FF, 2 * FF, DM, 64 * kb, c0, (bf16*)(ws + WS_WGU), nb * 32, scr, lane, F.in[I_NFPRE] + l * DM); continue; } r -= I3;
        if (r < I4) { const int kb = r / 32, nb = r % 32; transpose_item(F.in[I_WDN] + (size_t)l * FF * DM, DM, FF, 64 * kb, nb * 32, (bf16*)(ws + WS_WDN), nb * 32, scr, lane); continue; } r -= I4;
        if (r < I5) { const int kb = r / 8, nb = r % 8; transpose_item(F.in[I_WGLU] + (size_t)l * 256 * 256, 256, 256, 64 * kb, nb * 32, (bf16*)(ws + WS_WGLU), nb * 32, scr, lane); }
    }
}
constexpr size_t WS_DEP = 256 * 1024;
__device__ __forceinline__ unsigned* dep_word(Frame& F, int bank, int i) { return (unsigned*)(F.ws + WS_CTL + WS_DEP) + ((size_t)bank * 96 + i) * 64; }
__device__ __forceinline__ void dep_publish(Frame& F, unsigned* w0, unsigned* w1) {
    asm volatile("s_waitcnt vmcnt(0)" ::: "memory");
    __syncthreads();
    if (F.tid == 0) {
        __builtin_amdgcn_fence(__ATOMIC_RELEASE, "agent");
        asm volatile("s_waitcnt vmcnt(0)" ::: "memory");
        (void)xb_add(w0, 1u);
        if (w1) (void)xb_add(w1, 1u);
    }
}
__device__ __forceinline__ void dep_wait(Frame& F, unsigned* w0, unsigned n0, unsigned* w1, unsigned n1, unsigned* bar) {
    if (F.tid == 0) {
        XB_SPIN(xb_ld(w0) < n0, bar);
        if (w1) XB_SPIN(xb_ld(w1) < n1, bar);
        __builtin_amdgcn_fence(__ATOMIC_ACQUIRE, "agent");
        asm volatile("s_waitcnt vmcnt(0)" ::: "memory");
    }
    __syncthreads();
}
template <bool XIN_B, bool XOUT_B, bool LOCAL = false>
__device__ __forceinline__ void row_pass(Frame& F, const float* xp, const float* xs, const bf16* branch, const float* wb, float* xout, const float* wh, float* RS, const float* wab, float* AB, int lbase = 0, unsigned* sw = nullptr, unsigned sn = 0, unsigned* bar = nullptr) {
    int lane = F.lane; asm volatile("" : "+v"(lane));
    const int gw = F.wg * NWAVES + F.wave, NGW = F.G * NWAVES;
    f32x4 wbv[4], whv[4];
#pragma unroll
    for (int j = 0; j < 4; ++j) { wbv[j] = branch ? *(const GAS f32x4*)(wb + 4 * lane + 256 * j) : (f32x4){0.f, 0.f, 0.f, 0.f}; whv[j] = wh ? *(const GAS f32x4*)(wh + 4 * lane + 256 * j) : (f32x4){0.f, 0.f, 0.f, 0.f}; }
    LAS float* WL = (LAS float*)F.lds;
    if (wab) {
        f32x4 wl4[4];
#pragma unroll
        for (int k4 = 0; k4 < 4; ++k4) { const int i = F.tid + k4 * NTHR; const int k = i >> 1, hlf = i & 1; wl4[k4] = *(const GAS f32x4*)(wab + (size_t)k * INC + 2304 + hlf * 4); }
        __syncthreads();
#pragma unroll
        for (int k4 = 0; k4 < 4; ++k4) { const int i = F.tid + k4 * NTHR; const int k = i >> 1, hlf = i & 1; *(LAS f32x4*)(WL + k * 8 + hlf * 4) = wl4[k4]; }
        __syncthreads(); }
    const int nit = LOCAL ? (F.wave < 2 ? 9 : 8) : (MT - gw + NGW - 1) / NGW;
    for (int it = 0; it < nit; ++it) {
        const int m = LOCAL ? (it < 8 ? lbase + it : MP + 2 * F.wg + F.wave) : gw + it * NGW;
        if (LOCAL && it == 8) {
            XB_SPIN(xb_ld(sw) < sn, bar);
            __builtin_amdgcn_fence(__ATOMIC_ACQUIRE, "agent");
            asm volatile("s_waitcnt vmcnt(0)" ::: "memory");
        }
        f32x4 v[4];
        if (XIN_B) {
#pragma unroll
            for (int j = 0; j < 4; ++j) { const v2u w = *(const GAS v2u*)((const bf16*)xp + (size_t)m * DM + 4 * lane + 256 * j); v[j] = (f32x4){bflo(w.x), bfhi(w.x), bflo(w.y), bfhi(w.y)}; }
        } else {
            const float* xr = (xs && m >= MP) ? xs + (size_t)(m - MP) * DM : xp + (size_t)m * DM;
#pragma unroll
            for (int j = 0; j < 4; ++j) v[j] = *(const GAS f32x4*)(xr + 4 * lane + 256 * j);
        }
        if (branch) {
            f32x4 b[4]; float s = 0.f;
#pragma unroll
            for (int j = 0; j < 4; ++j) { const v2u bw = *(const GAS v2u*)(branch + (size_t)m * DM + 4 * lane + 256 * j); b[j] = (f32x4){bflo(bw.x), bfhi(bw.x), bflo(bw.y), bfhi(bw.y)}; s += (b[j].x * b[j].x + b[j].y * b[j].y) + (b[j].z * b[j].z + b[j].w * b[j].w); }
            const float rs = 1.0f / sqrtf(wave_sum(s) * (1.f / DM) + EPS);
#pragma unroll
            for (int j = 0; j < 4; ++j) v[j] = v[j] + b[j] * rs * wbv[j];
        }
        if (xout) {
#pragma unroll
            for (int j = 0; j < 4; ++j) {
                if (XOUT_B) { v2u o; o.x = pk2(v[j].x, v[j].y); o.y = pk2(v[j].z, v[j].w); *(GAS v2u*)((bf16*)xout + (size_t)m * DM + 4 * lane + 256 * j) = o; }
                else *(GAS f32x4*)(xout + (size_t)m * DM + 4 * lane + 256 * j) = v[j];
            }
        }
        if (RS) {
            float s = 0.f;
#pragma unroll
            for (int j = 0; j < 4; ++j) s += (v[j].x * v[j].x + v[j].y * v[j].y) + (v[j].z * v[j].z + v[j].w * v[j].w);
            const float rs = 1.0f / sqrtf(wave_sum(s) * (1.f / DM) + EPS);
            if (lane == 0) RS[m] = rs;
            if (wab) {
#pragma unroll
                for (int j = 0; j < 4; ++j) v[j] = v[j] * rs * whv[j];
            }
            if (wab) {
                float a8[8];
#pragma unroll
                for (int c = 0; c < 8; ++c) a8[c] = 0.f;
#pragma unroll
                for (int j = 0; j < 4; ++j)
#pragma unroll
                    for (int q = 0; q < 4; ++q) { const LAS float* wr = WL + (4 * lane + 256 * j + q) * 8; const f32x4 w0 = *(const LAS f32x4*)wr, w1 = *(const LAS f32x4*)(wr + 4); const float xv = v[j][q];
                        a8[0] += xv * w0.x; a8[1] += xv * w0.y; a8[2] += xv * w0.z; a8[3] += xv * w0.w; a8[4] += xv * w1.x; a8[5] += xv * w1.y; a8[6] += xv * w1.z; a8[7] += xv * w1.w; }
#pragma unroll
                for (int c = 0; c < 8; ++c) a8[c] = wave_sum(a8[c]);
                if (lane == 0) { *(GAS f32x4*)(AB + (size_t)m * 8) = (f32x4){a8[0], a8[1], a8[2], a8[3]}; *(GAS f32x4*)(AB + (size_t)m * 8 + 4) = (f32x4){a8[4], a8[5], a8[6], a8[7]}; }
            }
        }
    }
}

__device__ __forceinline__ void sample_gemm_f32(Frame& F, const bf16* A, const bf16* Bt, int K, bf16* C) {
    int tid = F.tid; asm volatile("" : "+v"(tid)); const int lane = tid & 63, wv = tid >> 6, fr = lane & 15, fq = lane >> 4;
    for (int t = F.wg; t < 256; t += F.G) {
        const int row0 = MP + 32 * (t >> 4) + 16 * (wv >> 2), col0 = 64 * (t & 15) + 16 * (wv & 3);
        const bf16* ap = A + (size_t)(row0 + fr) * K + 8 * fq; const bf16* bp = Bt + (size_t)(col0 + fr) * K + 8 * fq;
        f32x4 acc0 = (f32x4){0.f, 0.f, 0.f, 0.f}, acc1 = (f32x4){0.f, 0.f, 0.f, 0.f};
#pragma unroll 4
        for (int k = 0; k < K; k += 64) {
            const v4u a0 = *(const GAS v4u*)(ap + k), b0 = *(const GAS v4u*)(bp + k), a1 = *(const GAS v4u*)(ap + k + 32), b1 = *(const GAS v4u*)(bp + k + 32);
            acc0 = MFMA16(__builtin_bit_cast(bf16x8, a0), __builtin_bit_cast(bf16x8, b0), acc0); acc1 = MFMA16(__builtin_bit_cast(bf16x8, a1), __builtin_bit_cast(bf16x8, b1), acc1);
        }
#pragma unroll
        for (int r = 0; r < 4; ++r) C[(size_t)(row0 + 4 * fq + r) * DM + col0 + fr] = (bf16)f2bf(acc0[r] + acc1[r]);
    }
}

__device__ __forceinline__ void sample_gemm_lds(Frame& F, const bf16* A, const bf16* Bt, int K, bf16* C) {
    int tid = F.tid; asm volatile("" : "+v"(tid)); const int lane = tid & 63, wv = tid >> 6, fr = lane & 15, fq = lane >> 4;
    LAS unsigned char* L = F.lds;
    constexpr int SA = 32 * S512, SBUF = SA + 64 * S512;
    for (int t = F.wg; t < 256; t += F.G) {
        const int row0 = MP + 32 * (t >> 4), col0 = 64 * (t & 15);
        const int pr = tid >> 5, pc = (tid & 31) * 8;
        const bf16* ap = A + (size_t)(row0 + pr) * K + pc; const bf16* bp = Bt + (size_t)(col0 + pr) * K + pc;
        const size_t s16 = (size_t)16 * K;
        const int sa = pr * S512 + pc * 2, sb = SA + sa;
        v4u ra0 = *(const GAS v4u*)ap, ra1 = *(const GAS v4u*)(ap + s16);
        v4u rb0 = *(const GAS v4u*)bp, rb1 = *(const GAS v4u*)(bp + s16), rb2 = *(const GAS v4u*)(bp + 2 * s16), rb3 = *(const GAS v4u*)(bp + 3 * s16);
        *(LAS v4u*)(L + sa) = ra0; *(LAS v4u*)(L + sa + 16 * S512) = ra1;
        *(LAS v4u*)(L + sb) = rb0; *(LAS v4u*)(L + sb + 16 * S512) = rb1; *(LAS v4u*)(L + sb + 32 * S512) = rb2; *(LAS v4u*)(L + sb + 48 * S512) = rb3;
        __syncthreads();
        f32x4 acc = (f32x4){0.f, 0.f, 0.f, 0.f};
        const int nc = K >> 8;
        for (int kc = 0; kc < nc; ++kc) {
            const int cur = (kc & 1) * SBUF, nxt = ((kc + 1) & 1) * SBUF;
            if (kc + 1 < nc) { const int o = (kc + 1) * 256;
                ra0 = *(const GAS v4u*)(ap + o); ra1 = *(const GAS v4u*)(ap + s16 + o);
                rb0 = *(const GAS v4u*)(bp + o); rb1 = *(const GAS v4u*)(bp + s16 + o); rb2 = *(const GAS v4u*)(bp + 2 * s16 + o); rb3 = *(const GAS v4u*)(bp + 3 * s16 + o); }
#pragma unroll
            for (int ks = 0; ks < 8; ++ks) {
                const bf16x8 af = *(const LAS bf16x8*)(L + cur + (16 * (wv >> 2) + fr) * S512 + (32 * ks + 8 * fq) * 2);
                const bf16x8 bf = *(const LAS bf16x8*)(L + cur + SA + (16 * (wv & 3) + fr) * S512 + (32 * ks + 8 * fq) * 2);
                acc = MFMA16(af, bf, acc);
            }
            if (kc + 1 < nc) { *(LAS v4u*)(L + nxt + sa) = ra0; *(LAS v4u*)(L + nxt + sa + 16 * S512) = ra1;
                *(LAS v4u*)(L + nxt + sb) = rb0; *(LAS v4u*)(L + nxt + sb + 16 * S512) = rb1; *(LAS v4u*)(L + nxt + sb + 32 * S512) = rb2; *(LAS v4u*)(L + nxt + sb + 48 * S512) = rb3; }
            __syncthreads();
        }
#pragma unroll
        for (int r = 0; r < 4; ++r) C[(size_t)(row0 + 16 * (wv >> 2) + 4 * fq + r) * DM + col0 + 16 * (wv & 3) + fr] = (bf16)f2bf(acc[r]);
    }
}

constexpr int G_KN = 0, G_WKT = 0, G_QN = 18432, G_KT = G_QN + 64 * S256, G_VT = G_KT + 128 * S128, G_RAW = G_VT + 128 * S128, G_AT = G_RAW, G_T1 = G_AT + 64 * S128, G_T2 = G_T1 + 64 * S128, G_AF = G_T2 + 64 * S128, G_WVT = G_AF, G_VEC = G_RAW + 52544, G_CW = G_VEC + 1024;
constexpr int RAW_STRIDE = 784;
static_assert(G_RAW + 67 * RAW_STRIDE <= G_VEC && G_CW + 6144 <= LDSCTL_OFF && G_WVT + 128 * S128 <= G_VEC && 64 * S256 <= G_QN && 128 * S128 <= G_QN, "gdn prep lds");
__device__ __forceinline__ void gdn_raw_load(Frame& F, int u, int tid, v4u (&pre)[7], float (&abn)[2]) {
    const int c = u & 31, h = (u >> 5) & 3, b = u >> 7; const bf16* P = (const bf16*)(F.ws + WS_P);
    { const float* ABp = (const float*)(F.ws + WS_AB) + (size_t)(b * SEQ + c * 64 + (tid & 63)) * 8; abn[0] = ABp[h]; abn[1] = ABp[4 + h]; }
#pragma unroll
    for (int k7 = 0; k7 < 7; ++k7) { const int idx = tid + NTHR * k7; const int r = idx / 48, ck = idx % 48, ten = ck >> 4, c16 = ck & 15; const int tt = c * 64 - 3 + r;
        v4u val = (v4u){0u, 0u, 0u, 0u};
        if (idx < 67 * 48 && tt >= 0) val = *(const GAS v4u*)(P + (size_t)(b * SEQ + tt) * NPJ + PQ + ten * 512 + h * HD + c16 * 8);
        pre[k7] = val; }
}
template <int GP_CUT>
__device__ __forceinline__ void gdn_prep(Frame& F, int l, int u, int& cw_head, v4u (&pre)[7], float (&abn)[2], bool have_pre, int u_next) {
    LAS unsigned char* L = F.lds;
    int tid = F.tid; asm volatile("" : "+v"(tid)); const int lane = tid & 63, wv = tid >> 6;
    const int c = u & 31, h = (u >> 5) & 3, b = u >> 7;
    const int row0 = b * SEQ + c * 64;
    const bf16* P = (const bf16*)(F.ws + WS_P);
    const float* AB = (const float*)(F.ws + WS_AB);
    LAS float* VG = (LAS float*)(L + G_VEC); LAS float* VB = VG + 64; LAS float* VEG = VG + 128; LAS float* VEGL = VG + 192;
    const float galog = F.in[I_GALOG][l * 4 + h], gdtb = F.in[I_GDTB][l * 4 + h];
    if (h != cw_head) {
        for (int idx = tid; idx < 1536; idx += NTHR) { const int j = idx / 384, cc = idx % 384; ((LAS float*)(L + G_CW))[idx] = F.in[I_GCW][(size_t)(l * 4 + j) * 1536 + (cc >> 7) * 512 + h * HD + (cc & 127)]; }
        cw_head = h;
    }
    if (!have_pre) gdn_raw_load(F, u, tid, pre, abn);
#pragma unroll
    for (int k7 = 0; k7 < 7; ++k7) { const int idx = tid + NTHR * k7; if (idx < 67 * 48) { const int r = idx / 48, ck = idx % 48; *(LAS v4u*)(L + G_RAW + r * RAW_STRIDE + (ck >> 4) * 256 + (ck & 15) * 16) = pre[k7]; } }
    if (wv == 0) {
        const float a = abn[0], bb = abn[1];
        const float g = -__expf(galog) * softplus_fast(a + gdtb);
        const float be = frcp(1.0f + __expf(-bb));
        float Gc = g;
#pragma unroll
        for (int o = 1; o < 64; o <<= 1) { const float t = __shfl_up(Gc, o); if (lane >= o) Gc += t; }
        const float Gl = __shfl(Gc, 63);
        VG[lane] = Gc; VB[lane] = be; VEG[lane] = __expf(Gc); VEGL[lane] = __expf(Gl - Gc);
        if (lane == 0) ((float*)(F.ws + WS_EGL))[u] = __expf(Gl);
    }
    __syncthreads();
    if (u_next >= 0) gdn_raw_load(F, u_next, tid, pre, abn);
    if (c == 31 && tid < 384) {
        const int ten = tid >> 7, ch = tid & 127;
#pragma unroll
        for (int j = 0; j < 3; ++j) F.out[O_PGC + (size_t)((l * 8 + b) * 3 + j) * 1536 + ten * 512 + h * HD + ch] = bf2f(*(LAS bf16*)(L + G_RAW + (64 + j) * RAW_STRIDE + ten * 256 + ch * 2));
    }
    {
        const int i = tid >> 3, cg = tid & 7;
#pragma unroll 1
        for (int ten = 0; ten < 3; ++ten) {
            float acc[16];
#pragma unroll
            for (int e = 0; e < 16; ++e) acc[e] = 0.f;
#pragma unroll
            for (int j = 0; j < 4; ++j) {
                const v4u x0 = *(LAS v4u*)(L + G_RAW + (i + j) * RAW_STRIDE + ten * 256 + cg * 32), x1 = *(LAS v4u*)(L + G_RAW + (i + j) * RAW_STRIDE + ten * 256 + cg * 32 + 16);
                const LAS float* w = (const LAS float*)(L + G_CW) + j * 384 + ten * 128 + cg * 16;
                const f32x4 w0 = *(const LAS f32x4*)w, w1 = *(const LAS f32x4*)(w + 4), w2 = *(const LAS f32x4*)(w + 8), w3 = *(const LAS f32x4*)(w + 12);
                acc[0] += w0.x * bflo(x0.x); acc[1] += w0.y * bfhi(x0.x); acc[2] += w0.z * bflo(x0.y); acc[3] += w0.w * bfhi(x0.y);
                acc[4] += w1.x * bflo(x0.z); acc[5] += w1.y * bfhi(x0.z); acc[6] += w1.z * bflo(x0.w); acc[7] += w1.w * bfhi(x0.w);
                acc[8] += w2.x * bflo(x1.x); acc[9] += w2.y * bfhi(x1.x); acc[10] += w2.z * bflo(x1.y); acc[11] += w2.w * bfhi(x1.y);
                acc[12] += w3.x * bflo(x1.z); acc[13] += w3.y * bfhi(x1.z); acc[14] += w3.z * bflo(x1.w); acc[15] += w3.w * bfhi(x1.w);
            }
            float ss = 0.f;
#pragma unroll
            for (int e = 0; e < 16; ++e) { acc[e] = siluf_(acc[e]); ss += acc[e] * acc[e]; }
            ss += __shfl_xor(ss, 1); ss += __shfl_xor(ss, 2); ss += __shfl_xor(ss, 4);
            const float sc = ten == 2 ? 1.0f : frsq(ss + EPS) * (ten == 0 ? 0.08838834764831845f : 1.0f);
#pragma unroll
            for (int e = 0; e < 16; ++e) acc[e] *= sc;
            if (ten < 2) { const int base = ten == 0 ? G_QN : G_KN; *(LAS bf16x8*)(L + base + t256(i, cg * 16)) = pack8(acc); *(LAS bf16x8*)(L + base + t256(i, cg * 16 + 8)) = pack8(acc + 8); }
            if (ten > 0) { const int base = ten == 1 ? G_KT : G_VT;
#pragma unroll
                for (int e = 0; e < 16; ++e) *(LAS bf16*)(L + base + t128(cg * 16 + e, i)) = (bf16)f2bf(acc[e]); }
        }
    }
    __syncthreads();
    if constexpr (GP_CUT == 1) return;
    {
        const int prod = wv >> 2, mi = wv & 3, fr = lane & 15, fq = lane >> 4;
        bf16x8 a[4];
#pragma unroll
        for (int ks = 0; ks < 4; ++ks) a[ks] = *(LAS bf16x8*)(L + (prod ? G_QN : G_KN) + t256(16 * mi + fr, 32 * ks + 8 * fq));
#pragma unroll
        for (int nj = 0; nj < 4; ++nj) {
            f32x4 acc = (f32x4){0.f, 0.f, 0.f, 0.f};
            if (nj <= mi) {
#pragma unroll
                for (int ks = 0; ks < 4; ++ks) { const bf16x8 bb = *(LAS bf16x8*)(L + G_KN + t256(16 * nj + fr, 32 * ks + 8 * fq)); acc = MFMA16(a[ks], bb, acc); }
            }
            const int j = 16 * nj + fr; const float Gj = VG[j];
#pragma unroll
            for (int r = 0; r < 4; ++r) {
                const int i = 16 * mi + 4 * fq + r; const float Gi = VG[i];
                const float dec = (i >= j) ? __expf(Gi - Gj) : 0.f;
                if (prod == 0) { const float val = (i > j) ? acc[r] * VB[i] * dec : 0.f; *(LAS float*)(L + G_AF + (i * 64 + j) * 4) = val; }
                else { const float val = (i >= j) ? acc[r] * dec : 0.f; *(LAS bf16*)(L + G_AT + t128(i, j)) = (bf16)f2bf(val); }
            }
        }
    }
    __syncthreads();
    if constexpr (GP_CUT == 2) return;
    if (wv == 0) {
        const int q = lane >> 4, col = lane & 15; const LAS float* Ab = (const LAS float*)(L + G_AF) + (16 * q) * 64 + 16 * q;
        float t[16];
#pragma unroll
        for (int i = 0; i < 16; ++i) {
            float a0 = (col == i) ? 1.f : 0.f, a1 = 0.f, a2 = 0.f, a3 = 0.f;
#pragma unroll
            for (int j4 = 0; j4 < i; j4 += 4) { const f32x4 av = *(const LAS f32x4*)(Ab + i * 64 + j4);
                a0 -= av.x * t[j4]; if (j4 + 1 < i) a1 -= av.y * t[j4 + 1]; if (j4 + 2 < i) a2 -= av.z * t[j4 + 2]; if (j4 + 3 < i) a3 -= av.w * t[j4 + 3]; }
            t[i] = (a0 + a1) + (a2 + a3);
            if ((i & 3) == 3) asm volatile("" ::: "memory");
        }
        LAS float* Tb = (LAS float*)(L + G_AF) + (16 * q) * 64 + 16 * q;
#pragma unroll
        for (int i = 0; i < 16; ++i) Tb[i * 64 + col] = t[i];
    }
    __syncthreads();
    if (wv < 2) {
        LAS float* AF = (LAS float*)(L + G_AF) + (32 * wv) * 64 + 32 * wv; LAS float* X1 = (LAS float*)(L + G_T1) + 1024 + 256 * wv;
        const int fr = lane & 15, fq = lane >> 4;
        f32x4 acc = (f32x4){0.f, 0.f, 0.f, 0.f};
#pragma unroll
        for (int kk = 0; kk < 4; ++kk) { const float av = AF[(16 + fr) * 64 + 4 * kk + fq], bv = AF[(4 * kk + fq) * 64 + fr]; acc = __builtin_amdgcn_mfma_f32_16x16x4f32(av, bv, acc, 0, 0, 0); }
#pragma unroll
        for (int r = 0; r < 4; ++r) X1[(4 * fq + r) * 16 + fr] = acc[r];
        acc = (f32x4){0.f, 0.f, 0.f, 0.f};
#pragma unroll
        for (int kk = 0; kk < 4; ++kk) { const float av = AF[(16 + fr) * 64 + 16 + 4 * kk + fq], bv = X1[(4 * kk + fq) * 16 + fr]; acc = __builtin_amdgcn_mfma_f32_16x16x4f32(av, bv, acc, 0, 0, 0); }
#pragma unroll
        for (int r = 0; r < 4; ++r) AF[(16 + 4 * fq + r) * 64 + fr] = -acc[r];
    }
    __syncthreads();
    if constexpr (GP_CUT == 3) return;
    {
        LAS float* AF = (LAS float*)(L + G_AF); LAS float* XF = (LAS float*)(L + G_T1);
        const int mi2 = wv & 1, nj2 = (wv >> 1) & 1, fr = lane & 15, fq = lane >> 4;
        if (wv < 4) {
            f32x4 acc = (f32x4){0.f, 0.f, 0.f, 0.f};
#pragma unroll
            for (int kk = 0; kk < 8; ++kk) { const float av = AF[(32 + 16 * mi2 + fr) * 64 + 4 * kk + fq], bv = AF[(4 * kk + fq) * 64 + 16 * nj2 + fr]; acc = __builtin_amdgcn_mfma_f32_16x16x4f32(av, bv, acc, 0, 0, 0); }
#pragma unroll
            for (int r = 0; r < 4; ++r) XF[(16 * mi2 + 4 * fq + r) * 32 + 16 * nj2 + fr] = acc[r];
        }
        __syncthreads();
        if (wv < 4) {
            f32x4 acc = (f32x4){0.f, 0.f, 0.f, 0.f};
#pragma unroll
            for (int kk = 0; kk < 8; ++kk) { const float av = AF[(32 + 16 * mi2 + fr) * 64 + 32 + 4 * kk + fq], bv = XF[(4 * kk + fq) * 32 + 16 * nj2 + fr]; acc = __builtin_amdgcn_mfma_f32_16x16x4f32(av, bv, acc, 0, 0, 0); }
#pragma unroll
            for (int r = 0; r < 4; ++r) AF[(32 + 16 * mi2 + 4 * fq + r) * 64 + 16 * nj2 + fr] = -acc[r];
        }
        __syncthreads();
    }
    if constexpr (GP_CUT == 4) return;
    {
        const int i = tid >> 3, c8 = tid & 7; const LAS float* AF = (const LAS float*)(L + G_AF);
        const f32x4 t0 = *(const LAS f32x4*)(AF + i * 64 + 8 * c8), t1 = *(const LAS f32x4*)(AF + i * 64 + 8 * c8 + 4);
        float a1[8], a2[8];
#pragma unroll
        for (int e = 0; e < 8; ++e) { const float tv = e < 4 ? t0[e] : t1[e - 4]; const int j = 8 * c8 + e; a1[e] = tv * VB[j]; a2[e] = a1[e] * VEG[j]; }
        __syncthreads();
        *(LAS bf16x8*)(L + G_T1 + t128(i, 8 * c8)) = pack8(a1); *(LAS bf16x8*)(L + G_T2 + t128(i, 8 * c8)) = pack8(a2);
    }
    __syncthreads();
    if constexpr (GP_CUT == 5) return;
    {
        const int nd = wv, fr = lane & 15, fq = lane >> 4;
#pragma unroll
        for (int prod = 0; prod < 2; ++prod) {
            bf16x8 bfr[2];
#pragma unroll
            for (int ks = 0; ks < 2; ++ks) bfr[ks] = *(LAS bf16x8*)(L + (prod ? G_KT : G_VT) + t128(16 * nd + fr, 32 * ks + 8 * fq));
#pragma unroll
            for (int mi = 0; mi < 4; ++mi) {
                f32x4 acc = (f32x4){0.f, 0.f, 0.f, 0.f};
#pragma unroll
                for (int ks = 0; ks < 2; ++ks) { const bf16x8 af = *(LAS bf16x8*)(L + (prod ? G_T2 : G_T1) + t128(16 * mi + fr, 32 * ks + 8 * fq)); acc = MFMA16(af, bfr[ks], acc); }
                v2u o; o.x = pk2(acc[0], acc[1]); o.y = pk2(acc[2], acc[3]);
                *(LAS v2u*)(L + (prod ? G_WKT : G_WVT) + t128(16 * nd + fr, 16 * mi + 4 * fq)) = o;
            }
        }
    }
    __syncthreads();
    if constexpr (GP_CUT == 6) return;
    {
        const int nd = wv, fr = lane & 15, fq = lane >> 4;
        bf16x8 bk[2], bv[2];
#pragma unroll
        for (int ks = 0; ks < 2; ++ks) { bk[ks] = *(LAS bf16x8*)(L + G_WKT + t128(16 * nd + fr, 32 * ks + 8 * fq)); bv[ks] = *(LAS bf16x8*)(L + G_WVT + t128(16 * nd + fr, 32 * ks + 8 * fq)); }
        bf16* QT = (bf16*)(F.ws + WS_QT) + (size_t)u * 64 * 128; bf16* OL = (bf16*)(F.ws + WS_OL) + (size_t)u * 8192;
#pragma unroll
        for (int mi = 0; mi < 4; ++mi) {
            f32x4 ak = (f32x4){0.f, 0.f, 0.f, 0.f}, av = (f32x4){0.f, 0.f, 0.f, 0.f};
#pragma unroll
            for (int ks = 0; ks < 2; ++ks) { const bf16x8 af = *(LAS bf16x8*)(L + G_AT + t128(16 * mi + fr, 32 * ks + 8 * fq)); ak = MFMA16(af, bk[ks], ak); av = MFMA16(af, bv[ks], av); }
#pragma unroll
            for (int r = 0; r < 4; ++r) { const int i = 16 * mi + 4 * fq + r, d = 16 * nd + fr;
                const float qv = bf2f(*(LAS bf16*)(L + G_QN + t256(i, d)));
                QT[(((mi * 4 + (nd >> 1)) * 64) + (4 * fq + r) + 16 * (2 * (nd & 1) + (fr >> 3))) * 8 + (fr & 7)] = (bf16)f2bf(VEG[i] * qv - ak[r]);
                }
            { v2u o; o.x = pk2(av[0], av[1]); o.y = pk2(av[2], av[3]); *(GAS v2u*)(OL + ((nd * 4 + mi) * 64 + lane) * 4) = o; }
        }
    }
    if constexpr (GP_CUT == 7) return;
    {
        const int fr = lane & 15, fq = lane >> 4;
        bf16x8 kd[2];
#pragma unroll
        for (int ks = 0; ks < 2; ++ks) { const v4u raw = *(LAS v4u*)(L + G_KT + t128(16 * wv + fr, 32 * ks + 8 * fq)); const int i0 = 32 * ks + 8 * fq; float f[8];
            f[0] = bflo(raw.x) * VEGL[i0]; f[1] = bfhi(raw.x) * VEGL[i0 + 1]; f[2] = bflo(raw.y) * VEGL[i0 + 2]; f[3] = bfhi(raw.y) * VEGL[i0 + 3];
            f[4] = bflo(raw.z) * VEGL[i0 + 4]; f[5] = bfhi(raw.z) * VEGL[i0 + 5]; f[6] = bflo(raw.w) * VEGL[i0 + 6]; f[7] = bfhi(raw.w) * VEGL[i0 + 7]; kd[ks] = pack8(f); }
        bf16* PP = (bf16*)(F.ws + WS_PP) + (size_t)u * 128 * 128; bf16* RT = (bf16*)(F.ws + WS_RT) + (size_t)u * 128 * 128;
#pragma unroll 2
        for (int nd = 0; nd < 8; ++nd) {
            f32x4 ar = (f32x4){0.f, 0.f, 0.f, 0.f}, ap = (f32x4){0.f, 0.f, 0.f, 0.f};
#pragma unroll
            for (int ks = 0; ks < 2; ++ks) { const bf16x8 wvf = *(LAS bf16x8*)(L + G_WVT + t128(16 * nd + fr, 32 * ks + 8 * fq)), wkf = *(LAS bf16x8*)(L + G_WKT + t128(16 * nd + fr, 32 * ks + 8 * fq));
                ar = MFMA16(kd[ks], wvf, ar); ap = MFMA16(wkf, kd[ks], ap); }
            v2u o; o.x = pk2(ar[0], ar[1]); o.y = pk2(ar[2], ar[3]); *(GAS v2u*)(RT + (size_t)((nd * 8 + wv) * 64 + lane) * 4) = o;
            o.x = pk2(ap[0], ap[1]); o.y = pk2(ap[2], ap[3]); *(GAS v2u*)(PP + (size_t)(((wv * 4 + (nd >> 1)) * 64) + fr + 16 * (2 * (nd & 1) + (fq >> 1))) * 8 + 4 * (fq & 1)) = o;
        }
    }
    __syncthreads();
}

struct ChainSet { v4u ap[4], aq[4]; v2u rr, ol; float eg; };
constexpr int CH_O = 2 * 16 * S256, CH_S = CH_O + 32 * 4 * 512;
static_assert(CH_S + 32 * 4 * 64 <= LDSCTL_OFF, "chain lds");
struct ChainPtr { const bf16* pp; const bf16* qq; const bf16* rt; const bf16* ol; const float* egl; };
__device__ __forceinline__ void chain_load(ChainSet& s, const ChainPtr& p, int c, bool lowhalf) {
    const bf16* pp = p.pp + (size_t)c * 16384;
#pragma unroll
    for (int ks = 0; ks < 4; ++ks) s.ap[ks] = *(const GAS v4u*)(pp + 512 * ks);
    s.rr = *(const GAS v2u*)(p.rt + (size_t)c * 16384); s.eg = p.egl[c];
    if (lowhalf) {
        const bf16* qq = p.qq + (size_t)c * 8192;
#pragma unroll
        for (int ks = 0; ks < 4; ++ks) s.aq[ks] = *(const GAS v4u*)(qq + 512 * ks);
        s.ol = *(const GAS v2u*)(p.ol + (size_t)c * 8192);
    }
}
template <bool DRY>
__device__ __forceinline__ void gdn_chain(Frame& F, int l, int task) {
    LAS unsigned char* L = F.lds;
    int tid = F.tid; asm volatile("" : "+v"(tid)); const int lane = tid & 63, wv = tid >> 6, fr = lane & 15, fq = lane >> 4;
    const int xcd = task & 7, idx = task >> 3; const int chain = xcd * 4 + (idx >> 3), slab = idx & 7;
    const int b = chain >> 2, h = chain & 3;
    const bf16* PPb = (const bf16*)(F.ws + WS_PP) + (size_t)chain * 32 * 16384; bf16* RTb = (bf16*)(F.ws + WS_RT) + (size_t)chain * 32 * 16384;
    const bf16* QTb = (const bf16*)(F.ws + WS_QT) + (size_t)chain * 32 * 8192;
    bf16* OLb = (bf16*)(F.ws + WS_OL) + (size_t)chain * 32 * 8192;
    float* SSQ = (float*)(F.ws + WS_SSQ);
    const float* EGL = (const float*)(F.ws + WS_EGL) + chain * 32;
    const int row0h = b * SEQ;
    for (int i = F.tid; i < 2 * 16 * S256 / 4; i += NTHR) ((LAS unsigned*)L)[i] = 0u;
    __syncthreads();
    f32x4 S = (f32x4){0.f, 0.f, 0.f, 0.f};
    ChainSet cs[4];
    ChainPtr cp;
    cp.pp = PPb + (size_t)(wv * 4 * 64 + lane) * 8; cp.qq = QTb + (size_t)((wv & 3) * 4 * 64 + lane) * 8;
    cp.rt = RTb + (size_t)((slab * 8 + wv) * 64 + lane) * 4;
    cp.ol = OLb + ((slab * 4 + (wv & 3)) * 64 + lane) * 4; cp.egl = EGL;
    asm volatile("" : "+v"(cp.pp), "+v"(cp.qq), "+v"(cp.rt), "+v"(cp.ol));
    const bool lowhalf = wv < 4;
    chain_load(cs[0], cp, 0, lowhalf); chain_load(cs[1], cp, 1, lowhalf); chain_load(cs[2], cp, 2, lowhalf);
#pragma unroll 1
    for (int c0 = 0; c0 < NCH; c0 += 4) {
#pragma unroll
        for (int s = 0; s < 4; ++s) {
            const int c = c0 + s;
            chain_load(cs[(s + 3) & 3], cp, c + 3 < NCH ? c + 3 : NCH - 1, lowhalf);
            const ChainSet& q = cs[s];
            const LAS unsigned char* St = L + (s & 1) * (16 * S256);
            bf16x8 bs[4];
#pragma unroll
            for (int ks = 0; ks < 4; ++ks) bs[ks] = *(const LAS bf16x8*)(St + t256(fr, 32 * ks + 8 * fq));
            f32x4 acc = (f32x4){0.f, 0.f, 0.f, 0.f};
#pragma unroll
            for (int ks = 0; ks < 4; ++ks) acc = MFMA16(__builtin_bit_cast(bf16x8, q.ap[ks]), bs[ks], acc);
            if (lowhalf) {
                f32x4 ao = (f32x4){0.f, 0.f, 0.f, 0.f};
#pragma unroll
                for (int ks = 0; ks < 4; ++ks) ao = MFMA16(__builtin_bit_cast(bf16x8, q.aq[ks]), bs[ks], ao);
                const float o0 = ao[0] + bflo(q.ol.x), o1 = ao[1] + bfhi(q.ol.x), o2 = ao[2] + bflo(q.ol.y), o3 = ao[3] + bfhi(q.ol.y);
                v2u ov; ov.x = pk2(o0, o1); ov.y = pk2(o2, o3);
                f32x4 ss = (f32x4){o0 * o0, o1 * o1, o2 * o2, o3 * o3};
#pragma unroll
                for (int sh = 1; sh < 16; sh <<= 1) { ss[0] += __shfl_xor(ss[0], sh); ss[1] += __shfl_xor(ss[1], sh); ss[2] += __shfl_xor(ss[2], sh); ss[3] += __shfl_xor(ss[3], sh); }
                {
                    *(LAS v2u*)(L + CH_O + ((c * 4 + wv) * 64 + lane) * 8) = ov;
                    if (fr == 0) *(LAS f32x4*)(L + CH_S + ((c * 4 + wv) * 4 + fq) * 16) = ss;
                }
            }
            S[0] = q.eg * S[0] - acc[0] + bflo(q.rr.x); S[1] = q.eg * S[1] - acc[1] + bfhi(q.rr.x); S[2] = q.eg * S[2] - acc[2] + bflo(q.rr.y); S[3] = q.eg * S[3] - acc[3] + bfhi(q.rr.y);
            v2u o2; o2.x = pk2(S[0], S[1]); o2.y = pk2(S[2], S[3]);
            *(LAS v2u*)(L + ((s + 1) & 1) * (16 * S256) + t256(fr, 16 * wv + 4 * fq)) = o2;
            asm volatile("s_waitcnt lgkmcnt(0)" ::: "memory"); __builtin_amdgcn_s_barrier(); asm volatile("" ::: "memory");
        }
    }
    if (!DRY) {
        bf16* MXh = (bf16*)(F.ws + WS_X) + 512 + h * HD + 16 * slab;
#if HEADNORM_IN_GEMM
        const bf16* Zh = (const bf16*)(F.ws + WS_P) + PZ + h * HD + 16 * slab + 8 * (tid & 1);
        const float* gwp = F.in[I_GNW] + l * HD + 16 * slab + 8 * (tid & 1);
        const f32x4 w0 = *(const GAS f32x4*)gwp, w1 = *(const GAS f32x4*)(gwp + 4);
#endif
#if HEADNORM_IN_GEMM
        v4u zq[8];
#pragma unroll
        for (int k = 0; k < 8; ++k) { const int i = tid + k * NTHR; zq[k] = *(const GAS v4u*)(Zh + (size_t)(row0h + (i >> 7) * 64 + ((i >> 1) & 63)) * NPJ); }
#pragma unroll
        for (int k = 0; k < 8; ++k) { const int i = tid + k * NTHR; const int half = i & 1, rr = (i >> 1) & 63, cc = i >> 7; const int mi = rr >> 4, fq2 = (rr >> 2) & 3, r = rr & 3;
#else
        for (int i = tid; i < 32 * 64 * 2; i += NTHR) { const int half = i & 1, rr = (i >> 1) & 63, cc = i >> 7; const int mi = rr >> 4, fq2 = (rr >> 2) & 3, r = rr & 3;
#endif
            unsigned w[4];
#pragma unroll
            for (int e = 0; e < 4; ++e) { const int f0 = 8 * half + 2 * e;
                const unsigned lo = *(const LAS unsigned short*)(L + CH_O + ((cc * 4 + mi) * 64 + fq2 * 16 + f0) * 8 + r * 2), hi = *(const LAS unsigned short*)(L + CH_O + ((cc * 4 + mi) * 64 + fq2 * 16 + f0 + 1) * 8 + r * 2);
                w[e] = lo | (hi << 16); }
#if HEADNORM_IN_GEMM
            const v4u zv = zq[k];
            float y[8];
            y[0] = bflo(w[0]) * w0.x * siluf_(bflo(zv.x)); y[1] = bfhi(w[0]) * w0.y * siluf_(bfhi(zv.x)); y[2] = bflo(w[1]) * w0.z * siluf_(bflo(zv.y)); y[3] = bfhi(w[1]) * w0.w * siluf_(bfhi(zv.y));
            y[4] = bflo(w[2]) * w1.x * siluf_(bflo(zv.z)); y[5] = bfhi(w[2]) * w1.y * siluf_(bfhi(zv.z)); y[6] = bflo(w[3]) * w1.z * siluf_(bflo(zv.w)); y[7] = bfhi(w[3]) * w1.w * siluf_(bfhi(zv.w));
            *(GAS bf16x8*)(MXh + (size_t)(row0h + cc * 64 + rr) * DM + 8 * half) = pack8(y); }
#else
            *(GAS v4u*)(MXh + (size_t)(row0h + cc * 64 + rr) * DM + 8 * half) = (v4u){w[0], w[1], w[2], w[3]}; }
#endif
        for (int i = tid; i < 32 * 64; i += NTHR) { const int rr = i & 63, cc = i >> 6; const int mi = rr >> 4, fq2 = (rr >> 2) & 3, r = rr & 3;
            SSQ[(size_t)(row0h + cc * 64 + rr) * 32 + h * 8 + slab] = *(const LAS float*)(L + CH_S + ((cc * 4 + mi) * 4 + fq2) * 16 + r * 4); }
        float* So = F.out + O_PGS + (size_t)((l * 8 + b) * 4 + h) * 16384;
#pragma unroll
        for (int r = 0; r < 4; ++r) So[(size_t)(16 * wv + 4 * fq + r) * 128 + 16 * slab + fr] = S[r];
    }
    __syncthreads();
}

__device__ __forceinline__ void gdn_finalize(Frame& F, int l) {
    bf16* MX = (bf16*)(F.ws + WS_X); const bf16* P = (const bf16*)(F.ws + WS_P); const float* SSQ = (const float*)(F.ws + WS_SSQ);
    const int nth = F.G * NTHR;
    for (int it = F.wg * NTHR + F.tid; it < MP * 64; it += nth) {
        const int row = it >> 6, hh = (it >> 4) & 3, ck = it & 15;
        const f32x4 s0 = *(const GAS f32x4*)(SSQ + (size_t)row * 32 + hh * 8), s1 = *(const GAS f32x4*)(SSQ + (size_t)row * 32 + hh * 8 + 4);
        const float rs = frsq(((s0.x + s0.y) + (s0.z + s0.w) + (s1.x + s1.y) + (s1.z + s1.w)) * (1.f / HD) + EPS);
        const v4u ov = *(const GAS v4u*)(MX + (size_t)row * DM + 512 + hh * HD + ck * 8), zv = *(const GAS v4u*)(P + (size_t)row * NPJ + PZ + hh * HD + ck * 8);
        const f32x4 w0 = *(const GAS f32x4*)(F.in[I_GNW] + l * HD + ck * 8), w1 = *(const GAS f32x4*)(F.in[I_GNW] + l * HD + ck * 8 + 4);
        float y[8];
        y[0] = bflo(ov.x) * rs * w0.x * siluf_(bflo(zv.x)); y[1] = bfhi(ov.x) * rs * w0.y * siluf_(bfhi(zv.x)); y[2] = bflo(ov.y) * rs * w0.z * siluf_(bflo(zv.y)); y[3] = bfhi(ov.y) * rs * w0.w * siluf_(bfhi(zv.y));
        y[4] = bflo(ov.z) * rs * w1.x * siluf_(bflo(zv.z)); y[5] = bfhi(ov.z) * rs * w1.y * siluf_(bfhi(zv.z)); y[6] = bflo(ov.w) * rs * w1.z * siluf_(bflo(zv.w)); y[7] = bfhi(ov.w) * rs * w1.w * siluf_(bfhi(zv.w));
        *(GAS bf16x8*)(MX + (size_t)row * DM + 512 + hh * HD + ck * 8) = pack8(y);
    }
}


__device__ __forceinline__ void gdn_sample_load(Frame& F, int l, int task, float (&S)[32]) {
    const int b = task >> 2, h = task & 3, j = F.tid & 127, rq = F.tid >> 7;
    const float* S0 = F.in[I_GS] + (size_t)((l * 128 + b) * 4 + h) * 16384 + (size_t)(32 * rq) * 128 + j;
#pragma unroll
    for (int ii = 0; ii < 32; ++ii) S[ii] = S0[ii * 128];
}
__device__ __forceinline__ void gdn_sample(Frame& F, int l, int task, float (&S)[32]) {
    LAS float* L = (LAS float*)F.lds;
    LAS float* RAW = L;
    LAS float* QS = L + 7 * 384;
    LAS float* KS = QS + 512; LAS float* VS = KS + 512; LAS float* OS = VS + 512;
    LAS float* RED = OS + 512;
    LAS float* NRM = RED + 512;
    int tid = F.tid; asm volatile("" : "+v"(tid)); const int lane = tid & 63, wv = tid >> 6;
    const int b = task >> 2, h = task & 3; const int m0 = MP + b * 4;
    const bf16* P = (const bf16*)(F.ws + WS_P); const float* AB = (const float*)(F.ws + WS_AB); bf16* MX = (bf16*)(F.ws + WS_X);
    const int j = tid & 127, rq = tid >> 7;
    float cwv[3][4], gA[4], gB[4]; float zv, gnw;
    const float galog = F.in[I_GALOG][l * 4 + h], dtb = F.in[I_GDTB][l * 4 + h];
    {
        const int tok = tid >> 7, ch = tid & 127;
#pragma unroll
        for (int ten = 0; ten < 3; ++ten)
#pragma unroll
            for (int jj = 0; jj < 4; ++jj) cwv[ten][jj] = F.in[I_GCW][(size_t)(l * 4 + jj) * 1536 + ten * 512 + h * HD + ch];
#pragma unroll
        for (int t = 0; t < 4; ++t) { gA[t] = AB[(size_t)(m0 + t) * 8 + h]; gB[t] = AB[(size_t)(m0 + t) * 8 + 4 + h]; }
        zv = bf2f(P[(size_t)(m0 + tok) * NPJ + PZ + h * HD + ch]); gnw = F.in[I_GNW][l * HD + ch];
    }
    {
        float rv[6];
#pragma unroll
        for (int k6 = 0; k6 < 6; ++k6) { const int idx = tid + k6 * NTHR; const int r = idx / 384, cc = idx % 384, ten = cc >> 7, ch = cc & 127;
            float v = 0.f;
            if (idx < 7 * 384) { if (r < 3) v = F.in[I_GC][(size_t)((l * 128 + b) * 3 + r) * 1536 + ten * 512 + h * HD + ch]; else v = bf2f(P[(size_t)(m0 + r - 3) * NPJ + PQ + ten * 512 + h * HD + ch]); }
            rv[k6] = v; }
#pragma unroll
        for (int k6 = 0; k6 < 6; ++k6) { const int idx = tid + k6 * NTHR; if (idx < 7 * 384) RAW[idx] = rv[k6]; }
    }
    __syncthreads();
    if (tid < 384) { const int ten = tid >> 7, ch = tid & 127;
#pragma unroll
        for (int j = 0; j < 3; ++j) F.out[O_SGC + (size_t)((l * 128 + b) * 3 + j) * 1536 + ten * 512 + h * HD + ch] = RAW[(4 + j) * 384 + tid]; }
    float cq, ck, cv;
    {
        const int tok = tid >> 7, ch = tid & 127; float r3[3];
#pragma unroll
        for (int ten = 0; ten < 3; ++ten) { float a = 0.f;
#pragma unroll
            for (int j = 0; j < 4; ++j) a += cwv[ten][j] * RAW[(tok + j) * 384 + ten * 128 + ch];
            r3[ten] = siluf_(a); }
        cq = r3[0]; ck = r3[1]; cv = r3[2];
        const float sq = wave_sum(cq * cq), sk = wave_sum(ck * ck);
        if (lane == 0) { NRM[wv * 4] = sq; NRM[wv * 4 + 1] = sk; }
    }
    __syncthreads();
    {
        const int tok = tid >> 7, ch = tid & 127;
        const float sq = NRM[(2 * tok) * 4] + NRM[(2 * tok + 1) * 4], sk = NRM[(2 * tok) * 4 + 1] + NRM[(2 * tok + 1) * 4 + 1];
        QS[tok * 128 + ch] = cq * frsq(sq + EPS) * 0.08838834764831845f; KS[tok * 128 + ch] = ck * frsq(sk + EPS); VS[tok * 128 + ch] = cv;
    }
    __syncthreads();
    float egv[4], bev[4];
    {
        const float al = -__expf(galog);
#pragma unroll
        for (int t = 0; t < 4; ++t) { const float a = gA[t], bb = gB[t]; egv[t] = __expf(al * softplus_fast(a + dtb)); bev[t] = frcp(1.0f + __expf(-bb)); }
    }
#pragma unroll
    for (int t = 0; t < 4; ++t) {
        const float eg = egv[t], be = bev[t];
        float part = 0.f;
#pragma unroll
        for (int ii = 0; ii < 32; ++ii) { S[ii] *= eg; part += S[ii] * KS[t * 128 + 32 * rq + ii]; }
        RED[rq * 128 + j] = part;
        __syncthreads();
        const float vn = be * (VS[t * 128 + j] - (RED[j] + RED[128 + j] + RED[256 + j] + RED[384 + j]));
        __syncthreads();
        part = 0.f;
#pragma unroll
        for (int ii = 0; ii < 32; ++ii) { S[ii] += KS[t * 128 + 32 * rq + ii] * vn; part += S[ii] * QS[t * 128 + 32 * rq + ii]; }
        RED[rq * 128 + j] = part;
        __syncthreads();
        if (rq == 0) OS[t * 128 + j] = RED[j] + RED[128 + j] + RED[256 + j] + RED[384 + j];
        __syncthreads();
    }
    float* So = F.out + O_SGS + (size_t)((l * 128 + b) * 4 + h) * 16384;
#pragma unroll
    for (int ii = 0; ii < 32; ++ii) So[(size_t)(32 * rq + ii) * 128 + j] = S[ii];
    {
        const int tok = tid >> 7, ch = tid & 127; const float o = OS[tok * 128 + ch];
        const float ss = wave_sum(o * o);
        if (lane == 0) NRM[wv * 4 + 2] = ss;
        __syncthreads();
        const float tot = NRM[(2 * tok) * 4 + 2] + NRM[(2 * tok + 1) * 4 + 2];
        MX[(size_t)(m0 + tok) * DM + 512 + h * HD + ch] = (bf16)f2bf(o * (frsq(tot * (1.f / HD) + EPS)) * gnw * siluf_(zv));
    }
    __syncthreads();
}

struct S5Par { float ar, ai; float bbr[16], bbi[16]; };
__device__ __forceinline__ void s5_params(Frame& F, int l, int g, int p, S5Par& q) {
    const float lr = fminf(F.in[I_LRE][(l * 16 + g) * 64 + p], -1e-4f), li = F.in[I_LIM][(l * 16 + g) * 64 + p];
    const float dt = expf(F.in[I_LDT][l * 16 + g]);
    const float mag = __expf(lr * dt), ph = li * dt; q.ar = mag * __cosf(ph); q.ai = mag * __sinf(ph);
    const float den = lr * lr + li * li;
    const float fr = ((q.ar - 1.0f) * lr + q.ai * li) / den, fi = (q.ai * lr - (q.ar - 1.0f) * li) / den;
    const float* br = F.in[I_BRE] + (size_t)((l * 16 + g) * 64 + p) * 16; const float* bi = F.in[I_BIM] + (size_t)((l * 16 + g) * 64 + p) * 16;
#pragma unroll
    for (int h4 = 0; h4 < 4; ++h4) { const f32x4 r = *(const GAS f32x4*)(br + 4 * h4), i = *(const GAS f32x4*)(bi + 4 * h4);
#pragma unroll
        for (int e = 0; e < 4; ++e) { q.bbr[4 * h4 + e] = fr * r[e] - fi * i[e]; q.bbi[4 * h4 + e] = fr * i[e] + fi * r[e]; } }
}
__device__ __forceinline__ void s5_stage_u(Frame& F, LAS float* U, int m0, int nrows) {
    const bf16* P = (const bf16*)(F.ws + WS_P);
    for (int idx = F.tid; idx < nrows * 32; idx += NTHR) { const int r = idx >> 5, ck = idx & 31;
        const v4u w = *(const GAS v4u*)(P + (size_t)(m0 + r) * NPJ + PU + ck * 8);
        *(LAS f32x4*)(U + r * 256 + ck * 8) = (f32x4){bflo(w.x), bfhi(w.x), bflo(w.y), bfhi(w.y)}; *(LAS f32x4*)(U + r * 256 + ck * 8 + 4) = (f32x4){bflo(w.z), bfhi(w.z), bflo(w.w), bfhi(w.w)}; }
}
__device__ __forceinline__ void s5_step(const S5Par& q, const LAS float* urow, float& xr, float& xi) {
    const f32x4 u0 = *(const LAS f32x4*)urow, u1 = *(const LAS f32x4*)(urow + 4), u2 = *(const LAS f32x4*)(urow + 8), u3 = *(const LAS f32x4*)(urow + 12);
    float br = 0.f, bi = 0.f;
#pragma unroll
    for (int e = 0; e < 4; ++e) { br += q.bbr[e] * u0[e]; bi += q.bbi[e] * u0[e]; br += q.bbr[4 + e] * u1[e]; bi += q.bbi[4 + e] * u1[e]; br += q.bbr[8 + e] * u2[e]; bi += q.bbi[8 + e] * u2[e]; br += q.bbr[12 + e] * u3[e]; bi += q.bbi[12 + e] * u3[e]; }
    const float nr = q.ar * xr - q.ai * xi + br, ni = q.ar * xi + q.ai * xr + bi; xr = nr; xi = ni;
}
__device__ __forceinline__ void s5_pass1(Frame& F, int l, int b, int c) {
    LAS float* U = (LAS float*)F.lds;
    int tid = F.tid; asm volatile("" : "+v"(tid)); const int lane = tid & 63, g0 = 2 * (tid >> 6);
    S5Par q0, q1; s5_params(F, l, g0, lane, q0); s5_params(F, l, g0 + 1, lane, q1);
    s5_stage_u(F, U, b * SEQ + c * 64, 64);
    __syncthreads();
    float* E = (float*)(F.ws + WS_S5E);
    float xr0 = 0.f, xi0 = 0.f, xr1 = 0.f, xi1 = 0.f;
#pragma unroll 4
    for (int t = 0; t < 64; ++t) { s5_step(q0, U + t * 256 + 16 * g0, xr0, xi0); s5_step(q1, U + t * 256 + 16 * g0 + 16, xr1, xi1); }
    E[(size_t)((b * 32 + c) * 16 + g0) * 128 + lane] = xr0; E[(size_t)((b * 32 + c) * 16 + g0) * 128 + 64 + lane] = xi0;
    E[(size_t)((b * 32 + c) * 16 + g0 + 1) * 128 + lane] = xr1; E[(size_t)((b * 32 + c) * 16 + g0 + 1) * 128 + 64 + lane] = xi1;
    __syncthreads();
}
constexpr int S5_U = 0, S5_XT = 65536, S5_YG = S5_XT + 8 * 16 * S256;
static_assert(S5_YG + 64 * S512 <= LDSCTL_OFF, "s5 lds");
template <bool SAMPLE>
__device__ __forceinline__ void s5_pass2(Frame& F, int l, int ua, int ub) {
    LAS unsigned char* L = F.lds; LAS float* U = (LAS float*)(L + S5_U); LAS unsigned char* XT = L + S5_XT + (F.tid >> 6) * (16 * S256); LAS unsigned char* YG = L + S5_YG;
    int tid = F.tid; asm volatile("" : "+v"(tid)); const int lane = tid & 63, wv = tid >> 6, fr = lane & 15, fq = lane >> 4;
    constexpr int NSUB = SAMPLE ? 1 : 4;
    const int m0 = SAMPLE ? MP + 4 * ua : ua * SEQ + ub * 64;
    constexpr int NTT = SAMPLE ? 4 : 16;
    S5Par qq[2]; bf16x8 cbb[2][4]; float dskk[2];
#pragma unroll
    for (int gi = 0; gi < 2; ++gi) {
        const int g = 2 * wv + gi; s5_params(F, l, g, lane, qq[gi]);
        bf16x8 (&cb)[4] = cbb[gi];
#pragma unroll
        for (int ks = 0; ks < 4; ++ks) { const float* src = F.in[ks < 2 ? I_CRE : I_CIM] + (size_t)((l * 16 + g) * 16 + fr) * 64 + 32 * (ks & 1) + 8 * fq;
            const f32x4 c0 = *(const GAS f32x4*)src, c1 = *(const GAS f32x4*)(src + 4); const float sg = ks < 2 ? 1.f : -1.f;
            float f[8] = {sg * c0.x, sg * c0.y, sg * c0.z, sg * c0.w, sg * c1.x, sg * c1.y, sg * c1.z, sg * c1.w}; cb[ks] = pack8(f); }
        dskk[gi] = F.in[I_S5D][l * 256 + 16 * g + fr];
    }
    s5_stage_u(F, U, m0, SAMPLE ? 4 : 64);
    __syncthreads();
    const float* E = (const float*)(F.ws + WS_S5E);
#pragma unroll
    for (int gi = 0; gi < 2; ++gi) {
        const int g = 2 * wv + gi; const S5Par& q = qq[gi]; const bf16x8 (&cb)[4] = cbb[gi];
        const float dsk = dskk[gi];
        float xr = 0.f, xi = 0.f;
        if (!SAMPLE) {
            float pr = q.ar, pi = q.ai;
#pragma unroll
            for (int s = 0; s < 6; ++s) { const float nr = pr * pr - pi * pi, ni = 2.f * pr * pi; pr = nr; pi = ni; }
            float er[31], ei[31];
            const float* Eb = E + (size_t)((ua * 32) * 16 + g) * 128 + lane; asm volatile("" : "+v"(Eb));
#pragma unroll
            for (int cc = 0; cc < 31; ++cc) { er[cc] = Eb[cc * 2048]; ei[cc] = Eb[cc * 2048 + 64]; }
#pragma unroll
            for (int cc = 0; cc < 31; ++cc) { const float nr = pr * xr - pi * xi + er[cc], ni = pr * xi + pi * xr + ei[cc]; xr = cc < ub ? nr : xr; xi = cc < ub ? ni : xi; }
        }
        for (int sub = 0; sub < NSUB; ++sub) {
#pragma unroll
            for (int tt = 0; tt < NTT; ++tt) {
                if (SAMPLE && (tt & 3) == 0) { const int bs = ua; xr = F.in[I_S5RE][(size_t)((l * 128 + bs) * 16 + g) * 64 + lane]; xi = F.in[I_S5IM][(size_t)((l * 128 + bs) * 16 + g) * 64 + lane]; }
                s5_step(q, U + (16 * sub + tt) * 256 + 16 * g, xr, xi);
                *(LAS bf16*)(XT + t256(tt, lane)) = (bf16)f2bf(xr); *(LAS bf16*)(XT + t256(tt, 64 + lane)) = (bf16)f2bf(xi);
                if (SAMPLE && (tt & 3) == 3) { const int bs = ua; F.out[O_SS5RE + (size_t)((l * 128 + bs) * 16 + g) * 64 + lane] = xr; F.out[O_SS5IM + (size_t)((l * 128 + bs) * 16 + g) * 64 + lane] = xi; }
            }
            f32x4 acc = (f32x4){0.f, 0.f, 0.f, 0.f};
#pragma unroll
            for (int ks = 0; ks < 4; ++ks) { const bf16x8 af = *(const LAS bf16x8*)(XT + t256(fr, 32 * ks + 8 * fq)); acc = MFMA16(af, cb[ks], acc); }
#pragma unroll
            for (int r = 0; r < 4; ++r) { const int t = 16 * sub + 4 * fq + r; if (SAMPLE && t >= 4) continue; const float y = acc[r] + dsk * U[t * 256 + 16 * g + fr];
                *(LAS bf16*)(YG + t512(t, 16 * g + fr)) = (bf16)f2bf(gelu_tanh(y)); }
            asm volatile("" ::: "memory");
        }
        if (!SAMPLE && ub == 31) { F.out[O_PS5RE + (size_t)((l * 8 + ua) * 16 + g) * 64 + lane] = xr; F.out[O_PS5IM + (size_t)((l * 8 + ua) * 16 + g) * 64 + lane] = xi; }
    }
    __syncthreads();
    {
        const bf16* WG = (const bf16*)(F.ws + WS_WGLU); bf16* MX = (bf16*)(F.ws + WS_X);
#pragma unroll 1
        for (int ni = 0; ni < 2; ++ni) {
            const int nt = 2 * wv + ni; bf16x8 bw[8];
#pragma unroll
            for (int ks = 0; ks < 8; ++ks) bw[ks] = __builtin_bit_cast(bf16x8, *(const GAS v4u*)(WG + (size_t)(16 * nt + fr) * 256 + 32 * ks + 8 * fq));
            const float bg = F.in[I_BGLU][l * 256 + 16 * nt + fr];
#pragma unroll 1
            for (int mi = 0; mi < NSUB; ++mi) {
                f32x4 acc = (f32x4){0.f, 0.f, 0.f, 0.f};
#pragma unroll
                for (int ks = 0; ks < 8; ++ks) { const bf16x8 af = *(const LAS bf16x8*)(YG + t512(16 * mi + fr, 32 * ks + 8 * fq)); acc = MFMA16(af, bw[ks], acc); }
#pragma unroll
                for (int r = 0; r < 4; ++r) { const int t = 16 * mi + 4 * fq + r; if (SAMPLE && t >= 4) continue; const float yg = bf2f(*(const LAS bf16*)(YG + t512(t, 16 * nt + fr)));
                    MX[(size_t)(m0 + t) * DM + 16 * nt + fr] = (bf16)f2bf(yg * sigmoidf_(acc[r] + bg)); }
            }
        }
    }
    __syncthreads();
}

constexpr int LR_RAW = 0, LR_XC = 73728, LR_AGG = 139264;
struct LruW { float wa[32], wx[32], ba, bx, c8, cb, cw[4]; };
__device__ __forceinline__ void lru_weights(Frame& F, int l, int j, LruW& w) {
    const int blk = j >> 5, jj = j & 31;
#pragma unroll
    for (int i = 0; i < 32; ++i) { w.wa[i] = F.in[I_LWA][(size_t)((l * 8 + blk) * 32 + i) * 32 + jj]; w.wx[i] = F.in[I_LWX][(size_t)((l * 8 + blk) * 32 + i) * 32 + jj]; }
    w.ba = F.in[I_LBA][l * 256 + j]; w.bx = F.in[I_LBX][l * 256 + j]; w.c8 = -8.0f * softplusf_(-F.in[I_LLAM][l * 256 + j]); w.cb = F.in[I_LCB][l * 256 + j];
#pragma unroll
    for (int k = 0; k < 4; ++k) w.cw[k] = F.in[I_LCW][(l * 4 + k) * 256 + j];
}
__device__ __forceinline__ void lru_gate(const LruW& w, const LAS float* xrow, float xown, bool reset, float& a, float& bt) {
    float ra = w.ba, rx = w.bx;
#pragma unroll
    for (int i4 = 0; i4 < 8; ++i4) { const f32x4 xv = *(const LAS f32x4*)(xrow + 4 * i4);
#pragma unroll
        for (int e = 0; e < 4; ++e) { ra += w.wa[4 * i4 + e] * xv[e]; rx += w.wx[4 * i4 + e] * xv[e]; } }
    const float r = sigmoidf_(ra), gi = sigmoidf_(rx);
    const float la = w.c8 * r; a = __expf(la);
    const float mult = reset ? 1.0f : __builtin_amdgcn_sqrtf(fmaxf(1.0f - a * a, 0.f));
    bt = mult * gi * xown;
}
template <int PASS>
__device__ __forceinline__ void lru_pass(Frame& F, int l, int b, int c) {
    LAS float* RAW = (LAS float*)(F.lds + LR_RAW); LAS float* XC = (LAS float*)(F.lds + LR_XC); LAS float* AGG = (LAS float*)(F.lds + LR_AGG);
    int tid = F.tid; asm volatile("" : "+v"(tid)); const int j = tid & 255, hh = tid >> 8; const int row0 = b * SEQ + c * 64;
    const bf16* P = (const bf16*)(F.ws + WS_P); bf16* MX = (bf16*)(F.ws + WS_X); float* LA = (float*)(F.ws + WS_LAGG);
    for (int idx = tid; idx < 67 * 32; idx += NTHR) { const int r = idx >> 5, ck = idx & 31, tt = c * 64 - 3 + r;
        v4u w = (v4u){0u, 0u, 0u, 0u}; if (tt >= 0) w = *(const GAS v4u*)(P + (size_t)(b * SEQ + tt) * NPJ + PXL + ck * 8);
        *(LAS f32x4*)(RAW + r * 256 + ck * 8) = (f32x4){bflo(w.x), bfhi(w.x), bflo(w.y), bfhi(w.y)}; *(LAS f32x4*)(RAW + r * 256 + ck * 8 + 4) = (f32x4){bflo(w.z), bfhi(w.z), bflo(w.w), bfhi(w.w)}; }
    __syncthreads();
    LruW w; lru_weights(F, l, j, w);
    for (int ii = 0; ii < 32; ++ii) { const int i = 32 * hh + ii;
        XC[i * 256 + j] = w.cb + w.cw[0] * RAW[i * 256 + j] + w.cw[1] * RAW[(i + 1) * 256 + j] + w.cw[2] * RAW[(i + 2) * 256 + j] + w.cw[3] * RAW[(i + 3) * 256 + j]; }
    __syncthreads();
    float A = 1.f, B = 0.f; float hl[32], ca[32];
#pragma unroll
    for (int ii = 0; ii < 32; ++ii) { const int i = 32 * hh + ii; float a, bt;
        lru_gate(w, XC + i * 256 + (j & ~31), XC[i * 256 + j], (c == 0 && i == 0), a, bt);
        B = a * B + bt; A *= a; if (PASS == 2) { hl[ii] = B; ca[ii] = A; }
        if (ii & 1) __builtin_amdgcn_sched_barrier(0); }
    if (hh == 0) { AGG[j] = A; AGG[256 + j] = B; }
    __syncthreads();
    if (PASS == 1) {
        if (hh == 1) { const float A0 = AGG[j], B0 = AGG[256 + j]; LA[(size_t)((b * 32 + c) * 2) * 256 + j] = A0 * A; LA[(size_t)((b * 32 + c) * 2 + 1) * 256 + j] = A * B0 + B; }
    } else {
        float H = 0.f;
        {
            float la[31], lb[31];
            const float* Lb = LA + (size_t)(b * 32 * 2) * 256 + j; asm volatile("" : "+v"(Lb));
#pragma unroll
            for (int cc = 0; cc < 31; ++cc) { la[cc] = Lb[cc * 512]; lb[cc] = Lb[cc * 512 + 256]; }
#pragma unroll
            for (int cc = 0; cc < 31; ++cc) { const float nh = la[cc] * H + lb[cc]; H = cc < c ? nh : H; }
        }
        if (hh == 1) H = AGG[j] * H + AGG[256 + j];
#pragma unroll
        for (int ii = 0; ii < 32; ++ii) { const int i = 32 * hh + ii; const float hv = hl[ii] + ca[ii] * H;
            const float gt = bf2f(P[(size_t)(row0 + i) * NPJ + PGL + j]);
            MX[(size_t)(row0 + i) * DM + 256 + j] = (bf16)f2bf(hv * gelu_tanh(gt));
            if (c == 31 && hh == 1 && ii == 31) F.out[O_PLRUH + (size_t)(l * 8 + b) * 256 + j] = hv; }
        if (c == 31 && hh == 0) {
#pragma unroll
            for (int k = 0; k < 3; ++k) F.out[O_PLRUC + (size_t)((l * 8 + b) * 3 + k) * 256 + j] = RAW[(64 + k) * 256 + j]; }
    }
    __syncthreads();
}
__device__ __forceinline__ void lru_sample(Frame& F, int l, int q) {
    LAS float* XC = (LAS float*)F.lds;
    int tid = F.tid; asm volatile("" : "+v"(tid)); const int j = tid & 255, hh = tid >> 8;
    const bf16* P = (const bf16*)(F.ws + WS_P); bf16* MX = (bf16*)(F.ws + WS_X);
    LruW w; const int bs = q;
    if (hh == 0) {
        lru_weights(F, l, j, w);
        float r[7];
#pragma unroll
        for (int k = 0; k < 3; ++k) r[k] = F.in[I_LRUC][(size_t)((l * 128 + bs) * 3 + k) * 256 + j];
#pragma unroll
        for (int t = 0; t < 4; ++t) r[3 + t] = bf2f(P[(size_t)(MP + bs * 4 + t) * NPJ + PXL + j]);
#pragma unroll
        for (int t = 0; t < 4; ++t) XC[t * 256 + j] = w.cb + w.cw[0] * r[t] + w.cw[1] * r[t + 1] + w.cw[2] * r[t + 2] + w.cw[3] * r[t + 3];
#pragma unroll
        for (int k = 0; k < 3; ++k) F.out[O_SLRUC + (size_t)((l * 128 + bs) * 3 + k) * 256 + j] = r[4 + k];
    }
    float H = 0.f, gtv[4] = {0.f, 0.f, 0.f, 0.f};
    if (hh == 0) {
        H = F.in[I_LRUH][(size_t)(l * 128 + bs) * 256 + j];
#pragma unroll
        for (int t = 0; t < 4; ++t) gtv[t] = bf2f(P[(size_t)(MP + bs * 4 + t) * NPJ + PGL + j]);
    }
    __syncthreads();
    if (hh == 0) {
#pragma unroll
        for (int t = 0; t < 4; ++t) { float a, bt;
            lru_gate(w, XC + t * 256 + (j & ~31), XC[t * 256 + j], false, a, bt); H = a * H + bt;
            const float gt = gtv[t];
            MX[(size_t)(MP + bs * 4 + t) * DM + 256 + j] = (bf16)f2bf(H * gelu_tanh(gt)); }
        F.out[O_SLRUH + (size_t)(l * 128 + bs) * 256 + j] = H;
    }
    __syncthreads();
}

constexpr int S5M_U = 0, S5M_XT = 64 * S512, S5M_YG = S5M_XT + 8 * 16 * S256;
static_assert(S5M_YG + 64 * S512 <= LDSCTL_OFF, "s5m lds");
__device__ __forceinline__ void cmul_acc(float ar, float ai, float br, float bi, float& cr, float& ci) { cr += ar * br - ai * bi; ci += ar * bi + ai * br; }
struct S5Stage { v4u su[4]; };
__device__ __forceinline__ void s5m_stage_load(Frame& F, int m0, S5Stage& st) {
    const bf16* P = (const bf16*)(F.ws + WS_P);
#pragma unroll
    for (int k = 0; k < 4; ++k) { const int idx = F.tid + k * NTHR; const int r = idx >> 5, ck = idx & 31; st.su[k] = *(const GAS v4u*)(P + (size_t)(m0 + r) * NPJ + PU + ck * 8); }
}
struct NoHook { __device__ __forceinline__ void operator()() const {} };
template <int MODE, bool PRE = false, class Hook = NoHook>
__device__ __forceinline__ void s5m_unit(Frame& F, int l, int ua, int ub, const S5Stage* pre = nullptr, const Hook& hook = Hook()) {
    LAS unsigned char* L = F.lds;
    int tid = F.tid; asm volatile("" : "+v"(tid)); const int lane = tid & 63, wv = tid >> 6, fr = lane & 15, fq = lane >> 4;
    LAS unsigned char* U16 = L + S5M_U; LAS unsigned char* XT = L + S5M_XT + wv * (16 * S256); LAS float* SCR = (LAS float*)XT; LAS unsigned char* YG = L + S5M_YG;
    constexpr bool SAMPLE = MODE == 3; constexpr int NSUB = SAMPLE ? 1 : 4;
    const int m0 = SAMPLE ? MP + 4 * ua : ua * SEQ + ub * 64;
    { const bf16* P = (const bf16*)(F.ws + WS_P); constexpr int nrows = SAMPLE ? 4 : 64; constexpr int NK = (nrows * 32 + NTHR - 1) / NTHR;
      v4u su[NK];
#pragma unroll
      for (int k = 0; k < NK; ++k) { const int idx = tid + k * NTHR; const int r = idx >> 5, ck = idx & 31; if (PRE) su[k] = pre->su[k]; else if (idx < nrows * 32) su[k] = *(const GAS v4u*)(P + (size_t)(m0 + r) * NPJ + PU + ck * 8); }
#pragma unroll
      for (int k = 0; k < NK; ++k) { const int idx = tid + k * NTHR; const int r = idx >> 5, ck = idx & 31; if (idx < nrows * 32) *(LAS v4u*)(U16 + r * S512 + ck * 16) = su[k]; } }
    __syncthreads();
    float* Eo = (float*)(F.ws + WS_S5E);
#pragma unroll 1
    for (int gi = 0; gi < 2; ++gi) {
        const int g = 2 * wv + gi;
        S5Par q; s5_params(F, l, g, lane, q);
        bf16x8 bfrag[8];
#pragma unroll
        for (int part = 0; part < 2; ++part) {
#pragma unroll
            for (int h4 = 0; h4 < 4; ++h4) *(LAS f32x4*)(SCR + lane * 16 + 4 * h4) = part == 0 ? (f32x4){q.bbr[4 * h4], q.bbr[4 * h4 + 1], q.bbr[4 * h4 + 2], q.bbr[4 * h4 + 3]} : (f32x4){q.bbi[4 * h4], q.bbi[4 * h4 + 1], q.bbi[4 * h4 + 2], q.bbi[4 * h4 + 3]};
#pragma unroll
            for (int nt = 0; nt < 4; ++nt) { const LAS float* src = SCR + (16 * nt + fr) * 16 + 8 * (fq & 1);
                const f32x4 v0 = *(const LAS f32x4*)src, v1 = *(const LAS f32x4*)(src + 4); float f[8] = {v0.x, v0.y, v0.z, v0.w, v1.x, v1.y, v1.z, v1.w};
                if (fq >= 2) {
#pragma unroll
                    for (int e = 0; e < 8; ++e) f[e] = f[e] - bf2f(f2bf(f[e]));
                }
                bfrag[4 * part + nt] = pack8(f); }
        }
        float l1r[4], l1i[4], xinr[4], xini[4];
        *(LAS f32x2_t*)(SCR + lane * 2) = (f32x2_t){q.ar, q.ai};
        if (MODE == 2) {
            float pr = q.ar, pi = q.ai;
#pragma unroll
            for (int s = 0; s < 6; ++s) { const float nr = pr * pr - pi * pi, ni = 2.f * pr * pi; pr = nr; pi = ni; }
            float er[31], ei[31];
            const float* Eb = Eo + (size_t)((ua * 32) * 16 + g) * 128 + lane; asm volatile("" : "+v"(Eb));
#pragma unroll
            for (int cc = 0; cc < 31; ++cc) { er[cc] = Eb[cc * 2048]; ei[cc] = Eb[cc * 2048 + 64]; }
            float xr = 0.f, xi = 0.f;
#pragma unroll
            for (int cc = 0; cc < 31; ++cc) { const float nr = pr * xr - pi * xi + er[cc], ni = pr * xi + pi * xr + ei[cc]; xr = cc < ub ? nr : xr; xi = cc < ub ? ni : xi; }
            *(LAS f32x2_t*)(SCR + 128 + lane * 2) = (f32x2_t){xr, xi};
        }
#pragma unroll
        for (int s = 0; s < 4; ++s) { const f32x2_t lv = *(const LAS f32x2_t*)(SCR + (16 * s + fr) * 2); l1r[s] = lv.x; l1i[s] = lv.y;
            if (MODE == 2) { const f32x2_t xv = *(const LAS f32x2_t*)(SCR + 128 + (16 * s + fr) * 2); xinr[s] = xv.x; xini[s] = xv.y; }
            else if (MODE == 3) { xinr[s] = F.in[I_S5RE][(size_t)((l * 128 + ua) * 16 + g) * 64 + 16 * s + fr]; xini[s] = F.in[I_S5IM][(size_t)((l * 128 + ua) * 16 + g) * 64 + 16 * s + fr]; }
            else { xinr[s] = 0.f; xini[s] = 0.f; } }
        float l2r[4], l2i[4], l3r[4], l3i[4], l4r[4], l4i[4], l8r[4], l8i[4], lpr[4], lpi[4];
#pragma unroll
        for (int s = 0; s < 4; ++s) {
            l2r[s] = l1r[s] * l1r[s] - l1i[s] * l1i[s]; l2i[s] = 2.f * l1r[s] * l1i[s];
            l3r[s] = l2r[s] * l1r[s] - l2i[s] * l1i[s]; l3i[s] = l2r[s] * l1i[s] + l2i[s] * l1r[s];
            l4r[s] = l2r[s] * l2r[s] - l2i[s] * l2i[s]; l4i[s] = 2.f * l2r[s] * l2i[s];
            l8r[s] = l4r[s] * l4r[s] - l4i[s] * l4i[s]; l8i[s] = 2.f * l4r[s] * l4i[s];
            const float l12r = l8r[s] * l4r[s] - l8i[s] * l4i[s], l12i = l8r[s] * l4i[s] + l8i[s] * l4r[s];
            lpr[s] = fq == 0 ? 1.f : fq == 1 ? l4r[s] : fq == 2 ? l8r[s] : l12r; lpi[s] = fq == 0 ? 0.f : fq == 1 ? l4i[s] : fq == 2 ? l8i[s] : l12i;
        }
        bf16x8 cb[4]; float dsk = 0.f;
        if (MODE != 1) {
#pragma unroll
            for (int ks = 0; ks < 4; ++ks) { const float* src = F.in[ks < 2 ? I_CRE : I_CIM] + (size_t)((l * 16 + g) * 16 + fr) * 64 + 32 * (ks & 1) + 8 * fq;
                const f32x4 c0 = *(const GAS f32x4*)src, c1 = *(const GAS f32x4*)(src + 4); const float sg = ks < 2 ? 1.f : -1.f;
                float f[8] = {sg * c0.x, sg * c0.y, sg * c0.z, sg * c0.w, sg * c1.x, sg * c1.y, sg * c1.z, sg * c1.w}; cb[ks] = pack8(f); }
            dsk = F.in[I_S5D][l * 256 + 16 * g + fr];
        }
#pragma unroll 1
        for (int sub = 0; sub < NSUB; ++sub) {
            const bf16x8 au = *(const LAS bf16x8*)(U16 + (16 * sub + fr) * S512 + (16 * g + 8 * (fq & 1)) * 2);
            f32x4 d[8];
#pragma unroll
            for (int nt = 0; nt < 8; ++nt) d[nt] = MFMA16(au, bfrag[nt], ((f32x4){0.f, 0.f, 0.f, 0.f}));
            float Lr[4][4], Li[4][4], Er[4], Ei[4];
#pragma unroll
            for (int s = 0; s < 4; ++s) {
                Lr[s][0] = d[s][0]; Li[s][0] = d[4 + s][0];
#pragma unroll
                for (int r = 1; r < 4; ++r) { Lr[s][r] = d[s][r]; Li[s][r] = d[4 + s][r]; cmul_acc(l1r[s], l1i[s], Lr[s][r - 1], Li[s][r - 1], Lr[s][r], Li[s][r]); }
                Er[s] = Lr[s][3]; Ei[s] = Li[s][3];
            }
            {
                float pr_[4], pi_[4];
#pragma unroll
                for (int s = 0; s < 4; ++s) { pr_[s] = __shfl_up(Er[s], 16); pi_[s] = __shfl_up(Ei[s], 16); }
#pragma unroll
                for (int s = 0; s < 4; ++s) { float ar_ = 0.f, ai_ = 0.f; cmul_acc(l4r[s], l4i[s], pr_[s], pi_[s], ar_, ai_); if (fq >= 1) { Er[s] += ar_; Ei[s] += ai_; } }
#pragma unroll
                for (int s = 0; s < 4; ++s) { pr_[s] = __shfl_up(Er[s], 32); pi_[s] = __shfl_up(Ei[s], 32); }
#pragma unroll
                for (int s = 0; s < 4; ++s) { float ar_ = 0.f, ai_ = 0.f; cmul_acc(l8r[s], l8i[s], pr_[s], pi_[s], ar_, ai_); if (fq >= 2) { Er[s] += ar_; Ei[s] += ai_; } }
#pragma unroll
                for (int s = 0; s < 4; ++s) { pr_[s] = __shfl_up(Er[s], 16); pi_[s] = __shfl_up(Ei[s], 16); }
#pragma unroll
                for (int s = 0; s < 4; ++s) { float xr = fq >= 1 ? pr_[s] : 0.f, xi = fq >= 1 ? pi_[s] : 0.f; cmul_acc(lpr[s], lpi[s], xinr[s], xini[s], xr, xi); Er[s] = xr; Ei[s] = xi; }
            }
#pragma unroll
            for (int s = 0; s < 4; ++s) {
                cmul_acc(l1r[s], l1i[s], Er[s], Ei[s], Lr[s][0], Li[s][0]); cmul_acc(l2r[s], l2i[s], Er[s], Ei[s], Lr[s][1], Li[s][1]);
                cmul_acc(l3r[s], l3i[s], Er[s], Ei[s], Lr[s][2], Li[s][2]); cmul_acc(l4r[s], l4i[s], Er[s], Ei[s], Lr[s][3], Li[s][3]);
            }
#pragma unroll
            for (int s = 0; s < 4; ++s) { xinr[s] = __shfl(Lr[s][3], fr + (SAMPLE ? 0 : 48)); xini[s] = __shfl(Li[s][3], fr + (SAMPLE ? 0 : 48)); }
            if (MODE != 1) {
#pragma unroll
                for (int s = 0; s < 4; ++s)
#pragma unroll
                    for (int r = 0; r < 4; ++r) { *(LAS bf16*)(XT + t256(4 * fq + r, 16 * s + fr)) = (bf16)f2bf(Lr[s][r]); *(LAS bf16*)(XT + t256(4 * fq + r, 64 + 16 * s + fr)) = (bf16)f2bf(Li[s][r]); }
                f32x4 acc = (f32x4){0.f, 0.f, 0.f, 0.f};
#pragma unroll
                for (int ks = 0; ks < 4; ++ks) { const bf16x8 af = *(const LAS bf16x8*)(XT + t256(fr, 32 * ks + 8 * fq)); acc = MFMA16(af, cb[ks], acc); }
#pragma unroll
                for (int r = 0; r < 4; ++r) { const int t = 16 * sub + 4 * fq + r; if (SAMPLE && t >= 4) continue;
                    const float y = acc[r] + dsk * bf2f(*(const LAS bf16*)(U16 + t * S512 + (16 * g + fr) * 2));
                    *(LAS bf16*)(YG + t512(t, 16 * g + fr)) = (bf16)f2bf(gelu_tanh(y)); }
                asm volatile("" ::: "memory");
            }
        }
        if (MODE == 1 && gi == 0) hook();
        if (fq == 0) {
#pragma unroll
            for (int s = 0; s < 4; ++s) { const int p = 16 * s + fr;
                if (MODE == 1) { Eo[(size_t)((ua * 32 + ub) * 16 + g) * 128 + p] = xinr[s]; Eo[(size_t)((ua * 32 + ub) * 16 + g) * 128 + 64 + p] = xini[s]; }
                if (MODE == 2 && ub == 31) { F.out[O_PS5RE + (size_t)((l * 8 + ua) * 16 + g) * 64 + p] = xinr[s]; F.out[O_PS5IM + (size_t)((l * 8 + ua) * 16 + g) * 64 + p] = xini[s]; }
                if (MODE == 3) { F.out[O_SS5RE + (size_t)((l * 128 + ua) * 16 + g) * 64 + p] = xinr[s]; F.out[O_SS5IM + (size_t)((l * 128 + ua) * 16 + g) * 64 + p] = xini[s]; } }
        }
    }
    if (MODE != 1) hook();
    bf16x8 bwA[8], bwB[8]; float bgA = 0.f, bgB = 0.f;
    if (MODE != 1) {
        const bf16* WG = (const bf16*)(F.ws + WS_WGLU);
#pragma unroll
        for (int ks = 0; ks < 8; ++ks) { bwA[ks] = __builtin_bit_cast(bf16x8, *(const GAS v4u*)(WG + (size_t)(16 * (2 * wv) + fr) * 256 + 32 * ks + 8 * fq)); bwB[ks] = __builtin_bit_cast(bf16x8, *(const GAS v4u*)(WG + (size_t)(16 * (2 * wv + 1) + fr) * 256 + 32 * ks + 8 * fq)); }
        bgA = F.in[I_BGLU][l * 256 + 16 * (2 * wv) + fr]; bgB = F.in[I_BGLU][l * 256 + 16 * (2 * wv + 1) + fr];
    }
    __syncthreads();
    if (MODE != 1) {
        bf16* MX = (bf16*)(F.ws + WS_X);
        auto glu_block = [&](const bf16x8 (&bw)[8], const float bg, const int nt) {
#pragma unroll 1
            for (int mi = 0; mi < NSUB; ++mi) {
                f32x4 acc = (f32x4){0.f, 0.f, 0.f, 0.f};
#pragma unroll
                for (int ks = 0; ks < 8; ++ks) { const bf16x8 af = *(const LAS bf16x8*)(YG + t512(16 * mi + fr, 32 * ks + 8 * fq)); acc = MFMA16(af, bw[ks], acc); }
#pragma unroll
                for (int r = 0; r < 4; ++r) { const int t = 16 * mi + 4 * fq + r; if (SAMPLE && t >= 4) continue; const float yg = bf2f(*(const LAS bf16*)(YG + t512(t, 16 * nt + fr)));
                    MX[(size_t)(m0 + t) * DM + 16 * nt + fr] = (bf16)f2bf(yg * sigmoidf_(acc[r] + bg)); }
            }
        };
        glu_block(bwA, bgA, 2 * wv); glu_block(bwB, bgB, 2 * wv + 1);
        __syncthreads();
    }
}


constexpr int LM_RAW = 0, LM_XCB = 69632, LM_GT = LM_XCB + 64 * S512;
static_assert(LM_GT + 64 * S512 <= LDSCTL_OFF && 67 * 1024 <= LM_XCB, "lru mfma lds");
struct LruStage { v4u sw[5], sg[4]; };
template <int PASS>
__device__ __forceinline__ void lrum_stage_load(Frame& F, int b, int c, LruStage& st) {
    const bf16* P = (const bf16*)(F.ws + WS_P); const int row0 = b * SEQ + c * 64;
#pragma unroll
    for (int k5 = 0; k5 < 5; ++k5) { const int idx = F.tid + k5 * NTHR; const int r = idx >> 5, ck = idx & 31, tt = c * 64 - 3 + r;
        st.sw[k5] = (v4u){0u, 0u, 0u, 0u}; if (idx < 67 * 32 && tt >= 0) st.sw[k5] = *(const GAS v4u*)(P + (size_t)(b * SEQ + tt) * NPJ + PXL + ck * 8); }
    if (PASS == 2) {
#pragma unroll
        for (int k4 = 0; k4 < 4; ++k4) { const int idx = F.tid + k4 * NTHR; const int r = idx >> 5, ck = idx & 31; st.sg[k4] = *(const GAS v4u*)(P + (size_t)(row0 + r) * NPJ + PGL + ck * 8); }
    }
}
template <int PASS, bool PRE = false>
__device__ __forceinline__ void lrum_pass(Frame& F, int l, int b, int c, const LruStage* pre = nullptr) {
    LAS float* RAW = (LAS float*)(F.lds + LM_RAW); LAS unsigned char* XCB = F.lds + LM_XCB;
    int tid = F.tid; asm volatile("" : "+v"(tid)); const int lane = tid & 63, wv = tid >> 6, fr = lane & 15, fq = lane >> 4;
    const int row0 = b * SEQ + c * 64;
    const bf16* P = (const bf16*)(F.ws + WS_P); bf16* MX = (bf16*)(F.ws + WS_X); float* LA = (float*)(F.ws + WS_LAGG);
    {
        v4u sw[5], sg[4];
        if (PRE) {
#pragma unroll
            for (int k5 = 0; k5 < 5; ++k5) sw[k5] = pre->sw[k5];
            if (PASS == 2) {
#pragma unroll
                for (int k4 = 0; k4 < 4; ++k4) sg[k4] = pre->sg[k4];
            }
        } else {
#pragma unroll
        for (int k5 = 0; k5 < 5; ++k5) { const int idx = tid + k5 * NTHR; const int r = idx >> 5, ck = idx & 31, tt = c * 64 - 3 + r;
            sw[k5] = (v4u){0u, 0u, 0u, 0u}; if (idx < 67 * 32 && tt >= 0) sw[k5] = *(const GAS v4u*)(P + (size_t)(b * SEQ + tt) * NPJ + PXL + ck * 8); }
        if (PASS == 2) {
#pragma unroll
            for (int k4 = 0; k4 < 4; ++k4) { const int idx = tid + k4 * NTHR; const int r = idx >> 5, ck = idx & 31; sg[k4] = *(const GAS v4u*)(P + (size_t)(row0 + r) * NPJ + PGL + ck * 8); }
        }
        }
#pragma unroll
        for (int k5 = 0; k5 < 5; ++k5) { const int idx = tid + k5 * NTHR; const int r = idx >> 5, ck = idx & 31; const v4u w = sw[k5];
            if (idx < 67 * 32) { *(LAS f32x4*)(RAW + r * 256 + ck * 8) = (f32x4){bflo(w.x), bfhi(w.x), bflo(w.y), bfhi(w.y)}; *(LAS f32x4*)(RAW + r * 256 + ck * 8 + 4) = (f32x4){bflo(w.z), bfhi(w.z), bflo(w.w), bfhi(w.w)}; } }
        if (PASS == 2) {
#pragma unroll
            for (int k4 = 0; k4 < 4; ++k4) { const int idx = tid + k4 * NTHR; const int r = idx >> 5, ck = idx & 31; *(LAS v4u*)(F.lds + LM_GT + r * S512 + ck * 16) = sg[k4]; }
        }
    }
    bf16x8 wah[2], wal[2], wxh[2], wxl[2]; float ba[2], bx[2], c8[2];
#pragma unroll
    for (int nt = 0; nt < 2; ++nt) {
        const int jc = 16 * nt + fr; float fa[8], fx[8], ga[8], gx[8];
#pragma unroll
        for (int e = 0; e < 8; ++e) { fa[e] = F.in[I_LWA][(size_t)((l * 8 + wv) * 32 + 8 * fq + e) * 32 + jc]; fx[e] = F.in[I_LWX][(size_t)((l * 8 + wv) * 32 + 8 * fq + e) * 32 + jc]; }
        wah[nt] = pack8(fa); wxh[nt] = pack8(fx);
#pragma unroll
        for (int e = 0; e < 8; ++e) { ga[e] = fa[e] - bf2f(f2bf(fa[e])); gx[e] = fx[e] - bf2f(f2bf(fx[e])); }
        wal[nt] = pack8(ga); wxl[nt] = pack8(gx);
        const int j = 32 * wv + jc; ba[nt] = F.in[I_LBA][l * 256 + j]; bx[nt] = F.in[I_LBX][l * 256 + j]; c8[nt] = -8.0f * softplusf_(-F.in[I_LLAM][l * 256 + j]);
    }
    float Hin[2] = {0.f, 0.f};
    if (PASS == 2) {
        const int js = 32 * wv + 16 * (fq & 1) + fr; float H = 0.f;
        float la[31], lb[31];
        const float* Lb = LA + (size_t)(b * 32 * 2) * 256 + js; asm volatile("" : "+v"(Lb));
#pragma unroll
        for (int cc = 0; cc < 31; ++cc) { la[cc] = Lb[cc * 512]; lb[cc] = Lb[cc * 512 + 256]; }
#pragma unroll
        for (int cc = 0; cc < 31; ++cc) { const float nh = la[cc] * H + lb[cc]; H = cc < c ? nh : H; }
        Hin[0] = __shfl(H, fr); Hin[1] = __shfl(H, fr + 16);
    }
    float cw[4]; const float cb = F.in[I_LCB][l * 256 + (tid & 255)];
#pragma unroll
    for (int k = 0; k < 4; ++k) cw[k] = F.in[I_LCW][(l * 4 + k) * 256 + (tid & 255)];
    __syncthreads();
    {
        const int j = tid & 255, hh = tid >> 8; float xcv[32];
#pragma unroll
        for (int ii = 0; ii < 32; ++ii) { const int i = 32 * hh + ii; xcv[ii] = cb + cw[0] * RAW[i * 256 + j] + cw[1] * RAW[(i + 1) * 256 + j] + cw[2] * RAW[(i + 2) * 256 + j] + cw[3] * RAW[(i + 3) * 256 + j]; }
        __syncthreads();
#pragma unroll
        for (int ii = 0; ii < 32; ++ii) { const int i = 32 * hh + ii; RAW[i * 256 + j] = xcv[ii]; *(LAS bf16*)(XCB + i * S512 + j * 2) = (bf16)f2bf(xcv[ii]); }
    }
    __syncthreads();
    float At[2] = {1.f, 1.f}, Bt[2] = {0.f, 0.f};
#pragma unroll 1
    for (int sub = 0; sub < 4; ++sub) {
        const bf16x8 au = *(const LAS bf16x8*)(XCB + (16 * sub + fr) * S512 + (32 * wv + 8 * fq) * 2);
        unsigned short gt[2][4];
        if (PASS == 2) {
#pragma unroll
            for (int nt = 0; nt < 2; ++nt)
#pragma unroll
                for (int r = 0; r < 4; ++r) gt[nt][r] = *(const LAS unsigned short*)(F.lds + LM_GT + (16 * sub + 4 * fq + r) * S512 + (32 * wv + 16 * nt + fr) * 2);
        }
#pragma unroll
        for (int nt = 0; nt < 2; ++nt) {
            const f32x4 z = (f32x4){0.f, 0.f, 0.f, 0.f};
            f32x4 da = MFMA16(au, wah[nt], z); da = MFMA16(au, wal[nt], da);
            f32x4 dx = MFMA16(au, wxh[nt], z); dx = MFMA16(au, wxl[nt], dx);
            const int j = 32 * wv + 16 * nt + fr;
            float hl[4], ca[4]; float A = 1.f, B = 0.f;
#pragma unroll
            for (int r = 0; r < 4; ++r) { const int t = 16 * sub + 4 * fq + r;
                const float rr = sigmoidf_(da[r] + ba[nt]), gi = sigmoidf_(dx[r] + bx[nt]); const float a = __expf(c8[nt] * rr);
                const float mult = (c == 0 && t == 0) ? 1.0f : __builtin_amdgcn_sqrtf(fmaxf(1.0f - a * a, 0.f));
                const float bt = mult * gi * RAW[t * 256 + j];
                B = a * B + bt; A *= a; hl[r] = B; ca[r] = A; }
            float Ap = __shfl_up(A, 16), Bp = __shfl_up(B, 16); if (fq >= 1) { B = A * Bp + B; A = A * Ap; }
            Ap = __shfl_up(A, 32); Bp = __shfl_up(B, 32); if (fq >= 2) { B = A * Bp + B; A = A * Ap; }
            float Ae = __shfl_up(A, 16), Be = __shfl_up(B, 16); if (fq == 0) { Ae = 1.f; Be = 0.f; }
            const float As = __shfl(A, fr + 48), Bs = __shfl(B, fr + 48);
            if (PASS == 1) { Bt[nt] = As * Bt[nt] + Bs; At[nt] *= As; }
            else {
                const float Hs = Ae * Hin[nt] + Be;
#pragma unroll
                for (int r = 0; r < 4; ++r) { const float hv = hl[r] + ca[r] * Hs;
                    MX[(size_t)(row0 + 16 * sub + 4 * fq + r) * DM + 256 + j] = (bf16)f2bf(hv * gelu_tanh(bf2f(gt[nt][r]))); }
                Hin[nt] = As * Hin[nt] + Bs;
            }
        }
    }
    if (fq == 0) {
#pragma unroll
        for (int nt = 0; nt < 2; ++nt) { const int j = 32 * wv + 16 * nt + fr;
            if (PASS == 1) { LA[(size_t)((b * 32 + c) * 2) * 256 + j] = At[nt]; LA[(size_t)((b * 32 + c) * 2 + 1) * 256 + j] = Bt[nt]; }
            else if (c == 31) F.out[O_PLRUH + (size_t)(l * 8 + b) * 256 + j] = Hin[nt]; }
    }
    if (PASS == 2 && c == 31 && tid < 256) {
#pragma unroll
        for (int k = 0; k < 3; ++k) F.out[O_PLRUC + (size_t)((l * 8 + b) * 3 + k) * 256 + tid] = RAW[(64 + k) * 256 + tid]; }
    __syncthreads();
}
#ifndef MK_N_LAUNCHES
#define MK_N_LAUNCHES 1
#endif
constexpr int N_PHASES = 19;
#ifndef STAGE_AHEAD
#define STAGE_AHEAD 1
#endif
struct Args { const float* in[37]; float* out; unsigned char* ws; int ph_lo, ph_hi; };
#if MK_N_LAUNCHES == 1
#define GRID_BAR() xcd_barrier(bar)
#else
#define GRID_BAR() do { } while (0)
#endif
#ifndef DUPM
#define DUPM 0
#endif
#define REP(bit) for (int rep_ = 0; rep_ < (((DUPM) >> (bit)) & 1 ? 2 : 1); ++rep_)
#ifndef PH_MASK
#define PH_MASK 0x3ff
#endif
#define IN(k) (lo <= (k) && (k) < hi)
#define INL(i) (((PH_MASK >> ((i) + 1)) & 1) && IN(pb + (i)))
#define OPQ() asm volatile("" : "+s"(F.wg), "+s"(F.G), "+s"(F.ws), "+s"(F.out), "+s"(l), "+s"(F.lds))
#ifndef BAR_TWICE
#define BAR_TWICE 0
#endif
#define SEAM(k) do { if (IN(k) && IN((k) + 1)) { GRID_BAR(); if (BAR_TWICE) GRID_BAR(); } } while (0)
#define X ((bf16*)(F.ws + WS_X))
#define P ((bf16*)(F.ws + WS_P))
#define BIG ((bf16*)(F.ws + WS_BIG))
#define AB ((float*)(F.ws + WS_AB))
#define Y (F.out + O_YP)
#define X1B ((float*)(F.ws + WS_BIG + 34 * MiB))
#define RSA ((float*)(F.ws + WS_CTL + 512 * 1024))
#define RSB ((float*)(F.ws + WS_CTL + 768 * 1024))
#define X2B Y
template <int LAYER>
__device__ __forceinline__ void layer_phases(Frame& F, const XcdBarrier& bar, const int lo, const int hi) {
    int l = LAYER;
#if defined(SEGREP) || defined(SEGPRE)
    int seg_n = 0;
#endif
        const int pb = 1 + 9 * l;
#if (defined(SEGREP) || defined(SEGPRE)) && SEG_LO == 0
        seg_start: asm volatile("" : "+v"(F.tid), "+v"(F.lane)); F.wave = __builtin_amdgcn_readfirstlane(F.tid >> 6);
#endif
        if (INL(0)) REP(1) { OPQ();
            pg8::Gemm g{(const bf16*)X2B, (const bf16*)(F.ws + WS_WIN), MT, NPJ, DM}; pg8::StaticOrder S; S.init(MT, NPJ, F.G, F.wg);
            pg8::EpiBf16 E{P, NPJ, RSA};
            pg8::gemm_phase<pg8::EpiBf16, pg8::StaticOrder, true, true>(F.lds, g, S, E);
            if (LAYER == 0) convert_items<2 | 8>(F, l, ((MT / 256) * (NPJ / 256)) % F.G); else convert_items<8>(F, l, ((MT / 256) * (NPJ / 256)) % F.G);
        }
#if defined(SEGPRE) && SEG_HI == 0
        if (((SEGPRE >> LAYER) & 1) && seg_n < hi - (N_PHASES - 1)) { ++seg_n; if (SEGPRE_MODE == 1) xcd_barrier<true>(bar); else if (SEGPRE_MODE == 2) xcd_barrier<false>(bar); goto seg_start; }
#endif
        SEAM(pb + 0);
#if defined(SEGREP) && SEG_HI == 0
        if (((SEGREP >> LAYER) & 1) && seg_n < hi - (N_PHASES - 1)) { ++seg_n; if (0 == 8 && LAYER == 1) GRID_BAR(); goto seg_start; }
#endif
#if (defined(SEGREP) || defined(SEGPRE)) && SEG_LO == 1
        seg_start: asm volatile("" : "+v"(F.tid), "+v"(F.lane)); F.wave = __builtin_amdgcn_readfirstlane(F.tid >> 6);
#endif
        if (INL(1)) { OPQ();
#if STAGE_AHEAD
            S5Stage s5a;
#endif
            {
                int cw_head = -1; v4u pre[7]; float abn[2]; bool have = false; float SS[32];
                int ts = F.wg; const int NT = NB_S * GDH;
                if (ts < NT) gdn_sample_load(F, l, ts, SS);
                int k = 0;
                const int nun = NB_P * GDH * NCH / F.G;
                auto unit_of = [&](int kk) { return ((F.wg & 7) * GDH + (F.wg >> 6)) * NCH + ((F.wg >> 3) & 7) * 4 + kk; };
                for (; k < nun; ++k) { const int u = unit_of(k);
                    gdn_prep<0>(F, l, u, cw_head, pre, abn, have, k + 1 < nun ? unit_of(k + 1) : -1); have = true;
#if STAGE_AHEAD
                    if (k + 1 == nun && F.wg < NB_P * 31) s5m_stage_load(F, (F.wg / 31) * SEQ + (F.wg % 31) * 64, s5a);
#endif
                    if (ts < NT) { gdn_sample(F, l, ts, SS); ts += F.G; if (ts < NT) gdn_sample_load(F, l, ts, SS); }
                }
                while (ts < NT) { gdn_sample(F, l, ts, SS); ts += F.G; if (ts < NT) gdn_sample_load(F, l, ts, SS); }
            }
#ifdef GPC
            { int cw_head = -1; v4u pre[7]; float abn[2]; for (int u = F.wg; u < NB_P * GDH * NCH; u += F.G) { gdn_prep<GPC>(F, l, u, cw_head, pre, abn, false, -1); } __syncthreads(); }
#endif
#if STAGE_AHEAD
            if (F.wg < NB_P * 31) { const int u = F.wg; LruStage lra;
                auto hook = [&]() { lrum_stage_load<1>(F, u / 31, u % 31, lra); };
                s5m_unit<1, true>(F, l, u / 31, u % 31, &s5a, hook);
                lrum_pass<1, true>(F, l, u / 31, u % 31, &lra); }
#else
            for (int u = F.wg; u < NB_P * 31; u += F.G) { REP(3) s5m_unit<1>(F, l, u / 31, u % 31); REP(4) lrum_pass<1>(F, l, u / 31, u % 31); }
#endif
            for (int q = F.wg; q < 2 * NB_S; q += F.G) REP(6) { if (q < NB_S) s5m_unit<3>(F, l, q, 0); else lru_sample(F, l, q - NB_S); }
        }
#if defined(SEGPRE) && SEG_HI == 1
        if (((SEGPRE >> LAYER) & 1) && seg_n < hi - (N_PHASES - 1)) { ++seg_n; if (SEGPRE_MODE == 1) xcd_barrier<true>(bar); else if (SEGPRE_MODE == 2) xcd_barrier<false>(bar); goto seg_start; }
#endif
        SEAM(pb + 1);
#if defined(SEGREP) && SEG_HI == 1
        if (((SEGREP >> LAYER) & 1) && seg_n < hi - (N_PHASES - 1)) { ++seg_n; if (1 == 8 && LAYER == 1) GRID_BAR(); goto seg_start; }
#endif
#if (defined(SEGREP) || defined(SEGPRE)) && SEG_LO == 2
        seg_start: asm volatile("" : "+v"(F.tid), "+v"(F.lane)); F.wave = __builtin_amdgcn_readfirstlane(F.tid >> 6);
#endif
        if (INL(2)) { OPQ();
#if STAGE_AHEAD
            {
                const int u = F.wg; S5Stage s5s; LruStage lrs;
                s5m_stage_load(F, (u >> 5) * SEQ + (u & 31) * 64, s5s);
                gdn_chain<false>(F, l, F.wg);
                auto hook = [&]() { lrum_stage_load<2>(F, u >> 5, u & 31, lrs); };
                s5m_unit<2, true>(F, l, u >> 5, u & 31, &s5s, hook);
                lrum_pass<2, true>(F, l, u >> 5, u & 31, &lrs);
            }
#else
            for (int t = F.wg; t < 256; t += F.G) gdn_chain<false>(F, l, t);
            for (int u = F.wg; u < NB_P * NCH; u += F.G) { REP(7) s5m_unit<2>(F, l, u >> 5, u & 31); REP(8) lrum_pass<2>(F, l, u >> 5, u & 31); }
#endif
        }
#if defined(SEGPRE) && SEG_HI == 2
        if (((SEGPRE >> LAYER) & 1) && seg_n < hi - (N_PHASES - 1)) { ++seg_n; if (SEGPRE_MODE == 1) xcd_barrier<true>(bar); else if (SEGPRE_MODE == 2) xcd_barrier<false>(bar); goto seg_start; }
#endif
        SEAM(pb + 2);
#if defined(SEGREP) && SEG_HI == 2
        if (((SEGREP >> LAYER) & 1) && seg_n < hi - (N_PHASES - 1)) { ++seg_n; if (2 == 8 && LAYER == 1) GRID_BAR(); goto seg_start; }
#endif
#if (defined(SEGREP) || defined(SEGPRE)) && SEG_LO == 3
        seg_start: asm volatile("" : "+v"(F.tid), "+v"(F.lane)); F.wave = __builtin_amdgcn_readfirstlane(F.tid >> 6);
#endif
        if (!HEADNORM_IN_GEMM && INL(3)) { OPQ();
            gdn_finalize(F, l);
        }
#if defined(SEGPRE) && SEG_HI == 3
        if (((SEGPRE >> LAYER) & 1) && seg_n < hi - (N_PHASES - 1)) { ++seg_n; if (SEGPRE_MODE == 1) xcd_barrier<true>(bar); else if (SEGPRE_MODE == 2) xcd_barrier<false>(bar); goto seg_start; }
#endif
#if !HEADNORM_IN_GEMM
        SEAM(pb + 3);
#endif
#if defined(SEGREP) && SEG_HI == 3
        if (((SEGREP >> LAYER) & 1) && seg_n < hi - (N_PHASES - 1)) { ++seg_n; if (3 == 8 && LAYER == 1) GRID_BAR(); goto seg_start; }
#endif
#if (defined(SEGREP) || defined(SEGPRE)) && SEG_LO == 4
        seg_start: asm volatile("" : "+v"(F.tid), "+v"(F.lane)); F.wave = __builtin_amdgcn_readfirstlane(F.tid >> 6);
#endif
        if (INL(4)) REP(9) { OPQ();
            pg8::Gemm g{X, (const bf16*)(F.ws + WS_WOUT), MP, DM, DM}; pg8::StaticOrder S; S.init(MP, DM, F.G, F.wg);
#if HEADNORM_IN_GEMM
            pg8::EpiBf16HeadNorm E{BIG, DM, (const float*)(F.ws + WS_SSQ), 1.f / HD, EPS};
            pg8::gemm_phase<pg8::EpiBf16HeadNorm, pg8::StaticOrder, true, true>(F.lds, g, S, E);
#else
            pg8::EpiBf16 E{BIG, DM, nullptr};
            pg8::gemm_phase<pg8::EpiBf16, pg8::StaticOrder, true, true>(F.lds, g, S, E);
#endif
            sample_gemm_lds(F, X, (const bf16*)(F.ws + WS_WOUT), DM, BIG);
        }
#if defined(SEGPRE) && SEG_HI == 4
        if (((SEGPRE >> LAYER) & 1) && seg_n < hi - (N_PHASES - 1)) { ++seg_n; if (SEGPRE_MODE == 1) xcd_barrier<true>(bar); else if (SEGPRE_MODE == 2) xcd_barrier<false>(bar); goto seg_start; }
#endif
        SEAM(pb + 4);
#if defined(SEGREP) && SEG_HI == 4
        if (((SEGREP >> LAYER) & 1) && seg_n < hi - (N_PHASES - 1)) { ++seg_n; if (4 == 8 && LAYER == 1) GRID_BAR(); goto seg_start; }
#endif
#if (defined(SEGREP) || defined(SEGPRE)) && SEG_LO == 5
        seg_start: asm volatile("" : "+v"(F.tid), "+v"(F.lane)); F.wave = __builtin_amdgcn_readfirstlane(F.tid >> 6);
#endif
        if (INL(5)) { OPQ();
            REP(13) row_pass<true, true>(F, X2B, nullptr, BIG, F.in[I_NMPOST] + l * DM, X1B, nullptr, RSB, nullptr, nullptr);
        }
#if defined(SEGPRE) && SEG_HI == 5
        if (((SEGPRE >> LAYER) & 1) && seg_n < hi - (N_PHASES - 1)) { ++seg_n; if (SEGPRE_MODE == 1) xcd_barrier<true>(bar); else if (SEGPRE_MODE == 2) xcd_barrier<false>(bar); goto seg_start; }
#endif
        SEAM(pb + 5);
#if defined(SEGREP) && SEG_HI == 5
        if (((SEGREP >> LAYER) & 1) && seg_n < hi - (N_PHASES - 1)) { ++seg_n; if (5 == 8 && LAYER == 1) GRID_BAR(); goto seg_start; }
#endif
#if (defined(SEGREP) || defined(SEGPRE)) && SEG_LO == 6
        seg_start: asm volatile("" : "+v"(F.tid), "+v"(F.lane)); F.wave = __builtin_amdgcn_readfirstlane(F.tid >> 6);
#endif
        if (INL(6)) REP(10) { OPQ();
            pg8::Gemm g{(const bf16*)X1B, (const bf16*)(F.ws + WS_WGU), MT, 2 * FF, DM}; pg8::StaticOrder S; S.init(MT, 2 * FF, F.G, F.wg);
            pg8::EpiSwiGLU E{P, FF, RSB};
            pg8::gemm_phase<pg8::EpiSwiGLU, pg8::StaticOrder, true, true>(F.lds, g, S, E);
            if (LAYER + 1 < DEPTH) convert_items<1 | 2>(F, l + 1, ((MT / 256) * (2 * FF / 256)) % F.G);
        }
#if defined(SEGPRE) && SEG_HI == 6
        if (((SEGPRE >> LAYER) & 1) && seg_n < hi - (N_PHASES - 1)) { ++seg_n; if (SEGPRE_MODE == 1) xcd_barrier<true>(bar); else if (SEGPRE_MODE == 2) xcd_barrier<false>(bar); goto seg_start; }
#endif
        SEAM(pb + 6);
#if defined(SEGREP) && SEG_HI == 6
        if (((SEGREP >> LAYER) & 1) && seg_n < hi - (N_PHASES - 1)) { ++seg_n; if (6 == 8 && LAYER == 1) GRID_BAR(); goto seg_start; }
#endif
#if (defined(SEGREP) || defined(SEGPRE)) && SEG_LO == 7
        seg_start: asm volatile("" : "+v"(F.tid), "+v"(F.lane)); F.wave = __builtin_amdgcn_readfirstlane(F.tid >> 6);
#endif
        if (INL(7)) REP(11) { OPQ();
            pg8::Gemm g{P, (const bf16*)(F.ws + WS_WDN), MP, DM, FF}; pg8::StaticOrder S; S.init(MP, DM, F.G, F.wg);
            pg8::EpiBf16 E{BIG, DM, nullptr};
            pg8::gemm_phase<pg8::EpiBf16, pg8::StaticOrder, true, true>(F.lds, g, S, E);
            sample_gemm_lds(F, P, (const bf16*)(F.ws + WS_WDN), FF, BIG);
        }
#if defined(SEGPRE) && SEG_HI == 7
        if (((SEGPRE >> LAYER) & 1) && seg_n < hi - (N_PHASES - 1)) { ++seg_n; if (SEGPRE_MODE == 1) xcd_barrier<true>(bar); else if (SEGPRE_MODE == 2) xcd_barrier<false>(bar); goto seg_start; }
#endif
        SEAM(pb + 7);
#if defined(SEGREP) && SEG_HI == 7
        if (((SEGREP >> LAYER) & 1) && seg_n < hi - (N_PHASES - 1)) { ++seg_n; if (7 == 8 && LAYER == 1) GRID_BAR(); goto seg_start; }
#endif
#if (defined(SEGREP) || defined(SEGPRE)) && SEG_LO == 8
        seg_start: asm volatile("" : "+v"(F.tid), "+v"(F.lane)); F.wave = __builtin_amdgcn_readfirstlane(F.tid >> 6);
#endif
        if (INL(8)) { OPQ();
            if (l + 1 < DEPTH) {
                convert_items<4 | 16>(F, l + 1, 0);
                row_pass<true, true>(F, X1B, nullptr, BIG, F.in[I_NFPOST] + l * DM, X2B, F.in[I_NMPRE] + (l + 1) * DM, RSA, F.in[I_WIN] + (size_t)(l + 1) * DM * INC, AB);
            } else row_pass<true, false>(F, X1B, nullptr, BIG, F.in[I_NFPOST] + l * DM, Y, nullptr, nullptr, nullptr, nullptr);
        }
#if defined(SEGPRE) && SEG_HI == 8
        if (((SEGPRE >> LAYER) & 1) && seg_n < hi - (N_PHASES - 1)) { ++seg_n; if (SEGPRE_MODE == 1) xcd_barrier<true>(bar); else if (SEGPRE_MODE == 2) xcd_barrier<false>(bar); goto seg_start; }
#endif
        SEAM(pb + 8);
#if defined(SEGREP) && SEG_HI == 8
        if (((SEGREP >> LAYER) & 1) && seg_n < hi - (N_PHASES - 1)) { ++seg_n; if (8 == 8 && LAYER == 1) GRID_BAR(); goto seg_start; }
#endif
    }
__global__ void __launch_bounds__(NTHR, 2) mega_fwd(Args args) {
    extern __shared__ __attribute__((aligned(16))) unsigned char lds[];
    Frame F;
    F.lds = (LAS unsigned char*)lds;
    F.tid = threadIdx.x; F.lane = F.tid & 63; F.wave = __builtin_amdgcn_readfirstlane(F.tid >> 6);
    F.G = gridDim.x; F.wg = blockIdx.x;
    F.in = args.in;
    F.out = args.out; F.ws = args.ws;
    volatile LAS unsigned* MISC = (volatile LAS unsigned*)(F.lds + LDSCTL_OFF);
    for (int u = F.tid; u < (LDS_BYTES - LDSCTL_OFF) / 4; u += NTHR) ((LAS unsigned*)(F.lds + LDSCTL_OFF))[u] = 0u;
    __syncthreads();
#if MK_N_LAUNCHES == 1
    XcdBarrier bar = xcd_barrier_post((unsigned*)(F.ws + WS_CTL) + CW_BAR, MISC + 8);
#else
    (void)MISC; XcdBarrier bar; bar.bar = nullptr; bar.x = 0; bar.st = nullptr;
#endif
    const int lo = args.ph_lo, hi = args.ph_hi;
#ifdef FULLREP
    for (int rep2 = 0; rep2 < args.ph_hi - (N_PHASES - FULLREP); ++rep2) {
        F.tid = threadIdx.x; asm volatile("" : "+v"(F.tid)); F.lane = F.tid & 63; F.wave = __builtin_amdgcn_readfirstlane(F.tid >> 6);
#endif
    if ((PH_MASK & 1) && IN(0)) REP(12) {
        convert_items<1 | 4 | 16>(F, 0, 0);
        row_pass<false, true>(F, F.in[I_XP], F.in[I_XS], nullptr, nullptr, X2B, F.in[I_NMPRE], RSA, F.in[I_WIN], AB);
    }
    SEAM(0);
    layer_phases<0>(F, bar, lo, hi);
    layer_phases<1>(F, bar, lo, hi);
#ifdef FULLREP
    GRID_BAR(); }
#endif
}

extern "C" void kernel_launch(void* const* d_in, const int* in_sizes, int n_in, void* d_out, int out_size, void* d_ws, size_t ws_size, hipStream_t stream) {
    static int grid = 0;
    if (grid == 0) {
        if (n_in != 37 || (size_t)out_size != O_END || ws_size < WS_OL + 16 * MiB) { fprintf(stderr, "kernel_launch: unexpected shapes: n_in %d out %d ws %zu\n", n_in, out_size, ws_size); grid = -1; return; }
        int dev = 0, cus = 0, per_cu = 0;
        if (hipGetDevice(&dev) != hipSuccess || hipDeviceGetAttribute(&cus, hipDeviceAttributeMultiprocessorCount, dev) != hipSuccess) { grid = -1; return; }
        if (hipFuncSetAttribute((const void*)mega_fwd, hipFuncAttributeMaxDynamicSharedMemorySize, LDS_BYTES) != hipSuccess) { fprintf(stderr, "kernel_launch: hipFuncSetAttribute failed\n"); grid = -1; return; }
        if (hipOccupancyMaxActiveBlocksPerMultiprocessor(&per_cu, (const void*)mega_fwd, NTHR, LDS_BYTES) != hipSuccess || per_cu < 1) { fprintf(stderr, "kernel_launch: occupancy query says %d blocks per CU\n", per_cu); (void)hipGetLastError(); per_cu = 1; }
        grid = cus;
        if (grid > 256) grid = 256;
        if (HEADNORM_IN_GEMM && grid != 256) { fprintf(stderr, "kernel_launch: %d compute units, this build needs 256 (one out-projection unit per workgroup)\n", cus); grid = -1; return; }
    }
    if (grid < 0) return;
    (void)hipMemsetAsync((char*)d_ws + WS_CTL, 0, CTL_ZERO_BYTES, stream);
    Args a{};
    for (int i = 0; i < 37; ++i) a.in[i] = (const float*)d_in[i];
    a.out = (float*)d_out; a.ws = (unsigned char*)d_ws;
#if MK_N_LAUNCHES == 1
    a.ph_lo = 0; a.ph_hi = N_PHASES;
    hipLaunchKernelGGL(mega_fwd, dim3(grid), dim3(NTHR), LDS_BYTES, stream, a);
#else
    for (int ph = 0; ph < N_PHASES; ++ph) { a.ph_lo = ph; a.ph_hi = ph + 1; hipLaunchKernelGGL(mega_fwd, dim3(grid), dim3(NTHR), LDS_BYTES, stream, a); }
#endif
}
```

```cpp
#include <hip/hip_runtime.h>
#include <cstdio>
#include <cstdint>
#include <cmath>
namespace pg8 {
#define PG8_LAS __attribute__((address_space(3)))
typedef unsigned short bf16_t;
typedef short bf16x8 __attribute__((ext_vector_type(8)));
typedef float f32x4 __attribute__((ext_vector_type(4)));
typedef unsigned u32x4 __attribute__((ext_vector_type(4)));
constexpr int BM = 256, BK = 64, HALF = 128, HTB = HALF * BK * 2  , STAGE_BYTES = 8 * HTB, NXCD = 8, WGM = 8;

__host__ __device__ __forceinline__ int lds_byte(int r, int c) { const int st = (r >> 4) * 2 + (c >> 5), rr = r & 15, cc = c & 31, ob = rr * 64 + cc * 2; return st * 1024 + (ob ^ (((ob >> 9) & 1) << 5)); }
__host__ __device__ __forceinline__ void stage_rc(int b, int& R, int& C) { const int st = b / 1024, sb = b % 1024, swz = sb ^ (((sb >> 9) & 1) << 5); R = (st >> 1) * 16 + swz / 64; C = (st & 1) * 32 + (swz % 64) / 2; }
__host__ __device__ __forceinline__ int perm32(int rho) { const int n = rho >> 4, i = rho & 15; return 8 * (i >> 2) + 4 * n + (i & 3); }

struct Unit { int pm, pn; };
struct Gemm { const bf16_t* A; const bf16_t* Bt; int M, N, K; };

struct StaticOrder {
    int nM, nN, nwg, G, c;
    __host__ __device__ void init(int M, int N, int G_, int c_) { nM = M / BM; nN = N / BM; nwg = nM * nN; G = G_; c = c_; }
    __host__ __device__ bool next(int i, Unit& u) const {
        const long L = (long)i * G + c; if (L >= nwg) return false;
        int wgid = (int)L; { const int q = nwg / NXCD, r = nwg % NXCD, xcd = wgid % NXCD, off = wgid / NXCD; wgid = (xcd < r ? xcd * (q + 1) : r * (q + 1) + (xcd - r) * q) + off; }
        const int nig = WGM * nN, gid = wgid / nig, fm = gid * WGM, gsz = (nM - fm) < WGM ? (nM - fm) : WGM;
        u.pm = fm + ((wgid % nig) % gsz); u.pn = (wgid % nig) / gsz; return true;
    }
    __device__ __forceinline__ void a_ready(const Unit&) const {}
    __device__ __forceinline__ void done(const Unit&) const {}
};


__device__ __forceinline__ unsigned cvt_pk_bf16(float lo, float hi) { unsigned r; asm volatile("v_cvt_pk_bf16_f32 %0, %1, %2" : "=v"(r) : "v"(lo), "v"(hi)); return r; }

template <bool WT>
__device__ __forceinline__ void st16(void* p, u32x4 v) {
    if constexpr (WT) asm volatile("global_store_dwordx4 %0, %1, off sc1\n\ts_nop 1" :: "v"(p), "v"(v) : "memory");
    else *(u32x4*)p = v;
}
struct EpiF32 {
    static constexpr bool PERM = false, AFTER_DRAIN = false, KSCALE = false;
    float* C; int ldc;
    template <bool WT>
    __device__ __forceinline__ void run(const f32x4 (&acc)[2][2][4][2], const Unit& u, int wr, int wc, int fr, int fq) const {
        const int row0 = u.pm * BM + wr * 64 + fr, col0 = u.pn * BM + wc * 32 + 4 * fq;
#pragma unroll
        for (int ai = 0; ai < 2; ++ai)
#pragma unroll
            for (int m = 0; m < 4; ++m) { float* rowp = C + (size_t)(row0 + ai * HALF + m * 16) * ldc + col0;
#pragma unroll
                for (int bj = 0; bj < 2; ++bj)
#pragma unroll
                    for (int n = 0; n < 2; ++n) *(f32x4*)(rowp + bj * HALF + n * 16) = acc[ai][bj][m][n]; }
    }
};
struct EpiBf16 {
    static constexpr bool PERM = true, AFTER_DRAIN = false, KSCALE = false;
    bf16_t* O; int ldc; const float* RS;
    template <bool WT>
    __device__ __forceinline__ void run(const f32x4 (&acc)[2][2][4][2], const Unit& u, int wr, int wc, int fr, int fq) const {
        const int row0 = u.pm * BM + wr * 64 + fr; const int col0 = u.pn * BM + wc * 32 + 8 * fq;
        float rsc[2][4];
#pragma unroll
        for (int ai = 0; ai < 2; ++ai)
#pragma unroll
            for (int m = 0; m < 4; ++m) rsc[ai][m] = RS ? RS[row0 + ai * HALF + m * 16] : 1.0f;
#pragma unroll
        for (int ai = 0; ai < 2; ++ai)
#pragma unroll
            for (int m = 0; m < 4; ++m) { bf16_t* rowp = O + (size_t)(row0 + ai * HALF + m * 16) * ldc + col0;
#pragma unroll
                for (int bj = 0; bj < 2; ++bj) { const f32x4 v0 = acc[ai][bj][m][0] * rsc[ai][m], v1 = acc[ai][bj][m][1] * rsc[ai][m];
                    u32x4 w; w.x = cvt_pk_bf16(v0[0], v0[1]); w.y = cvt_pk_bf16(v0[2], v0[3]); w.z = cvt_pk_bf16(v1[0], v1[1]); w.w = cvt_pk_bf16(v1[2], v1[3]);
                    st16<WT>(rowp + bj * HALF, w); } }
    }
};
struct EpiBf16HeadNorm {
    static constexpr bool PERM = true, AFTER_DRAIN = false, KSCALE = true;
    static constexpr int KT0 = 8, TAB = STAGE_BYTES;
    bf16_t* O; int ldc; const float* SSQ; float inv_n, eps;
    struct Pre { f32x4 v[8]; };
    __device__ __forceinline__ void setup_load(Pre& p, const Unit& u, int tid) const {
        const float* sp = SSQ + (size_t)(u.pm * BM + (tid & 255)) * 32;
#pragma unroll
        for (int i = 0; i < 8; ++i) p.v[i] = *(const f32x4*)(sp + 4 * i);
    }
    __device__ __forceinline__ void setup_store(const Pre& p, PG8_LAS unsigned char* lds, int tid) const {
        if (tid < 256) {
            float sq[4], rs[4];
#pragma unroll
            for (int h = 0; h < 4; ++h) { const f32x4 a = p.v[2 * h], b = p.v[2 * h + 1]; const float x = ((a.x + a.y) + (a.z + a.w) + (b.x + b.y) + (b.z + b.w)) * inv_n + eps; rs[h] = __builtin_amdgcn_rsqf(x); sq[h] = x * rs[h]; }
            PG8_LAS float* t = (PG8_LAS float*)(lds + TAB) + tid * 8;
            *(PG8_LAS f32x4*)t = (f32x4){sq[0], rs[0] * sq[1], rs[1] * sq[2], rs[2] * sq[3]}; t[4] = rs[3];
        }
    }
    __device__ __forceinline__ void scale(f32x4 (&acc)[2][2][4][2], PG8_LAS unsigned char* lds, int wr, int fr, int p) const {
        const PG8_LAS float* t = (const PG8_LAS float*)(lds + TAB) + (wr * 64 + fr) * 8 + p;
#pragma unroll
        for (int ai = 0; ai < 2; ++ai)
#pragma unroll
            for (int m = 0; m < 4; ++m) { const float f = t[(ai * HALF + m * 16) * 8];
#pragma unroll
                for (int bj = 0; bj < 2; ++bj)
#pragma unroll
                    for (int n = 0; n < 2; ++n) acc[ai][bj][m][n] = acc[ai][bj][m][n] * f; }
    }
    template <bool WT>
    __device__ __forceinline__ void run(const f32x4 (&acc)[2][2][4][2], const Unit& u, int wr, int wc, int fr, int fq) const { EpiBf16 e{O, ldc, nullptr}; e.template run<WT>(acc, u, wr, wc, fr, fq); }
};
struct EpiSwiGLU {
    static constexpr bool PERM = true, AFTER_DRAIN = false, KSCALE = false;
    bf16_t* O; int ldc; const float* RS;
    template <bool WT>
    __device__ __forceinline__ void run(const f32x4 (&acc)[2][2][4][2], const Unit& u, int wr, int wc, int fr, int fq) const {
        const int row0 = u.pm * BM + wr * 64 + fr; const int col0 = u.pn * HALF + wc * 32 + 8 * fq;
        float rsc[2][4];
#pragma unroll
        for (int ai = 0; ai < 2; ++ai)
#pragma unroll
            for (int m = 0; m < 4; ++m) rsc[ai][m] = RS[row0 + ai * HALF + m * 16];
#pragma unroll
        for (int ai = 0; ai < 2; ++ai)
#pragma unroll
            for (int m = 0; m < 4; ++m) { bf16_t* rowp = O + (size_t)(row0 + ai * HALF + m * 16) * ldc + col0;
                float o[8];
#pragma unroll
                for (int n = 0; n < 2; ++n)
#pragma unroll
                    for (int j = 0; j < 4; ++j) { const float g = acc[ai][0][m][n][j] * rsc[ai][m], up = acc[ai][1][m][n][j] * rsc[ai][m]; o[n * 4 + j] = g * up * __builtin_amdgcn_rcpf(1.0f + __expf(-g)); }
                u32x4 w; w.x = cvt_pk_bf16(o[0], o[1]); w.y = cvt_pk_bf16(o[2], o[3]); w.z = cvt_pk_bf16(o[4], o[5]); w.w = cvt_pk_bf16(o[6], o[7]);
                st16<WT>(rowp, w); }
    }
};

#ifndef PG8_LAST_WT
#define PG8_LAST_WT 0
#endif
template <class E, bool K = E::KSCALE> struct Epi_pre { typedef int type; };
template <class E> struct Epi_pre<E, true> { typedef typename E::Pre type; };
template <class Epi, class Sched, bool ALIGN_EPI = false, bool SP2 = false>
__device__ __forceinline__ void gemm_phase(PG8_LAS unsigned char* lds, const Gemm g, const Sched& S, const Epi& E) {
    int tid_ = threadIdx.x; asm volatile("" : "+v"(tid_));
    const int tid = tid_, wid = __builtin_amdgcn_readfirstlane(tid >> 6), lane = tid & 63, wr = wid >> 2, wc = wid & 3, fr = lane & 15, fq = lane >> 4;
    const int K = g.K, nt = K / BK;
    unsigned voffA[2], voffB[2];
#pragma unroll
    for (int i = 0; i < 2; ++i) { int R, C; stage_rc(tid * 16 + i * 8192, R, C); const int Rb = Epi::PERM ? ((R & ~31) + perm32(R & 31)) : R;
        voffA[i] = (unsigned)(R * K + C) * 2u; voffB[i] = (unsigned)(Rb * K + C) * 2u; }
    const size_t kstep = (size_t)(BK * 2);
    const size_t hstep = (size_t)HALF * K * 2;
    const size_t tstep = 2 * hstep;
    const unsigned ldsw = (unsigned)wid * 1024u;
    const int aoff = lds_byte(wr * 64 + fr, fq * 8), boff = lds_byte(wc * 32 + fr, fq * 8);
#define PG8_SA(b, h) (((b) * 2 + (h)) * HTB)
#define PG8_SB(b, h) ((4 + (b) * 2 + (h)) * HTB)
#define PG8_STAGE(bufoff, gbase, voff) do { _Pragma("unroll") for (int _i = 0; _i < 2; ++_i) \
        __builtin_amdgcn_global_load_lds((const unsigned*)((const char*)(gbase) + (voff)[_i]), (PG8_LAS unsigned*)(lds + (bufoff) + ldsw + _i * 8192), 16, 0, 0); } while (0)
#define PG8_LDA(dst, b, h) do { _Pragma("unroll") for (int m = 0; m < 4; ++m) _Pragma("unroll") for (int k = 0; k < 2; ++k) dst[m][k] = *(const PG8_LAS bf16x8*)(lds + PG8_SA(b, h) + aoff + m * 2048 + k * 1024); } while (0)
#define PG8_LDB(dst, b, h) do { _Pragma("unroll") for (int n = 0; n < 2; ++n) _Pragma("unroll") for (int k = 0; k < 2; ++k) dst[n][k] = *(const PG8_LAS bf16x8*)(lds + PG8_SB(b, h) + boff + n * 2048 + k * 1024); } while (0)
#define PG8_MMA(ai, bj, At, Bt) do { __builtin_amdgcn_s_setprio(1); _Pragma("unroll") for (int m = 0; m < 4; ++m) _Pragma("unroll") for (int n = 0; n < 2; ++n) _Pragma("unroll") for (int k = 0; k < 2; ++k) \
        acc[ai][bj][m][n] = __builtin_amdgcn_mfma_f32_16x16x32_bf16(Bt[n][k], At[m][k], acc[ai][bj][m][n], 0, 0, 0); __builtin_amdgcn_s_setprio(0); } while (0)
#define PG8_WAIT_V(n) asm volatile("s_waitcnt vmcnt(" #n ")" ::: "memory")
#define PG8_WAIT_L(n) asm volatile("s_waitcnt lgkmcnt(" #n ")" ::: "memory")
#define PG8_BAR __builtin_amdgcn_s_barrier()
#define PG8_SCHED __builtin_amdgcn_sched_barrier(0)
    Unit cur, nxt; int ui = 0;
    if (!S.next(0, cur)) return;
    f32x4 acc[2][2][4][2];
#pragma unroll
    for (int a = 0; a < 2; ++a)
#pragma unroll
        for (int b = 0; b < 2; ++b)
#pragma unroll
            for (int m = 0; m < 4; ++m)
#pragma unroll
                for (int n = 0; n < 2; ++n) acc[a][b][m][n] = (f32x4){0.f, 0.f, 0.f, 0.f};
    bf16x8 At[4][2], B0[2][2], B1[2][2];
    const char* cA = (const char*)g.A + (size_t)cur.pm * tstep; const char* cB = (const char*)g.Bt + (size_t)cur.pn * tstep;
    S.a_ready(cur);
    typename Epi_pre<Epi>::type epre;
    if constexpr (Epi::KSCALE) E.setup_load(epre, cur, tid);
    if constexpr (SP2) {
        PG8_STAGE(PG8_SB(0, 0), cB, voffB); PG8_STAGE(PG8_SB(0, 1), cB + hstep, voffB); PG8_STAGE(PG8_SA(0, 0), cA, voffA); PG8_STAGE(PG8_SA(0, 1), cA + hstep, voffA);
        if (wr == 1) PG8_BAR;
        PG8_WAIT_V(2); PG8_BAR;
        PG8_STAGE(PG8_SB(1, 0), cB + kstep, voffB); PG8_STAGE(PG8_SA(1, 0), cA + kstep, voffA); PG8_STAGE(PG8_SB(1, 1), cB + hstep + kstep, voffB);
        PG8_WAIT_V(6); PG8_BAR;
        if constexpr (Epi::KSCALE) E.setup_store(epre, lds, tid);
    } else {
        PG8_STAGE(PG8_SB(0, 0), cB, voffB); PG8_STAGE(PG8_SA(0, 0), cA, voffA); PG8_STAGE(PG8_SB(0, 1), cB + hstep, voffB); PG8_STAGE(PG8_SA(0, 1), cA + hstep, voffA);
        if (wr == 1) PG8_BAR;
        PG8_WAIT_V(4); PG8_BAR;
        PG8_STAGE(PG8_SB(1, 0), cB + kstep, voffB); PG8_STAGE(PG8_SA(1, 0), cA + kstep, voffA); PG8_STAGE(PG8_SB(1, 1), cB + hstep + kstep, voffB);
        PG8_WAIT_V(6); PG8_BAR;
    }
    for (;;) {
        const bool has_next = S.next(ui + 1, nxt);
        const char* nA = has_next ? (const char*)g.A + (size_t)nxt.pm * tstep : cA; const char* nB = has_next ? (const char*)g.Bt + (size_t)nxt.pn * tstep : cB;
        for (int t = 0; t < nt; t += 2) {
            const bool last = (t == nt - 2);
            const char* a1 = cA + (size_t)(t + 1) * kstep;
            const char* a2 = last ? nA : cA + (size_t)(t + 2) * kstep; const char* b2 = last ? nB : cB + (size_t)(t + 2) * kstep;
            const char* a3 = a2 + kstep; const char* b3 = b2 + kstep;
            if (last && has_next) S.a_ready(nxt);
            if constexpr (Epi::KSCALE) { if (t >= Epi::KT0) E.scale(acc, lds, wr, fr, (t - Epi::KT0) >> 1); }
            if constexpr (SP2) {
            PG8_LDB(B0, 0, 0); PG8_LDB(B1, 0, 1); PG8_SCHED; PG8_LDA(At, 0, 0); PG8_STAGE(PG8_SA(1, 1), a1 + hstep, voffA);
            PG8_WAIT_V(8); PG8_WAIT_L(0); PG8_BAR; PG8_MMA(0, 0, At, B0); PG8_MMA(0, 1, At, B1); PG8_BAR; PG8_SCHED;
            PG8_LDA(At, 0, 1); PG8_STAGE(PG8_SB(0, 0), b2, voffB); PG8_STAGE(PG8_SB(0, 1), b2 + hstep, voffB); PG8_STAGE(PG8_SA(0, 0), a2, voffA);
            PG8_WAIT_V(8); PG8_WAIT_L(0); PG8_BAR; PG8_MMA(1, 0, At, B0); PG8_MMA(1, 1, At, B1); PG8_BAR; PG8_SCHED;
            PG8_LDB(B0, 1, 0); PG8_LDB(B1, 1, 1); PG8_SCHED; PG8_LDA(At, 1, 0); PG8_STAGE(PG8_SA(0, 1), a2 + hstep, voffA);
            PG8_WAIT_V(8); PG8_WAIT_L(0); PG8_BAR; PG8_MMA(0, 0, At, B0); PG8_MMA(0, 1, At, B1); PG8_BAR; PG8_SCHED;
            PG8_LDA(At, 1, 1); PG8_STAGE(PG8_SB(1, 0), b3, voffB); PG8_STAGE(PG8_SB(1, 1), b3 + hstep, voffB); PG8_STAGE(PG8_SA(1, 0), a3, voffA);
            PG8_WAIT_V(8); PG8_WAIT_L(0); PG8_BAR; PG8_MMA(1, 0, At, B0); PG8_MMA(1, 1, At, B1); PG8_BAR; PG8_SCHED;
            } else {
            PG8_LDB(B0, 0, 0); PG8_SCHED; PG8_LDA(At, 0, 0); PG8_STAGE(PG8_SA(1, 1), a1 + hstep, voffA);
            PG8_WAIT_L(8); PG8_BAR; PG8_WAIT_L(0); PG8_MMA(0, 0, At, B0); PG8_BAR; PG8_SCHED;
            PG8_LDB(B1, 0, 1); PG8_STAGE(PG8_SB(0, 0), b2, voffB);
            PG8_BAR; PG8_WAIT_L(0); PG8_MMA(0, 1, At, B1); PG8_BAR;
            PG8_LDA(At, 0, 1); PG8_STAGE(PG8_SA(0, 0), a2, voffA);
            PG8_BAR; PG8_WAIT_L(0); PG8_MMA(1, 0, At, B0); PG8_BAR; PG8_SCHED;
            PG8_STAGE(PG8_SB(0, 1), b2 + hstep, voffB);
            PG8_WAIT_V(6); PG8_BAR; PG8_MMA(1, 1, At, B1); PG8_BAR;
            PG8_LDB(B0, 1, 0); PG8_SCHED; PG8_LDA(At, 1, 0); PG8_STAGE(PG8_SA(0, 1), a2 + hstep, voffA);
            PG8_WAIT_L(8); PG8_BAR; PG8_WAIT_L(0); PG8_MMA(0, 0, At, B0); PG8_BAR; PG8_SCHED;
            PG8_LDB(B1, 1, 1); PG8_STAGE(PG8_SB(1, 0), b3, voffB);
            PG8_BAR; PG8_WAIT_L(0); PG8_MMA(0, 1, At, B1); PG8_BAR;
            PG8_LDA(At, 1, 1); PG8_STAGE(PG8_SA(1, 0), a3, voffA);
            PG8_BAR; PG8_WAIT_L(0); PG8_MMA(1, 0, At, B0); PG8_BAR; PG8_SCHED;
            PG8_STAGE(PG8_SB(1, 1), b3 + hstep, voffB);
            PG8_WAIT_V(6); PG8_BAR; PG8_MMA(1, 1, At, B1); PG8_BAR;
            }
        }
        if constexpr (Epi::KSCALE) E.scale(acc, lds, wr, fr, 4);
        if constexpr (ALIGN_EPI) { if (wr == 0) PG8_BAR; }
        if constexpr (!Epi::AFTER_DRAIN) {
            if (PG8_LAST_WT && !has_next) E.template run<true>(acc, cur, wr, wc, fr, fq); else E.template run<false>(acc, cur, wr, wc, fr, fq);
            S.done(cur); }
        if (!has_next) break;
#pragma unroll
        for (int a = 0; a < 2; ++a)
#pragma unroll
            for (int b = 0; b < 2; ++b)
#pragma unroll
                for (int m = 0; m < 4; ++m)
#pragma unroll
                    for (int n = 0; n < 2; ++n) acc[a][b][m][n] = (f32x4){0.f, 0.f, 0.f, 0.f};
        cur = nxt; cA = nA; cB = nB; ++ui;
        if constexpr (ALIGN_EPI) { if (wr == 1) PG8_BAR; }
    }
    PG8_WAIT_V(0);
    if constexpr (!ALIGN_EPI) { if (wr == 0) PG8_BAR; }
    PG8_BAR;
    if constexpr (Epi::AFTER_DRAIN) { E.fused(acc, cur, wr, wc, fr, fq, lds, wid, lane); S.done(cur); }
#undef PG8_SA
#undef PG8_SB
#undef PG8_STAGE
#undef PG8_LDA
#undef PG8_LDB
#undef PG8_MMA
#undef PG8_WAIT_V
#undef PG8_WAIT_L
#undef PG8_BAR
#undef PG8_SCHED
}
}

constexpr int NWAVES = 8, NTHR = 512;
constexpr int DM = 1024, SEQ = 2048, NB_P = 8, MP = NB_P * SEQ, NB_S = 128, DSEQ = 4, MS = NB_S * DSEQ, MT = MP + MS;
constexpr int DEPTH = 2, INC = 2824, NPJ = 2816, FF = 2816, GDH = 4, HD = 128, NCH = SEQ / 64;
constexpr int PU = 0, PXL = 256, PGL = 512, PQ = 768, PK = 1280, PV = 1792, PZ = 2304;
constexpr float EPS = 1e-6f;
#ifndef HEADNORM_IN_GEMM
#define HEADNORM_IN_GEMM 1
#endif
constexpr size_t O_YP = 0, O_YS = O_YP + (size_t)MP * DM, O_PS5RE = O_YS + (size_t)MS * DM, O_PS5IM = O_PS5RE + 2 * 8 * 16 * 64, O_PLRUH = O_PS5IM + 2 * 8 * 16 * 64,
    O_PLRUC = O_PLRUH + 2 * 8 * 256, O_PGS = O_PLRUC + 2 * 8 * 3 * 256, O_PGC = O_PGS + (size_t)2 * 8 * 4 * 128 * 128, O_SS5RE = O_PGC + 2 * 8 * 3 * 1536,
    O_SS5IM = O_SS5RE + 2 * 128 * 16 * 64, O_SLRUH = O_SS5IM + 2 * 128 * 16 * 64, O_SLRUC = O_SLRUH + 2 * 128 * 256, O_SGS = O_SLRUC + 2 * 128 * 3 * 256,
    O_SGC = O_SGS + (size_t)2 * 128 * 4 * 128 * 128, O_END = O_SGC + (size_t)2 * 128 * 3 * 1536;
static_assert(O_END == 37216256, "output size");
constexpr size_t MiB = 1u << 20;
constexpr size_t WS_CTL = 0, CTL_ZERO_BYTES = 1 * MiB;
constexpr size_t WS_S5E = 1 * MiB;
constexpr size_t WS_LAGG = 3 * MiB;
constexpr size_t WS_AB = 3 * MiB + 512 * 1024;
constexpr size_t WS_EGL = 4 * MiB + 256 * 1024;
constexpr size_t WS_WIN = 5 * MiB;
constexpr size_t WS_WOUT = WS_WIN + (size_t)NPJ * DM * 2;
constexpr size_t WS_WGU = WS_WOUT + (size_t)DM * DM * 2;
constexpr size_t WS_WDN = WS_WGU + (size_t)2 * FF * DM * 2;
constexpr size_t WS_WGLU = WS_WDN + (size_t)DM * FF * 2;
constexpr size_t WS_X = 30 * MiB;
constexpr size_t WS_P = 63 * MiB;
constexpr size_t WS_BIG = 154 * MiB;
constexpr size_t WS_PP = WS_BIG, WS_RT = WS_BIG + 32 * MiB, WS_QT = WS_BIG + 64 * MiB, WS_END = WS_BIG + 80 * MiB;
static_assert(WS_WGLU + 256 * 256 * 2 <= WS_X && WS_X + (size_t)MT * DM * 2 <= WS_P && WS_P + (size_t)MT * NPJ * 2 <= WS_BIG && WS_BIG + (size_t)MT * DM * 4 <= WS_END && WS_END + (size_t)MP * 32 * 4 <= 256 * MiB, "ws map");
static_assert(WS_AB + (size_t)MT * 8 * 4 <= WS_EGL && WS_EGL + 4096 <= WS_WIN, "ws map 2");
constexpr size_t WS_SSQ = WS_END;
constexpr size_t WS_OL = WS_END + 2 * MiB;
constexpr size_t WS_DUMH = WS_END + 18 * MiB, WS_DUMF = WS_END + 19 * MiB;
static_assert(WS_DUMF + 2 * MiB <= 256 * MiB, "ws tail");
constexpr int CW_BAR = 4096;
constexpr int RING_BYTES = 131072, LDSCTL_OFF = 143360, LDS_BYTES = 147456;

#define GAS __attribute__((address_space(1)))
#define LAS __attribute__((address_space(3)))
typedef unsigned short bf16;
typedef unsigned v4u __attribute__((ext_vector_type(4)));
typedef unsigned v2u __attribute__((ext_vector_type(2)));
typedef float f32x4 __attribute__((ext_vector_type(4)));
typedef short bf16x8 __attribute__((ext_vector_type(8)));
#define LDS_WAIT() asm volatile("s_waitcnt lgkmcnt(0)" ::: "memory")
#define VM_WAIT() asm volatile("s_waitcnt vmcnt(0)" ::: "memory")
#define MFMA16(a, b, c) __builtin_amdgcn_mfma_f32_16x16x32_bf16(a, b, c, 0, 0, 0)
typedef float f32x2_t __attribute__((ext_vector_type(2))); typedef __bf16 bf16x2_t __attribute__((ext_vector_type(2)));
__device__ __forceinline__ unsigned pk2(float lo, float hi) { f32x2_t v = {lo, hi}; bf16x2_t b = __builtin_convertvector(v, bf16x2_t); return __builtin_bit_cast(unsigned, b); }
__device__ __forceinline__ unsigned f2bf(float f) { return pk2(f, f) & 0xffffu; }
__device__ __forceinline__ float bf2f(unsigned b) { return __builtin_bit_cast(float, b << 16); }
__device__ __forceinline__ float bflo(unsigned w) { return __builtin_bit_cast(float, w << 16); }
__device__ __forceinline__ float bfhi(unsigned w) { return __builtin_bit_cast(float, w & 0xffff0000u); }
__device__ __forceinline__ float frcp(float x) { return __builtin_amdgcn_rcpf(x); }
__device__ __forceinline__ float frsq(float x) { return __builtin_amdgcn_rsqf(x); }
__device__ __forceinline__ float sigmoidf_(float x) { return frcp(1.0f + __expf(-x)); }
__device__ __forceinline__ float siluf_(float x) { return x * frcp(1.0f + __expf(-x)); }
__device__ __forceinline__ float gelu_tanh(float x) { const float z = 0.7978845608028654f * (x + 0.044715f * x * x * x); return x * frcp(1.0f + __expf(-2.0f * z)); }
__device__ __forceinline__ float softplusf_(float x) { return x > 20.f ? x : log1pf(expf(x)); }
__device__ __forceinline__ float softplus_fast(float x) { return x > 20.f ? x : __logf(1.0f + __expf(x)); }
__device__ __forceinline__ float wave_sum(float v) {
#pragma unroll
    for (int o = 1; o < 64; o <<= 1) v += __shfl_xor(v, o);
    return v;
}
__device__ __forceinline__ bf16x8 pack8(const float* f) { v4u w; w.x = pk2(f[0], f[1]); w.y = pk2(f[2], f[3]); w.z = pk2(f[4], f[5]); w.w = pk2(f[6], f[7]); return __builtin_bit_cast(bf16x8, w); }
constexpr int S256 = 272, S128 = 144, S512 = 528;
__device__ __forceinline__ int t256(int row, int col) { return row * S256 + col * 2; }
__device__ __forceinline__ int t128(int row, int col) { return row * S128 + col * 2; }
__device__ __forceinline__ int t512(int row, int col) { return row * S512 + col * 2; }

#define XB_TMO      128
#define XB_XCNT(j)  (256  + 64 * (j))
#define XB_XSUB(j)  (1280 + 64 * (j))
#define XB_XGEN(j)  (2304 + 64 * (j))
#define XB_TOP      3328
#define XB_TOPGEN   3392
#define XCD_BAR_WORDS 3456
#define XB_SPIN_CAP (1u << 20)
__device__ __forceinline__ unsigned xb_ld(unsigned* p)              { return __hip_atomic_load(p, __ATOMIC_RELAXED, __HIP_MEMORY_SCOPE_AGENT); }
__device__ __forceinline__ unsigned xb_add(unsigned* p, unsigned v) { return __hip_atomic_fetch_add(p, v, __ATOMIC_RELAXED, __HIP_MEMORY_SCOPE_AGENT); }
__device__ __forceinline__ unsigned xb_xcc_id() { return (unsigned)__builtin_amdgcn_s_getreg((3 << 11) | 20) & 0xFu; }
#define XB_SPIN(cond, bar) do { unsigned _sp = 0; while (cond) { __builtin_amdgcn_s_sleep(1); \
    if ((++_sp & 255u) == 0u) { if (xb_ld(&(bar)[XB_TMO])) break; if (_sp > XB_SPIN_CAP) { atomicAdd(&(bar)[XB_TMO], 1u); break; } } } } while (0)
struct XcdBarrier { unsigned* bar; unsigned x; volatile LAS unsigned* st; };
__device__ __forceinline__ XcdBarrier xcd_barrier_post(unsigned* bar, volatile LAS unsigned* st) {
    XcdBarrier b; b.bar = bar; b.x = xb_xcc_id(); b.st = st;
    if (threadIdx.x == 0) (void)xb_add(&bar[XB_XCNT(b.x)], 1u);
    return b;
}
__device__ __forceinline__ void xcd_barrier_complete(unsigned* bar, unsigned x, unsigned& nloc, unsigned& nx) {
    const unsigned G = gridDim.x * gridDim.y * gridDim.z;
    unsigned sum, cnt, mine, sp = 0u;
    for (;;) {
        sum = 0u; cnt = 0u; mine = 0u;
#pragma unroll
        for (unsigned j = 0; j < 16; ++j) { const unsigned c = xb_ld(&bar[XB_XCNT(j)]); sum += c; cnt += (c > 0u) ? 1u : 0u; mine = (j == x) ? c : mine; }
        if (sum == G) break;
        __builtin_amdgcn_s_sleep(1);
        if ((++sp & 255u) == 0u) { if (xb_ld(&bar[XB_TMO])) break; if (sp > XB_SPIN_CAP) { atomicAdd(&bar[XB_TMO], 1u); break; } }
    }
    nloc = mine > 0u ? mine : 1u; nx = cnt > 0u ? cnt : 1u;
}
template <bool FENCED = true>
__device__ __forceinline__ void xcd_barrier(const XcdBarrier& b) {
    asm volatile("s_waitcnt vmcnt(0)" ::: "memory");
    __syncthreads();
    if (threadIdx.x == 0) {
        unsigned* bar = b.bar;
        __builtin_amdgcn_s_waitcnt(0);
        unsigned nloc = b.st[0], nx = b.st[1];
        if (nloc == 0u) { xcd_barrier_complete(bar, b.x, nloc, nx); b.st[0] = nloc; b.st[1] = nx; }
        const unsigned old = xb_add(&bar[XB_XSUB(b.x)], 1u);
        const unsigned gen = old / nloc;
        if (old + 1u == (gen + 1u) * nloc) {
            if (FENCED) __builtin_amdgcn_fence(__ATOMIC_RELEASE, "agent");
            asm volatile("s_waitcnt vmcnt(0)" ::: "memory");
            const unsigned og = xb_add(&bar[XB_TOP], 1u);
            const unsigned tg = og / nx;
            if (og + 1u == (tg + 1u) * nx) xb_add(&bar[XB_TOPGEN], 1u);
            else XB_SPIN(xb_ld(&bar[XB_TOPGEN]) == tg, bar);
            if (FENCED) __builtin_amdgcn_fence(__ATOMIC_ACQUIRE, "agent");
            xb_add(&bar[XB_XGEN(b.x)], 1u);
            asm volatile("s_waitcnt vmcnt(0)" ::: "memory");
        } else {
            XB_SPIN(xb_ld(&bar[XB_XGEN(b.x)]) == gen, bar);
            if (FENCED) __builtin_amdgcn_fence(__ATOMIC_ACQUIRE, "agent");
            asm volatile("s_waitcnt vmcnt(0)" ::: "memory");
        }
    }
    __syncthreads();
}

struct Frame {
    LAS unsigned char* lds;
    int tid, lane, wave, wg, G;
    const float* const* in;
    float* out; unsigned char* ws;
};
enum { I_XP = 0, I_XS, I_S5RE, I_S5IM, I_LRUH, I_LRUC, I_GS, I_GC, I_NMPRE, I_NMPOST, I_NFPRE, I_NFPOST, I_WIN, I_LRE, I_LIM, I_LDT, I_BRE, I_BIM, I_CRE, I_CIM, I_S5D, I_WGLU, I_BGLU,
       I_LCW, I_LCB, I_LWA, I_LBA, I_LWX, I_LBX, I_LLAM, I_GCW, I_GALOG, I_GDTB, I_GNW, I_WOUT, I_WGU, I_WDN };

__device__ __forceinline__ void transpose_item(const float* W, int ldw, int K, int k0, int c0, bf16* WT, int r0, LAS float* scr, int lane, const float* ksc = nullptr) {
    float tv[32];
#pragma unroll
    for (int i = 0; i < 32; ++i) tv[i] = W[(size_t)(k0 + 2 * i + (lane >> 5)) * ldw + c0 + (lane & 31)];
    if (ksc) {
#pragma unroll
        for (int i = 0; i < 32; ++i) tv[i] *= ksc[k0 + 2 * i + (lane >> 5)];
    }
#pragma unroll
    for (int i = 0; i < 32; ++i) scr[(2 * i + (lane >> 5)) * 33 + (lane & 31)] = tv[i];
    LDS_WAIT(); asm volatile("" ::: "memory");
    const int c = lane & 7;
#pragma unroll
    for (int j = 0; j < 4; ++j) { const int n = (lane >> 3) + 8 * j; const LAS float* s = scr + (8 * c) * 33 + n;
        v4u o; o.x = pk2(s[0 * 33], s[1 * 33]); o.y = pk2(s[2 * 33], s[3 * 33]); o.z = pk2(s[4 * 33], s[5 * 33]); o.w = pk2(s[6 * 33], s[7 * 33]);
        *(GAS v4u*)(WT + (size_t)(r0 + n) * K + k0 + 8 * c) = o; }
    LDS_WAIT(); asm volatile("" ::: "memory");
}
template <int MASK>
__device__ __forceinline__ void convert_items(Frame& F, int l, int wg0) {
    LAS float* scr = (LAS float*)(F.lds + F.wave * 16384);
    int lane = F.lane; asm volatile("" : "+v"(lane));
    const int gw = (F.wg - wg0) * NWAVES + F.wave, NGW = (F.G - wg0) * NWAVES;
    if (gw < 0) return;
    constexpr int I1 = (MASK & 1) ? 16 * 88 : 0, I2 = (MASK & 2) ? 16 * 32 : 0, I3 = (MASK & 4) ? 16 * 176 : 0, I4 = (MASK & 8) ? 44 * 32 : 0, I5 = (MASK & 16) ? 4 * 8 : 0, NIT = I1 + I2 + I3 + I4 + I5;
    unsigned char* ws = F.ws;
    for (int it = gw; it < NIT; it += NGW) {
        int r = it;
        if (r < I1) { const int kb = r / 88, nb = r % 88; transpose_item(F.in[I_WIN] + (size_t)l * DM * INC, INC, DM, 64 * kb, nb * 32 + (nb >= 72 ? 8 : 0), (bf16*)(ws + WS_WIN), nb * 32, scr, lane, F.in[I_NMPRE] + l * DM); continue; } r -= I1;
        if (r < I2) { const int kb = r / 32, nb = r % 32; transpose_item(F.in[I_WOUT] + (size_t)l * DM * DM, DM, DM, 64 * kb, nb * 32, (bf16*)(ws + WS_WOUT), nb * 32, scr, lane); continue; } r -= I2;
        if (r < I3) { const int kb = r / 176, nb = r % 176, tile = nb >> 3, wi = nb & 7; const int c0 = wi < 4 ? tile * 128 + wi * 32 : FF + tile * 128 + (wi - 4) * 32;
                      transpose_item(F.in[I_WGU] + (size_t)l * DM * 2 * FF, 2 * FF, DM, 64 * kb, c0, (bf16*)(ws + WS_WGU), nb * 32, scr, lane, F.in[I_NFPRE] + l * DM); continue; } r -= I3;
        if (r < I4) { const int kb = r / 32, nb = r % 32; transpose_item(F.in[I_WDN] + (size_t)l * FF * DM, DM, FF, 64 * kb, nb * 32, (bf16*)(ws + WS_WDN), nb * 32, scr, lane); continue; } r -= I4;
        if (r < I5) { const int kb = r / 8, nb = r % 8; transpose_item(F.in[I_WGLU] + (size_t)l * 256 * 256, 256, 256, 64 * kb, nb * 32, (bf16*)(ws + WS_WGLU), nb * 32, scr, lane); }
    }
}
constexpr size_t WS_DEP = 256 * 1024;
__device__ __forceinline__ unsigned* dep_word(Frame& F, int bank, int i) { return (unsigned*)(F.ws + WS_CTL + WS_DEP) + ((size_t)bank * 96 + i) * 64; }
__device__ __forceinline__ void dep_publish(Frame& F, unsigned* w0, unsigned* w1) {
    asm volatile("s_waitcnt vmcnt(0)" ::: "memory");
    __syncthreads();
    if (F.tid == 0) {
        __builtin_amdgcn_fence(__ATOMIC_RELEASE, "agent");
        asm volatile("s_waitcnt vmcnt(0)" ::: "memory");
        (void)xb_add(w0, 1u);
        if (w1) (void)xb_add(w1, 1u);
    }
}
__device__ __forceinline__ void dep_wait(Frame& F, unsigned* w0, unsigned n0, unsigned* w1, unsigned n1, unsigned* bar) {
    if (F.tid == 0) {
        XB_SPIN(xb_ld(w0) < n0, bar);
        if (w1) XB_SPIN(xb_ld(w1) < n1, bar);
        __builtin_amdgcn_fence(__ATOMIC_ACQUIRE, "agent");
        asm volatile("s_waitcnt vmcnt(0)" ::: "memory");
    }
    __syncthreads();
}
template <bool XIN_B, bool XOUT_B, bool LOCAL = false>
__device__ __forceinline__ void row_pass(Frame& F, const float* xp, const float* xs, const bf16* branch, const float* wb, float* xout, const float* wh, float* RS, const float* wab, float* AB, int lbase = 0, unsigned* sw = nullptr, unsigned sn = 0, unsigned* bar = nullptr) {
    int lane = F.lane; asm volatile("" : "+v"(lane));
    const int gw = F.wg * NWAVES + F.wave, NGW = F.G * NWAVES;
    f32x4 wbv[4], whv[4];
#pragma unroll
    for (int j = 0; j < 4; ++j) { wbv[j] = branch ? *(const GAS f32x4*)(wb + 4 * lane + 256 * j) : (f32x4){0.f, 0.f, 0.f, 0.f}; whv[j] = wh ? *(const GAS f32x4*)(wh + 4 * lane + 256 * j) : (f32x4){0.f, 0.f, 0.f, 0.f}; }
    LAS float* WL = (LAS float*)F.lds;
    if (wab) {
        f32x4 wl4[4];
#pragma unroll
        for (int k4 = 0; k4 < 4; ++k4) { const int i = F.tid + k4 * NTHR; const int k = i >> 1, hlf = i & 1; wl4[k4] = *(const GAS f32x4*)(wab + (size_t)k * INC + 2304 + hlf * 4); }
        __syncthreads();
#pragma unroll
        for (int k4 = 0; k4 < 4; ++k4) { const int i = F.tid + k4 * NTHR; const int k = i >> 1, hlf = i & 1; *(LAS f32x4*)(WL + k * 8 + hlf * 4) = wl4[k4]; }
        __syncthreads(); }
    const int nit = LOCAL ? (F.wave < 2 ? 9 : 8) : (MT - gw + NGW - 1) / NGW;
    for (int it = 0; it < nit; ++it) {
        const int m = LOCAL ? (it < 8 ? lbase + it : MP + 2 * F.wg + F.wave) : gw + it * NGW;
        if (LOCAL && it == 8) {
            XB_SPIN(xb_ld(sw) < sn, bar);
            __builtin_amdgcn_fence(__ATOMIC_ACQUIRE, "agent");
            asm volatile("s_waitcnt vmcnt(0)" ::: "memory");
        }
        f32x4 v[4];
        if (XIN_B) {
#pragma unroll
            for (int j = 0; j < 4; ++j) { const v2u w = *(const GAS v2u*)((const bf16*)xp + (size_t)m * DM + 4 * lane + 256 * j); v[j] = (f32x4){bflo(w.x), bfhi(w.x), bflo(w.y), bfhi(w.y)}; }
        } else {
            const float* xr = (xs && m >= MP) ? xs + (size_t)(m - MP) * DM : xp + (size_t)m * DM;
#pragma unroll
            for (int j = 0; j < 4; ++j) v[j] = *(const GAS f32x4*)(xr + 4 * lane + 256 * j);
        }
        if (branch) {
            f32x4 b[4]; float s = 0.f;
#pragma unroll
            for (int j = 0; j < 4; ++j) { const v2u bw = *(const GAS v2u*)(branch + (size_t)m * DM + 4 * lane + 256 * j); b[j] = (f32x4){bflo(bw.x), bfhi(bw.x), bflo(bw.y), bfhi(bw.y)}; s += (b[j].x * b[j].x + b[j].y * b[j].y) + (b[j].z * b[j].z + b[j].w * b[j].w); }
            const float rs = 1.0f / sqrtf(wave_sum(s) * (1.f / DM) + EPS);
#pragma unroll
            for (int j = 0; j < 4; ++j) v[j] = v[j] + b[j] * rs * wbv[j];
        }
        if (xout) {
#pragma unroll
            for (int j = 0; j < 4; ++j) {
                if (XOUT_B) { v2u o; o.x = pk2(v[j].x, v[j].y); o.y = pk2(v[j].z, v[j].w); *(GAS v2u*)((bf16*)xout + (size_t)m * DM + 4 * lane + 256 * j) = o; }
                else *(GAS f32x4*)(xout + (size_t)m * DM + 4 * lane + 256 * j) = v[j];
            }
        }
        if (RS) {
            float s = 0.f;
#pragma unroll
            for (int j = 0; j < 4; ++j) s += (v[j].x * v[j].x + v[j].y * v[j].y) + (v[j].z * v[j].z + v[j].w * v[j].w);
            const float rs = 1.0f / sqrtf(wave_sum(s) * (1.f / DM) + EPS);
            if (lane == 0) RS[m] = rs;
            if (wab) {
#pragma unroll
                for (int j = 0; j < 4; ++j) v[j] = v[j] * rs * whv[j];
            }
            if (wab) {
                float a8[8];
#pragma unroll
                for (int c = 0; c < 8; ++c) a8[c] = 0.f;
#pragma unroll
                for (int j = 0; j < 4; ++j)
#pragma unroll
                    for (int q = 0; q < 4; ++q) { const LAS float* wr = WL + (4 * lane + 256 * j + q) * 8; const f32x4 w0 = *(const LAS f32x4*)wr, w1 = *(const LAS f32x4*)(wr + 4); const float xv = v[j][q];
                        a8[0] += xv * w0.x; a8[1] += xv * w0.y; a8[2] += xv * w0.z; a8[3] += xv * w0.w; a8[4] += xv * w1.x; a8[5] += xv * w1.y; a8[6] += xv * w1.z; a8[7] += xv * w1.w; }
#pragma unroll
                for (int c = 0; c < 8; ++c) a8[c] = wave_sum(a8[c]);
                if (lane == 0) { *(GAS f32x4*)(AB + (size_t)m * 8) = (f32x4){a8[0], a8[1], a8[2], a8[3]}; *(GAS f32x4*)(AB + (size_t)m * 8 + 4) = (f32x4){a8[4], a8[5], a8[6], a8[7]}; }
            }
        }
    }
}

__device__ __forceinline__ void sample_gemm_f32(Frame& F, const bf16* A, const bf16* Bt, int K, bf16* C) {
    int tid = F.tid; asm volatile("" : "+v"(tid)); const int lane = tid & 63, wv = tid >> 6, fr = lane & 15, fq = lane >> 4;
    for (int t = F.wg; t < 256; t += F.G) {
        const int row0 = MP + 32 * (t >> 4) + 16 * (wv >> 2), col0 = 64 * (t & 15) + 16 * (wv & 3);
        const bf16* ap = A + (size_t)(row0 + fr) * K + 8 * fq; const bf16* bp = Bt + (size_t)(col0 + fr) * K + 8 * fq;
        f32x4 acc0 = (f32x4){0.f, 0.f, 0.f, 0.f}, acc1 = (f32x4){0.f, 0.f, 0.f, 0.f};
#pragma unroll 4
        for (int k = 0; k < K; k += 64) {
            const v4u a0 = *(const GAS v4u*)(ap + k), b0 = *(const GAS v4u*)(bp + k), a1 = *(const GAS v4u*)(ap + k + 32), b1 = *(const GAS v4u*)(bp + k + 32);
            acc0 = MFMA16(__builtin_bit_cast(bf16x8, a0), __builtin_bit_cast(bf16x8, b0), acc0); acc1 = MFMA16(__builtin_bit_cast(bf16x8, a1), __builtin_bit_cast(bf16x8, b1), acc1);
        }
#pragma unroll
        for (int r = 0; r < 4; ++r) C[(size_t)(row0 + 4 * fq + r) * DM + col0 + fr] = (bf16)f2bf(acc0[r] + acc1[r]);
    }
}

__device__ __forceinline__ void sample_gemm_lds(Frame& F, const bf16* A, const bf16* Bt, int K, bf16* C) {
    int tid = F.tid; asm volatile("" : "+v"(tid)); const int lane = tid & 63, wv = tid >> 6, fr = lane & 15, fq = lane >> 4;
    LAS unsigned char* L = F.lds;
    constexpr int SA = 32 * S512, SBUF = SA + 64 * S512;
    for (int t = F.wg; t < 256; t += F.G) {
        const int row0 = MP + 32 * (t >> 4), col0 = 64 * (t & 15);
        const int pr = tid >> 5, pc = (tid & 31) * 8;
        const bf16* ap = A + (size_t)(row0 + pr) * K + pc; const bf16* bp = Bt + (size_t)(col0 + pr) * K + pc;
        const size_t s16 = (size_t)16 * K;
        const int sa = pr * S512 + pc * 2, sb = SA + sa;
        v4u ra0 = *(const GAS v4u*)ap, ra1 = *(const GAS v4u*)(ap + s16);
        v4u rb0 = *(const GAS v4u*)bp, rb1 = *(const GAS v4u*)(bp + s16), rb2 = *(const GAS v4u*)(bp + 2 * s16), rb3 = *(const GAS v4u*)(bp + 3 * s16);
        *(LAS v4u*)(L + sa) = ra0; *(LAS v4u*)(L + sa + 16 * S512) = ra1;
        *(LAS v4u*)(L + sb) = rb0; *(LAS v4u*)(L + sb + 16 * S512) = rb1; *(LAS v4u*)(L + sb + 32 * S512) = rb2; *(LAS v4u*)(L + sb + 48 * S512) = rb3;
        __syncthreads();
        f32x4 acc = (f32x4){0.f, 0.f, 0.f, 0.f};
        const int nc = K >> 8;
        for (int kc = 0; kc < nc; ++kc) {
            const int cur = (kc & 1) * SBUF, nxt = ((kc + 1) & 1) * SBUF;
            if (kc + 1 < nc) { const int o = (kc + 1) * 256;
                ra0 = *(const GAS v4u*)(ap + o); ra1 = *(const GAS v4u*)(ap + s16 + o);
                rb0 = *(const GAS v4u*)(bp + o); rb1 = *(const GAS v4u*)(bp + s16 + o); rb2 = *(const GAS v4u*)(bp + 2 * s16 + o); rb3 = *(const GAS v4u*)(bp + 3 * s16 + o); }
#pragma unroll
            for (int ks = 0; ks < 8; ++ks) {
                const bf16x8 af = *(const LAS bf16x8*)(L + cur + (16 * (wv >> 2) + fr) * S512 + (32 * ks + 8 * fq) * 2);
                const bf16x8 bf = *(const LAS bf16x8*)(L + cur + SA + (16 * (wv & 3) + fr) * S512 + (32 * ks + 8 * fq) * 2);
                acc = MFMA16(af, bf, acc);
            }
            if (kc + 1 < nc) { *(LAS v4u*)(L + nxt + sa) = ra0; *(LAS v4u*)(L + nxt + sa + 16 * S512) = ra1;
                *(LAS v4u*)(L + nxt + sb) = rb0; *(LAS v4u*)(L + nxt + sb + 16 * S512) = rb1; *(LAS v4u*)(L + nxt + sb + 32 * S512) = rb2; *(LAS v4u*)(L + nxt + sb + 48 * S512) = rb3; }
            __syncthreads();
        }
#pragma unroll
        for (int r = 0; r < 4; ++r) C[(size_t)(row0 + 16 * (wv >> 2) + 4 * fq + r) * DM + col0 + 16 * (wv & 3) + fr] = (bf16)f2bf(acc[r]);
    }
}

constexpr int G_KN = 0, G_WKT = 0, G_QN = 18432, G_KT = G_QN + 64 * S256, G_VT = G_KT + 128 * S128, G_RAW = G_VT + 128 * S128, G_AT = G_RAW, G_T1 = G_AT + 64 * S128, G_T2 = G_T1 + 64 * S128, G_AF = G_T2 + 64 * S128, G_WVT = G_AF, G_VEC = G_RAW + 52544, G_CW = G_VEC + 1024;
constexpr int RAW_STRIDE = 784;
static_assert(G_RAW + 67 * RAW_STRIDE <= G_VEC && G_CW + 6144 <= LDSCTL_OFF && G_WVT + 128 * S128 <= G_VEC && 64 * S256 <= G_QN && 128 * S128 <= G_QN, "gdn prep lds");
__device__ __forceinline__ void gdn_raw_load(Frame& F, int u, int tid, v4u (&pre)[7], float (&abn)[2]) {
    const int c = u & 31, h = (u >> 5) & 3, b = u >> 7; const bf16* P = (const bf16*)(F.ws + WS_P);
    { const float* ABp = (const float*)(F.ws + WS_AB) + (size_t)(b * SEQ + c * 64 + (tid & 63)) * 8; abn[0] = ABp[h]; abn[1] = ABp[4 + h]; }
#pragma unroll
    for (int k7 = 0; k7 < 7; ++k7) { const int idx = tid + NTHR * k7; const int r = idx / 48, ck = idx % 48, ten = ck >> 4, c16 = ck & 15; const int tt = c * 64 - 3 + r;
        v4u val = (v4u){0u, 0u, 0u, 0u};
        if (idx < 67 * 48 && tt >= 0) val = *(const GAS v4u*)(P + (size_t)(b * SEQ + tt) * NPJ + PQ + ten * 512 + h * HD + c16 * 8);
        pre[k7] = val; }
}
template <int GP_CUT>
__device__ __forceinline__ void gdn_prep(Frame& F, int l, int u, int& cw_head, v4u (&pre)[7], float (&abn)[2], bool have_pre, int u_next) {
    LAS unsigned char* L = F.lds;
    int tid = F.tid; asm volatile("" : "+v"(tid)); const int lane = tid & 63, wv = tid >> 6;
    const int c = u & 31, h = (u >> 5) & 3, b = u >> 7;
    const int row0 = b * SEQ + c * 64;
    const bf16* P = (const bf16*)(F.ws + WS_P);
    const float* AB = (const float*)(F.ws + WS_AB);
    LAS float* VG = (LAS float*)(L + G_VEC); LAS float* VB = VG + 64; LAS float* VEG = VG + 128; LAS float* VEGL = VG + 192;
    const float galog = F.in[I_GALOG][l * 4 + h], gdtb = F.in[I_GDTB][l * 4 + h];
    if (h != cw_head) {
        for (int idx = tid; idx < 1536; idx += NTHR) { const int j = idx / 384, cc = idx % 384; ((LAS float*)(L + G_CW))[idx] = F.in[I_GCW][(size_t)(l * 4 + j) * 1536 + (cc >> 7) * 512 + h * HD + (cc & 127)]; }
        cw_head = h;
    }
    if (!have_pre) gdn_raw_load(F, u, tid, pre, abn);
#pragma unroll
    for (int k7 = 0; k7 < 7; ++k7) { const int idx = tid + NTHR * k7; if (idx < 67 * 48) { const int r = idx / 48, ck = idx % 48; *(LAS v4u*)(L + G_RAW + r * RAW_STRIDE + (ck >> 4) * 256 + (ck & 15) * 16) = pre[k7]; } }
    if (wv == 0) {
        const float a = abn[0], bb = abn[1];
        const float g = -__expf(galog) * softplus_fast(a + gdtb);
        const float be = frcp(1.0f + __expf(-bb));
        float Gc = g;
#pragma unroll
        for (int o = 1; o < 64; o <<= 1) { const float t = __shfl_up(Gc, o); if (lane >= o) Gc += t; }
        const float Gl = __shfl(Gc, 63);
        VG[lane] = Gc; VB[lane] = be; VEG[lane] = __expf(Gc); VEGL[lane] = __expf(Gl - Gc);
        if (lane == 0) ((float*)(F.ws + WS_EGL))[u] = __expf(Gl);
    }
    __syncthreads();
    if (u_next >= 0) gdn_raw_load(F, u_next, tid, pre, abn);
    if (c == 31 && tid < 384) {
        const int ten = tid >> 7, ch = tid & 127;
#pragma unroll
        for (int j = 0; j < 3; ++j) F.out[O_PGC + (size_t)((l * 8 + b) * 3 + j) * 1536 + ten * 512 + h * HD + ch] = bf2f(*(LAS bf16*)(L + G_RAW + (64 + j) * RAW_STRIDE + ten * 256 + ch * 2));
    }
    {
        const int i = tid >> 3, cg = tid & 7;
#pragma unroll 1
        for (int ten = 0; ten < 3; ++ten) {
            float acc[16];
#pragma unroll
            for (int e = 0; e < 16; ++e) acc[e] = 0.f;
#pragma unroll
            for (int j = 0; j < 4; ++j) {
                const v4u x0 = *(LAS v4u*)(L + G_RAW + (i + j) * RAW_STRIDE + ten * 256 + cg * 32), x1 = *(LAS v4u*)(L + G_RAW + (i + j) * RAW_STRIDE + ten * 256 + cg * 32 + 16);
                const LAS float* w = (const LAS float*)(L + G_CW) + j * 384 + ten * 128 + cg * 16;
                const f32x4 w0 = *(const LAS f32x4*)w, w1 = *(const LAS f32x4*)(w + 4), w2 = *(const LAS f32x4*)(w + 8), w3 = *(const LAS f32x4*)(w + 12);
                acc[0] += w0.x * bflo(x0.x); acc[1] += w0.y * bfhi(x0.x); acc[2] += w0.z * bflo(x0.y); acc[3] += w0.w * bfhi(x0.y);
                acc[4] += w1.x * bflo(x0.z); acc[5] += w1.y * bfhi(x0.z); acc[6] += w1.z * bflo(x0.w); acc[7] += w1.w * bfhi(x0.w);
                acc[8] += w2.x * bflo(x1.x); acc[9] += w2.y * bfhi(x1.x); acc[10] += w2.z * bflo(x1.y); acc[11] += w2.w * bfhi(x1.y);
                acc[12] += w3.x * bflo(x1.z); acc[13] += w3.y * bfhi(x1.z); acc[14] += w3.z * bflo(x1.w); acc[15] += w3.w * bfhi(x1.w);
            }
            float ss = 0.f;
#pragma unroll
            for (int e = 0; e < 16; ++e) { acc[e] = siluf_(acc[e]); ss += acc[e] * acc[e]; }
            ss += __shfl_xor(ss, 1); ss += __shfl_xor(ss, 2); ss += __shfl_xor(ss, 4);
            const float sc = ten == 2 ? 1.0f : frsq(ss + EPS) * (ten == 0 ? 0.08838834764831845f : 1.0f);
#pragma unroll
            for (int e = 0; e < 16; ++e) acc[e] *= sc;
            if (ten < 2) { const int base = ten == 0 ? G_QN : G_KN; *(LAS bf16x8*)(L + base + t256(i, cg * 16)) = pack8(acc); *(LAS bf16x8*)(L + base + t256(i, cg * 16 + 8)) = pack8(acc + 8); }
            if (ten > 0) { const int base = ten == 1 ? G_KT : G_VT;
#pragma unroll
                for (int e = 0; e < 16; ++e) *(LAS bf16*)(L + base + t128(cg * 16 + e, i)) = (bf16)f2bf(acc[e]); }
        }
    }
    __syncthreads();
    if constexpr (GP_CUT == 1) return;
    {
        const int prod = wv >> 2, mi = wv & 3, fr = lane & 15, fq = lane >> 4;
        bf16x8 a[4];
#pragma unroll
        for (int ks = 0; ks < 4; ++ks) a[ks] = *(LAS bf16x8*)(L + (prod ? G_QN : G_KN) + t256(16 * mi + fr, 32 * ks + 8 * fq));
#pragma unroll
        for (int nj = 0; nj < 4; ++nj) {
            f32x4 acc = (f32x4){0.f, 0.f, 0.f, 0.f};
            if (nj <= mi) {
#pragma unroll
                for (int ks = 0; ks < 4; ++ks) { const bf16x8 bb = *(LAS bf16x8*)(L + G_KN + t256(16 * nj + fr, 32 * ks + 8 * fq)); acc = MFMA16(a[ks], bb, acc); }
            }
            const int j = 16 * nj + fr; const float Gj = VG[j];
#pragma unroll
            for (int r = 0; r < 4; ++r) {
                const int i = 16 * mi + 4 * fq + r; const float Gi = VG[i];
                const float dec = (i >= j) ? __expf(Gi - Gj) : 0.f;
                if (prod == 0) { const float val = (i > j) ? acc[r] * VB[i] * dec : 0.f; *(LAS float*)(L + G_AF + (i * 64 + j) * 4) = val; }
                else { const float val = (i >= j) ? acc[r] * dec : 0.f; *(LAS bf16*)(L + G_AT + t128(i, j)) = (bf16)f2bf(val); }
            }
        }
    }
    __syncthreads();
    if constexpr (GP_CUT == 2) return;
    if (wv == 0) {
        const int q = lane >> 4, col = lane & 15; const LAS float* Ab = (const LAS float*)(L + G_AF) + (16 * q) * 64 + 16 * q;
        float t[16];
#pragma unroll
        for (int i = 0; i < 16; ++i) {
            float a0 = (col == i) ? 1.f : 0.f, a1 = 0.f, a2 = 0.f, a3 = 0.f;
#pragma unroll
            for (int j4 = 0; j4 < i; j4 += 4) { const f32x4 av = *(const LAS f32x4*)(Ab + i * 64 + j4);
                a0 -= av.x * t[j4]; if (j4 + 1 < i) a1 -= av.y * t[j4 + 1]; if (j4 + 2 < i) a2 -= av.z * t[j4 + 2]; if (j4 + 3 < i) a3 -= av.w * t[j4 + 3]; }
            t[i] = (a0 + a1) + (a2 + a3);
            if ((i & 3) == 3) asm volatile("" ::: "memory");
        }
        LAS float* Tb = (LAS float*)(L + G_AF) + (16 * q) * 64 + 16 * q;
#pragma unroll
        for (int i = 0; i < 16; ++i) Tb[i * 64 + col] = t[i];
    }
    __syncthreads();
    if (wv < 2) {
        LAS float* AF = (LAS float*)(L + G_AF) + (32 * wv) * 64 + 32 * wv; LAS float* X1 = (LAS float*)(L + G_T1) + 1024 + 256 * wv;
        const int fr = lane & 15, fq = lane >> 4;
        f32x4 acc = (f32x4){0.f, 0.f, 0.f, 0.f};
#pragma unroll
        for (int kk = 0; kk < 4; ++kk) { const float av = AF[(16 + fr) * 64 + 4 * kk + fq], bv = AF[(4 * kk + fq) * 64 + fr]; acc = __builtin_amdgcn_mfma_f32_16x16x4f32(av, bv, acc, 0, 0, 0); }
#pragma unroll
        for (int r = 0; r < 4; ++r) X1[(4 * fq + r) * 16 + fr] = acc[r];
        acc = (f32x4){0.f, 0.f, 0.f, 0.f};
#pragma unroll
        for (int kk = 0; kk < 4; ++kk) { const float av = AF[(16 + fr) * 64 + 16 + 4 * kk + fq], bv = X1[(4 * kk + fq) * 16 + fr]; acc = __builtin_amdgcn_mfma_f32_16x16x4f32(av, bv, acc, 0, 0, 0); }
#pragma unroll
        for (int r = 0; r < 4; ++r) AF[(16 + 4 * fq + r) * 64 + fr] = -acc[r];
    }
    __syncthreads();
    if constexpr (GP_CUT == 3) return;
    {
        LAS float* AF = (LAS float*)(L + G_AF); LAS float* XF = (LAS float*)(L + G_T1);
        const int mi2 = wv & 1, nj2 = (wv >> 1) & 1, fr = lane & 15, fq = lane >> 4;
        if (wv < 4) {
            f32x4 acc = (f32x4){0.f, 0.f, 0.f, 0.f};
#pragma unroll
            for (int kk = 0; kk < 8; ++kk) { const float av = AF[(32 + 16 * mi2 + fr) * 64 + 4 * kk + fq], bv = AF[(4 * kk + fq) * 64 + 16 * nj2 + fr]; acc = __builtin_amdgcn_mfma_f32_16x16x4f32(av, bv, acc, 0, 0, 0); }
#pragma unroll
            for (int r = 0; r < 4; ++r) XF[(16 * mi2 + 4 * fq + r) * 32 + 16 * nj2 + fr] = acc[r];
        }
        __syncthreads();
        if (wv < 4) {
            f32x4 acc = (f32x4){0.f, 0.f, 0.f, 0.f};
#pragma unroll
            for (int kk = 0; kk < 8; ++kk) { const float av = AF[(32 + 16 * mi2 + fr) * 64 + 32 + 4 * kk + fq], bv = XF[(4 * kk + fq) * 32 + 16 * nj2 + fr]; acc = __builtin_amdgcn_mfma_f32_16x16x4f32(av, bv, acc, 0, 0, 0); }
#pragma unroll
            for (int r = 0; r < 4; ++r) AF[(32 + 16 * mi2 + 4 * fq + r) * 64 + 16 * nj2 + fr] = -acc[r];
        }
        __syncthreads();
    }
    if constexpr (GP_CUT == 4) return;
    {
        const int i = tid >> 3, c8 = tid & 7; const LAS float* AF = (const LAS float*)(L + G_AF);
        const f32x4 t0 = *(const LAS f32x4*)(AF + i * 64 + 8 * c8), t1 = *(const LAS f32x4*)(AF + i * 64 + 8 * c8 + 4);
        float a1[8], a2[8];
#pragma unroll
        for (int e = 0; e < 8; ++e) { const float tv = e < 4 ? t0[e] : t1[e - 4]; const int j = 8 * c8 + e; a1[e] = tv * VB[j]; a2[e] = a1[e] * VEG[j]; }
        __syncthreads();
        *(LAS bf16x8*)(L + G_T1 + t128(i, 8 * c8)) = pack8(a1); *(LAS bf16x8*)(L + G_T2 + t128(i, 8 * c8)) = pack8(a2);
    }
    __syncthreads();
    if constexpr (GP_CUT == 5) return;
    {
        const int nd = wv, fr = lane & 15, fq = lane >> 4;
#pragma unroll
        for (int prod = 0; prod < 2; ++prod) {
            bf16x8 bfr[2];
#pragma unroll
            for (int ks = 0; ks < 2; ++ks) bfr[ks] = *(LAS bf16x8*)(L + (prod ? G_KT : G_VT) + t128(16 * nd + fr, 32 * ks + 8 * fq));
#pragma unroll
            for (int mi = 0; mi < 4; ++mi) {
                f32x4 acc = (f32x4){0.f, 0.f, 0.f, 0.f};
#pragma unroll
                for (int ks = 0; ks < 2; ++ks) { const bf16x8 af = *(LAS bf16x8*)(L + (prod ? G_T2 : G_T1) + t128(16 * mi + fr, 32 * ks + 8 * fq)); acc = MFMA16(af, bfr[ks], acc); }
                v2u o; o.x = pk2(acc[0], acc[1]); o.y = pk2(acc[2], acc[3]);
                *(LAS v2u*)(L + (prod ? G_WKT : G_WVT) + t128(16 * nd + fr, 16 * mi + 4 * fq)) = o;
            }
        }
    }
    __syncthreads();
    if constexpr (GP_CUT == 6) return;
    {
        const int nd = wv, fr = lane & 15, fq = lane >> 4;
        bf16x8 bk[2], bv[2];
#pragma unroll
        for (int ks = 0; ks < 2; ++ks) { bk[ks] = *(LAS bf16x8*)(L + G_WKT + t128(16 * nd + fr, 32 * ks + 8 * fq)); bv[ks] = *(LAS bf16x8*)(L + G_WVT + t128(16 * nd + fr, 32 * ks + 8 * fq)); }
        bf16* QT = (bf16*)(F.ws + WS_QT) + (size_t)u * 64 * 128; bf16* OL = (bf16*)(F.ws + WS_OL) + (size_t)u * 8192;
#pragma unroll
        for (int mi = 0; mi < 4; ++mi) {
            f32x4 ak = (f32x4){0.f, 0.f, 0.f, 0.f}, av = (f32x4){0.f, 0.f, 0.f, 0.f};
#pragma unroll
            for (int ks = 0; ks < 2; ++ks) { const bf16x8 af = *(LAS bf16x8*)(L + G_AT + t128(16 * mi + fr, 32 * ks + 8 * fq)); ak = MFMA16(af, bk[ks], ak); av = MFMA16(af, bv[ks], av); }
#pragma unroll
            for (int r = 0; r < 4; ++r) { const int i = 16 * mi + 4 * fq + r, d = 16 * nd + fr;
                const float qv = bf2f(*(LAS bf16*)(L + G_QN + t256(i, d)));
                QT[(((mi * 4 + (nd >> 1)) * 64) + (4 * fq + r) + 16 * (2 * (nd & 1) + (fr >> 3))) * 8 + (fr & 7)] = (bf16)f2bf(VEG[i] * qv - ak[r]);
                }
            { v2u o; o.x = pk2(av[0], av[1]); o.y = pk2(av[2], av[3]); *(GAS v2u*)(OL + ((nd * 4 + mi) * 64 + lane) * 4) = o; }
        }
    }
    if constexpr (GP_CUT == 7) return;
    {
        const int fr = lane & 15, fq = lane >> 4;
        bf16x8 kd[2];
#pragma unroll
        for (int ks = 0; ks < 2; ++ks) { const v4u raw = *(LAS v4u*)(L + G_KT + t128(16 * wv + fr, 32 * ks + 8 * fq)); const int i0 = 32 * ks + 8 * fq; float f[8];
            f[0] = bflo(raw.x) * VEGL[i0]; f[1] = bfhi(raw.x) * VEGL[i0 + 1]; f[2] = bflo(raw.y) * VEGL[i0 + 2]; f[3] = bfhi(raw.y) * VEGL[i0 + 3];
            f[4] = bflo(raw.z) * VEGL[i0 + 4]; f[5] = bfhi(raw.z) * VEGL[i0 + 5]; f[6] = bflo(raw.w) * VEGL[i0 + 6]; f[7] = bfhi(raw.w) * VEGL[i0 + 7]; kd[ks] = pack8(f); }
        bf16* PP = (bf16*)(F.ws + WS_PP) + (size_t)u * 128 * 128; bf16* RT = (bf16*)(F.ws + WS_RT) + (size_t)u * 128 * 128;
#pragma unroll 2
        for (int nd = 0; nd < 8; ++nd) {
            f32x4 ar = (f32x4){0.f, 0.f, 0.f, 0.f}, ap = (f32x4){0.f, 0.f, 0.f, 0.f};
#pragma unroll
            for (int ks = 0; ks < 2; ++ks) { const bf16x8 wvf = *(LAS bf16x8*)(L + G_WVT + t128(16 * nd + fr, 32 * ks + 8 * fq)), wkf = *(LAS bf16x8*)(L + G_WKT + t128(16 * nd + fr, 32 * ks + 8 * fq));
                ar = MFMA16(kd[ks], wvf, ar); ap = MFMA16(wkf, kd[ks], ap); }
            v2u o; o.x = pk2(ar[0], ar[1]); o.y = pk2(ar[2], ar[3]); *(GAS v2u*)(RT + (size_t)((nd * 8 + wv) * 64 + lane) * 4) = o;
            o.x = pk2(ap[0], ap[1]); o.y = pk2(ap[2], ap[3]); *(GAS v2u*)(PP + (size_t)(((wv * 4 + (nd >> 1)) * 64) + fr + 16 * (2 * (nd & 1) + (fq >> 1))) * 8 + 4 * (fq & 1)) = o;
        }
    }
    __syncthreads();
}

struct ChainSet { v4u ap[4], aq[4]; v2u rr, ol; float eg; };
constexpr int CH_O = 2 * 16 * S256, CH_S = CH_O + 32 * 4 * 512;
static_assert(CH_S + 32 * 4 * 64 <= LDSCTL_OFF, "chain lds");
struct ChainPtr { const bf16* pp; const bf16* qq; const bf16* rt; const bf16* ol; const float* egl; };
__device__ __forceinline__ void chain_load(ChainSet& s, const ChainPtr& p, int c, bool lowhalf) {
    const bf16* pp = p.pp + (size_t)c * 16384;
#pragma unroll
    for (int ks = 0; ks < 4; ++ks) s.ap[ks] = *(const GAS v4u*)(pp + 512 * ks);
    s.rr = *(const GAS v2u*)(p.rt + (size_t)c * 16384); s.eg = p.egl[c];
    if (lowhalf) {
        const bf16* qq = p.qq + (size_t)c * 8192;
#pragma unroll
        for (int ks = 0; ks < 4; ++ks) s.aq[ks] = *(const GAS v4u*)(qq + 512 * ks);
        s.ol = *(const GAS v2u*)(p.ol + (size_t)c * 8192);
    }
}
template <bool DRY>
__device__ __forceinline__ void gdn_chain(Frame& F, int l, int task) {
    LAS unsigned char* L = F.lds;
    int tid = F.tid; asm volatile("" : "+v"(tid)); const int lane = tid & 63, wv = tid >> 6, fr = lane & 15, fq = lane >> 4;
    const int xcd = task & 7, idx = task >> 3; const int chain = xcd * 4 + (idx >> 3), slab = idx & 7;
    const int b = chain >> 2, h = chain & 3;
    const bf16* PPb = (const bf16*)(F.ws + WS_PP) + (size_t)chain * 32 * 16384; bf16* RTb = (bf16*)(F.ws + WS_RT) + (size_t)chain * 32 * 16384;
    const bf16* QTb = (const bf16*)(F.ws + WS_QT) + (size_t)chain * 32 * 8192;
    bf16* OLb = (bf16*)(F.ws + WS_OL) + (size_t)chain * 32 * 8192;
    float* SSQ = (float*)(F.ws + WS_SSQ);
    const float* EGL = (const float*)(F.ws + WS_EGL) + chain * 32;
    const int row0h = b * SEQ;
    for (int i = F.tid; i < 2 * 16 * S256 / 4; i += NTHR) ((LAS unsigned*)L)[i] = 0u;
    __syncthreads();
    f32x4 S = (f32x4){0.f, 0.f, 0.f, 0.f};
    ChainSet cs[4];
    ChainPtr cp;
    cp.pp = PPb + (size_t)(wv * 4 * 64 + lane) * 8; cp.qq = QTb + (size_t)((wv & 3) * 4 * 64 + lane) * 8;
    cp.rt = RTb + (size_t)((slab * 8 + wv) * 64 + lane) * 4;
    cp.ol = OLb + ((slab * 4 + (wv & 3)) * 64 + lane) * 4; cp.egl = EGL;
    asm volatile("" : "+v"(cp.pp), "+v"(cp.qq), "+v"(cp.rt), "+v"(cp.ol));
    const bool lowhalf = wv < 4;
    chain_load(cs[0], cp, 0, lowhalf); chain_load(cs[1], cp, 1, lowhalf); chain_load(cs[2], cp, 2, lowhalf);
#pragma unroll 1
    for (int c0 = 0; c0 < NCH; c0 += 4) {
#pragma unroll
        for (int s = 0; s < 4; ++s) {
            const int c = c0 + s;
            chain_load(cs[(s + 3) & 3], cp, c + 3 < NCH ? c + 3 : NCH - 1, lowhalf);
            const ChainSet& q = cs[s];
            const LAS unsigned char* St = L + (s & 1) * (16 * S256);
            bf16x8 bs[4];
#pragma unroll
            for (int ks = 0; ks < 4; ++ks) bs[ks] = *(const LAS bf16x8*)(St + t256(fr, 32 * ks + 8 * fq));
            f32x4 acc = (f32x4){0.f, 0.f, 0.f, 0.f};
#pragma unroll
            for (int ks = 0; ks < 4; ++ks) acc = MFMA16(__builtin_bit_cast(bf16x8, q.ap[ks]), bs[ks], acc);
            if (lowhalf) {
                f32x4 ao = (f32x4){0.f, 0.f, 0.f, 0.f};
#pragma unroll
                for (int ks = 0; ks < 4; ++ks) ao = MFMA16(__builtin_bit_cast(bf16x8, q.aq[ks]), bs[ks], ao);
                const float o0 = ao[0] + bflo(q.ol.x), o1 = ao[1] + bfhi(q.ol.x), o2 = ao[2] + bflo(q.ol.y), o3 = ao[3] + bfhi(q.ol.y);
                v2u ov; ov.x = pk2(o0, o1); ov.y = pk2(o2, o3);
                f32x4 ss = (f32x4){o0 * o0, o1 * o1, o2 * o2, o3 * o3};
#pragma unroll
                for (int sh = 1; sh < 16; sh <<= 1) { ss[0] += __shfl_xor(ss[0], sh); ss[1] += __shfl_xor(ss[1], sh); ss[2] += __shfl_xor(ss[2], sh); ss[3] += __shfl_xor(ss[3], sh); }
                {
                    *(LAS v2u*)(L + CH_O + ((c * 4 + wv) * 64 + lane) * 8) = ov;
                    if (fr == 0) *(LAS f32x4*)(L + CH_S + ((c * 4 + wv) * 4 + fq) * 16) = ss;
                }
            }
            S[0] = q.eg * S[0] - acc[0] + bflo(q.rr.x); S[1] = q.eg * S[1] - acc[1] + bfhi(q.rr.x); S[2] = q.eg * S[2] - acc[2] + bflo(q.rr.y); S[3] = q.eg * S[3] - acc[3] + bfhi(q.rr.y);
            v2u o2; o2.x = pk2(S[0], S[1]); o2.y = pk2(S[2], S[3]);
            *(LAS v2u*)(L + ((s + 1) & 1) * (16 * S256) + t256(fr, 16 * wv + 4 * fq)) = o2;
            asm volatile("s_waitcnt lgkmcnt(0)" ::: "memory"); __builtin_amdgcn_s_barrier(); asm volatile("" ::: "memory");
        }
    }
    if (!DRY) {
        bf16* MXh = (bf16*)(F.ws + WS_X) + 512 + h * HD + 16 * slab;
#if HEADNORM_IN_GEMM
        const bf16* Zh = (const bf16*)(F.ws + WS_P) + PZ + h * HD + 16 * slab + 8 * (tid & 1);
        const float* gwp = F.in[I_GNW] + l * HD + 16 * slab + 8 * (tid & 1);
        const f32x4 w0 = *(const GAS f32x4*)gwp, w1 = *(const GAS f32x4*)(gwp + 4);
#endif
#if HEADNORM_IN_GEMM
        v4u zq[8];
#pragma unroll
        for (int k = 0; k < 8; ++k) { const int i = tid + k * NTHR; zq[k] = *(const GAS v4u*)(Zh + (size_t)(row0h + (i >> 7) * 64 + ((i >> 1) & 63)) * NPJ); }
#pragma unroll
        for (int k = 0; k < 8; ++k) { const int i = tid + k * NTHR; const int half = i & 1, rr = (i >> 1) & 63, cc = i >> 7; const int mi = rr >> 4, fq2 = (rr >> 2) & 3, r = rr & 3;
#else
        for (int i = tid; i < 32 * 64 * 2; i += NTHR) { const int half = i & 1, rr = (i >> 1) & 63, cc = i >> 7; const int mi = rr >> 4, fq2 = (rr >> 2) & 3, r = rr & 3;
#endif
            unsigned w[4];
#pragma unroll
            for (int e = 0; e < 4; ++e) { const int f0 = 8 * half + 2 * e;
                const unsigned lo = *(const LAS unsigned short*)(L + CH_O + ((cc * 4 + mi) * 64 + fq2 * 16 + f0) * 8 + r * 2), hi = *(const LAS unsigned short*)(L + CH_O + ((cc * 4 + mi) * 64 + fq2 * 16 + f0 + 1) * 8 + r * 2);
                w[e] = lo | (hi << 16); }
#if HEADNORM_IN_GEMM
            const v4u zv = zq[k];
            float y[8];
            y[0] = bflo(w[0]) * w0.x * siluf_(bflo(zv.x)); y[1] = bfhi(w[0]) * w0.y * siluf_(bfhi(zv.x)); y[2] = bflo(w[1]) * w0.z * siluf_(bflo(zv.y)); y[3] = bfhi(w[1]) * w0.w * siluf_(bfhi(zv.y));
            y[4] = bflo(w[2]) * w1.x * siluf_(bflo(zv.z)); y[5] = bfhi(w[2]) * w1.y * siluf_(bfhi(zv.z)); y[6] = bflo(w[3]) * w1.z * siluf_(bflo(zv.w)); y[7] = bfhi(w[3]) * w1.w * siluf_(bfhi(zv.w));
            *(GAS bf16x8*)(MXh + (size_t)(row0h + cc * 64 + rr) * DM + 8 * half) = pack8(y); }
#else
            *(GAS v4u*)(MXh + (size_t)(row0h + cc * 64 + rr) * DM + 8 * half) = (v4u){w[0], w[1], w[2], w[3]}; }
#endif
        for (int i = tid; i < 32 * 64; i += NTHR) { const int rr = i & 63, cc = i >> 6; const int mi = rr >> 4, fq2 = (rr >> 2) & 3, r = rr & 3;
            SSQ[(size_t)(row0h + cc * 64 + rr) * 32 + h * 8 + slab] = *(const LAS float*)(L + CH_S + ((cc * 4 + mi) * 4 + fq2) * 16 + r * 4); }
        float* So = F.out + O_PGS + (size_t)((l * 8 + b) * 4 + h) * 16384;
#pragma unroll
        for (int r = 0; r < 4; ++r) So[(size_t)(16 * wv + 4 * fq + r) * 128 + 16 * slab + fr] = S[r];
    }
    __syncthreads();
}

__device__ __forceinline__ void gdn_finalize(Frame& F, int l) {
    bf16* MX = (bf16*)(F.ws + WS_X); const bf16* P = (const bf16*)(F.ws + WS_P); const float* SSQ = (const float*)(F.ws + WS_SSQ);
    const int nth = F.G * NTHR;
    for (int it = F.wg * NTHR + F.tid; it < MP * 64; it += nth) {
        const int row = it >> 6, hh = (it >> 4) & 3, ck = it & 15;
        const f32x4 s0 = *(const GAS f32x4*)(SSQ + (size_t)row * 32 + hh * 8), s1 = *(const GAS f32x4*)(SSQ + (size_t)row * 32 + hh * 8 + 4);
        const float rs = frsq(((s0.x + s0.y) + (s0.z + s0.w) + (s1.x + s1.y) + (s1.z + s1.w)) * (1.f / HD) + EPS);
        const v4u ov = *(const GAS v4u*)(MX + (size_t)row * DM + 512 + hh * HD + ck * 8), zv = *(const GAS v4u*)(P + (size_t)row * NPJ + PZ + hh * HD + ck * 8);
        const f32x4 w0 = *(const GAS f32x4*)(F.in[I_GNW] + l * HD + ck * 8), w1 = *(const GAS f32x4*)(F.in[I_GNW] + l * HD + ck * 8 + 4);
        float y[8];
        y[0] = bflo(ov.x) * rs * w0.x * siluf_(bflo(zv.x)); y[1] = bfhi(ov.x) * rs * w0.y * siluf_(bfhi(zv.x)); y[2] = bflo(ov.y) * rs * w0.z * siluf_(bflo(zv.y)); y[3] = bfhi(ov.y) * rs * w0.w * siluf_(bfhi(zv.y));
        y[4] = bflo(ov.z) * rs * w1.x * siluf_(bflo(zv.z)); y[5] = bfhi(ov.z) * rs * w1.y * siluf_(bfhi(zv.z)); y[6] = bflo(ov.w) * rs * w1.z * siluf_(bflo(zv.w)); y[7] = bfhi(ov.w) * rs * w1.w * siluf_(bfhi(zv.w));
        *(GAS bf16x8*)(MX + (size_t)row * DM + 512 + hh * HD + ck * 8) = pack8(y);
    }
}


__device__ __forceinline__ void gdn_sample_load(Frame& F, int l, int task, float (&S)[32]) {
    const int b = task >> 2, h = task & 3, j = F.tid & 127, rq = F.tid >> 7;
    const float* S0 = F.in[I_GS] + (size_t)((l * 128 + b) * 4 + h) * 16384 + (size_t)(32 * rq) * 128 + j;
#pragma unroll
    for (int ii = 0; ii < 32; ++ii) S[ii] = S0[ii * 128];
}
struct GsAux { float cwv[3][4], rv[6]; };
__device__ __forceinline__ void gdn_sample_aux_load(Frame& F, int l, int task, GsAux& a) {
    const int tid = F.tid; const int b = task >> 2, h = task & 3; const int m0 = MP + b * 4;
    const bf16* P = (const bf16*)(F.ws + WS_P);
    {
        const int ch = tid & 127;
#pragma unroll
        for (int ten = 0; ten < 3; ++ten)
#pragma unroll
            for (int jj = 0; jj < 4; ++jj) a.cwv[ten][jj] = F.in[I_GCW][(size_t)(l * 4 + jj) * 1536 + ten * 512 + h * HD + ch];
    }
#pragma unroll
    for (int k6 = 0; k6 < 6; ++k6) { const int idx = tid + k6 * NTHR; const int r = idx / 384, cc = idx % 384, ten = cc >> 7, ch = cc & 127;
        float v = 0.f;
        if (idx < 7 * 384) { if (r < 3) v = F.in[I_GC][(size_t)((l * 128 + b) * 3 + r) * 1536 + ten * 512 + h * HD + ch]; else v = bf2f(P[(size_t)(m0 + r - 3) * NPJ + PQ + ten * 512 + h * HD + ch]); }
        a.rv[k6] = v; }
}
__device__ __forceinline__ void gdn_sample(Frame& F, int l, int task, float (&S)[32], const GsAux& ax) {
    LAS float* L = (LAS float*)F.lds;
    LAS float* RAW = L;
    LAS float* QS = L + 7 * 384;
    LAS float* KS = QS + 512; LAS float* VS = KS + 512; LAS float* OS = VS + 512;
    LAS float* RED = OS + 512;
    LAS float* NRM = RED + 512;
    int tid = F.tid; asm volatile("" : "+v"(tid)); const int lane = tid & 63, wv = tid >> 6;
    const int b = task >> 2, h = task & 3; const int m0 = MP + b * 4;
    const bf16* P = (const bf16*)(F.ws + WS_P); const float* AB = (const float*)(F.ws + WS_AB); bf16* MX = (bf16*)(F.ws + WS_X);
    const int j = tid & 127, rq = tid >> 7;
    float cwv[3][4], gA[4], gB[4];
#pragma unroll
    for (int ten = 0; ten < 3; ++ten)
#pragma unroll
        for (int jj = 0; jj < 4; ++jj) cwv[ten][jj] = ax.cwv[ten][jj];
    const float galog = F.in[I_GALOG][l * 4 + h], dtb = F.in[I_GDTB][l * 4 + h];
#pragma unroll
    for (int t = 0; t < 4; ++t) { gA[t] = AB[(size_t)(m0 + t) * 8 + h]; gB[t] = AB[(size_t)(m0 + t) * 8 + 4 + h]; }
    const float zv = bf2f(P[(size_t)(m0 + (tid >> 7)) * NPJ + PZ + h * HD + (tid & 127)]), gnw = F.in[I_GNW][l * HD + (tid & 127)];
#pragma unroll
    for (int k6 = 0; k6 < 6; ++k6) { const int idx = tid + k6 * NTHR; if (idx < 7 * 384) RAW[idx] = ax.rv[k6]; }
    __syncthreads();
    if (tid < 384) { const int ten = tid >> 7, ch = tid & 127;
#pragma unroll
        for (int j = 0; j < 3; ++j) F.out[O_SGC + (size_t)((l * 128 + b) * 3 + j) * 1536 + ten * 512 + h * HD + ch] = RAW[(4 + j) * 384 + tid]; }
    float cq, ck, cv;
    {
        const int tok = tid >> 7, ch = tid & 127; float r3[3];
#pragma unroll
        for (int ten = 0; ten < 3; ++ten) { float a = 0.f;
#pragma unroll
            for (int j = 0; j < 4; ++j) a += cwv[ten][j] * RAW[(tok + j) * 384 + ten * 128 + ch];
            r3[ten] = siluf_(a); }
        cq = r3[0]; ck = r3[1]; cv = r3[2];
        const float sq = wave_sum(cq * cq), sk = wave_sum(ck * ck);
        if (lane == 0) { NRM[wv * 4] = sq; NRM[wv * 4 + 1] = sk; }
    }
    __syncthreads();
    {
        const int tok = tid >> 7, ch = tid & 127;
        const float sq = NRM[(2 * tok) * 4] + NRM[(2 * tok + 1) * 4], sk = NRM[(2 * tok) * 4 + 1] + NRM[(2 * tok + 1) * 4 + 1];
        QS[tok * 128 + ch] = cq * frsq(sq + EPS) * 0.08838834764831845f; KS[tok * 128 + ch] = ck * frsq(sk + EPS); VS[tok * 128 + ch] = cv;
    }
    __syncthreads();
    float egv[4], bev[4];
    {
        const float al = -__expf(galog);
#pragma unroll
        for (int t = 0; t < 4; ++t) { const float a = gA[t], bb = gB[t]; egv[t] = __expf(al * softplus_fast(a + dtb)); bev[t] = frcp(1.0f + __expf(-bb)); }
    }
#pragma unroll
    for (int t = 0; t < 4; ++t) {
        const float eg = egv[t], be = bev[t];
        float part = 0.f;
#pragma unroll
        for (int ii = 0; ii < 32; ++ii) { S[ii] *= eg; part += S[ii] * KS[t * 128 + 32 * rq + ii]; }
        RED[rq * 128 + j] = part;
        __syncthreads();
        const float vn = be * (VS[t * 128 + j] - (RED[j] + RED[128 + j] + RED[256 + j] + RED[384 + j]));
        __syncthreads();
        part = 0.f;
#pragma unroll
        for (int ii = 0; ii < 32; ++ii) { S[ii] += KS[t * 128 + 32 * rq + ii] * vn; part += S[ii] * QS[t * 128 + 32 * rq + ii]; }
        RED[rq * 128 + j] = part;
        __syncthreads();
        if (rq == 0) OS[t * 128 + j] = RED[j] + RED[128 + j] + RED[256 + j] + RED[384 + j];
        __syncthreads();
    }
    float* So = F.out + O_SGS + (size_t)((l * 128 + b) * 4 + h) * 16384;
#pragma unroll
    for (int ii = 0; ii < 32; ++ii) So[(size_t)(32 * rq + ii) * 128 + j] = S[ii];
    {
        const int tok = tid >> 7, ch = tid & 127; const float o = OS[tok * 128 + ch];
        const float ss = wave_sum(o * o);
        if (lane == 0) NRM[wv * 4 + 2] = ss;
        __syncthreads();
        const float tot = NRM[(2 * tok) * 4 + 2] + NRM[(2 * tok + 1) * 4 + 2];
        MX[(size_t)(m0 + tok) * DM + 512 + h * HD + ch] = (bf16)f2bf(o * (frsq(tot * (1.f / HD) + EPS)) * gnw * siluf_(zv));
    }
    __syncthreads();
}

struct S5Par { float ar, ai; float bbr[16], bbi[16]; };
__device__ __forceinline__ void s5_params(Frame& F, int l, int g, int p, S5Par& q) {
    const float lr = fminf(F.in[I_LRE][(l * 16 + g) * 64 + p], -1e-4f), li = F.in[I_LIM][(l * 16 + g) * 64 + p];
    const float dt = expf(F.in[I_LDT][l * 16 + g]);
    const float mag = __expf(lr * dt), ph = li * dt; q.ar = mag * __cosf(ph); q.ai = mag * __sinf(ph);
    const float den = lr * lr + li * li;
    const float fr = ((q.ar - 1.0f) * lr + q.ai * li) / den, fi = (q.ai * lr - (q.ar - 1.0f) * li) / den;
    const float* br = F.in[I_BRE] + (size_t)((l * 16 + g) * 64 + p) * 16; const float* bi = F.in[I_BIM] + (size_t)((l * 16 + g) * 64 + p) * 16;
#pragma unroll
    for (int h4 = 0; h4 < 4; ++h4) { const f32x4 r = *(const GAS f32x4*)(br + 4 * h4), i = *(const GAS f32x4*)(bi + 4 * h4);
#pragma unroll
        for (int e = 0; e < 4; ++e) { q.bbr[4 * h4 + e] = fr * r[e] - fi * i[e]; q.bbi[4 * h4 + e] = fr * i[e] + fi * r[e]; } }
}
__device__ __forceinline__ void s5_stage_u(Frame& F, LAS float* U, int m0, int nrows) {
    const bf16* P = (const bf16*)(F.ws + WS_P);
    for (int idx = F.tid; idx < nrows * 32; idx += NTHR) { const int r = idx >> 5, ck = idx & 31;
        const v4u w = *(const GAS v4u*)(P + (size_t)(m0 + r) * NPJ + PU + ck * 8);
        *(LAS f32x4*)(U + r * 256 + ck * 8) = (f32x4){bflo(w.x), bfhi(w.x), bflo(w.y), bfhi(w.y)}; *(LAS f32x4*)(U + r * 256 + ck * 8 + 4) = (f32x4){bflo(w.z), bfhi(w.z), bflo(w.w), bfhi(w.w)}; }
}
__device__ __forceinline__ void s5_step(const S5Par& q, const LAS float* urow, float& xr, float& xi) {
    const f32x4 u0 = *(const LAS f32x4*)urow, u1 = *(const LAS f32x4*)(urow + 4), u2 = *(const LAS f32x4*)(urow + 8), u3 = *(const LAS f32x4*)(urow + 12);
    float br = 0.f, bi = 0.f;
#pragma unroll
    for (int e = 0; e < 4; ++e) { br += q.bbr[e] * u0[e]; bi += q.bbi[e] * u0[e]; br += q.bbr[4 + e] * u1[e]; bi += q.bbi[4 + e] * u1[e]; br += q.bbr[8 + e] * u2[e]; bi += q.bbi[8 + e] * u2[e]; br += q.bbr[12 + e] * u3[e]; bi += q.bbi[12 + e] * u3[e]; }
    const float nr = q.ar * xr - q.ai * xi + br, ni = q.ar * xi + q.ai * xr + bi; xr = nr; xi = ni;
}
__device__ __forceinline__ void s5_pass1(Frame& F, int l, int b, int c) {
    LAS float* U = (LAS float*)F.lds;
    int tid = F.tid; asm volatile("" : "+v"(tid)); const int lane = tid & 63, g0 = 2 * (tid >> 6);
    S5Par q0, q1; s5_params(F, l, g0, lane, q0); s5_params(F, l, g0 + 1, lane, q1);
    s5_stage_u(F, U, b * SEQ + c * 64, 64);
    __syncthreads();
    float* E = (float*)(F.ws + WS_S5E);
    float xr0 = 0.f, xi0 = 0.f, xr1 = 0.f, xi1 = 0.f;
#pragma unroll 4
    for (int t = 0; t < 64; ++t) { s5_step(q0, U + t * 256 + 16 * g0, xr0, xi0); s5_step(q1, U + t * 256 + 16 * g0 + 16, xr1, xi1); }
    E[(size_t)((b * 32 + c) * 16 + g0) * 128 + lane] = xr0; E[(size_t)((b * 32 + c) * 16 + g0) * 128 + 64 + lane] = xi0;
    E[(size_t)((b * 32 + c) * 16 + g0 + 1) * 128 + lane] = xr1; E[(size_t)((b * 32 + c) * 16 + g0 + 1) * 128 + 64 + lane] = xi1;
    __syncthreads();
}
constexpr int S5_U = 0, S5_XT = 65536, S5_YG = S5_XT + 8 * 16 * S256;
static_assert(S5_YG + 64 * S512 <= LDSCTL_OFF, "s5 lds");
template <bool SAMPLE>
__device__ __forceinline__ void s5_pass2(Frame& F, int l, int ua, int ub) {
    LAS unsigned char* L = F.lds; LAS float* U = (LAS float*)(L + S5_U); LAS unsigned char* XT = L + S5_XT + (F.tid >> 6) * (16 * S256); LAS unsigned char* YG = L + S5_YG;
    int tid = F.tid; asm volatile("" : "+v"(tid)); const int lane = tid & 63, wv = tid >> 6, fr = lane & 15, fq = lane >> 4;
    constexpr int NSUB = SAMPLE ? 1 : 4;
    const int m0 = SAMPLE ? MP + 4 * ua : ua * SEQ + ub * 64;
    constexpr int NTT = SAMPLE ? 4 : 16;
    S5Par qq[2]; bf16x8 cbb[2][4]; float dskk[2];
#pragma unroll
    for (int gi = 0; gi < 2; ++gi) {
        const int g = 2 * wv + gi; s5_params(F, l, g, lane, qq[gi]);
        bf16x8 (&cb)[4] = cbb[gi];
#pragma unroll
        for (int ks = 0; ks < 4; ++ks) { const float* src = F.in[ks < 2 ? I_CRE : I_CIM] + (size_t)((l * 16 + g) * 16 + fr) * 64 + 32 * (ks & 1) + 8 * fq;
            const f32x4 c0 = *(const GAS f32x4*)src, c1 = *(const GAS f32x4*)(src + 4); const float sg = ks < 2 ? 1.f : -1.f;
            float f[8] = {sg * c0.x, sg * c0.y, sg * c0.z, sg * c0.w, sg * c1.x, sg * c1.y, sg * c1.z, sg * c1.w}; cb[ks] = pack8(f); }
        dskk[gi] = F.in[I_S5D][l * 256 + 16 * g + fr];
    }
    s5_stage_u(F, U, m0, SAMPLE ? 4 : 64);
    __syncthreads();
    const float* E = (const float*)(F.ws + WS_S5E);
#pragma unroll
    for (int gi = 0; gi < 2; ++gi) {
        const int g = 2 * wv + gi; const S5Par& q = qq[gi]; const bf16x8 (&cb)[4] = cbb[gi];
        const float dsk = dskk[gi];
        float xr = 0.f, xi = 0.f;
        if (!SAMPLE) {
            float pr = q.ar, pi = q.ai;
#pragma unroll
            for (int s = 0; s < 6; ++s) { const float nr = pr * pr - pi * pi, ni = 2.f * pr * pi; pr = nr; pi = ni; }
            float er[31], ei[31];
            const float* Eb = E + (size_t)((ua * 32) * 16 + g) * 128 + lane; asm volatile("" : "+v"(Eb));
#pragma unroll
            for (int cc = 0; cc < 31; ++cc) { er[cc] = Eb[cc * 2048]; ei[cc] = Eb[cc * 2048 + 64]; }
#pragma unroll
            for (int cc = 0; cc < 31; ++cc) { const float nr = pr * xr - pi * xi + er[cc], ni = pr * xi + pi * xr + ei[cc]; xr = cc < ub ? nr : xr; xi = cc < ub ? ni : xi; }
        }
        for (int sub = 0; sub < NSUB; ++sub) {
#pragma unroll
            for (int tt = 0; tt < NTT; ++tt) {
                if (SAMPLE && (tt & 3) == 0) { const int bs = ua; xr = F.in[I_S5RE][(size_t)((l * 128 + bs) * 16 + g) * 64 + lane]; xi = F.in[I_S5IM][(size_t)((l * 128 + bs) * 16 + g) * 64 + lane]; }
                s5_step(q, U + (16 * sub + tt) * 256 + 16 * g, xr, xi);
                *(LAS bf16*)(XT + t256(tt, lane)) = (bf16)f2bf(xr); *(LAS bf16*)(XT + t256(tt, 64 + lane)) = (bf16)f2bf(xi);
                if (SAMPLE && (tt & 3) == 3) { const int bs = ua; F.out[O_SS5RE + (size_t)((l * 128 + bs) * 16 + g) * 64 + lane] = xr; F.out[O_SS5IM + (size_t)((l * 128 + bs) * 16 + g) * 64 + lane] = xi; }
            }
            f32x4 acc = (f32x4){0.f, 0.f, 0.f, 0.f};
#pragma unroll
            for (int ks = 0; ks < 4; ++ks) { const bf16x8 af = *(const LAS bf16x8*)(XT + t256(fr, 32 * ks + 8 * fq)); acc = MFMA16(af, cb[ks], acc); }
#pragma unroll
            for (int r = 0; r < 4; ++r) { const int t = 16 * sub + 4 * fq + r; if (SAMPLE && t >= 4) continue; const float y = acc[r] + dsk * U[t * 256 + 16 * g + fr];
                *(LAS bf16*)(YG + t512(t, 16 * g + fr)) = (bf16)f2bf(gelu_tanh(y)); }
            asm volatile("" ::: "memory");
        }
        if (!SAMPLE && ub == 31) { F.out[O_PS5RE + (size_t)((l * 8 + ua) * 16 + g) * 64 + lane] = xr; F.out[O_PS5IM + (size_t)((l * 8 + ua) * 16 + g) * 64 + lane] = xi; }
    }
    __syncthreads();
    {
        const bf16* WG = (const bf16*)(F.ws + WS_WGLU); bf16* MX = (bf16*)(F.ws + WS_X);
#pragma unroll 1
        for (int ni = 0; ni < 2; ++ni) {
            const int nt = 2 * wv + ni; bf16x8 bw[8];
#pragma unroll
            for (int ks = 0; ks < 8; ++ks) bw[ks] = __builtin_bit_cast(bf16x8, *(const GAS v4u*)(WG + (size_t)(16 * nt + fr) * 256 + 32 * ks + 8 * fq));
            const float bg = F.in[I_BGLU][l * 256 + 16 * nt + fr];
#pragma unroll 1
            for (int mi = 0; mi < NSUB; ++mi) {
                f32x4 acc = (f32x4){0.f, 0.f, 0.f, 0.f};
#pragma unroll
                for (int ks = 0; ks < 8; ++ks) { const bf16x8 af = *(const LAS bf16x8*)(YG + t512(16 * mi + fr, 32 * ks + 8 * fq)); acc = MFMA16(af, bw[ks], acc); }
#pragma unroll
                for (int r = 0; r < 4; ++r) { const int t = 16 * mi + 4 * fq + r; if (SAMPLE && t >= 4) continue; const float yg = bf2f(*(const LAS bf16*)(YG + t512(t, 16 * nt + fr)));
                    MX[(size_t)(m0 + t) * DM + 16 * nt + fr] = (bf16)f2bf(yg * sigmoidf_(acc[r] + bg)); }
            }
        }
    }
    __syncthreads();
}

constexpr int LR_RAW = 0, LR_XC = 73728, LR_AGG = 139264;
struct LruW { float wa[32], wx[32], ba, bx, c8, cb, cw[4]; };
__device__ __forceinline__ void lru_weights(Frame& F, int l, int j, LruW& w) {
    const int blk = j >> 5, jj = j & 31;
#pragma unroll
    for (int i = 0; i < 32; ++i) { w.wa[i] = F.in[I_LWA][(size_t)((l * 8 + blk) * 32 + i) * 32 + jj]; w.wx[i] = F.in[I_LWX][(size_t)((l * 8 + blk) * 32 + i) * 32 + jj]; }
    w.ba = F.in[I_LBA][l * 256 + j]; w.bx = F.in[I_LBX][l * 256 + j]; w.c8 = -8.0f * softplusf_(-F.in[I_LLAM][l * 256 + j]); w.cb = F.in[I_LCB][l * 256 + j];
#pragma unroll
    for (int k = 0; k < 4; ++k) w.cw[k] = F.in[I_LCW][(l * 4 + k) * 256 + j];
}
__device__ __forceinline__ void lru_gate(const LruW& w, const LAS float* xrow, float xown, bool reset, float& a, float& bt) {
    float ra = w.ba, rx = w.bx;
#pragma unroll
    for (int i4 = 0; i4 < 8; ++i4) { const f32x4 xv = *(const LAS f32x4*)(xrow + 4 * i4);
#pragma unroll
        for (int e = 0; e < 4; ++e) { ra += w.wa[4 * i4 + e] * xv[e]; rx += w.wx[4 * i4 + e] * xv[e]; } }
    const float r = sigmoidf_(ra), gi = sigmoidf_(rx);
    const float la = w.c8 * r; a = __expf(la);
    const float mult = reset ? 1.0f : __builtin_amdgcn_sqrtf(fmaxf(1.0f - a * a, 0.f));
    bt = mult * gi * xown;
}
template <int PASS>
__device__ __forceinline__ void lru_pass(Frame& F, int l, int b, int c) {
    LAS float* RAW = (LAS float*)(F.lds + LR_RAW); LAS float* XC = (LAS float*)(F.lds + LR_XC); LAS float* AGG = (LAS float*)(F.lds + LR_AGG);
    int tid = F.tid; asm volatile("" : "+v"(tid)); const int j = tid & 255, hh = tid >> 8; const int row0 = b * SEQ + c * 64;
    const bf16* P = (const bf16*)(F.ws + WS_P); bf16* MX = (bf16*)(F.ws + WS_X); float* LA = (float*)(F.ws + WS_LAGG);
    for (int idx = tid; idx < 67 * 32; idx += NTHR) { const int r = idx >> 5, ck = idx & 31, tt = c * 64 - 3 + r;
        v4u w = (v4u){0u, 0u, 0u, 0u}; if (tt >= 0) w = *(const GAS v4u*)(P + (size_t)(b * SEQ + tt) * NPJ + PXL + ck * 8);
        *(LAS f32x4*)(RAW + r * 256 + ck * 8) = (f32x4){bflo(w.x), bfhi(w.x), bflo(w.y), bfhi(w.y)}; *(LAS f32x4*)(RAW + r * 256 + ck * 8 + 4) = (f32x4){bflo(w.z), bfhi(w.z), bflo(w.w), bfhi(w.w)}; }
    __syncthreads();
    LruW w; lru_weights(F, l, j, w);
    for (int ii = 0; ii < 32; ++ii) { const int i = 32 * hh + ii;
        XC[i * 256 + j] = w.cb + w.cw[0] * RAW[i * 256 + j] + w.cw[1] * RAW[(i + 1) * 256 + j] + w.cw[2] * RAW[(i + 2) * 256 + j] + w.cw[3] * RAW[(i + 3) * 256 + j]; }
    __syncthreads();
    float A = 1.f, B = 0.f; float hl[32], ca[32];
#pragma unroll
    for (int ii = 0; ii < 32; ++ii) { const int i = 32 * hh + ii; float a, bt;
        lru_gate(w, XC + i * 256 + (j & ~31), XC[i * 256 + j], (c == 0 && i == 0), a, bt);
        B = a * B + bt; A *= a; if (PASS == 2) { hl[ii] = B; ca[ii] = A; }
        if (ii & 1) __builtin_amdgcn_sched_barrier(0); }
    if (hh == 0) { AGG[j] = A; AGG[256 + j] = B; }
    __syncthreads();
    if (PASS == 1) {
        if (hh == 1) { const float A0 = AGG[j], B0 = AGG[256 + j]; LA[(size_t)((b * 32 + c) * 2) * 256 + j] = A0 * A; LA[(size_t)((b * 32 + c) * 2 + 1) * 256 + j] = A * B0 + B; }
    } else {
        float H = 0.f;
        {
            float la[31], lb[31];
            const float* Lb = LA + (size_t)(b * 32 * 2) * 256 + j; asm volatile("" : "+v"(Lb));
#pragma unroll
            for (int cc = 0; cc < 31; ++cc) { la[cc] = Lb[cc * 512]; lb[cc] = Lb[cc * 512 + 256]; }
#pragma unroll
            for (int cc = 0; cc < 31; ++cc) { const float nh = la[cc] * H + lb[cc]; H = cc < c ? nh : H; }
        }
        if (hh == 1) H = AGG[j] * H + AGG[256 + j];
#pragma unroll
        for (int ii = 0; ii < 32; ++ii) { const int i = 32 * hh + ii; const float hv = hl[ii] + ca[ii] * H;
            const float gt = bf2f(P[(size_t)(row0 + i) * NPJ + PGL + j]);
            MX[(size_t)(row0 + i) * DM + 256 + j] = (bf16)f2bf(hv * gelu_tanh(gt));
            if (c == 31 && hh == 1 && ii == 31) F.out[O_PLRUH + (size_t)(l * 8 + b) * 256 + j] = hv; }
        if (c == 31 && hh == 0) {
#pragma unroll
            for (int k = 0; k < 3; ++k) F.out[O_PLRUC + (size_t)((l * 8 + b) * 3 + k) * 256 + j] = RAW[(64 + k) * 256 + j]; }
    }
    __syncthreads();
}
__device__ __forceinline__ void lru_sample(Frame& F, int l, int q) {
    LAS float* XC = (LAS float*)F.lds;
    int tid = F.tid; asm volatile("" : "+v"(tid)); const int j = tid & 255, hh = tid >> 8;
    const bf16* P = (const bf16*)(F.ws + WS_P); bf16* MX = (bf16*)(F.ws + WS_X);
    LruW w; const int bs = q;
    if (hh == 0) {
        lru_weights(F, l, j, w);
        float r[7];
#pragma unroll
        for (int k = 0; k < 3; ++k) r[k] = F.in[I_LRUC][(size_t)((l * 128 + bs) * 3 + k) * 256 + j];
#pragma unroll
        for (int t = 0; t < 4; ++t) r[3 + t] = bf2f(P[(size_t)(MP + bs * 4 + t) * NPJ + PXL + j]);
#pragma unroll
        for (int t = 0; t < 4; ++t) XC[t * 256 + j] = w.cb + w.cw[0] * r[t] + w.cw[1] * r[t + 1] + w.cw[2] * r[t + 2] + w.cw[3] * r[t + 3];
#pragma unroll
        for (int k = 0; k < 3; ++k) F.out[O_SLRUC + (size_t)((l * 128 + bs) * 3 + k) * 256 + j] = r[4 + k];
    }
    float H = 0.f, gtv[4] = {0.f, 0.f, 0.f, 0.f};
    if (hh == 0) {
        H = F.in[I_LRUH][(size_t)(l * 128 + bs) * 256 + j];
#pragma unroll
        for (int t = 0; t < 4; ++t) gtv[t] = bf2f(P[(size_t)(MP + bs * 4 + t) * NPJ + PGL + j]);
    }
    __syncthreads();
    if (hh == 0) {
#pragma unroll
        for (int t = 0; t < 4; ++t) { float a, bt;
            lru_gate(w, XC + t * 256 + (j & ~31), XC[t * 256 + j], false, a, bt); H = a * H + bt;
            const float gt = gtv[t];
            MX[(size_t)(MP + bs * 4 + t) * DM + 256 + j] = (bf16)f2bf(H * gelu_tanh(gt)); }
        F.out[O_SLRUH + (size_t)(l * 128 + bs) * 256 + j] = H;
    }
    __syncthreads();
}

constexpr int S5M_U = 0, S5M_XT = 64 * S512, S5M_YG = S5M_XT + 8 * 16 * S256;
static_assert(S5M_YG + 64 * S512 <= LDSCTL_OFF, "s5m lds");
__device__ __forceinline__ void cmul_acc(float ar, float ai, float br, float bi, float& cr, float& ci) { cr += ar * br - ai * bi; ci += ar * bi + ai * br; }
struct S5Stage { v4u su[4]; };
__device__ __forceinline__ void s5m_stage_load(Frame& F, int m0, S5Stage& st) {
    const bf16* P = (const bf16*)(F.ws + WS_P);
#pragma unroll
    for (int k = 0; k < 4; ++k) { const int idx = F.tid + k * NTHR; const int r = idx >> 5, ck = idx & 31; st.su[k] = *(const GAS v4u*)(P + (size_t)(m0 + r) * NPJ + PU + ck * 8); }
}
struct NoHook { __device__ __forceinline__ void operator()() const {} };
template <int MODE, bool PRE = false, class Hook = NoHook>
__device__ __forceinline__ void s5m_unit(Frame& F, int l, int ua, int ub, const S5Stage* pre = nullptr, const Hook& hook = Hook()) {
    LAS unsigned char* L = F.lds;
    int tid = F.tid; asm volatile("" : "+v"(tid)); const int lane = tid & 63, wv = tid >> 6, fr = lane & 15, fq = lane >> 4;
    LAS unsigned char* U16 = L + S5M_U; LAS unsigned char* XT = L + S5M_XT + wv * (16 * S256); LAS float* SCR = (LAS float*)XT; LAS unsigned char* YG = L + S5M_YG;
    constexpr bool SAMPLE = MODE == 3; constexpr int NSUB = SAMPLE ? 1 : 4;
    const int m0 = SAMPLE ? MP + 4 * ua : ua * SEQ + ub * 64;
    { const bf16* P = (const bf16*)(F.ws + WS_P); constexpr int nrows = SAMPLE ? 4 : 64; constexpr int NK = (nrows * 32 + NTHR - 1) / NTHR;
      v4u su[NK];
#pragma unroll
      for (int k = 0; k < NK; ++k) { const int idx = tid + k * NTHR; const int r = idx >> 5, ck = idx & 31; if (PRE) su[k] = pre->su[k]; else if (idx < nrows * 32) su[k] = *(const GAS v4u*)(P + (size_t)(m0 + r) * NPJ + PU + ck * 8); }
#pragma unroll
      for (int k = 0; k < NK; ++k) { const int idx = tid + k * NTHR; const int r = idx >> 5, ck = idx & 31; if (idx < nrows * 32) *(LAS v4u*)(U16 + r * S512 + ck * 16) = su[k]; } }
    __syncthreads();
    float* Eo = (float*)(F.ws + WS_S5E);
#pragma unroll 1
    for (int gi = 0; gi < 2; ++gi) {
        const int g = 2 * wv + gi;
        S5Par q; s5_params(F, l, g, lane, q);
        bf16x8 bfrag[8];
#pragma unroll
        for (int part = 0; part < 2; ++part) {
#pragma unroll
            for (int h4 = 0; h4 < 4; ++h4) *(LAS f32x4*)(SCR + lane * 16 + 4 * h4) = part == 0 ? (f32x4){q.bbr[4 * h4], q.bbr[4 * h4 + 1], q.bbr[4 * h4 + 2], q.bbr[4 * h4 + 3]} : (f32x4){q.bbi[4 * h4], q.bbi[4 * h4 + 1], q.bbi[4 * h4 + 2], q.bbi[4 * h4 + 3]};
#pragma unroll
            for (int nt = 0; nt < 4; ++nt) { const LAS float* src = SCR + (16 * nt + fr) * 16 + 8 * (fq & 1);
                const f32x4 v0 = *(const LAS f32x4*)src, v1 = *(const LAS f32x4*)(src + 4); float f[8] = {v0.x, v0.y, v0.z, v0.w, v1.x, v1.y, v1.z, v1.w};
                if (fq >= 2) {
#pragma unroll
                    for (int e = 0; e < 8; ++e) f[e] = f[e] - bf2f(f2bf(f[e]));
                }
                bfrag[4 * part + nt] = pack8(f); }
        }
        float l1r[4], l1i[4], xinr[4], xini[4];
        *(LAS f32x2_t*)(SCR + lane * 2) = (f32x2_t){q.ar, q.ai};
        if (MODE == 2) {
            float pr = q.ar, pi = q.ai;
#pragma unroll
            for (int s = 0; s < 6; ++s) { const float nr = pr * pr - pi * pi, ni = 2.f * pr * pi; pr = nr; pi = ni; }
            float er[31], ei[31];
            const float* Eb = Eo + (size_t)((ua * 32) * 16 + g) * 128 + lane; asm volatile("" : "+v"(Eb));
#pragma unroll
            for (int cc = 0; cc < 31; ++cc) { er[cc] = Eb[cc * 2048]; ei[cc] = Eb[cc * 2048 + 64]; }
            float xr = 0.f, xi = 0.f;
#pragma unroll
            for (int cc = 0; cc < 31; ++cc) { const float nr = pr * xr - pi * xi + er[cc], ni = pr * xi + pi * xr + ei[cc]; xr = cc < ub ? nr : xr; xi = cc < ub ? ni : xi; }
            *(LAS f32x2_t*)(SCR + 128 + lane * 2) = (f32x2_t){xr, xi};
        }
#pragma unroll
        for (int s = 0; s < 4; ++s) { const f32x2_t lv = *(const LAS f32x2_t*)(SCR + (16 * s + fr) * 2); l1r[s] = lv.x; l1i[s] = lv.y;
            if (MODE == 2) { const f32x2_t xv = *(const LAS f32x2_t*)(SCR + 128 + (16 * s + fr) * 2); xinr[s] = xv.x; xini[s] = xv.y; }
            else if (MODE == 3) { xinr[s] = F.in[I_S5RE][(size_t)((l * 128 + ua) * 16 + g) * 64 + 16 * s + fr]; xini[s] = F.in[I_S5IM][(size_t)((l * 128 + ua) * 16 + g) * 64 + 16 * s + fr]; }
            else { xinr[s] = 0.f; xini[s] = 0.f; } }
        float l2r[4], l2i[4], l3r[4], l3i[4], l4r[4], l4i[4], l8r[4], l8i[4], lpr[4], lpi[4];
#pragma unroll
        for (int s = 0; s < 4; ++s) {
            l2r[s] = l1r[s] * l1r[s] - l1i[s] * l1i[s]; l2i[s] = 2.f * l1r[s] * l1i[s];
            l3r[s] = l2r[s] * l1r[s] - l2i[s] * l1i[s]; l3i[s] = l2r[s] * l1i[s] + l2i[s] * l1r[s];
            l4r[s] = l2r[s] * l2r[s] - l2i[s] * l2i[s]; l4i[s] = 2.f * l2r[s] * l2i[s];
            l8r[s] = l4r[s] * l4r[s] - l4i[s] * l4i[s]; l8i[s] = 2.f * l4r[s] * l4i[s];
            const float l12r = l8r[s] * l4r[s] - l8i[s] * l4i[s], l12i = l8r[s] * l4i[s] + l8i[s] * l4r[s];
            lpr[s] = fq == 0 ? 1.f : fq == 1 ? l4r[s] : fq == 2 ? l8r[s] : l12r; lpi[s] = fq == 0 ? 0.f : fq == 1 ? l4i[s] : fq == 2 ? l8i[s] : l12i;
        }
        bf16x8 cb[4]; float dsk = 0.f;
        if (MODE != 1) {
#pragma unroll
            for (int ks = 0; ks < 4; ++ks) { const float* src = F.in[ks < 2 ? I_CRE : I_CIM] + (size_t)((l * 16 + g) * 16 + fr) * 64 + 32 * (ks & 1) + 8 * fq;
                const f32x4 c0 = *(const GAS f32x4*)src, c1 = *(const GAS f32x4*)(src + 4); const float sg = ks < 2 ? 1.f : -1.f;
                float f[8] = {sg * c0.x, sg * c0.y, sg * c0.z, sg * c0.w, sg * c1.x, sg * c1.y, sg * c1.z, sg * c1.w}; cb[ks] = pack8(f); }
            dsk = F.in[I_S5D][l * 256 + 16 * g + fr];
        }
#pragma unroll 1
        for (int sub = 0; sub < NSUB; ++sub) {
            const bf16x8 au = *(const LAS bf16x8*)(U16 + (16 * sub + fr) * S512 + (16 * g + 8 * (fq & 1)) * 2);
            f32x4 d[8];
#pragma unroll
            for (int nt = 0; nt < 8; ++nt) d[nt] = MFMA16(au, bfrag[nt], ((f32x4){0.f, 0.f, 0.f, 0.f}));
            float Lr[4][4], Li[4][4], Er[4], Ei[4];
#pragma unroll
            for (int s = 0; s < 4; ++s) {
                Lr[s][0] = d[s][0]; Li[s][0] = d[4 + s][0];
#pragma unroll
                for (int r = 1; r < 4; ++r) { Lr[s][r] = d[s][r]; Li[s][r] = d[4 + s][r]; cmul_acc(l1r[s], l1i[s], Lr[s][r - 1], Li[s][r - 1], Lr[s][r], Li[s][r]); }
                Er[s] = Lr[s][3]; Ei[s] = Li[s][3];
            }
            {
                float pr_[4], pi_[4];
#pragma unroll
                for (int s = 0; s < 4; ++s) { pr_[s] = __shfl_up(Er[s], 16); pi_[s] = __shfl_up(Ei[s], 16); }
#pragma unroll
                for (int s = 0; s < 4; ++s) { float ar_ = 0.f, ai_ = 0.f; cmul_acc(l4r[s], l4i[s], pr_[s], pi_[s], ar_, ai_); if (fq >= 1) { Er[s] += ar_; Ei[s] += ai_; } }
#pragma unroll
                for (int s = 0; s < 4; ++s) { pr_[s] = __shfl_up(Er[s], 32); pi_[s] = __shfl_up(Ei[s], 32); }
#pragma unroll
                for (int s = 0; s < 4; ++s) { float ar_ = 0.f, ai_ = 0.f; cmul_acc(l8r[s], l8i[s], pr_[s], pi_[s], ar_, ai_); if (fq >= 2) { Er[s] += ar_; Ei[s] += ai_; } }
#pragma unroll
                for (int s = 0; s < 4; ++s) { pr_[s] = __shfl_up(Er[s], 16); pi_[s] = __shfl_up(Ei[s], 16); }
#pragma unroll
                for (int s = 0; s < 4; ++s) { float xr = fq >= 1 ? pr_[s] : 0.f, xi = fq >= 1 ? pi_[s] : 0.f; cmul_acc(lpr[s], lpi[s], xinr[s], xini[s], xr, xi); Er[s] = xr; Ei[s] = xi; }
            }
#pragma unroll
            for (int s = 0; s < 4; ++s) {
                cmul_acc(l1r[s], l1i[s], Er[s], Ei[s], Lr[s][0], Li[s][0]); cmul_acc(l2r[s], l2i[s], Er[s], Ei[s], Lr[s][1], Li[s][1]);
                cmul_acc(l3r[s], l3i[s], Er[s], Ei[s], Lr[s][2], Li[s][2]); cmul_acc(l4r[s], l4i[s], Er[s], Ei[s], Lr[s][3], Li[s][3]);
            }
#pragma unroll
            for (int s = 0; s < 4; ++s) { xinr[s] = __shfl(Lr[s][3], fr + (SAMPLE ? 0 : 48)); xini[s] = __shfl(Li[s][3], fr + (SAMPLE ? 0 : 48)); }
            if (MODE != 1) {
#pragma unroll
                for (int s = 0; s < 4; ++s)
#pragma unroll
                    for (int r = 0; r < 4; ++r) { *(LAS bf16*)(XT + t256(4 * fq + r, 16 * s + fr)) = (bf16)f2bf(Lr[s][r]); *(LAS bf16*)(XT + t256(4 * fq + r, 64 + 16 * s + fr)) = (bf16)f2bf(Li[s][r]); }
                f32x4 acc = (f32x4){0.f, 0.f, 0.f, 0.f};
#pragma unroll
                for (int ks = 0; ks < 4; ++ks) { const bf16x8 af = *(const LAS bf16x8*)(XT + t256(fr, 32 * ks + 8 * fq)); acc = MFMA16(af, cb[ks], acc); }
#pragma unroll
                for (int r = 0; r < 4; ++r) { const int t = 16 * sub + 4 * fq + r; if (SAMPLE && t >= 4) continue;
                    const float y = acc[r] + dsk * bf2f(*(const LAS bf16*)(U16 + t * S512 + (16 * g + fr) * 2));
                    *(LAS bf16*)(YG + t512(t, 16 * g + fr)) = (bf16)f2bf(gelu_tanh(y)); }
                asm volatile("" ::: "memory");
            }
        }
        if (MODE == 1 && gi == 0) hook();
        if (fq == 0) {
#pragma unroll
            for (int s = 0; s < 4; ++s) { const int p = 16 * s + fr;
                if (MODE == 1) { Eo[(size_t)((ua * 32 + ub) * 16 + g) * 128 + p] = xinr[s]; Eo[(size_t)((ua * 32 + ub) * 16 + g) * 128 + 64 + p] = xini[s]; }
                if (MODE == 2 && ub == 31) { F.out[O_PS5RE + (size_t)((l * 8 + ua) * 16 + g) * 64 + p] = xinr[s]; F.out[O_PS5IM + (size_t)((l * 8 + ua) * 16 + g) * 64 + p] = xini[s]; }
                if (MODE == 3) { F.out[O_SS5RE + (size_t)((l * 128 + ua) * 16 + g) * 64 + p] = xinr[s]; F.out[O_SS5IM + (size_t)((l * 128 + ua) * 16 + g) * 64 + p] = xini[s]; } }
        }
    }
    if (MODE != 1) hook();
    bf16x8 bwA[8], bwB[8]; float bgA = 0.f, bgB = 0.f;
    if (MODE != 1) {
        const bf16* WG = (const bf16*)(F.ws + WS_WGLU);
#pragma unroll
        for (int ks = 0; ks < 8; ++ks) { bwA[ks] = __builtin_bit_cast(bf16x8, *(const GAS v4u*)(WG + (size_t)(16 * (2 * wv) + fr) * 256 + 32 * ks + 8 * fq)); bwB[ks] = __builtin_bit_cast(bf16x8, *(const GAS v4u*)(WG + (size_t)(16 * (2 * wv + 1) + fr) * 256 + 32 * ks + 8 * fq)); }
        bgA = F.in[I_BGLU][l * 256 + 16 * (2 * wv) + fr]; bgB = F.in[I_BGLU][l * 256 + 16 * (2 * wv + 1) + fr];
    }
    __syncthreads();
    if (MODE != 1) {
        bf16* MX = (bf16*)(F.ws + WS_X);
        auto glu_block = [&](const bf16x8 (&bw)[8], const float bg, const int nt) {
#pragma unroll 1
            for (int mi = 0; mi < NSUB; ++mi) {
                f32x4 acc = (f32x4){0.f, 0.f, 0.f, 0.f};
#pragma unroll
                for (int ks = 0; ks < 8; ++ks) { const bf16x8 af = *(const LAS bf16x8*)(YG + t512(16 * mi + fr, 32 * ks + 8 * fq)); acc = MFMA16(af, bw[ks], acc); }
#pragma unroll
                for (int r = 0; r < 4; ++r) { const int t = 16 * mi + 4 * fq + r; if (SAMPLE && t >= 4) continue; const float yg = bf2f(*(const LAS bf16*)(YG + t512(t, 16 * nt + fr)));
                    MX[(size_t)(m0 + t) * DM + 16 * nt + fr] = (bf16)f2bf(yg * sigmoidf_(acc[r] + bg)); }
            }
        };
        glu_block(bwA, bgA, 2 * wv); glu_block(bwB, bgB, 2 * wv + 1);
        __syncthreads();
    }
}


constexpr int LM_RAW = 0, LM_XCB = 69632, LM_GT = LM_XCB + 64 * S512;
static_assert(LM_GT + 64 * S512 <= LDSCTL_OFF && 67 * 1024 <= LM_XCB, "lru mfma lds");
struct LruStage { v4u sw[5], sg[4]; };
template <int PASS>
__device__ __forceinline__ void lrum_stage_load(Frame& F, int b, int c, LruStage& st) {
    const bf16* P = (const bf16*)(F.ws + WS_P); const int row0 = b * SEQ + c * 64;
#pragma unroll
    for (int k5 = 0; k5 < 5; ++k5) { const int idx = F.tid + k5 * NTHR; const int r = idx >> 5, ck = idx & 31, tt = c * 64 - 3 + r;
        st.sw[k5] = (v4u){0u, 0u, 0u, 0u}; if (idx < 67 * 32 && tt >= 0) st.sw[k5] = *(const GAS v4u*)(P + (size_t)(b * SEQ + tt) * NPJ + PXL + ck * 8); }
    if (PASS == 2) {
#pragma unroll
        for (int k4 = 0; k4 < 4; ++k4) { const int idx = F.tid + k4 * NTHR; const int r = idx >> 5, ck = idx & 31; st.sg[k4] = *(const GAS v4u*)(P + (size_t)(row0 + r) * NPJ + PGL + ck * 8); }
    }
}
template <int PASS, bool PRE = false>
__device__ __forceinline__ void lrum_pass(Frame& F, int l, int b, int c, const LruStage* pre = nullptr) {
    LAS float* RAW = (LAS float*)(F.lds + LM_RAW); LAS unsigned char* XCB = F.lds + LM_XCB;
    int tid = F.tid; asm volatile("" : "+v"(tid)); const int lane = tid & 63, wv = tid >> 6, fr = lane & 15, fq = lane >> 4;
    const int row0 = b * SEQ + c * 64;
    const bf16* P = (const bf16*)(F.ws + WS_P); bf16* MX = (bf16*)(F.ws + WS_X); float* LA = (float*)(F.ws + WS_LAGG);
    {
        v4u sw[5], sg[4];
        if (PRE) {
#pragma unroll
            for (int k5 = 0; k5 < 5; ++k5) sw[k5] = pre->sw[k5];
            if (PASS == 2) {
#pragma unroll
                for (int k4 = 0; k4 < 4; ++k4) sg[k4] = pre->sg[k4];
            }
        } else {
#pragma unroll
        for (int k5 = 0; k5 < 5; ++k5) { const int idx = tid + k5 * NTHR; const int r = idx >> 5, ck = idx & 31, tt = c * 64 - 3 + r;
            sw[k5] = (v4u){0u, 0u, 0u, 0u}; if (idx < 67 * 32 && tt >= 0) sw[k5] = *(const GAS v4u*)(P + (size_t)(b * SEQ + tt) * NPJ + PXL + ck * 8); }
        if (PASS == 2) {
#pragma unroll
            for (int k4 = 0; k4 < 4; ++k4) { const int idx = tid + k4 * NTHR; const int r = idx >> 5, ck = idx & 31; sg[k4] = *(const GAS v4u*)(P + (size_t)(row0 + r) * NPJ + PGL + ck * 8); }
        }
        }
#pragma unroll
        for (int k5 = 0; k5 < 5; ++k5) { const int idx = tid + k5 * NTHR; const int r = idx >> 5, ck = idx & 31; const v4u w = sw[k5];
            if (idx < 67 * 32) { *(LAS f32x4*)(RAW + r * 256 + ck * 8) = (f32x4){bflo(w.x), bfhi(w.x), bflo(w.y), bfhi(w.y)}; *(LAS f32x4*)(RAW + r * 256 + ck * 8 + 4) = (f32x4){bflo(w.z), bfhi(w.z), bflo(w.w), bfhi(w.w)}; } }
        if (PASS == 2) {
#pragma unroll
            for (int k4 = 0; k4 < 4; ++k4) { const int idx = tid + k4 * NTHR; const int r = idx >> 5, ck = idx & 31; *(LAS v4u*)(F.lds + LM_GT + r * S512 + ck * 16) = sg[k4]; }
        }
    }
    bf16x8 wah[2], wal[2], wxh[2], wxl[2]; float ba[2], bx[2], c8[2];
#pragma unroll
    for (int nt = 0; nt < 2; ++nt) {
        const int jc = 16 * nt + fr; float fa[8], fx[8], ga[8], gx[8];
#pragma unroll
        for (int e = 0; e < 8; ++e) { fa[e] = F.in[I_LWA][(size_t)((l * 8 + wv) * 32 + 8 * fq + e) * 32 + jc]; fx[e] = F.in[I_LWX][(size_t)((l * 8 + wv) * 32 + 8 * fq + e) * 32 + jc]; }
        wah[nt] = pack8(fa); wxh[nt] = pack8(fx);
#pragma unroll
        for (int e = 0; e < 8; ++e) { ga[e] = fa[e] - bf2f(f2bf(fa[e])); gx[e] = fx[e] - bf2f(f2bf(fx[e])); }
        wal[nt] = pack8(ga); wxl[nt] = pack8(gx);
        const int j = 32 * wv + jc; ba[nt] = F.in[I_LBA][l * 256 + j]; bx[nt] = F.in[I_LBX][l * 256 + j]; c8[nt] = -8.0f * softplusf_(-F.in[I_LLAM][l * 256 + j]);
    }
    float Hin[2] = {0.f, 0.f};
    if (PASS == 2) {
        const int js = 32 * wv + 16 * (fq & 1) + fr; float H = 0.f;
        float la[31], lb[31];
        const float* Lb = LA + (size_t)(b * 32 * 2) * 256 + js; asm volatile("" : "+v"(Lb));
#pragma unroll
        for (int cc = 0; cc < 31; ++cc) { la[cc] = Lb[cc * 512]; lb[cc] = Lb[cc * 512 + 256]; }
#pragma unroll
        for (int cc = 0; cc < 31; ++cc) { const float nh = la[cc] * H + lb[cc]; H = cc < c ? nh : H; }
        Hin[0] = __shfl(H, fr); Hin[1] = __shfl(H, fr + 16);
    }
    float cw[4]; const float cb = F.in[I_LCB][l * 256 + (tid & 255)];
#pragma unroll
    for (int k = 0; k < 4; ++k) cw[k] = F.in[I_LCW][(l * 4 + k) * 256 + (tid & 255)];
    __syncthreads();
    {
        const int j = tid & 255, hh = tid >> 8; float xcv[32];
#pragma unroll
        for (int ii = 0; ii < 32; ++ii) { const int i = 32 * hh + ii; xcv[ii] = cb + cw[0] * RAW[i * 256 + j] + cw[1] * RAW[(i + 1) * 256 + j] + cw[2] * RAW[(i + 2) * 256 + j] + cw[3] * RAW[(i + 3) * 256 + j]; }
        __syncthreads();
#pragma unroll
        for (int ii = 0; ii < 32; ++ii) { const int i = 32 * hh + ii; RAW[i * 256 + j] = xcv[ii]; *(LAS bf16*)(XCB + i * S512 + j * 2) = (bf16)f2bf(xcv[ii]); }
    }
    __syncthreads();
    float At[2] = {1.f, 1.f}, Bt[2] = {0.f, 0.f};
#pragma unroll 1
    for (int sub = 0; sub < 4; ++sub) {
        const bf16x8 au = *(const LAS bf16x8*)(XCB + (16 * sub + fr) * S512 + (32 * wv + 8 * fq) * 2);
        unsigned short gt[2][4];
        if (PASS == 2) {
#pragma unroll
            for (int nt = 0; nt < 2; ++nt)
#pragma unroll
                for (int r = 0; r < 4; ++r) gt[nt][r] = *(const LAS unsigned short*)(F.lds + LM_GT + (16 * sub + 4 * fq + r) * S512 + (32 * wv + 16 * nt + fr) * 2);
        }
#pragma unroll
        for (int nt = 0; nt < 2; ++nt) {
            const f32x4 z = (f32x4){0.f, 0.f, 0.f, 0.f};
            f32x4 da = MFMA16(au, wah[nt], z); da = MFMA16(au, wal[nt], da);
            f32x4 dx = MFMA16(au, wxh[nt], z); dx = MFMA16(au, wxl[nt], dx);
            const int j = 32 * wv + 16 * nt + fr;
            float hl[4], ca[4]; float A = 1.f, B = 0.f;
#pragma unroll
            for (int r = 0; r < 4; ++r) { const int t = 16 * sub + 4 * fq + r;
                const float rr = sigmoidf_(da[r] + ba[nt]), gi = sigmoidf_(dx[r] + bx[nt]); const float a = __expf(c8[nt] * rr);
                const float mult = (c == 0 && t == 0) ? 1.0f : __builtin_amdgcn_sqrtf(fmaxf(1.0f - a * a, 0.f));
                const float bt = mult * gi * RAW[t * 256 + j];
                B = a * B + bt; A *= a; hl[r] = B; ca[r] = A; }
            float Ap = __shfl_up(A, 16), Bp = __shfl_up(B, 16); if (fq >= 1) { B = A * Bp + B; A = A * Ap; }
            Ap = __shfl_up(A, 32); Bp = __shfl_up(B, 32); if (fq >= 2) { B = A * Bp + B; A = A * Ap; }
            float Ae = __shfl_up(A, 16), Be = __shfl_up(B, 16); if (fq == 0) { Ae = 1.f; Be = 0.f; }
            const float As = __shfl(A, fr + 48), Bs = __shfl(B, fr + 48);
            if (PASS == 1) { Bt[nt] = As * Bt[nt] + Bs; At[nt] *= As; }
            else {
                const float Hs = Ae * Hin[nt] + Be;
#pragma unroll
                for (int r = 0; r < 4; ++r) { const float hv = hl[r] + ca[r] * Hs;
                    MX[(size_t)(row0 + 16 * sub + 4 * fq + r) * DM + 256 + j] = (bf16)f2bf(hv * gelu_tanh(bf2f(gt[nt][r]))); }
                Hin[nt] = As * Hin[nt] + Bs;
            }
        }
    }
    if (fq == 0) {
#pragma unroll
        for (int nt = 0; nt < 2; ++nt) { const int j = 32 * wv + 16 * nt + fr;
            if (PASS == 1) { LA[(size_t)((b * 32 + c) * 2) * 256 + j] = At[nt]; LA[(size_t)((b * 32 + c) * 2 + 1) * 256 + j] = Bt[nt]; }
            else if (c == 31) F.out[O_PLRUH + (size_t)(l * 8 + b) * 256 + j] = Hin[nt]; }
    }
    if (PASS == 2 && c == 31 && tid < 256) {
#pragma unroll
        for (int k = 0; k < 3; ++k) F.out[O_PLRUC + (size_t)((l * 8 + b) * 3 + k) * 256 + tid] = RAW[(64 + k) * 256 + tid]; }
    __syncthreads();
}
#ifndef MK_N_LAUNCHES
#define MK_N_LAUNCHES 1
#endif
constexpr int N_PHASES = 19;
#ifndef STAGE_AHEAD
#define STAGE_AHEAD 1
#endif
struct Args { const float* in[37]; float* out; unsigned char* ws; int ph_lo, ph_hi; };
#if MK_N_LAUNCHES == 1
#define GRID_BAR() xcd_barrier(bar)
#else
#define GRID_BAR() do { } while (0)
#endif
#ifndef DUPM
#define DUPM 0
#endif
#define REP(bit) for (int rep_ = 0; rep_ < (((DUPM) >> (bit)) & 1 ? 2 : 1); ++rep_)
#ifndef PH_MASK
#define PH_MASK 0x3ff
#endif
#define IN(k) (lo <= (k) && (k) < hi)
#define INL(i) (((PH_MASK >> ((i) + 1)) & 1) && IN(pb + (i)))
#define OPQ() asm volatile("" : "+s"(F.wg), "+s"(F.G), "+s"(F.ws), "+s"(F.out), "+s"(l), "+s"(F.lds))
#ifndef BAR_TWICE
#define BAR_TWICE 0
#endif
#define SEAM(k) do { if (IN(k) && IN((k) + 1)) { GRID_BAR(); if (BAR_TWICE) GRID_BAR(); } } while (0)
#define X ((bf16*)(F.ws + WS_X))
#define P ((bf16*)(F.ws + WS_P))
#define BIG ((bf16*)(F.ws + WS_BIG))
#define AB ((float*)(F.ws + WS_AB))
#define Y (F.out + O_YP)
#define X1B ((float*)(F.ws + WS_BIG + 34 * MiB))
#define RSA ((float*)(F.ws + WS_CTL + 512 * 1024))
#define RSB ((float*)(F.ws + WS_CTL + 768 * 1024))
#define X2B Y
template <int LAYER>
__device__ __forceinline__ void layer_phases(Frame& F, const XcdBarrier& bar, const int lo, const int hi) {
    int l = LAYER;
#if defined(SEGREP) || defined(SEGPRE)
    int seg_n = 0;
#endif
        const int pb = 1 + 9 * l;
#if (defined(SEGREP) || defined(SEGPRE)) && SEG_LO == 0
        seg_start: asm volatile("" : "+v"(F.tid), "+v"(F.lane)); F.wave = __builtin_amdgcn_readfirstlane(F.tid >> 6);
#endif
        if (INL(0)) REP(1) { OPQ();
            pg8::Gemm g{(const bf16*)X2B, (const bf16*)(F.ws + WS_WIN), MT, NPJ, DM}; pg8::StaticOrder S; S.init(MT, NPJ, F.G, F.wg);
            pg8::EpiBf16 E{P, NPJ, RSA};
            pg8::gemm_phase<pg8::EpiBf16, pg8::StaticOrder, true, true>(F.lds, g, S, E);
            if (LAYER == 0) convert_items<2 | 8>(F, l, ((MT / 256) * (NPJ / 256)) % F.G); else convert_items<8>(F, l, ((MT / 256) * (NPJ / 256)) % F.G);
        }
#if defined(SEGPRE) && SEG_HI == 0
        if (((SEGPRE >> LAYER) & 1) && seg_n < hi - (N_PHASES - 1)) { ++seg_n; if (SEGPRE_MODE == 1) xcd_barrier<true>(bar); else if (SEGPRE_MODE == 2) xcd_barrier<false>(bar); goto seg_start; }
#endif
        SEAM(pb + 0);
#if defined(SEGREP) && SEG_HI == 0
        if (((SEGREP >> LAYER) & 1) && seg_n < hi - (N_PHASES - 1)) { ++seg_n; if (0 == 8 && LAYER == 1) GRID_BAR(); goto seg_start; }
#endif
#if (defined(SEGREP) || defined(SEGPRE)) && SEG_LO == 1
        seg_start: asm volatile("" : "+v"(F.tid), "+v"(F.lane)); F.wave = __builtin_amdgcn_readfirstlane(F.tid >> 6);
#endif
        if (INL(1)) { OPQ();
#if STAGE_AHEAD
            S5Stage s5a;
#endif
            {
                int cw_head = -1; v4u pre[7]; float abn[2]; bool have = false; float SS[32]; GsAux gax;
                int ts = F.wg; const int NT = NB_S * GDH;
                if (ts < NT) { gdn_sample_load(F, l, ts, SS); gdn_sample_aux_load(F, l, ts, gax); }
                int k = 0;
                const int nun = NB_P * GDH * NCH / F.G;
                auto unit_of = [&](int kk) { return ((F.wg & 7) * GDH + (F.wg >> 6)) * NCH + ((F.wg >> 3) & 7) * 4 + kk; };
                for (; k < nun; ++k) { const int u = unit_of(k);
                    gdn_prep<0>(F, l, u, cw_head, pre, abn, have, k + 1 < nun ? unit_of(k + 1) : -1); have = true;
#if STAGE_AHEAD
                    if (k + 1 == nun && F.wg < NB_P * 31) s5m_stage_load(F, (F.wg / 31) * SEQ + (F.wg % 31) * 64, s5a);
#endif
                    if (ts < NT) { gdn_sample(F, l, ts, SS, gax); ts += F.G; if (ts < NT) { gdn_sample_load(F, l, ts, SS); gdn_sample_aux_load(F, l, ts, gax); } }
                }
                while (ts < NT) { gdn_sample(F, l, ts, SS, gax); ts += F.G; if (ts < NT) { gdn_sample_load(F, l, ts, SS); gdn_sample_aux_load(F, l, ts, gax); } }
            }
#ifdef GPC
            { int cw_head = -1; v4u pre[7]; float abn[2]; for (int u = F.wg; u < NB_P * GDH * NCH; u += F.G) { gdn_prep<GPC>(F, l, u, cw_head, pre, abn, false, -1); } __syncthreads(); }
#endif
#if STAGE_AHEAD
            if (F.wg < NB_P * 31) { const int u = F.wg; LruStage lra;
                auto hook = [&]() { lrum_stage_load<1>(F, u / 31, u % 31, lra); };
                s5m_unit<1, true>(F, l, u / 31, u % 31, &s5a, hook);
                lrum_pass<1, true>(F, l, u / 31, u % 31, &lra); }
#else
            for (int u = F.wg; u < NB_P * 31; u += F.G) { REP(3) s5m_unit<1>(F, l, u / 31, u % 31); REP(4) lrum_pass<1>(F, l, u / 31, u % 31); }
#endif
            for (int q = F.wg; q < 2 * NB_S; q += F.G) REP(6) { if (q < NB_S) s5m_unit<3>(F, l, q, 0); else lru_sample(F, l, q - NB_S); }
        }
#if defined(SEGPRE) && SEG_HI == 1
        if (((SEGPRE >> LAYER) & 1) && seg_n < hi - (N_PHASES - 1)) { ++seg_n; if (SEGPRE_MODE == 1) xcd_barrier<true>(bar); else if (SEGPRE_MODE == 2) xcd_barrier<false>(bar); goto seg_start; }
#endif
        SEAM(pb + 1);
#if defined(SEGREP) && SEG_HI == 1
        if (((SEGREP >> LAYER) & 1) && seg_n < hi - (N_PHASES - 1)) { ++seg_n; if (1 == 8 && LAYER == 1) GRID_BAR(); goto seg_start; }
#endif
#if (defined(SEGREP) || defined(SEGPRE)) && SEG_LO == 2
        seg_start: asm volatile("" : "+v"(F.tid), "+v"(F.lane)); F.wave = __builtin_amdgcn_readfirstlane(F.tid >> 6);
#endif
        if (INL(2)) { OPQ();
#if STAGE_AHEAD
            {
                const int u = F.wg; S5Stage s5s; LruStage lrs;
                s5m_stage_load(F, (u >> 5) * SEQ + (u & 31) * 64, s5s);
                gdn_chain<false>(F, l, F.wg);
                auto hook = [&]() { lrum_stage_load<2>(F, u >> 5, u & 31, lrs); };
                s5m_unit<2, true>(F, l, u >> 5, u & 31, &s5s, hook);
                lrum_pass<2, true>(F, l, u >> 5, u & 31, &lrs);
            }
#else
            for (int t = F.wg; t < 256; t += F.G) gdn_chain<false>(F, l, t);
            for (int u = F.wg; u < NB_P * NCH; u += F.G) { REP(7) s5m_unit<2>(F, l, u >> 5, u & 31); REP(8) lrum_pass<2>(F, l, u >> 5, u & 31); }
#endif
        }
#if defined(SEGPRE) && SEG_HI == 2
        if (((SEGPRE >> LAYER) & 1) && seg_n < hi - (N_PHASES - 1)) { ++seg_n; if (SEGPRE_MODE == 1) xcd_barrier<true>(bar); else if (SEGPRE_MODE == 2) xcd_barrier<false>(bar); goto seg_start; }
#endif
        SEAM(pb + 2);
#if defined(SEGREP) && SEG_HI == 2
        if (((SEGREP >> LAYER) & 1) && seg_n < hi - (N_PHASES - 1)) { ++seg_n; if (2 == 8 && LAYER == 1) GRID_BAR(); goto seg_start; }
#endif
#if (defined(SEGREP) || defined(SEGPRE)) && SEG_LO == 3
        seg_start: asm volatile("" : "+v"(F.tid), "+v"(F.lane)); F.wave = __builtin_amdgcn_readfirstlane(F.tid >> 6);
#endif
        if (!HEADNORM_IN_GEMM && INL(3)) { OPQ();
            gdn_finalize(F, l);
        }
#if defined(SEGPRE) && SEG_HI == 3
        if (((SEGPRE >> LAYER) & 1) && seg_n < hi - (N_PHASES - 1)) { ++seg_n; if (SEGPRE_MODE == 1) xcd_barrier<true>(bar); else if (SEGPRE_MODE == 2) xcd_barrier<false>(bar); goto seg_start; }
#endif
#if !HEADNORM_IN_GEMM
        SEAM(pb + 3);
#endif
#if defined(SEGREP) && SEG_HI == 3
        if (((SEGREP >> LAYER) & 1) && seg_n < hi - (N_PHASES - 1)) { ++seg_n; if (3 == 8 && LAYER == 1) GRID_BAR(); goto seg_start; }
#endif
#if (defined(SEGREP) || defined(SEGPRE)) && SEG_LO == 4
        seg_start: asm volatile("" : "+v"(F.tid), "+v"(F.lane)); F.wave = __builtin_amdgcn_readfirstlane(F.tid >> 6);
#endif
        if (INL(4)) REP(9) { OPQ();
            pg8::Gemm g{X, (const bf16*)(F.ws + WS_WOUT), MP, DM, DM}; pg8::StaticOrder S; S.init(MP, DM, F.G, F.wg);
#if HEADNORM_IN_GEMM
            pg8::EpiBf16HeadNorm E{BIG, DM, (const float*)(F.ws + WS_SSQ), 1.f / HD, EPS};
            pg8::gemm_phase<pg8::EpiBf16HeadNorm, pg8::StaticOrder, true, true>(F.lds, g, S, E);
#else
            pg8::EpiBf16 E{BIG, DM, nullptr};
            pg8::gemm_phase<pg8::EpiBf16, pg8::StaticOrder, true, true>(F.lds, g, S, E);
#endif
            sample_gemm_lds(F, X, (const bf16*)(F.ws + WS_WOUT), DM, BIG);
        }
#if defined(SEGPRE) && SEG_HI == 4
        if (((SEGPRE >> LAYER) & 1) && seg_n < hi - (N_PHASES - 1)) { ++seg_n; if (SEGPRE_MODE == 1) xcd_barrier<true>(bar); else if (SEGPRE_MODE == 2) xcd_barrier<false>(bar); goto seg_start; }
#endif
        SEAM(pb + 4);
#if defined(SEGREP) && SEG_HI == 4
        if (((SEGREP >> LAYER) & 1) && seg_n < hi - (N_PHASES - 1)) { ++seg_n; if (4 == 8 && LAYER == 1) GRID_BAR(); goto seg_start; }
#endif
#if (defined(SEGREP) || defined(SEGPRE)) && SEG_LO == 5
        seg_start: asm volatile("" : "+v"(F.tid), "+v"(F.lane)); F.wave = __builtin_amdgcn_readfirstlane(F.tid >> 6);
#endif
        if (INL(5)) { OPQ();
            REP(13) row_pass<true, true>(F, X2B, nullptr, BIG, F.in[I_NMPOST] + l * DM, X1B, nullptr, RSB, nullptr, nullptr);
        }
#if defined(SEGPRE) && SEG_HI == 5
        if (((SEGPRE >> LAYER) & 1) && seg_n < hi - (N_PHASES - 1)) { ++seg_n; if (SEGPRE_MODE == 1) xcd_barrier<true>(bar); else if (SEGPRE_MODE == 2) xcd_barrier<false>(bar); goto seg_start; }
#endif
        SEAM(pb + 5);
#if defined(SEGREP) && SEG_HI == 5
        if (((SEGREP >> LAYER) & 1) && seg_n < hi - (N_PHASES - 1)) { ++seg_n; if (5 == 8 && LAYER == 1) GRID_BAR(); goto seg_start; }
#endif
#if (defined(SEGREP) || defined(SEGPRE)) && SEG_LO == 6
        seg_start: asm volatile("" : "+v"(F.tid), "+v"(F.lane)); F.wave = __builtin_amdgcn_readfirstlane(F.tid >> 6);
#endif
        if (INL(6)) REP(10) { OPQ();
            pg8::Gemm g{(const bf16*)X1B, (const bf16*)(F.ws + WS_WGU), MT, 2 * FF, DM}; pg8::StaticOrder S; S.init(MT, 2 * FF, F.G, F.wg);
            pg8::EpiSwiGLU E{P, FF, RSB};
            pg8::gemm_phase<pg8::EpiSwiGLU, pg8::StaticOrder, true, true>(F.lds, g, S, E);
            if (LAYER + 1 < DEPTH) convert_items<1 | 2>(F, l + 1, ((MT / 256) * (2 * FF / 256)) % F.G);
        }
#if defined(SEGPRE) && SEG_HI == 6
        if (((SEGPRE >> LAYER) & 1) && seg_n < hi - (N_PHASES - 1)) { ++seg_n; if (SEGPRE_MODE == 1) xcd_barrier<true>(bar); else if (SEGPRE_MODE == 2) xcd_barrier<false>(bar); goto seg_start; }
#endif
        SEAM(pb + 6);
#if defined(SEGREP) && SEG_HI == 6
        if (((SEGREP >> LAYER) & 1) && seg_n < hi - (N_PHASES - 1)) { ++seg_n; if (6 == 8 && LAYER == 1) GRID_BAR(); goto seg_start; }
#endif
#if (defined(SEGREP) || defined(SEGPRE)) && SEG_LO == 7
        seg_start: asm volatile("" : "+v"(F.tid), "+v"(F.lane)); F.wave = __builtin_amdgcn_readfirstlane(F.tid >> 6);
#endif
        if (INL(7)) REP(11) { OPQ();
            pg8::Gemm g{P, (const bf16*)(F.ws + WS_WDN), MP, DM, FF}; pg8::StaticOrder S; S.init(MP, DM, F.G, F.wg);
            pg8::EpiBf16 E{BIG, DM, nullptr};
            pg8::gemm_phase<pg8::EpiBf16, pg8::StaticOrder, true, true>(F.lds, g, S, E);
            sample_gemm_lds(F, P, (const bf16*)(F.ws + WS_WDN), FF, BIG);
        }
#if defined(SEGPRE) && SEG_HI == 7
        if (((SEGPRE >> LAYER) & 1) && seg_n < hi - (N_PHASES - 1)) { ++seg_n; if (SEGPRE_MODE == 1) xcd_barrier<true>(bar); else if (SEGPRE_MODE == 2) xcd_barrier<false>(bar); goto seg_start; }
#endif
        SEAM(pb + 7);
#if defined(SEGREP) && SEG_HI == 7
        if (((SEGREP >> LAYER) & 1) && seg_n < hi - (N_PHASES - 1)) { ++seg_n; if (7 == 8 && LAYER == 1) GRID_BAR(); goto seg_start; }
#endif
#if (defined(SEGREP) || defined(SEGPRE)) && SEG_LO == 8
        seg_start: asm volatile("" : "+v"(F.tid), "+v"(F.lane)); F.wave = __builtin_amdgcn_readfirstlane(F.tid >> 6);
#endif
        if (INL(8)) { OPQ();
            if (l + 1 < DEPTH) {
                convert_items<4 | 16>(F, l + 1, 0);
                row_pass<true, true>(F, X1B, nullptr, BIG, F.in[I_NFPOST] + l * DM, X2B, F.in[I_NMPRE] + (l + 1) * DM, RSA, F.in[I_WIN] + (size_t)(l + 1) * DM * INC, AB);
            } else row_pass<true, false>(F, X1B, nullptr, BIG, F.in[I_NFPOST] + l * DM, Y, nullptr, nullptr, nullptr, nullptr);
        }
#if defined(SEGPRE) && SEG_HI == 8
        if (((SEGPRE >> LAYER) & 1) && seg_n < hi - (N_PHASES - 1)) { ++seg_n; if (SEGPRE_MODE == 1) xcd_barrier<true>(bar); else if (SEGPRE_MODE == 2) xcd_barrier<false>(bar); goto seg_start; }
#endif
        SEAM(pb + 8);
#if defined(SEGREP) && SEG_HI == 8
        if (((SEGREP >> LAYER) & 1) && seg_n < hi - (N_PHASES - 1)) { ++seg_n; if (8 == 8 && LAYER == 1) GRID_BAR(); goto seg_start; }
#endif
    }
__global__ void __launch_bounds__(NTHR, 2) mega_fwd(Args args) {
    extern __shared__ __attribute__((aligned(16))) unsigned char lds[];
    Frame F;
    F.lds = (LAS unsigned char*)lds;
    F.tid = threadIdx.x; F.lane = F.tid & 63; F.wave = __builtin_amdgcn_readfirstlane(F.tid >> 6);
    F.G = gridDim.x; F.wg = blockIdx.x;
    F.in = args.in;
    F.out = args.out; F.ws = args.ws;
    volatile LAS unsigned* MISC = (volatile LAS unsigned*)(F.lds + LDSCTL_OFF);
    for (int u = F.tid; u < (LDS_BYTES - LDSCTL_OFF) / 4; u += NTHR) ((LAS unsigned*)(F.lds + LDSCTL_OFF))[u] = 0u;
    __syncthreads();
#if MK_N_LAUNCHES == 1
    XcdBarrier bar = xcd_barrier_post((unsigned*)(F.ws + WS_CTL) + CW_BAR, MISC + 8);
#else
    (void)MISC; XcdBarrier bar; bar.bar = nullptr; bar.x = 0; bar.st = nullptr;
#endif
    const int lo = args.ph_lo, hi = args.ph_hi;
#ifdef FULLREP
    for (int rep2 = 0; rep2 < args.ph_hi - (N_PHASES - FULLREP); ++rep2) {
        F.tid = threadIdx.x; asm volatile("" : "+v"(F.tid)); F.lane = F.tid & 63; F.wave = __builtin_amdgcn_readfirstlane(F.tid >> 6);
#endif
    if ((PH_MASK & 1) && IN(0)) REP(12) {
        convert_items<1 | 4 | 16>(F, 0, 0);
        row_pass<false, true>(F, F.in[I_XP], F.in[I_XS], nullptr, nullptr, X2B, F.in[I_NMPRE], RSA, F.in[I_WIN], AB);
    }
    SEAM(0);
    layer_phases<0>(F, bar, lo, hi);
    layer_phases<1>(F, bar, lo, hi);
#ifdef FULLREP
    GRID_BAR(); }
#endif
}

extern "C" void kernel_launch(void* const* d_in, const int* in_sizes, int n_in, void* d_out, int out_size, void* d_ws, size_t ws_size, hipStream_t stream) {
    static int grid = 0;
    if (grid == 0) {
        if (n_in != 37 || (size_t)out_size != O_END || ws_size < WS_OL + 16 * MiB) { fprintf(stderr, "kernel_launch: unexpected shapes: n_in %d out %d ws %zu\n", n_in, out_size, ws_size); grid = -1; return; }
        int dev = 0, cus = 0, per_cu = 0;
        if (hipGetDevice(&dev) != hipSuccess || hipDeviceGetAttribute(&cus, hipDeviceAttributeMultiprocessorCount, dev) != hipSuccess) { grid = -1; return; }
        if (hipFuncSetAttribute((const void*)mega_fwd, hipFuncAttributeMaxDynamicSharedMemorySize, LDS_BYTES) != hipSuccess) { fprintf(stderr, "kernel_launch: hipFuncSetAttribute failed\n"); grid = -1; return; }
        if (hipOccupancyMaxActiveBlocksPerMultiprocessor(&per_cu, (const void*)mega_fwd, NTHR, LDS_BYTES) != hipSuccess || per_cu < 1) { fprintf(stderr, "kernel_launch: occupancy query says %d blocks per CU\n", per_cu); (void)hipGetLastError(); per_cu = 1; }
        grid = cus;
        if (grid > 256) grid = 256;
        if (HEADNORM_IN_GEMM && grid != 256) { fprintf(stderr, "kernel_launch: %d compute units, this build needs 256 (one out-projection unit per workgroup)\n", cus); grid = -1; return; }
    }
    if (grid < 0) return;
    (void)hipMemsetAsync((char*)d_ws + WS_CTL, 0, CTL_ZERO_BYTES, stream);
    Args a{};
    for (int i = 0; i < 37; ++i) a.in[i] = (const float*)d_in[i];
    a.out = (float*)d_out; a.ws = (unsigned char*)d_ws;
#if MK_N_LAUNCHES == 1
    a.ph_lo = 0; a.ph_hi = N_PHASES;
    hipLaunchKernelGGL(mega_fwd, dim3(grid), dim3(NTHR), LDS_BYTES, stream, a);
#else
    for (int ph = 0; ph < N_PHASES; ++ph) { a.ph_lo = ph; a.ph_hi = ph + 1; hipLaunchKernelGGL(mega_fwd, dim3(grid), dim3(NTHR), LDS_BYTES, stream, a); }
#endif
}
```

```cpp
#include <hip/hip_runtime.h>
#include <cstdio>
#include <cstdint>
#include <cmath>
namespace pg8 {
#define PG8_LAS __attribute__((address_space(3)))
typedef unsigned short bf16_t;
typedef short bf16x8 __attribute__((ext_vector_type(8)));
typedef float f32x4 __attribute__((ext_vector_type(4)));
typedef unsigned u32x4 __attribute__((ext_vector_type(4)));
constexpr int BM = 256, BK = 64, HALF = 128, HTB = HALF * BK * 2  , STAGE_BYTES = 8 * HTB, NXCD = 8, WGM = 4;

__host__ __device__ __forceinline__ int lds_byte(int r, int c) { const int st = (r >> 4) * 2 + (c >> 5), rr = r & 15, cc = c & 31, ob = rr * 64 + cc * 2; return st * 1024 + (ob ^ (((ob >> 9) & 1) << 5)); }
__host__ __device__ __forceinline__ void stage_rc(int b, int& R, int& C) { const int st = b / 1024, sb = b % 1024, swz = sb ^ (((sb >> 9) & 1) << 5); R = (st >> 1) * 16 + swz / 64; C = (st & 1) * 32 + (swz % 64) / 2; }
__host__ __device__ __forceinline__ int perm32(int rho) { const int n = rho >> 4, i = rho & 15; return 8 * (i >> 2) + 4 * n + (i & 3); }

struct Unit { int pm, pn; };
struct Gemm { const bf16_t* A; const bf16_t* Bt; int M, N, K; };

struct StaticOrder {
    int nM, nN, nwg, G, c;
    __host__ __device__ void init(int M, int N, int G_, int c_) { nM = M / BM; nN = N / BM; nwg = nM * nN; G = G_; c = c_; }
    __host__ __device__ bool next(int i, Unit& u) const {
        const long L = (long)i * G + c; if (L >= nwg) return false;
        int wgid = (int)L; { const int q = nwg / NXCD, r = nwg % NXCD, xcd = wgid % NXCD, off = wgid / NXCD; wgid = (xcd < r ? xcd * (q + 1) : r * (q + 1) + (xcd - r) * q) + off; }
        const int nig = WGM * nN, gid = wgid / nig, fm = gid * WGM, gsz = (nM - fm) < WGM ? (nM - fm) : WGM;
        u.pm = fm + ((wgid % nig) % gsz); u.pn = (wgid % nig) / gsz; return true;
    }
    __device__ __forceinline__ void a_ready(const Unit&) const {}
    __device__ __forceinline__ void done(const Unit&) const {}
};


__device__ __forceinline__ unsigned cvt_pk_bf16(float lo, float hi) { unsigned r; asm volatile("v_cvt_pk_bf16_f32 %0, %1, %2" : "=v"(r) : "v"(lo), "v"(hi)); return r; }

template <bool WT>
__device__ __forceinline__ void st16(void* p, u32x4 v) {
    if constexpr (WT) asm volatile("global_store_dwordx4 %0, %1, off sc1\n\ts_nop 1" :: "v"(p), "v"(v) : "memory");
    else *(u32x4*)p = v;
}
struct EpiF32 {
    static constexpr bool PERM = false, AFTER_DRAIN = false, KSCALE = false;
    float* C; int ldc;
    template <bool WT>
    __device__ __forceinline__ void run(const f32x4 (&acc)[2][2][4][2], const Unit& u, int wr, int wc, int fr, int fq) const {
        const int row0 = u.pm * BM + wr * 64 + fr, col0 = u.pn * BM + wc * 32 + 4 * fq;
#pragma unroll
        for (int ai = 0; ai < 2; ++ai)
#pragma unroll
            for (int m = 0; m < 4; ++m) { float* rowp = C + (size_t)(row0 + ai * HALF + m * 16) * ldc + col0;
#pragma unroll
                for (int bj = 0; bj < 2; ++bj)
#pragma unroll
                    for (int n = 0; n < 2; ++n) *(f32x4*)(rowp + bj * HALF + n * 16) = acc[ai][bj][m][n]; }
    }
};
struct EpiBf16 {
    static constexpr bool PERM = true, AFTER_DRAIN = false, KSCALE = false;
    bf16_t* O; int ldc; const float* RS;
    template <bool WT>
    __device__ __forceinline__ void run(const f32x4 (&acc)[2][2][4][2], const Unit& u, int wr, int wc, int fr, int fq) const {
        const int row0 = u.pm * BM + wr * 64 + fr; const int col0 = u.pn * BM + wc * 32 + 8 * fq;
        float rsc[2][4];
#pragma unroll
        for (int ai = 0; ai < 2; ++ai)
#pragma unroll
            for (int m = 0; m < 4; ++m) rsc[ai][m] = RS ? RS[row0 + ai * HALF + m * 16] : 1.0f;
#pragma unroll
        for (int ai = 0; ai < 2; ++ai)
#pragma unroll
            for (int m = 0; m < 4; ++m) { bf16_t* rowp = O + (size_t)(row0 + ai * HALF + m * 16) * ldc + col0;
#pragma unroll
                for (int bj = 0; bj < 2; ++bj) { const f32x4 v0 = acc[ai][bj][m][0] * rsc[ai][m], v1 = acc[ai][bj][m][1] * rsc[ai][m];
                    u32x4 w; w.x = cvt_pk_bf16(v0[0], v0[1]); w.y = cvt_pk_bf16(v0[2], v0[3]); w.z = cvt_pk_bf16(v1[0], v1[1]); w.w = cvt_pk_bf16(v1[2], v1[3]);
                    st16<WT>(rowp + bj * HALF, w); } }
    }
};
struct EpiBf16HeadNorm {
    static constexpr bool PERM = true, AFTER_DRAIN = false, KSCALE = true;
    static constexpr int KT0 = 8, TAB = STAGE_BYTES;
    bf16_t* O; int ldc; const float* SSQ; float inv_n, eps;
    struct Pre { f32x4 v[8]; };
    __device__ __forceinline__ void setup_load(Pre& p, const Unit& u, int tid) const {
        const float* sp = SSQ + (size_t)(u.pm * BM + (tid & 255)) * 32;
#pragma unroll
        for (int i = 0; i < 8; ++i) p.v[i] = *(const f32x4*)(sp + 4 * i);
    }
    __device__ __forceinline__ void setup_store(const Pre& p, PG8_LAS unsigned char* lds, int tid) const {
        if (tid < 256) {
            float sq[4], rs[4];
#pragma unroll
            for (int h = 0; h < 4; ++h) { const f32x4 a = p.v[2 * h], b = p.v[2 * h + 1]; const float x = ((a.x + a.y) + (a.z + a.w) + (b.x + b.y) + (b.z + b.w)) * inv_n + eps; rs[h] = __builtin_amdgcn_rsqf(x); sq[h] = x * rs[h]; }
            PG8_LAS float* t = (PG8_LAS float*)(lds + TAB) + tid * 8;
            *(PG8_LAS f32x4*)t = (f32x4){sq[0], rs[0] * sq[1], rs[1] * sq[2], rs[2] * sq[3]}; t[4] = rs[3];
        }
    }
    __device__ __forceinline__ void scale(f32x4 (&acc)[2][2][4][2], PG8_LAS unsigned char* lds, int wr, int fr, int p) const {
        const PG8_LAS float* t = (const PG8_LAS float*)(lds + TAB) + (wr * 64 + fr) * 8 + p;
#pragma unroll
        for (int ai = 0; ai < 2; ++ai)
#pragma unroll
            for (int m = 0; m < 4; ++m) { const float f = t[(ai * HALF + m * 16) * 8];
#pragma unroll
                for (int bj = 0; bj < 2; ++bj)
#pragma unroll
                    for (int n = 0; n < 2; ++n) acc[ai][bj][m][n] = acc[ai][bj][m][n] * f; }
    }
    template <bool WT>
    __device__ __forceinline__ void run(const f32x4 (&acc)[2][2][4][2], const Unit& u, int wr, int wc, int fr, int fq) const { EpiBf16 e{O, ldc, nullptr}; e.template run<WT>(acc, u, wr, wc, fr, fq); }
};
struct EpiSwiGLU {
    static constexpr bool PERM = true, AFTER_DRAIN = false, KSCALE = false;
    bf16_t* O; int ldc; const float* RS;
    template <bool WT>
    __device__ __forceinline__ void run(const f32x4 (&acc)[2][2][4][2], const Unit& u, int wr, int wc, int fr, int fq) const {
        const int row0 = u.pm * BM + wr * 64 + fr; const int col0 = u.pn * HALF + wc * 32 + 8 * fq;
        float rsc[2][4];
#pragma unroll
        for (int ai = 0; ai < 2; ++ai)
#pragma unroll
            for (int m = 0; m < 4; ++m) rsc[ai][m] = RS[row0 + ai * HALF + m * 16];
#pragma unroll
        for (int ai = 0; ai < 2; ++ai)
#pragma unroll
            for (int m = 0; m < 4; ++m) { bf16_t* rowp = O + (size_t)(row0 + ai * HALF + m * 16) * ldc + col0;
                const float rsr = rsc[ai][m], cex = rsr * -1.4426950408889634f, irs2 = __builtin_amdgcn_rcpf(rsr * rsr);
                float o[8];
#pragma unroll
                for (int n = 0; n < 2; ++n)
#pragma unroll
                    for (int j = 0; j < 4; ++j) {
                        const float ag = acc[ai][0][m][n][j], au = acc[ai][1][m][n][j];
                        const float e = __builtin_amdgcn_exp2f(ag * cex); o[n * 4 + j] = (ag * au) * __builtin_amdgcn_rcpf(__builtin_fmaf(e, irs2, irs2)); }
                u32x4 w; w.x = cvt_pk_bf16(o[0], o[1]); w.y = cvt_pk_bf16(o[2], o[3]); w.z = cvt_pk_bf16(o[4], o[5]); w.w = cvt_pk_bf16(o[6], o[7]);
                st16<WT>(rowp, w); }
    }
};

#ifndef PG8_LAST_WT
#define PG8_LAST_WT 0
#endif
template <class E, bool K = E::KSCALE> struct Epi_pre { typedef int type; };
template <class E> struct Epi_pre<E, true> { typedef typename E::Pre type; };
template <class Epi, class Sched, bool ALIGN_EPI = false, bool SP2 = false>
__device__ __forceinline__ void gemm_phase(PG8_LAS unsigned char* lds, const Gemm g, const Sched& S, const Epi& E) {
    int tid_ = threadIdx.x; asm volatile("" : "+v"(tid_));
    const int tid = tid_, wid = __builtin_amdgcn_readfirstlane(tid >> 6), lane = tid & 63, wr = wid >> 2, wc = wid & 3, fr = lane & 15, fq = lane >> 4;
    const int K = g.K, nt = K / BK;
    unsigned voffA[2], voffB[2];
#pragma unroll
    for (int i = 0; i < 2; ++i) { int R, C; stage_rc(tid * 16 + i * 8192, R, C); const int Rb = Epi::PERM ? ((R & ~31) + perm32(R & 31)) : R;
        voffA[i] = (unsigned)(R * K + C) * 2u; voffB[i] = (unsigned)(Rb * K + C) * 2u; }
    const size_t kstep = (size_t)(BK * 2);
    const size_t hstep = (size_t)HALF * K * 2;
    const size_t tstep = 2 * hstep;
    const unsigned ldsw = (unsigned)wid * 1024u;
    const int aoff = lds_byte(wr * 64 + fr, fq * 8), boff = lds_byte(wc * 32 + fr, fq * 8);
#define PG8_SA(b, h) (((b) * 2 + (h)) * HTB)
#define PG8_SB(b, h) ((4 + (b) * 2 + (h)) * HTB)
#define PG8_STAGE(bufoff, gbase, voff) do { _Pragma("unroll") for (int _i = 0; _i < 2; ++_i) \
        __builtin_amdgcn_global_load_lds((const unsigned*)((const char*)(gbase) + (voff)[_i]), (PG8_LAS unsigned*)(lds + (bufoff) + ldsw + _i * 8192), 16, 0, 0); } while (0)
#define PG8_LDA(dst, b, h) do { _Pragma("unroll") for (int m = 0; m < 4; ++m) _Pragma("unroll") for (int k = 0; k < 2; ++k) dst[m][k] = *(const PG8_LAS bf16x8*)(lds + PG8_SA(b, h) + aoff + m * 2048 + k * 1024); } while (0)
#define PG8_LDB(dst, b, h) do { _Pragma("unroll") for (int n = 0; n < 2; ++n) _Pragma("unroll") for (int k = 0; k < 2; ++k) dst[n][k] = *(const PG8_LAS bf16x8*)(lds + PG8_SB(b, h) + boff + n * 2048 + k * 1024); } while (0)
#define PG8_MMA(ai, bj, At, Bt) do { __builtin_amdgcn_s_setprio(1); _Pragma("unroll") for (int m = 0; m < 4; ++m) _Pragma("unroll") for (int n = 0; n < 2; ++n) _Pragma("unroll") for (int k = 0; k < 2; ++k) \
        acc[ai][bj][m][n] = __builtin_amdgcn_mfma_f32_16x16x32_bf16(Bt[n][k], At[m][k], acc[ai][bj][m][n], 0, 0, 0); __builtin_amdgcn_s_setprio(0); } while (0)
#define PG8_WAIT_V(n) asm volatile("s_waitcnt vmcnt(" #n ")" ::: "memory")
#define PG8_WAIT_L(n) asm volatile("s_waitcnt lgkmcnt(" #n ")" ::: "memory")
#define PG8_BAR __builtin_amdgcn_s_barrier()
#define PG8_SCHED __builtin_amdgcn_sched_barrier(0)
    Unit cur, nxt; int ui = 0;
    if (!S.next(0, cur)) return;
    f32x4 acc[2][2][4][2];
#pragma unroll
    for (int a = 0; a < 2; ++a)
#pragma unroll
        for (int b = 0; b < 2; ++b)
#pragma unroll
            for (int m = 0; m < 4; ++m)
#pragma unroll
                for (int n = 0; n < 2; ++n) acc[a][b][m][n] = (f32x4){0.f, 0.f, 0.f, 0.f};
    bf16x8 At[4][2], B0[2][2], B1[2][2];
    const char* cA = (const char*)g.A + (size_t)cur.pm * tstep; const char* cB = (const char*)g.Bt + (size_t)cur.pn * tstep;
    S.a_ready(cur);
    typename Epi_pre<Epi>::type epre;
    if constexpr (Epi::KSCALE) E.setup_load(epre, cur, tid);
    if constexpr (SP2) {
        PG8_STAGE(PG8_SB(0, 0), cB, voffB); PG8_STAGE(PG8_SB(0, 1), cB + hstep, voffB); PG8_STAGE(PG8_SA(0, 0), cA, voffA); PG8_STAGE(PG8_SA(0, 1), cA + hstep, voffA);
        if (wr == 1) PG8_BAR;
        PG8_WAIT_V(2); PG8_BAR;
        PG8_STAGE(PG8_SB(1, 0), cB + kstep, voffB); PG8_STAGE(PG8_SA(1, 0), cA + kstep, voffA); PG8_STAGE(PG8_SB(1, 1), cB + hstep + kstep, voffB);
        PG8_WAIT_V(6); PG8_BAR;
        if constexpr (Epi::KSCALE) E.setup_store(epre, lds, tid);
    } else {
        PG8_STAGE(PG8_SB(0, 0), cB, voffB); PG8_STAGE(PG8_SA(0, 0), cA, voffA); PG8_STAGE(PG8_SB(0, 1), cB + hstep, voffB); PG8_STAGE(PG8_SA(0, 1), cA + hstep, voffA);
        if (wr == 1) PG8_BAR;
        PG8_WAIT_V(4); PG8_BAR;
        PG8_STAGE(PG8_SB(1, 0), cB + kstep, voffB); PG8_STAGE(PG8_SA(1, 0), cA + kstep, voffA); PG8_STAGE(PG8_SB(1, 1), cB + hstep + kstep, voffB);
        PG8_WAIT_V(6); PG8_BAR;
    }
    for (;;) {
        const bool has_next = S.next(ui + 1, nxt);
        const char* nA = has_next ? (const char*)g.A + (size_t)nxt.pm * tstep : cA; const char* nB = has_next ? (const char*)g.Bt + (size_t)nxt.pn * tstep : cB;
        for (int t = 0; t < nt; t += 2) {
            const bool last = (t == nt - 2);
            const char* a1 = cA + (size_t)(t + 1) * kstep;
            const char* a2 = last ? nA : cA + (size_t)(t + 2) * kstep; const char* b2 = last ? nB : cB + (size_t)(t + 2) * kstep;
            const char* a3 = a2 + kstep; const char* b3 = b2 + kstep;
            if (last && has_next) S.a_ready(nxt);
            if constexpr (Epi::KSCALE) { if (t >= Epi::KT0) E.scale(acc, lds, wr, fr, (t - Epi::KT0) >> 1); }
            if constexpr (SP2) {
            PG8_LDB(B0, 0, 0); PG8_LDB(B1, 0, 1); PG8_SCHED; PG8_LDA(At, 0, 0); PG8_STAGE(PG8_SA(1, 1), a1 + hstep, voffA);
            PG8_WAIT_V(8); PG8_WAIT_L(0); PG8_BAR; PG8_MMA(0, 0, At, B0); PG8_MMA(0, 1, At, B1); PG8_BAR; PG8_SCHED;
            PG8_LDA(At, 0, 1); PG8_STAGE(PG8_SB(0, 0), b2, voffB); PG8_STAGE(PG8_SB(0, 1), b2 + hstep, voffB); PG8_STAGE(PG8_SA(0, 0), a2, voffA);
            PG8_WAIT_V(8); PG8_WAIT_L(0); PG8_BAR; PG8_MMA(1, 0, At, B0); PG8_MMA(1, 1, At, B1); PG8_BAR; PG8_SCHED;
            PG8_LDB(B0, 1, 0); PG8_LDB(B1, 1, 1); PG8_SCHED; PG8_LDA(At, 1, 0); PG8_STAGE(PG8_SA(0, 1), a2 + hstep, voffA);
            PG8_WAIT_V(8); PG8_WAIT_L(0); PG8_BAR; PG8_MMA(0, 0, At, B0); PG8_MMA(0, 1, At, B1); PG8_BAR; PG8_SCHED;
            PG8_LDA(At, 1, 1); PG8_STAGE(PG8_SB(1, 0), b3, voffB); PG8_STAGE(PG8_SB(1, 1), b3 + hstep, voffB); PG8_STAGE(PG8_SA(1, 0), a3, voffA);
            PG8_WAIT_V(8); PG8_WAIT_L(0); PG8_BAR; PG8_MMA(1, 0, At, B0); PG8_MMA(1, 1, At, B1); PG8_BAR; PG8_SCHED;
            } else {
            PG8_LDB(B0, 0, 0); PG8_SCHED; PG8_LDA(At, 0, 0); PG8_STAGE(PG8_SA(1, 1), a1 + hstep, voffA);
            PG8_WAIT_L(8); PG8_BAR; PG8_WAIT_L(0); PG8_MMA(0, 0, At, B0); PG8_BAR; PG8_SCHED;
            PG8_LDB(B1, 0, 1); PG8_STAGE(PG8_SB(0, 0), b2, voffB);
            PG8_BAR; PG8_WAIT_L(0); PG8_MMA(0, 1, At, B1); PG8_BAR;
            PG8_LDA(At, 0, 1); PG8_STAGE(PG8_SA(0, 0), a2, voffA);
            PG8_BAR; PG8_WAIT_L(0); PG8_MMA(1, 0, At, B0); PG8_BAR; PG8_SCHED;
            PG8_STAGE(PG8_SB(0, 1), b2 + hstep, voffB);
            PG8_WAIT_V(6); PG8_BAR; PG8_MMA(1, 1, At, B1); PG8_BAR;
            PG8_LDB(B0, 1, 0); PG8_SCHED; PG8_LDA(At, 1, 0); PG8_STAGE(PG8_SA(0, 1), a2 + hstep, voffA);
            PG8_WAIT_L(8); PG8_BAR; PG8_WAIT_L(0); PG8_MMA(0, 0, At, B0); PG8_BAR; PG8_SCHED;
            PG8_LDB(B1, 1, 1); PG8_STAGE(PG8_SB(1, 0), b3, voffB);
            PG8_BAR; PG8_WAIT_L(0); PG8_MMA(0, 1, At, B1); PG8_BAR;
            PG8_LDA(At, 1, 1); PG8_STAGE(PG8_SA(1, 0), a3, voffA);
            PG8_BAR; PG8_WAIT_L(0); PG8_MMA(1, 0, At, B0); PG8_BAR; PG8_SCHED;
            PG8_STAGE(PG8_SB(1, 1), b3 + hstep, voffB);
            PG8_WAIT_V(6); PG8_BAR; PG8_MMA(1, 1, At, B1); PG8_BAR;
            }
        }
        if constexpr (Epi::KSCALE) E.scale(acc, lds, wr, fr, 4);
        if constexpr (ALIGN_EPI) { if (wr == 0) PG8_BAR; }
        if constexpr (!Epi::AFTER_DRAIN) {
            if (PG8_LAST_WT && !has_next) E.template run<true>(acc, cur, wr, wc, fr, fq); else E.template run<false>(acc, cur, wr, wc, fr, fq);
            S.done(cur); }
        if (!has_next) break;
#pragma unroll
        for (int a = 0; a < 2; ++a)
#pragma unroll
            for (int b = 0; b < 2; ++b)
#pragma unroll
                for (int m = 0; m < 4; ++m)
#pragma unroll
                    for (int n = 0; n < 2; ++n) acc[a][b][m][n] = (f32x4){0.f, 0.f, 0.f, 0.f};
        cur = nxt; cA = nA; cB = nB; ++ui;
        if constexpr (ALIGN_EPI) { if (wr == 1) PG8_BAR; }
    }
    PG8_WAIT_V(0);
    if constexpr (!ALIGN_EPI) { if (wr == 0) PG8_BAR; }
    PG8_BAR;
    if constexpr (Epi::AFTER_DRAIN) { E.fused(acc, cur, wr, wc, fr, fq, lds, wid, lane); S.done(cur); }
#undef PG8_SA
#undef PG8_SB
#undef PG8_STAGE
#undef PG8_LDA
#undef PG8_LDB
#undef PG8_MMA
#undef PG8_WAIT_V
#undef PG8_WAIT_L
#undef PG8_BAR
#undef PG8_SCHED
}
}

constexpr int NWAVES = 8, NTHR = 512;
constexpr int DM = 1024, SEQ = 2048, NB_P = 8, MP = NB_P * SEQ, NB_S = 128, DSEQ = 4, MS = NB_S * DSEQ, MT = MP + MS;
constexpr int DEPTH = 2, INC = 2824, NPJ = 2816, FF = 2816, GDH = 4, HD = 128, NCH = SEQ / 64;
constexpr int PU = 0, PXL = 256, PGL = 512, PQ = 768, PK = 1280, PV = 1792, PZ = 2304;
constexpr float EPS = 1e-6f;
#ifndef HEADNORM_IN_GEMM
#define HEADNORM_IN_GEMM 1
#endif
constexpr size_t O_YP = 0, O_YS = O_YP + (size_t)MP * DM, O_PS5RE = O_YS + (size_t)MS * DM, O_PS5IM = O_PS5RE + 2 * 8 * 16 * 64, O_PLRUH = O_PS5IM + 2 * 8 * 16 * 64,
    O_PLRUC = O_PLRUH + 2 * 8 * 256, O_PGS = O_PLRUC + 2 * 8 * 3 * 256, O_PGC = O_PGS + (size_t)2 * 8 * 4 * 128 * 128, O_SS5RE = O_PGC + 2 * 8 * 3 * 1536,
    O_SS5IM = O_SS5RE + 2 * 128 * 16 * 64, O_SLRUH = O_SS5IM + 2 * 128 * 16 * 64, O_SLRUC = O_SLRUH + 2 * 128 * 256, O_SGS = O_SLRUC + 2 * 128 * 3 * 256,
    O_SGC = O_SGS + (size_t)2 * 128 * 4 * 128 * 128, O_END = O_SGC + (size_t)2 * 128 * 3 * 1536;
static_assert(O_END == 37216256, "output size");
constexpr size_t MiB = 1u << 20;
constexpr size_t WS_CTL = 0, CTL_ZERO_BYTES = 1 * MiB;
constexpr size_t WS_S5E = 1 * MiB;
constexpr size_t WS_LAGG = 3 * MiB;
constexpr size_t WS_AB = 3 * MiB + 512 * 1024;
constexpr size_t WS_EGL = 4 * MiB + 256 * 1024;
constexpr size_t WS_WIN = 5 * MiB;
constexpr size_t WS_WOUT = WS_WIN + (size_t)NPJ * DM * 2;
constexpr size_t WS_WGU = WS_WOUT + (size_t)DM * DM * 2;
constexpr size_t WS_WDN = WS_WGU + (size_t)2 * FF * DM * 2;
constexpr size_t WS_WGLU = WS_WDN + (size_t)DM * FF * 2;
constexpr size_t WS_X = 30 * MiB;
constexpr size_t WS_P = 63 * MiB;
constexpr size_t WS_BIG = 154 * MiB;
constexpr size_t WS_PP = WS_BIG, WS_RT = WS_BIG + 32 * MiB, WS_QT = WS_BIG + 64 * MiB, WS_END = WS_BIG + 80 * MiB;
static_assert(WS_WGLU + 256 * 256 * 2 <= WS_X && WS_X + (size_t)MT * DM * 2 <= WS_P && WS_P + (size_t)MT * NPJ * 2 <= WS_BIG && WS_BIG + (size_t)MT * DM * 4 <= WS_END && WS_END + (size_t)MP * 32 * 4 <= 256 * MiB, "ws map");
static_assert(WS_AB + (size_t)MT * 8 * 4 <= WS_EGL && WS_EGL + 4096 <= WS_WIN, "ws map 2");
constexpr size_t WS_SSQ = WS_END;
constexpr size_t WS_OL = WS_END + 2 * MiB;
constexpr size_t WS_DUMH = WS_END + 18 * MiB, WS_DUMF = WS_END + 19 * MiB;
static_assert(WS_DUMF + 2 * MiB <= 256 * MiB, "ws tail");
constexpr int CW_BAR = 4096;
constexpr int RING_BYTES = 131072, LDSCTL_OFF = 143360, LDS_BYTES = 147456;

#define GAS __attribute__((address_space(1)))
#define LAS __attribute__((address_space(3)))
typedef unsigned short bf16;
typedef unsigned v4u __attribute__((ext_vector_type(4)));
typedef unsigned v2u __attribute__((ext_vector_type(2)));
typedef float f32x4 __attribute__((ext_vector_type(4)));
typedef short bf16x8 __attribute__((ext_vector_type(8)));
#define LDS_WAIT() asm volatile("s_waitcnt lgkmcnt(0)" ::: "memory")
#define VM_WAIT() asm volatile("s_waitcnt vmcnt(0)" ::: "memory")
#define MFMA16(a, b, c) __builtin_amdgcn_mfma_f32_16x16x32_bf16(a, b, c, 0, 0, 0)
typedef float f32x2_t __attribute__((ext_vector_type(2))); typedef __bf16 bf16x2_t __attribute__((ext_vector_type(2)));
__device__ __forceinline__ unsigned pk2(float lo, float hi) { f32x2_t v = {lo, hi}; bf16x2_t b = __builtin_convertvector(v, bf16x2_t); return __builtin_bit_cast(unsigned, b); }
__device__ __forceinline__ unsigned f2bf(float f) { return pk2(f, f) & 0xffffu; }
__device__ __forceinline__ float bf2f(unsigned b) { return __builtin_bit_cast(float, b << 16); }
__device__ __forceinline__ float bflo(unsigned w) { return __builtin_bit_cast(float, w << 16); }
__device__ __forceinline__ float bfhi(unsigned w) { return __builtin_bit_cast(float, w & 0xffff0000u); }
__device__ __forceinline__ float frcp(float x) { return __builtin_amdgcn_rcpf(x); }
__device__ __forceinline__ float frsq(float x) { return __builtin_amdgcn_rsqf(x); }
__device__ __forceinline__ float sigmoidf_(float x) { return frcp(1.0f + __expf(-x)); }
__device__ __forceinline__ float siluf_(float x) { return x * frcp(1.0f + __expf(-x)); }
__device__ __forceinline__ float gelu_tanh(float x) {
    const float p = __builtin_fmaf(x * x, -0.10294324f, -2.3022082f); return x * frcp(1.0f + __builtin_amdgcn_exp2f(x * p)); }
__device__ __forceinline__ float softplusf_(float x) { return x > 20.f ? x : log1pf(expf(x)); }
__device__ __forceinline__ float softplus_fast(float x) { return x > 20.f ? x : __logf(1.0f + __expf(x)); }
template <int CTRL> __device__ __forceinline__ float dppf(float v) { return __builtin_bit_cast(float, __builtin_amdgcn_update_dpp(0, __builtin_bit_cast(int, v), CTRL, 0xF, 0xF, true)); }
constexpr int DPP_XOR1 = 0xB1, DPP_XOR2 = 0x4E, DPP_HALF_MIRROR = 0x141, DPP_MIRROR = 0x140, DPP_ROR4 = 0x124, DPP_ROR8 = 0x128;
__device__ __forceinline__ float row16_sum(float v) {
    v += dppf<DPP_XOR1>(v); v += dppf<DPP_XOR2>(v); v += dppf<DPP_HALF_MIRROR>(v); v += dppf<DPP_MIRROR>(v); return v;
}
__device__ __forceinline__ float xrow_sum(float x) {
    const auto s = __builtin_amdgcn_permlane16_swap(__float_as_uint(x), __float_as_uint(x), false, false); x = __uint_as_float(s[0]) + __uint_as_float(s[1]);
    const auto t = __builtin_amdgcn_permlane32_swap(__float_as_uint(x), __float_as_uint(x), false, false); return __uint_as_float(t[0]) + __uint_as_float(t[1]);
}
__device__ __forceinline__ float xrow_up32(float x) {
    const auto t = __builtin_amdgcn_permlane32_swap(__float_as_uint(x), __float_as_uint(x), false, false); return __uint_as_float(t[0]);
}
__device__ __forceinline__ float xrow_up16(float x, int fq) {
    const auto s = __builtin_amdgcn_permlane16_swap(__float_as_uint(x), __float_as_uint(x), false, false);
    const auto t = __builtin_amdgcn_permlane32_swap(s[1], s[1], false, false);
    return __uint_as_float(fq == 2 ? t[0] : s[0]);
}
template <bool LAST> __device__ __forceinline__ float xrow_bcast(float x) {
    const auto t = __builtin_amdgcn_permlane32_swap(__float_as_uint(x), __float_as_uint(x), false, false);
    const unsigned h = LAST ? t[1] : t[0];
    const auto s = __builtin_amdgcn_permlane16_swap(h, h, false, false);
    return __uint_as_float(LAST ? s[1] : s[0]);
}
__device__ __forceinline__ float wave_sum(float v) { return xrow_sum(row16_sum(v)); }
__device__ __forceinline__ bf16x8 pack8(const float* f) { v4u w; w.x = pk2(f[0], f[1]); w.y = pk2(f[2], f[3]); w.z = pk2(f[4], f[5]); w.w = pk2(f[6], f[7]); return __builtin_bit_cast(bf16x8, w); }
constexpr int S256 = 272, S128 = 144, S512 = 528;
__device__ __forceinline__ int t256(int row, int col) { return row * S256 + col * 2; }
__device__ __forceinline__ int t128(int row, int col) { return row * S128 + col * 2; }
__device__ __forceinline__ int t512(int row, int col) { return row * S512 + col * 2; }

#define XB_TMO      128
#define XB_XCNT(j)  (256  + 64 * (j))
#define XB_XSUB(j)  (1280 + 64 * (j))
#define XB_XGEN(j)  (2304 + 64 * (j))
#define XB_TOP      3328
#define XB_TOPGEN   3392
#define XCD_BAR_WORDS 3456
#define XB_SPIN_CAP (1u << 20)
__device__ __forceinline__ unsigned xb_ld(unsigned* p)              { return __hip_atomic_load(p, __ATOMIC_RELAXED, __HIP_MEMORY_SCOPE_AGENT); }
__device__ __forceinline__ unsigned xb_add(unsigned* p, unsigned v) { return __hip_atomic_fetch_add(p, v, __ATOMIC_RELAXED, __HIP_MEMORY_SCOPE_AGENT); }
__device__ __forceinline__ unsigned xb_xcc_id() { return (unsigned)__builtin_amdgcn_s_getreg((3 << 11) | 20) & 0xFu; }
#define XB_SPIN(cond, bar) do { unsigned _sp = 0; while (cond) { __builtin_amdgcn_s_sleep(1); \
    if ((++_sp & 255u) == 0u) { if (xb_ld(&(bar)[XB_TMO])) break; if (_sp > XB_SPIN_CAP) { atomicAdd(&(bar)[XB_TMO], 1u); break; } } } } while (0)
struct XcdBarrier { unsigned* bar; unsigned x; volatile LAS unsigned* st; };
__device__ __forceinline__ XcdBarrier xcd_barrier_post(unsigned* bar, volatile LAS unsigned* st) {
    XcdBarrier b; b.bar = bar; b.x = xb_xcc_id(); b.st = st;
    if (threadIdx.x == 0) (void)xb_add(&bar[XB_XCNT(b.x)], 1u);
    return b;
}
__device__ __forceinline__ void xcd_barrier_complete(unsigned* bar, unsigned x, unsigned& nloc, unsigned& nx) {
    const unsigned G = gridDim.x * gridDim.y * gridDim.z;
    unsigned sum, cnt, mine, sp = 0u;
    for (;;) {
        sum = 0u; cnt = 0u; mine = 0u;
#pragma unroll
        for (unsigned j = 0; j < 16; ++j) { const unsigned c = xb_ld(&bar[XB_XCNT(j)]); sum += c; cnt += (c > 0u) ? 1u : 0u; mine = (j == x) ? c : mine; }
        if (sum == G) break;
        __builtin_amdgcn_s_sleep(1);
        if ((++sp & 255u) == 0u) { if (xb_ld(&bar[XB_TMO])) break; if (sp > XB_SPIN_CAP) { atomicAdd(&bar[XB_TMO], 1u); break; } }
    }
    nloc = mine > 0u ? mine : 1u; nx = cnt > 0u ? cnt : 1u;
}
template <bool FENCED = true>
__device__ __forceinline__ void xcd_barrier(const XcdBarrier& b) {
    asm volatile("s_waitcnt vmcnt(0)" ::: "memory");
    __syncthreads();
    if (threadIdx.x == 0) {
        unsigned* bar = b.bar;
        __builtin_amdgcn_s_waitcnt(0);
        unsigned nloc = b.st[0], nx = b.st[1];
        if (nloc == 0u) { xcd_barrier_complete(bar, b.x, nloc, nx); b.st[0] = nloc; b.st[1] = nx; }
        const unsigned old = xb_add(&bar[XB_XSUB(b.x)], 1u);
        const unsigned gen = old / nloc;
        if (old + 1u == (gen + 1u) * nloc) {
            if (FENCED) __builtin_amdgcn_fence(__ATOMIC_RELEASE, "agent");
            asm volatile("s_waitcnt vmcnt(0)" ::: "memory");
            (void)xb_add(&bar[XB_TOP], 1u);
            XB_SPIN(xb_ld(&bar[XB_TOP]) < (gen + 1u) * nx, bar);
            xb_add(&bar[XB_XGEN(b.x)], 1u);
            if (FENCED) __builtin_amdgcn_fence(__ATOMIC_ACQUIRE, "agent");
            asm volatile("s_waitcnt vmcnt(0)" ::: "memory");
        } else {
            XB_SPIN(xb_ld(&bar[XB_XGEN(b.x)]) == gen, bar);
            if (FENCED) __builtin_amdgcn_fence(__ATOMIC_ACQUIRE, "agent");
            asm volatile("s_waitcnt vmcnt(0)" ::: "memory");
        }
    }
    __syncthreads();
}

struct Frame {
    LAS unsigned char* lds;
    int tid, lane, wave, wg, G;
    const float* const* in;
    float* out; unsigned char* ws;
};
enum { I_XP = 0, I_XS, I_S5RE, I_S5IM, I_LRUH, I_LRUC, I_GS, I_GC, I_NMPRE, I_NMPOST, I_NFPRE, I_NFPOST, I_WIN, I_LRE, I_LIM, I_LDT, I_BRE, I_BIM, I_CRE, I_CIM, I_S5D, I_WGLU, I_BGLU,
       I_LCW, I_LCB, I_LWA, I_LBA, I_LWX, I_LBX, I_LLAM, I_GCW, I_GALOG, I_GDTB, I_GNW, I_WOUT, I_WGU, I_WDN };

__device__ __forceinline__ void transpose_item(const float* W, int ldw, int K, int k0, int c0, bf16* WT, int r0, LAS float* scr, int lane, const float* ksc = nullptr) {
    float tv[32];
#pragma unroll
    for (int i = 0; i < 32; ++i) tv[i] = W[(size_t)(k0 + 2 * i + (lane >> 5)) * ldw + c0 + (lane & 31)];
    if (ksc) {
#pragma unroll
        for (int i = 0; i < 32; ++i) tv[i] *= ksc[k0 + 2 * i + (lane >> 5)];
    }
#pragma unroll
    for (int i = 0; i < 32; ++i) scr[(2 * i + (lane >> 5)) * 33 + (lane & 31)] = tv[i];
    LDS_WAIT(); asm volatile("" ::: "memory");
    const int c = lane & 7;
#pragma unroll
    for (int j = 0; j < 4; ++j) { const int n = (lane >> 3) + 8 * j; const LAS float* s = scr + (8 * c) * 33 + n;
        v4u o; o.x = pk2(s[0 * 33], s[1 * 33]); o.y = pk2(s[2 * 33], s[3 * 33]); o.z = pk2(s[4 * 33], s[5 * 33]); o.w = pk2(s[6 * 33], s[7 * 33]);
        *(GAS v4u*)(WT + (size_t)(r0 + n) * K + k0 + 8 * c) = o; }
    LDS_WAIT(); asm volatile("" ::: "memory");
}
template <int MASK>
__device__ __forceinline__ void convert_items(Frame& F, int l, int wg0) {
    LAS float* scr = (LAS float*)(F.lds + F.wave * 16384);
    int lane = F.lane; asm volatile("" : "+v"(lane));
    const int gw = (F.wg - wg0) * NWAVES + F.wave, NGW = (F.G - wg0) * NWAVES;
    if (gw < 0) return;
    constexpr int I1 = (MASK & 1) ? 16 * 88 : 0, I2 = (MASK & 2) ? 16 * 32 : 0, I3 = (MASK & 4) ? 16 * 176 : 0, I4 = (MASK & 8) ? 44 * 32 : 0, I5 = (MASK & 16) ? 4 * 8 : 0, NIT = I1 + I2 + I3 + I4 + I5;
    unsigned char* ws = F.ws;
    for (int it = gw; it < NIT; it += NGW) {
        int r = it;
        if (r < I1) { const int kb = r / 88, nb = r % 88; transpose_item(F.in[I_WIN] + (size_t)l * DM * INC, INC, DM, 64 * kb, nb * 32 + (nb >= 72 ? 8 : 0), (bf16*)(ws + WS_WIN), nb * 32, scr, lane, F.in[I_NMPRE] + l * DM); continue; } r -= I1;
        if (r < I2) { const int kb = r / 32, nb = r % 32; transpose_item(F.in[I_WOUT] + (size_t)l * DM * DM, DM, DM, 64 * kb, nb * 32, (bf16*)(ws + WS_WOUT), nb * 32, scr, lane); continue; } r -= I2;
        if (r < I3) { const int kb = r / 176, nb = r % 176, tile = nb >> 3, wi = nb & 7; const int c0 = wi < 4 ? tile * 128 + wi * 32 : FF + tile * 128 + (wi - 4) * 32;
                      transpose_item(F.in[I_WGU] + (size_t)l * DM * 2 * FF, 2 * FF, DM, 64 * kb, c0, (bf16*)(ws + WS_WGU), nb * 32, scr, lane, F.in[I_NFPRE] + l * DM); continue; } r -= I3;
        if (r < I4) { const int kb = r / 32, nb = r % 32; transpose_item(F.in[I_WDN] + (size_t)l * FF * DM, DM, FF, 64 * kb, nb * 32, (bf16*)(ws + WS_WDN), nb * 32, scr, lane); continue; } r -= I4;
        if (r < I5) { const int kb = r / 8, nb = r % 8; transpose_item(F.in[I_WGLU] + (size_t)l * 256 * 256, 256, 256, 64 * kb, nb * 32, (bf16*)(ws + WS_WGLU), nb * 32, scr, lane); }
    }
}
constexpr size_t WS_DEP = 256 * 1024;
__device__ __forceinline__ unsigned* dep_word(Frame& F, int bank, int i) { return (unsigned*)(F.ws + WS_CTL + WS_DEP) + ((size_t)bank * 96 + i) * 64; }
__device__ __forceinline__ void dep_publish(Frame& F, unsigned* w0, unsigned* w1) {
    asm volatile("s_waitcnt vmcnt(0)" ::: "memory");
    __syncthreads();
    if (F.tid == 0) {
        __builtin_amdgcn_fence(__ATOMIC_RELEASE, "agent");
        asm volatile("s_waitcnt vmcnt(0)" ::: "memory");
        (void)xb_add(w0, 1u);
        if (w1) (void)xb_add(w1, 1u);
    }
}
__device__ __forceinline__ void dep_wait(Frame& F, unsigned* w0, unsigned n0, unsigned* w1, unsigned n1, unsigned* bar) {
    if (F.tid == 0) {
        XB_SPIN(xb_ld(w0) < n0, bar);
        if (w1) XB_SPIN(xb_ld(w1) < n1, bar);
        __builtin_amdgcn_fence(__ATOMIC_ACQUIRE, "agent");
        asm volatile("s_waitcnt vmcnt(0)" ::: "memory");
    }
    __syncthreads();
}
template <bool XIN_B, bool XOUT_B, bool LOCAL = false>
__device__ __forceinline__ void row_pass(Frame& F, const float* xp, const float* xs, const bf16* branch, const float* wb, float* xout, const float* wh, float* RS, const float* wab, float* AB, int lbase = 0, unsigned* sw = nullptr, unsigned sn = 0, unsigned* bar = nullptr) {
    int lane = F.lane; asm volatile("" : "+v"(lane));
    const int gw = F.wg * NWAVES + F.wave, NGW = F.G * NWAVES;
    f32x4 wbv[4], whv[4];
#pragma unroll
    for (int j = 0; j < 4; ++j) { wbv[j] = branch ? *(const GAS f32x4*)(wb + 4 * lane + 256 * j) : (f32x4){0.f, 0.f, 0.f, 0.f}; whv[j] = wh ? *(const GAS f32x4*)(wh + 4 * lane + 256 * j) : (f32x4){0.f, 0.f, 0.f, 0.f}; }
    LAS float* WL = (LAS float*)F.lds;
    if (wab) {
        f32x4 wl4[4];
#pragma unroll
        for (int k4 = 0; k4 < 4; ++k4) { const int i = F.tid + k4 * NTHR; const int k = i >> 1, hlf = i & 1; wl4[k4] = *(const GAS f32x4*)(wab + (size_t)k * INC + 2304 + hlf * 4); }
        __syncthreads();
#pragma unroll
        for (int k4 = 0; k4 < 4; ++k4) { const int i = F.tid + k4 * NTHR; const int k = i >> 1, hlf = i & 1; *(LAS f32x4*)(WL + k * 8 + hlf * 4) = wl4[k4]; }
        __syncthreads(); }
    const int nit = LOCAL ? (F.wave < 2 ? 9 : 8) : (MT - gw + NGW - 1) / NGW;
    for (int it = 0; it < nit; ++it) {
        const int m = LOCAL ? (it < 8 ? lbase + it : MP + 2 * F.wg + F.wave) : gw + it * NGW;
        if (LOCAL && it == 8) {
            XB_SPIN(xb_ld(sw) < sn, bar);
            __builtin_amdgcn_fence(__ATOMIC_ACQUIRE, "agent");
            asm volatile("s_waitcnt vmcnt(0)" ::: "memory");
        }
        f32x4 v[4];
        if (XIN_B) {
#pragma unroll
            for (int j = 0; j < 4; ++j) { const v2u w = *(const GAS v2u*)((const bf16*)xp + (size_t)m * DM + 4 * lane + 256 * j); v[j] = (f32x4){bflo(w.x), bfhi(w.x), bflo(w.y), bfhi(w.y)}; }
        } else {
            const float* xr = (xs && m >= MP) ? xs + (size_t)(m - MP) * DM : xp + (size_t)m * DM;
#pragma unroll
            for (int j = 0; j < 4; ++j) v[j] = *(const GAS f32x4*)(xr + 4 * lane + 256 * j);
        }
        if (branch) {
            f32x4 b[4]; float s = 0.f;
#pragma unroll
            for (int j = 0; j < 4; ++j) { const v2u bw = *(const GAS v2u*)(branch + (size_t)m * DM + 4 * lane + 256 * j); b[j] = (f32x4){bflo(bw.x), bfhi(bw.x), bflo(bw.y), bfhi(bw.y)}; s += (b[j].x * b[j].x + b[j].y * b[j].y) + (b[j].z * b[j].z + b[j].w * b[j].w); }
            const float rs = 1.0f / sqrtf(wave_sum(s) * (1.f / DM) + EPS);
#pragma unroll
            for (int j = 0; j < 4; ++j) v[j] = v[j] + b[j] * rs * wbv[j];
        }
        if (xout) {
#pragma unroll
            for (int j = 0; j < 4; ++j) {
                if (XOUT_B) { v2u o; o.x = pk2(v[j].x, v[j].y); o.y = pk2(v[j].z, v[j].w); *(GAS v2u*)((bf16*)xout + (size_t)m * DM + 4 * lane + 256 * j) = o; }
                else *(GAS f32x4*)(xout + (size_t)m * DM + 4 * lane + 256 * j) = v[j];
            }
        }
        if (RS) {
            float s = 0.f;
#pragma unroll
            for (int j = 0; j < 4; ++j) s += (v[j].x * v[j].x + v[j].y * v[j].y) + (v[j].z * v[j].z + v[j].w * v[j].w);
            const float rs = 1.0f / sqrtf(wave_sum(s) * (1.f / DM) + EPS);
            if (lane == 0) RS[m] = rs;
            if (wab) {
#pragma unroll
                for (int j = 0; j < 4; ++j) v[j] = v[j] * rs * whv[j];
            }
            if (wab) {
                float a8[8];
#pragma unroll
                for (int c = 0; c < 8; ++c) a8[c] = 0.f;
#pragma unroll
                for (int j = 0; j < 4; ++j)
#pragma unroll
                    for (int q = 0; q < 4; ++q) { const LAS float* wr = WL + (4 * lane + 256 * j + q) * 8; const f32x4 w0 = *(const LAS f32x4*)wr, w1 = *(const LAS f32x4*)(wr + 4); const float xv = v[j][q];
                        a8[0] += xv * w0.x; a8[1] += xv * w0.y; a8[2] += xv * w0.z; a8[3] += xv * w0.w; a8[4] += xv * w1.x; a8[5] += xv * w1.y; a8[6] += xv * w1.z; a8[7] += xv * w1.w; }
                {
                    const bool b0 = lane & 1, b1 = lane & 2, b2 = lane & 4;
                    float b4[4], c2[2];
#pragma unroll
                    for (int i = 0; i < 4; ++i) { const float snd = b0 ? a8[i] : a8[i + 4], kp = b0 ? a8[i + 4] : a8[i]; b4[i] = kp + dppf<DPP_XOR1>(snd); }
#pragma unroll
                    for (int i = 0; i < 2; ++i) { const float snd = b1 ? b4[i] : b4[i + 2], kp = b1 ? b4[i + 2] : b4[i]; c2[i] = kp + dppf<DPP_XOR2>(snd); }
                    const float snd = b2 ? c2[0] : c2[1], kp = b2 ? c2[1] : c2[0]; float d = kp + __shfl_xor(snd, 4);
                    d += dppf<DPP_ROR8>(d); d = xrow_sum(d);
                    if (lane < 8) AB[(size_t)m * 8 + ((lane & 1) << 2 | (lane & 2) | (lane & 4) >> 2)] = d;
                }
            }
        }
    }
}

__device__ __forceinline__ void sample_gemm_f32(Frame& F, const bf16* A, const bf16* Bt, int K, bf16* C) {
    int tid = F.tid; asm volatile("" : "+v"(tid)); const int lane = tid & 63, wv = tid >> 6, fr = lane & 15, fq = lane >> 4;
    for (int t = F.wg; t < 256; t += F.G) {
        const int row0 = MP + 32 * (t >> 4) + 16 * (wv >> 2), col0 = 64 * (t & 15) + 16 * (wv & 3);
        const bf16* ap = A + (size_t)(row0 + fr) * K + 8 * fq; const bf16* bp = Bt + (size_t)(col0 + fr) * K + 8 * fq;
        f32x4 acc0 = (f32x4){0.f, 0.f, 0.f, 0.f}, acc1 = (f32x4){0.f, 0.f, 0.f, 0.f};
#pragma unroll 4
        for (int k = 0; k < K; k += 64) {
            const v4u a0 = *(const GAS v4u*)(ap + k), b0 = *(const GAS v4u*)(bp + k), a1 = *(const GAS v4u*)(ap + k + 32), b1 = *(const GAS v4u*)(bp + k + 32);
            acc0 = MFMA16(__builtin_bit_cast(bf16x8, a0), __builtin_bit_cast(bf16x8, b0), acc0); acc1 = MFMA16(__builtin_bit_cast(bf16x8, a1), __builtin_bit_cast(bf16x8, b1), acc1);
        }
#pragma unroll
        for (int r = 0; r < 4; ++r) C[(size_t)(row0 + 4 * fq + r) * DM + col0 + fr] = (bf16)f2bf(acc0[r] + acc1[r]);
    }
}

__device__ __forceinline__ void sample_gemm_lds(Frame& F, const bf16* A, const bf16* Bt, int K, bf16* C) {
    int tid = F.tid; asm volatile("" : "+v"(tid)); const int lane = tid & 63, wv = tid >> 6, fr = lane & 15, fq = lane >> 4;
    LAS unsigned char* L = F.lds;
    constexpr int SA = 32 * S512, SBUF = SA + 64 * S512;
    for (int t = F.wg; t < 256; t += F.G) {
        const int row0 = MP + 32 * (t >> 4), col0 = 64 * (t & 15);
        const int pr = tid >> 5, pc = (tid & 31) * 8;
        const bf16* ap = A + (size_t)(row0 + pr) * K + pc; const bf16* bp = Bt + (size_t)(col0 + pr) * K + pc;
        const size_t s16 = (size_t)16 * K;
        const int sa = pr * S512 + pc * 2, sb = SA + sa;
        struct Regs { v4u a0, a1, b0, b1, b2, b3; } r0, r1;
#define SG_ISSUE(R, KC) do { const int o_ = (KC) * 256; R.a0 = *(const GAS v4u*)(ap + o_); R.a1 = *(const GAS v4u*)(ap + s16 + o_); \
            R.b0 = *(const GAS v4u*)(bp + o_); R.b1 = *(const GAS v4u*)(bp + s16 + o_); R.b2 = *(const GAS v4u*)(bp + 2 * s16 + o_); R.b3 = *(const GAS v4u*)(bp + 3 * s16 + o_); } while (0)
#define SG_WRITE(R, BUF) do { *(LAS v4u*)(L + (BUF) + sa) = R.a0; *(LAS v4u*)(L + (BUF) + sa + 16 * S512) = R.a1; \
            *(LAS v4u*)(L + (BUF) + sb) = R.b0; *(LAS v4u*)(L + (BUF) + sb + 16 * S512) = R.b1; *(LAS v4u*)(L + (BUF) + sb + 32 * S512) = R.b2; *(LAS v4u*)(L + (BUF) + sb + 48 * S512) = R.b3; } while (0)
#define SG_MMA(BUF) do { _Pragma("unroll") for (int ks = 0; ks < 8; ++ks) { \
            const bf16x8 af = *(const LAS bf16x8*)(L + (BUF) + (16 * (wv >> 2) + fr) * S512 + (32 * ks + 8 * fq) * 2); \
            const bf16x8 bf = *(const LAS bf16x8*)(L + (BUF) + SA + (16 * (wv & 3) + fr) * S512 + (32 * ks + 8 * fq) * 2); acc = MFMA16(af, bf, acc); } } while (0)
#define SG_BAR() do { asm volatile("s_waitcnt lgkmcnt(0)" ::: "memory"); __builtin_amdgcn_s_barrier(); asm volatile("" ::: "memory"); } while (0)
        const int nc = K >> 8;
        __syncthreads();
        SG_ISSUE(r0, 0); if (nc > 1) SG_ISSUE(r1, 1);
        SG_WRITE(r0, 0);
        SG_BAR();
        f32x4 acc = (f32x4){0.f, 0.f, 0.f, 0.f};
        for (int kc = 0; kc < nc; kc += 2) {
            if (kc + 2 < nc) SG_ISSUE(r0, kc + 2);
            SG_MMA(0);
            if (kc + 1 < nc) SG_WRITE(r1, SBUF);
            SG_BAR();
            if (kc + 1 >= nc) break;
            if (kc + 3 < nc) SG_ISSUE(r1, kc + 3);
            SG_MMA(SBUF);
            if (kc + 2 < nc) SG_WRITE(r0, 0);
            SG_BAR();
        }
#undef SG_ISSUE
#undef SG_WRITE
#undef SG_MMA
#undef SG_BAR
#pragma unroll
        for (int r = 0; r < 4; ++r) C[(size_t)(row0 + 16 * (wv >> 2) + 4 * fq + r) * DM + col0 + 16 * (wv & 3) + fr] = (bf16)f2bf(acc[r]);
    }
}

constexpr int G_KN = 0, G_WKT = 0, G_QN = 18432, G_KT = G_QN + 64 * S256, G_VT = G_KT + 128 * S128, G_RAW = G_VT + 128 * S128, G_AT = G_RAW, G_T1 = G_AT + 64 * S128, G_T2 = G_T1 + 64 * S128, G_AF = G_T2 + 64 * S128, G_WVT = G_AF, G_VEC = G_RAW + 52544, G_CW = G_VEC + 1024;
constexpr int RAW_STRIDE = 784;
static_assert(G_RAW + 67 * RAW_STRIDE <= G_VEC && G_CW + 6144 <= LDSCTL_OFF && G_WVT + 128 * S128 <= G_VEC && 64 * S256 <= G_QN && 128 * S128 <= G_QN, "gdn prep lds");
__device__ __forceinline__ void gdn_raw_load(Frame& F, int u, int tid, v4u (&pre)[7], float (&abn)[2]) {
    const int c = u & 31, h = (u >> 5) & 3, b = u >> 7; const bf16* P = (const bf16*)(F.ws + WS_P);
    { const float* ABp = (const float*)(F.ws + WS_AB) + (size_t)(b * SEQ + c * 64 + (tid & 63)) * 8; abn[0] = ABp[h]; abn[1] = ABp[4 + h]; }
#pragma unroll
    for (int k7 = 0; k7 < 7; ++k7) { const int idx = tid + NTHR * k7; const int r = idx / 48, ck = idx % 48, ten = ck >> 4, c16 = ck & 15; const int tt = c * 64 - 3 + r;
        v4u val = (v4u){0u, 0u, 0u, 0u};
        if (idx < 67 * 48 && tt >= 0) val = *(const GAS v4u*)(P + (size_t)(b * SEQ + tt) * NPJ + PQ + ten * 512 + h * HD + c16 * 8);
        pre[k7] = val; }
}
template <int GP_CUT>
__device__ __forceinline__ void gdn_prep(Frame& F, int l, int u, int& cw_head, v4u (&pre)[7], float (&abn)[2], bool have_pre, int u_next) {
    LAS unsigned char* L = F.lds;
    int tid = F.tid; asm volatile("" : "+v"(tid)); const int lane = tid & 63, wv = tid >> 6;
    const int c = u & 31, h = (u >> 5) & 3, b = u >> 7;
    const int row0 = b * SEQ + c * 64;
    const bf16* P = (const bf16*)(F.ws + WS_P);
    const float* AB = (const float*)(F.ws + WS_AB);
    LAS float* VG = (LAS float*)(L + G_VEC); LAS float* VB = VG + 64; LAS float* VEG = VG + 128; LAS float* VEGL = VG + 192;
    const float galog = F.in[I_GALOG][l * 4 + h], gdtb = F.in[I_GDTB][l * 4 + h];
    if (h != cw_head) {
        for (int idx = tid; idx < 1536; idx += NTHR) { const int j = idx / 384, cc = idx % 384; ((LAS float*)(L + G_CW))[idx] = F.in[I_GCW][(size_t)(l * 4 + j) * 1536 + (cc >> 7) * 512 + h * HD + (cc & 127)]; }
        cw_head = h;
    }
    if (!have_pre) gdn_raw_load(F, u, tid, pre, abn);
#pragma unroll
    for (int k7 = 0; k7 < 7; ++k7) { const int idx = tid + NTHR * k7; if (idx < 67 * 48) { const int r = idx / 48, ck = idx % 48; *(LAS v4u*)(L + G_RAW + r * RAW_STRIDE + (ck >> 4) * 256 + (ck & 15) * 16) = pre[k7]; } }
    if (wv == 0) {
        const float a = abn[0], bb = abn[1];
        const float g = -__expf(galog) * softplus_fast(a + gdtb);
        const float be = frcp(1.0f + __expf(-bb));
        float Gc = g;
        Gc += dppf<0x111>(Gc); Gc += dppf<0x112>(Gc); Gc += dppf<0x114>(Gc); Gc += dppf<0x118>(Gc);
        Gc += __builtin_bit_cast(float, __builtin_amdgcn_update_dpp(0, __builtin_bit_cast(int, Gc), 0x142, 0xA, 0xF, false));
        Gc += __builtin_bit_cast(float, __builtin_amdgcn_update_dpp(0, __builtin_bit_cast(int, Gc), 0x143, 0xC, 0xF, false));
        const float Gl = __builtin_bit_cast(float, __builtin_amdgcn_readlane(__builtin_bit_cast(int, Gc), 63));
        VG[lane] = Gc; VB[lane] = be; VEG[lane] = __expf(Gc); VEGL[lane] = __expf(Gl - Gc);
        if (lane == 0) ((float*)(F.ws + WS_EGL))[u] = __expf(Gl);
    }
    __syncthreads();
    if (u_next >= 0) gdn_raw_load(F, u_next, tid, pre, abn);
    if (c == 31 && tid < 384) {
        const int ten = tid >> 7, ch = tid & 127;
#pragma unroll
        for (int j = 0; j < 3; ++j) F.out[O_PGC + (size_t)((l * 8 + b) * 3 + j) * 1536 + ten * 512 + h * HD + ch] = bf2f(*(LAS bf16*)(L + G_RAW + (64 + j) * RAW_STRIDE + ten * 256 + ch * 2));
    }
    {
        const int tg = tid >> 5, cq = tid & 31;
#pragma unroll 1
        for (int ten = 0; ten < 3; ++ten) {
            float xr[7][4];
#pragma unroll
            for (int k = 0; k < 7; ++k) { const v2u xw = *(LAS v2u*)(L + G_RAW + (4 * tg + k) * RAW_STRIDE + ten * 256 + cq * 8); xr[k][0] = bflo(xw.x); xr[k][1] = bfhi(xw.x); xr[k][2] = bflo(xw.y); xr[k][3] = bfhi(xw.y); }
            float acc[4][4];
#pragma unroll
            for (int t = 0; t < 4; ++t)
#pragma unroll
                for (int c = 0; c < 4; ++c) acc[t][c] = 0.f;
#pragma unroll
            for (int j = 0; j < 4; ++j) { const f32x4 w = *(const LAS f32x4*)((const LAS float*)(L + G_CW) + j * 384 + ten * 128 + cq * 4);
#pragma unroll
                for (int t = 0; t < 4; ++t) { acc[t][0] += w.x * xr[t + j][0]; acc[t][1] += w.y * xr[t + j][1]; acc[t][2] += w.z * xr[t + j][2]; acc[t][3] += w.w * xr[t + j][3]; } }
#pragma unroll
            for (int t = 0; t < 4; ++t) {
                float ss = 0.f;
#pragma unroll
                for (int c = 0; c < 4; ++c) { acc[t][c] = siluf_(acc[t][c]); ss += acc[t][c] * acc[t][c]; }
                if (ten < 2) {
                    ss = row16_sum(ss);
                    const auto sw = __builtin_amdgcn_permlane16_swap(__float_as_uint(ss), __float_as_uint(ss), false, false); ss = __uint_as_float(sw[0]) + __uint_as_float(sw[1]);
                    const float sc = frsq(ss + EPS) * (ten == 0 ? 0.08838834764831845f : 1.0f);
#pragma unroll
                    for (int c = 0; c < 4; ++c) acc[t][c] *= sc;
                    v2u o; o.x = pk2(acc[t][0], acc[t][1]); o.y = pk2(acc[t][2], acc[t][3]);
                    *(LAS v2u*)(L + (ten == 0 ? G_QN : G_KN) + t256(4 * tg + t, 4 * cq)) = o;
                }
            }
            if (ten > 0) { const int base = ten == 1 ? G_KT : G_VT;
#pragma unroll
                for (int c = 0; c < 4; ++c) { v2u o; o.x = pk2(acc[0][c], acc[1][c]); o.y = pk2(acc[2][c], acc[3][c]); *(LAS v2u*)(L + base + t128(4 * cq + c, 4 * tg)) = o; } }
        }
    }
    __syncthreads();
    if constexpr (GP_CUT == 1) return;
    {
        const int prod = wv >> 2, mi = wv & 3, fr = lane & 15, fq = lane >> 4;
        bf16x8 a[4];
#pragma unroll
        for (int ks = 0; ks < 4; ++ks) a[ks] = *(LAS bf16x8*)(L + (prod ? G_QN : G_KN) + t256(16 * mi + fr, 32 * ks + 8 * fq));
#pragma unroll
        for (int nj = 0; nj < 4; ++nj) {
            f32x4 acc = (f32x4){0.f, 0.f, 0.f, 0.f};
            if (nj <= mi) {
#pragma unroll
                for (int ks = 0; ks < 4; ++ks) { const bf16x8 bb = *(LAS bf16x8*)(L + G_KN + t256(16 * nj + fr, 32 * ks + 8 * fq)); acc = MFMA16(a[ks], bb, acc); }
            }
            const int j = 16 * nj + fr; const float Gj = VG[j];
#pragma unroll
            for (int r = 0; r < 4; ++r) {
                const int i = 16 * mi + 4 * fq + r; const float Gi = VG[i];
                const float dec = (i >= j) ? __expf(Gi - Gj) : 0.f;
                if (prod == 0) { const float val = (i > j) ? acc[r] * VB[i] * dec : 0.f; *(LAS float*)(L + G_AF + (i * 64 + j) * 4) = val; }
                else { const float val = (i >= j) ? acc[r] * dec : 0.f; *(LAS bf16*)(L + G_AT + t128(i, j)) = (bf16)f2bf(val); }
            }
        }
    }
    __syncthreads();
    if constexpr (GP_CUT == 2) return;
    if (wv == 0) {
        const int q = lane >> 4, col = lane & 15; const LAS float* Ab = (const LAS float*)(L + G_AF) + (16 * q) * 64 + 16 * q;
        float t[16];
#pragma unroll
        for (int i = 0; i < 16; ++i) {
            float a0 = (col == i) ? 1.f : 0.f, a1 = 0.f, a2 = 0.f, a3 = 0.f;
#pragma unroll
            for (int j4 = 0; j4 < i; j4 += 4) { const f32x4 av = *(const LAS f32x4*)(Ab + i * 64 + j4);
                a0 -= av.x * t[j4]; if (j4 + 1 < i) a1 -= av.y * t[j4 + 1]; if (j4 + 2 < i) a2 -= av.z * t[j4 + 2]; if (j4 + 3 < i) a3 -= av.w * t[j4 + 3]; }
            t[i] = (a0 + a1) + (a2 + a3);
            if ((i & 3) == 3) asm volatile("" ::: "memory");
        }
        LAS float* Tb = (LAS float*)(L + G_AF) + (16 * q) * 64 + 16 * q;
#pragma unroll
        for (int i = 0; i < 16; ++i) Tb[i * 64 + col] = t[i];
    }
    __syncthreads();
    if (wv < 2) {
        LAS float* AF = (LAS float*)(L + G_AF) + (32 * wv) * 64 + 32 * wv; LAS float* X1 = (LAS float*)(L + G_T1) + 1024 + 256 * wv;
        const int fr = lane & 15, fq = lane >> 4;
        f32x4 acc = (f32x4){0.f, 0.f, 0.f, 0.f};
#pragma unroll
        for (int kk = 0; kk < 4; ++kk) { const float av = AF[(16 + fr) * 64 + 4 * kk + fq], bv = AF[(4 * kk + fq) * 64 + fr]; acc = __builtin_amdgcn_mfma_f32_16x16x4f32(av, bv, acc, 0, 0, 0); }
#pragma unroll
        for (int r = 0; r < 4; ++r) X1[(4 * fq + r) * 16 + fr] = acc[r];
        acc = (f32x4){0.f, 0.f, 0.f, 0.f};
#pragma unroll
        for (int kk = 0; kk < 4; ++kk) { const float av = AF[(16 + fr) * 64 + 16 + 4 * kk + fq], bv = X1[(4 * kk + fq) * 16 + fr]; acc = __builtin_amdgcn_mfma_f32_16x16x4f32(av, bv, acc, 0, 0, 0); }
#pragma unroll
        for (int r = 0; r < 4; ++r) AF[(16 + 4 * fq + r) * 64 + fr] = -acc[r];
    }
    __syncthreads();
    if constexpr (GP_CUT == 3) return;
    {
        LAS float* AF = (LAS float*)(L + G_AF); LAS float* XF = (LAS float*)(L + G_T1);
        const int mi2 = wv & 1, nj2 = (wv >> 1) & 1, fr = lane & 15, fq = lane >> 4;
        if (wv < 4) {
            f32x4 acc = (f32x4){0.f, 0.f, 0.f, 0.f};
#pragma unroll
            for (int kk = 0; kk < 8; ++kk) { const float av = AF[(32 + 16 * mi2 + fr) * 64 + 4 * kk + fq], bv = AF[(4 * kk + fq) * 64 + 16 * nj2 + fr]; acc = __builtin_amdgcn_mfma_f32_16x16x4f32(av, bv, acc, 0, 0, 0); }
#pragma unroll
            for (int r = 0; r < 4; ++r) XF[(16 * mi2 + 4 * fq + r) * 32 + 16 * nj2 + fr] = acc[r];
        }
        __syncthreads();
        if (wv < 4) {
            f32x4 acc = (f32x4){0.f, 0.f, 0.f, 0.f};
#pragma unroll
            for (int kk = 0; kk < 8; ++kk) { const float av = AF[(32 + 16 * mi2 + fr) * 64 + 32 + 4 * kk + fq], bv = XF[(4 * kk + fq) * 32 + 16 * nj2 + fr]; acc = __builtin_amdgcn_mfma_f32_16x16x4f32(av, bv, acc, 0, 0, 0); }
#pragma unroll
            for (int r = 0; r < 4; ++r) AF[(32 + 16 * mi2 + 4 * fq + r) * 64 + 16 * nj2 + fr] = -acc[r];
        }
        __syncthreads();
    }
    if constexpr (GP_CUT == 4) return;
    {
        const int i = tid >> 3, c8 = tid & 7; const LAS float* AF = (const LAS float*)(L + G_AF);
        const f32x4 t0 = *(const LAS f32x4*)(AF + i * 64 + 8 * c8), t1 = *(const LAS f32x4*)(AF + i * 64 + 8 * c8 + 4);
        float a1[8], a2[8];
#pragma unroll
        for (int e = 0; e < 8; ++e) { const float tv = e < 4 ? t0[e] : t1[e - 4]; const int j = 8 * c8 + e; a1[e] = tv * VB[j]; a2[e] = a1[e] * VEG[j]; }
        __syncthreads();
        *(LAS bf16x8*)(L + G_T1 + t128(i, 8 * c8)) = pack8(a1); *(LAS bf16x8*)(L + G_T2 + t128(i, 8 * c8)) = pack8(a2);
    }
    __syncthreads();
    if constexpr (GP_CUT == 5) return;
    {
        const int nd = wv, fr = lane & 15, fq = lane >> 4;
#pragma unroll
        for (int prod = 0; prod < 2; ++prod) {
            bf16x8 bfr[2];
#pragma unroll
            for (int ks = 0; ks < 2; ++ks) bfr[ks] = *(LAS bf16x8*)(L + (prod ? G_KT : G_VT) + t128(16 * nd + fr, 32 * ks + 8 * fq));
#pragma unroll
            for (int mi = 0; mi < 4; ++mi) {
                f32x4 acc = (f32x4){0.f, 0.f, 0.f, 0.f};
#pragma unroll
                for (int ks = 0; ks < 2; ++ks) { const bf16x8 af = *(LAS bf16x8*)(L + (prod ? G_T2 : G_T1) + t128(16 * mi + fr, 32 * ks + 8 * fq)); acc = MFMA16(af, bfr[ks], acc); }
                v2u o; o.x = pk2(acc[0], acc[1]); o.y = pk2(acc[2], acc[3]);
                *(LAS v2u*)(L + (prod ? G_WKT : G_WVT) + t128(16 * nd + fr, 16 * mi + 4 * fq)) = o;
            }
        }
    }
    __syncthreads();
    if constexpr (GP_CUT == 6) return;
    {
        const int nd = wv, fr = lane & 15, fq = lane >> 4;
        bf16x8 bk[2], bv[2];
#pragma unroll
        for (int ks = 0; ks < 2; ++ks) { bk[ks] = *(LAS bf16x8*)(L + G_WKT + t128(16 * nd + fr, 32 * ks + 8 * fq)); bv[ks] = *(LAS bf16x8*)(L + G_WVT + t128(16 * nd + fr, 32 * ks + 8 * fq)); }
        bf16* QT = (bf16*)(F.ws + WS_QT) + (size_t)u * 64 * 128; bf16* OL = (bf16*)(F.ws + WS_OL) + (size_t)u * 8192;
#pragma unroll
        for (int mi = 0; mi < 4; ++mi) {
            f32x4 ak = (f32x4){0.f, 0.f, 0.f, 0.f}, av = (f32x4){0.f, 0.f, 0.f, 0.f};
#pragma unroll
            for (int ks = 0; ks < 2; ++ks) { const bf16x8 af = *(LAS bf16x8*)(L + G_AT + t128(16 * mi + fr, 32 * ks + 8 * fq)); ak = MFMA16(af, bk[ks], ak); av = MFMA16(af, bv[ks], av); }
#pragma unroll
            for (int r = 0; r < 4; ++r) { const int i = 16 * mi + 4 * fq + r, d = 16 * nd + fr;
                const float qv = bf2f(*(LAS bf16*)(L + G_QN + t256(i, d)));
                QT[(((mi * 4 + (nd >> 1)) * 64) + (4 * fq + r) + 16 * (2 * (nd & 1) + (fr >> 3))) * 8 + (fr & 7)] = (bf16)f2bf(VEG[i] * qv - ak[r]);
                }
            { v2u o; o.x = pk2(av[0], av[1]); o.y = pk2(av[2], av[3]); *(GAS v2u*)(OL + ((nd * 4 + mi) * 64 + lane) * 4) = o; }
        }
    }
    if constexpr (GP_CUT == 7) return;
    {
        const int fr = lane & 15, fq = lane >> 4;
        bf16x8 kd[2];
#pragma unroll
        for (int ks = 0; ks < 2; ++ks) { const v4u raw = *(LAS v4u*)(L + G_KT + t128(16 * wv + fr, 32 * ks + 8 * fq)); const int i0 = 32 * ks + 8 * fq; float f[8];
            f[0] = bflo(raw.x) * VEGL[i0]; f[1] = bfhi(raw.x) * VEGL[i0 + 1]; f[2] = bflo(raw.y) * VEGL[i0 + 2]; f[3] = bfhi(raw.y) * VEGL[i0 + 3];
            f[4] = bflo(raw.z) * VEGL[i0 + 4]; f[5] = bfhi(raw.z) * VEGL[i0 + 5]; f[6] = bflo(raw.w) * VEGL[i0 + 6]; f[7] = bfhi(raw.w) * VEGL[i0 + 7]; kd[ks] = pack8(f); }
        bf16* PP = (bf16*)(F.ws + WS_PP) + (size_t)u * 128 * 128; bf16* RT = (bf16*)(F.ws + WS_RT) + (size_t)u * 128 * 128;
#pragma unroll 2
        for (int nd = 0; nd < 8; ++nd) {
            f32x4 ar = (f32x4){0.f, 0.f, 0.f, 0.f}, ap = (f32x4){0.f, 0.f, 0.f, 0.f};
#pragma unroll
            for (int ks = 0; ks < 2; ++ks) { const bf16x8 wvf = *(LAS bf16x8*)(L + G_WVT + t128(16 * nd + fr, 32 * ks + 8 * fq)), wkf = *(LAS bf16x8*)(L + G_WKT + t128(16 * nd + fr, 32 * ks + 8 * fq));
                ar = MFMA16(kd[ks], wvf, ar); ap = MFMA16(wkf, kd[ks], ap); }
            v2u o; o.x = pk2(ar[0], ar[1]); o.y = pk2(ar[2], ar[3]); *(GAS v2u*)(RT + (size_t)((nd * 8 + wv) * 64 + lane) * 4) = o;
            o.x = pk2(ap[0], ap[1]); o.y = pk2(ap[2], ap[3]); *(GAS v2u*)(PP + (size_t)(((wv * 4 + (nd >> 1)) * 64) + fr + 16 * (2 * (nd & 1) + (fq >> 1))) * 8 + 4 * (fq & 1)) = o;
        }
    }
    __syncthreads();
}

struct ChainSet { v4u ap[4], aq[4]; v2u rr, ol; float eg; };
constexpr int CH_O = 2 * 16 * S256, CH_S = CH_O + 32 * 4 * 512;
static_assert(CH_S + 32 * 4 * 64 <= LDSCTL_OFF, "chain lds");
struct ChainPtr { const bf16* pp; const bf16* qq; const bf16* rt; const bf16* ol; const float* egl; };
__device__ __forceinline__ void chain_load(ChainSet& s, const ChainPtr& p, int c, bool lowhalf) {
    const bf16* pp = p.pp + (size_t)c * 16384;
#pragma unroll
    for (int ks = 0; ks < 4; ++ks) s.ap[ks] = *(const GAS v4u*)(pp + 512 * ks);
    s.rr = *(const GAS v2u*)(p.rt + (size_t)c * 16384); s.eg = p.egl[c];
    if (lowhalf) {
        const bf16* qq = p.qq + (size_t)c * 8192;
#pragma unroll
        for (int ks = 0; ks < 4; ++ks) s.aq[ks] = *(const GAS v4u*)(qq + 512 * ks);
        s.ol = *(const GAS v2u*)(p.ol + (size_t)c * 8192);
    }
}
template <bool DRY>
__device__ __forceinline__ void gdn_chain(Frame& F, int l, int task) {
    LAS unsigned char* L = F.lds;
    int tid = F.tid; asm volatile("" : "+v"(tid)); const int lane = tid & 63, wv = tid >> 6, fr = lane & 15, fq = lane >> 4;
    const int xcd = task & 7, idx = task >> 3; const int chain = xcd * 4 + (idx >> 3), slab = idx & 7;
    const int b = chain >> 2, h = chain & 3;
    const bf16* PPb = (const bf16*)(F.ws + WS_PP) + (size_t)chain * 32 * 16384; bf16* RTb = (bf16*)(F.ws + WS_RT) + (size_t)chain * 32 * 16384;
    const bf16* QTb = (const bf16*)(F.ws + WS_QT) + (size_t)chain * 32 * 8192;
    bf16* OLb = (bf16*)(F.ws + WS_OL) + (size_t)chain * 32 * 8192;
    float* SSQ = (float*)(F.ws + WS_SSQ);
    const float* EGL = (const float*)(F.ws + WS_EGL) + chain * 32;
    const int row0h = b * SEQ;
    f32x4 S = (f32x4){0.f, 0.f, 0.f, 0.f};
    ChainSet cs[4];
    ChainPtr cp;
    cp.pp = PPb + (size_t)(wv * 4 * 64 + lane) * 8; cp.qq = QTb + (size_t)((wv & 3) * 4 * 64 + lane) * 8;
    cp.rt = RTb + (size_t)((slab * 8 + wv) * 64 + lane) * 4;
    cp.ol = OLb + ((slab * 4 + (wv & 3)) * 64 + lane) * 4; cp.egl = EGL;
    asm volatile("" : "+v"(cp.pp), "+v"(cp.qq), "+v"(cp.rt), "+v"(cp.ol));
    const bool lowhalf = wv < 4;
    chain_load(cs[0], cp, 0, lowhalf); chain_load(cs[1], cp, 1, lowhalf); chain_load(cs[2], cp, 2, lowhalf);
    for (int i = F.tid; i < 2 * 16 * S256 / 4; i += NTHR) ((LAS unsigned*)L)[i] = 0u;
    asm volatile("s_waitcnt lgkmcnt(0)" ::: "memory"); __builtin_amdgcn_s_barrier(); asm volatile("" ::: "memory");
#pragma unroll 1
    for (int c0 = 0; c0 < NCH; c0 += 4) {
#pragma unroll
        for (int s = 0; s < 4; ++s) {
            const int c = c0 + s;
            chain_load(cs[(s + 3) & 3], cp, c + 3 < NCH ? c + 3 : NCH - 1, lowhalf);
            const ChainSet& q = cs[s];
            const LAS unsigned char* St = L + (s & 1) * (16 * S256);
            bf16x8 bs[4];
#pragma unroll
            for (int ks = 0; ks < 4; ++ks) bs[ks] = *(const LAS bf16x8*)(St + t256(fr, 32 * ks + 8 * fq));
            f32x4 acc = (f32x4){0.f, 0.f, 0.f, 0.f};
#pragma unroll
            for (int ks = 0; ks < 4; ++ks) acc = MFMA16(__builtin_bit_cast(bf16x8, q.ap[ks]), bs[ks], acc);
            if (lowhalf) {
                f32x4 ao = (f32x4){0.f, 0.f, 0.f, 0.f};
#pragma unroll
                for (int ks = 0; ks < 4; ++ks) ao = MFMA16(__builtin_bit_cast(bf16x8, q.aq[ks]), bs[ks], ao);
                const float o0 = ao[0] + bflo(q.ol.x), o1 = ao[1] + bfhi(q.ol.x), o2 = ao[2] + bflo(q.ol.y), o3 = ao[3] + bfhi(q.ol.y);
                v2u ov; ov.x = pk2(o0, o1); ov.y = pk2(o2, o3);
                float ssr;
                {
                    const float q0 = o0 * o0, q1 = o1 * o1, q2 = o2 * o2, q3 = o3 * o3; const bool b0 = fr & 1, b1 = fr & 2;
                    const float t0 = (b0 ? q2 : q0) + dppf<DPP_XOR1>(b0 ? q0 : q2), t1 = (b0 ? q3 : q1) + dppf<DPP_XOR1>(b0 ? q1 : q3);
                    float u = (b1 ? t1 : t0) + dppf<DPP_XOR2>(b1 ? t0 : t1);
                    u += dppf<DPP_ROR4>(u); u += dppf<DPP_ROR8>(u); ssr = u;
                }
                {
                    *(LAS v2u*)(L + CH_O + ((c * 4 + wv) * 64 + lane) * 8) = ov;
                    if (fr < 4) *(LAS float*)(L + CH_S + ((c * 4 + wv) * 4 + fq) * 16 + (2 * (fr & 1) + (fr >> 1)) * 4) = ssr;
                }
            }
            S[0] = q.eg * S[0] - acc[0] + bflo(q.rr.x); S[1] = q.eg * S[1] - acc[1] + bfhi(q.rr.x); S[2] = q.eg * S[2] - acc[2] + bflo(q.rr.y); S[3] = q.eg * S[3] - acc[3] + bfhi(q.rr.y);
            v2u o2; o2.x = pk2(S[0], S[1]); o2.y = pk2(S[2], S[3]);
            *(LAS v2u*)(L + ((s + 1) & 1) * (16 * S256) + t256(fr, 16 * wv + 4 * fq)) = o2;
            asm volatile("s_waitcnt lgkmcnt(0)" ::: "memory"); __builtin_amdgcn_s_barrier(); asm volatile("" ::: "memory");
        }
    }
    if (!DRY) {
        bf16* MXh = (bf16*)(F.ws + WS_X) + 512 + h * HD + 16 * slab;
#if HEADNORM_IN_GEMM
        const bf16* Zh = (const bf16*)(F.ws + WS_P) + PZ + h * HD + 16 * slab + 8 * (tid & 1);
        const float* gwp = F.in[I_GNW] + l * HD + 16 * slab + 8 * (tid & 1);
        const f32x4 w0 = *(const GAS f32x4*)gwp, w1 = *(const GAS f32x4*)(gwp + 4);
#endif
#if HEADNORM_IN_GEMM
        v4u zq[8];
#pragma unroll
        for (int k = 0; k < 8; ++k) { const int i = tid + k * NTHR; zq[k] = *(const GAS v4u*)(Zh + (size_t)(row0h + (i >> 7) * 64 + ((i >> 1) & 63)) * NPJ); }
#pragma unroll
        for (int k = 0; k < 8; ++k) { const int i = tid + k * NTHR; const int half = i & 1, rr = (i >> 1) & 63, cc = i >> 7; const int mi = rr >> 4, fq2 = (rr >> 2) & 3, r = rr & 3;
#else
        for (int i = tid; i < 32 * 64 * 2; i += NTHR) { const int half = i & 1, rr = (i >> 1) & 63, cc = i >> 7; const int mi = rr >> 4, fq2 = (rr >> 2) & 3, r = rr & 3;
#endif
            unsigned w[4];
#pragma unroll
            for (int e = 0; e < 4; ++e) { const int f0 = 8 * half + 2 * e;
                const unsigned lo = *(const LAS unsigned short*)(L + CH_O + ((cc * 4 + mi) * 64 + fq2 * 16 + f0) * 8 + r * 2), hi = *(const LAS unsigned short*)(L + CH_O + ((cc * 4 + mi) * 64 + fq2 * 16 + f0 + 1) * 8 + r * 2);
                w[e] = lo | (hi << 16); }
#if HEADNORM_IN_GEMM
            const v4u zv = zq[k];
            float y[8];
            y[0] = bflo(w[0]) * w0.x * siluf_(bflo(zv.x)); y[1] = bfhi(w[0]) * w0.y * siluf_(bfhi(zv.x)); y[2] = bflo(w[1]) * w0.z * siluf_(bflo(zv.y)); y[3] = bfhi(w[1]) * w0.w * siluf_(bfhi(zv.y));
            y[4] = bflo(w[2]) * w1.x * siluf_(bflo(zv.z)); y[5] = bfhi(w[2]) * w1.y * siluf_(bfhi(zv.z)); y[6] = bflo(w[3]) * w1.z * siluf_(bflo(zv.w)); y[7] = bfhi(w[3]) * w1.w * siluf_(bfhi(zv.w));
            *(GAS bf16x8*)(MXh + (size_t)(row0h + cc * 64 + rr) * DM + 8 * half) = pack8(y); }
#else
            *(GAS v4u*)(MXh + (size_t)(row0h + cc * 64 + rr) * DM + 8 * half) = (v4u){w[0], w[1], w[2], w[3]}; }
#endif
        for (int i = tid; i < 32 * 64; i += NTHR) { const int rr = i & 63, cc = i >> 6; const int mi = rr >> 4, fq2 = (rr >> 2) & 3, r = rr & 3;
            SSQ[(size_t)(row0h + cc * 64 + rr) * 32 + h * 8 + slab] = *(const LAS float*)(L + CH_S + ((cc * 4 + mi) * 4 + fq2) * 16 + r * 4); }
        float* So = F.out + O_PGS + (size_t)((l * 8 + b) * 4 + h) * 16384;
#pragma unroll
        for (int r = 0; r < 4; ++r) So[(size_t)(16 * wv + 4 * fq + r) * 128 + 16 * slab + fr] = S[r];
    }
    __syncthreads();
}

__device__ __forceinline__ void gdn_finalize(Frame& F, int l) {
    bf16* MX = (bf16*)(F.ws + WS_X); const bf16* P = (const bf16*)(F.ws + WS_P); const float* SSQ = (const float*)(F.ws + WS_SSQ);
    const int nth = F.G * NTHR;
    for (int it = F.wg * NTHR + F.tid; it < MP * 64; it += nth) {
        const int row = it >> 6, hh = (it >> 4) & 3, ck = it & 15;
        const f32x4 s0 = *(const GAS f32x4*)(SSQ + (size_t)row * 32 + hh * 8), s1 = *(const GAS f32x4*)(SSQ + (size_t)row * 32 + hh * 8 + 4);
        const float rs = frsq(((s0.x + s0.y) + (s0.z + s0.w) + (s1.x + s1.y) + (s1.z + s1.w)) * (1.f / HD) + EPS);
        const v4u ov = *(const GAS v4u*)(MX + (size_t)row * DM + 512 + hh * HD + ck * 8), zv = *(const GAS v4u*)(P + (size_t)row * NPJ + PZ + hh * HD + ck * 8);
        const f32x4 w0 = *(const GAS f32x4*)(F.in[I_GNW] + l * HD + ck * 8), w1 = *(const GAS f32x4*)(F.in[I_GNW] + l * HD + ck * 8 + 4);
        float y[8];
        y[0] = bflo(ov.x) * rs * w0.x * siluf_(bflo(zv.x)); y[1] = bfhi(ov.x) * rs * w0.y * siluf_(bfhi(zv.x)); y[2] = bflo(ov.y) * rs * w0.z * siluf_(bflo(zv.y)); y[3] = bfhi(ov.y) * rs * w0.w * siluf_(bfhi(zv.y));
        y[4] = bflo(ov.z) * rs * w1.x * siluf_(bflo(zv.z)); y[5] = bfhi(ov.z) * rs * w1.y * siluf_(bfhi(zv.z)); y[6] = bflo(ov.w) * rs * w1.z * siluf_(bflo(zv.w)); y[7] = bfhi(ov.w) * rs * w1.w * siluf_(bfhi(zv.w));
        *(GAS bf16x8*)(MX + (size_t)row * DM + 512 + hh * HD + ck * 8) = pack8(y);
    }
}


__device__ __forceinline__ void gdn_sample_load(Frame& F, int l, int task, float (&S)[32]) {
    const int b = task >> 2, h = task & 3, j = F.tid & 127, rq = F.tid >> 7;
    const float* S0 = F.in[I_GS] + (size_t)((l * 128 + b) * 4 + h) * 16384 + (size_t)(32 * rq) * 128 + j;
#pragma unroll
    for (int ii = 0; ii < 32; ++ii) S[ii] = S0[ii * 128];
}
struct GsAux { float cwv[3][4], rv[6]; };
__device__ __forceinline__ void gdn_sample_aux_load(Frame& F, int l, int task, GsAux& a) {
    const int tid = F.tid; const int b = task >> 2, h = task & 3; const int m0 = MP + b * 4;
    const bf16* P = (const bf16*)(F.ws + WS_P);
    {
        const int ch = tid & 127;
#pragma unroll
        for (int ten = 0; ten < 3; ++ten)
#pragma unroll
            for (int jj = 0; jj < 4; ++jj) a.cwv[ten][jj] = F.in[I_GCW][(size_t)(l * 4 + jj) * 1536 + ten * 512 + h * HD + ch];
    }
#pragma unroll
    for (int k6 = 0; k6 < 6; ++k6) { const int idx = tid + k6 * NTHR; const int r = idx / 384, cc = idx % 384, ten = cc >> 7, ch = cc & 127;
        float v = 0.f;
        if (idx < 7 * 384) { if (r < 3) v = F.in[I_GC][(size_t)((l * 128 + b) * 3 + r) * 1536 + ten * 512 + h * HD + ch]; else v = bf2f(P[(size_t)(m0 + r - 3) * NPJ + PQ + ten * 512 + h * HD + ch]); }
        a.rv[k6] = v; }
}
__device__ __forceinline__ void gdn_sample(Frame& F, int l, int task, float (&S)[32], const GsAux& ax) {
    LAS float* L = (LAS float*)F.lds;
    LAS float* RAW = L;
    LAS float* QS = L + 7 * 384;
    LAS float* KS = QS + 512; LAS float* VS = KS + 512; LAS float* OS = VS + 512;
    LAS float* RED = OS + 512;
    LAS float* NRM = RED + 512;
    int tid = F.tid; asm volatile("" : "+v"(tid)); const int lane = tid & 63, wv = tid >> 6;
    const int b = task >> 2, h = task & 3; const int m0 = MP + b * 4;
    const bf16* P = (const bf16*)(F.ws + WS_P); const float* AB = (const float*)(F.ws + WS_AB); bf16* MX = (bf16*)(F.ws + WS_X);
    const int j = tid & 127, rq = tid >> 7;
    float cwv[3][4], gA[4], gB[4];
#pragma unroll
    for (int ten = 0; ten < 3; ++ten)
#pragma unroll
        for (int jj = 0; jj < 4; ++jj) cwv[ten][jj] = ax.cwv[ten][jj];
    const float galog = F.in[I_GALOG][l * 4 + h], dtb = F.in[I_GDTB][l * 4 + h];
#pragma unroll
    for (int t = 0; t < 4; ++t) { gA[t] = AB[(size_t)(m0 + t) * 8 + h]; gB[t] = AB[(size_t)(m0 + t) * 8 + 4 + h]; }
    const float zv = bf2f(P[(size_t)(m0 + (tid >> 7)) * NPJ + PZ + h * HD + (tid & 127)]), gnw = F.in[I_GNW][l * HD + (tid & 127)];
#pragma unroll
    for (int k6 = 0; k6 < 6; ++k6) { const int idx = tid + k6 * NTHR; if (idx < 7 * 384) RAW[idx] = ax.rv[k6]; }
    __syncthreads();
    if (tid < 384) { const int ten = tid >> 7, ch = tid & 127;
#pragma unroll
        for (int j = 0; j < 3; ++j) F.out[O_SGC + (size_t)((l * 128 + b) * 3 + j) * 1536 + ten * 512 + h * HD + ch] = RAW[(4 + j) * 384 + tid]; }
    float cq, ck, cv;
    {
        const int tok = tid >> 7, ch = tid & 127; float r3[3];
#pragma unroll
        for (int ten = 0; ten < 3; ++ten) { float a = 0.f;
#pragma unroll
            for (int j = 0; j < 4; ++j) a += cwv[ten][j] * RAW[(tok + j) * 384 + ten * 128 + ch];
            r3[ten] = siluf_(a); }
        cq = r3[0]; ck = r3[1]; cv = r3[2];
        const float sq = wave_sum(cq * cq), sk = wave_sum(ck * ck);
        if (lane == 0) { NRM[wv * 4] = sq; NRM[wv * 4 + 1] = sk; }
    }
    __syncthreads();
    {
        const int tok = tid >> 7, ch = tid & 127;
        const float sq = NRM[(2 * tok) * 4] + NRM[(2 * tok + 1) * 4], sk = NRM[(2 * tok) * 4 + 1] + NRM[(2 * tok + 1) * 4 + 1];
        const float qn = cq * frsq(sq + EPS) * 0.08838834764831845f, kn = ck * frsq(sk + EPS);
        QS[tok * 128 + ch] = qn; KS[tok * 128 + ch] = kn; VS[tok * 128 + ch] = cv;
        const float pqk = wave_sum(qn * kn); if (lane == 0) NRM[wv * 4 + 3] = pqk;
    }
    __syncthreads();
    float egv[4], bev[4];
    {
        const float al = -__expf(galog);
#pragma unroll
        for (int t = 0; t < 4; ++t) { const float a = gA[t], bb = gB[t]; egv[t] = __expf(al * softplus_fast(a + dtb)); bev[t] = frcp(1.0f + __expf(-bb)); }
    }
    LAS float* REDK = L + 5376; LAS float* REDQ = REDK + 1024;
    float qk[4];
#pragma unroll
    for (int t = 0; t < 4; ++t) qk[t] = NRM[(2 * t) * 4 + 3] + NRM[(2 * t + 1) * 4 + 3];
#pragma unroll
    for (int t = 0; t < 4; ++t) {
        const float eg = egv[t], be = bev[t];
        float pk = 0.f, pq = 0.f;
#pragma unroll
        for (int ii = 0; ii < 32; ++ii) { S[ii] *= eg; pk += S[ii] * KS[t * 128 + 32 * rq + ii]; pq += S[ii] * QS[t * 128 + 32 * rq + ii]; }
        LAS float* rk = REDK + (t & 1) * 512; LAS float* rq_ = REDQ + (t & 1) * 512;
        rk[rq * 128 + j] = pk; rq_[rq * 128 + j] = pq;
        __syncthreads();
        const float vn = be * (VS[t * 128 + j] - (rk[j] + rk[128 + j] + rk[256 + j] + rk[384 + j]));
#pragma unroll
        for (int ii = 0; ii < 32; ++ii) S[ii] += KS[t * 128 + 32 * rq + ii] * vn;
        if (rq == 0) OS[t * 128 + j] = (rq_[j] + rq_[128 + j] + rq_[256 + j] + rq_[384 + j]) + qk[t] * vn;
    }
    __syncthreads();
    float* So = F.out + O_SGS + (size_t)((l * 128 + b) * 4 + h) * 16384;
#pragma unroll
    for (int ii = 0; ii < 32; ++ii) So[(size_t)(32 * rq + ii) * 128 + j] = S[ii];
    {
        const int tok = tid >> 7, ch = tid & 127; const float o = OS[tok * 128 + ch];
        const float ss = wave_sum(o * o);
        if (lane == 0) NRM[wv * 4 + 2] = ss;
        __syncthreads();
        const float tot = NRM[(2 * tok) * 4 + 2] + NRM[(2 * tok + 1) * 4 + 2];
        MX[(size_t)(m0 + tok) * DM + 512 + h * HD + ch] = (bf16)f2bf(o * (frsq(tot * (1.f / HD) + EPS)) * gnw * siluf_(zv));
    }
    __syncthreads();
}

struct S5Par { float ar, ai; float bbr[16], bbi[16]; };
__device__ __forceinline__ void s5_params(Frame& F, int l, int g, int p, S5Par& q) {
    const float lr = fminf(F.in[I_LRE][(l * 16 + g) * 64 + p], -1e-4f), li = F.in[I_LIM][(l * 16 + g) * 64 + p];
    const float dt = expf(F.in[I_LDT][l * 16 + g]);
    const float mag = __expf(lr * dt), ph = li * dt; q.ar = mag * __cosf(ph); q.ai = mag * __sinf(ph);
    const float den = lr * lr + li * li;
    const float fr = ((q.ar - 1.0f) * lr + q.ai * li) / den, fi = (q.ai * lr - (q.ar - 1.0f) * li) / den;
    const float* br = F.in[I_BRE] + (size_t)((l * 16 + g) * 64 + p) * 16; const float* bi = F.in[I_BIM] + (size_t)((l * 16 + g) * 64 + p) * 16;
#pragma unroll
    for (int h4 = 0; h4 < 4; ++h4) { const f32x4 r = *(const GAS f32x4*)(br + 4 * h4), i = *(const GAS f32x4*)(bi + 4 * h4);
#pragma unroll
        for (int e = 0; e < 4; ++e) { q.bbr[4 * h4 + e] = fr * r[e] - fi * i[e]; q.bbi[4 * h4 + e] = fr * i[e] + fi * r[e]; } }
}
__device__ __forceinline__ void s5_stage_u(Frame& F, LAS float* U, int m0, int nrows) {
    const bf16* P = (const bf16*)(F.ws + WS_P);
    for (int idx = F.tid; idx < nrows * 32; idx += NTHR) { const int r = idx >> 5, ck = idx & 31;
        const v4u w = *(const GAS v4u*)(P + (size_t)(m0 + r) * NPJ + PU + ck * 8);
        *(LAS f32x4*)(U + r * 256 + ck * 8) = (f32x4){bflo(w.x), bfhi(w.x), bflo(w.y), bfhi(w.y)}; *(LAS f32x4*)(U + r * 256 + ck * 8 + 4) = (f32x4){bflo(w.z), bfhi(w.z), bflo(w.w), bfhi(w.w)}; }
}
__device__ __forceinline__ void s5_step(const S5Par& q, const LAS float* urow, float& xr, float& xi) {
    const f32x4 u0 = *(const LAS f32x4*)urow, u1 = *(const LAS f32x4*)(urow + 4), u2 = *(const LAS f32x4*)(urow + 8), u3 = *(const LAS f32x4*)(urow + 12);
    float br = 0.f, bi = 0.f;
#pragma unroll
    for (int e = 0; e < 4; ++e) { br += q.bbr[e] * u0[e]; bi += q.bbi[e] * u0[e]; br += q.bbr[4 + e] * u1[e]; bi += q.bbi[4 + e] * u1[e]; br += q.bbr[8 + e] * u2[e]; bi += q.bbi[8 + e] * u2[e]; br += q.bbr[12 + e] * u3[e]; bi += q.bbi[12 + e] * u3[e]; }
    const float nr = q.ar * xr - q.ai * xi + br, ni = q.ar * xi + q.ai * xr + bi; xr = nr; xi = ni;
}
__device__ __forceinline__ void s5_pass1(Frame& F, int l, int b, int c) {
    LAS float* U = (LAS float*)F.lds;
    int tid = F.tid; asm volatile("" : "+v"(tid)); const int lane = tid & 63, g0 = 2 * (tid >> 6);
    S5Par q0, q1; s5_params(F, l, g0, lane, q0); s5_params(F, l, g0 + 1, lane, q1);
    s5_stage_u(F, U, b * SEQ + c * 64, 64);
    __syncthreads();
    float* E = (float*)(F.ws + WS_S5E);
    float xr0 = 0.f, xi0 = 0.f, xr1 = 0.f, xi1 = 0.f;
#pragma unroll 4
    for (int t = 0; t < 64; ++t) { s5_step(q0, U + t * 256 + 16 * g0, xr0, xi0); s5_step(q1, U + t * 256 + 16 * g0 + 16, xr1, xi1); }
    E[(size_t)((b * 32 + c) * 16 + g0) * 128 + lane] = xr0; E[(size_t)((b * 32 + c) * 16 + g0) * 128 + 64 + lane] = xi0;
    E[(size_t)((b * 32 + c) * 16 + g0 + 1) * 128 + lane] = xr1; E[(size_t)((b * 32 + c) * 16 + g0 + 1) * 128 + 64 + lane] = xi1;
    __syncthreads();
}
constexpr int S5_U = 0, S5_XT = 65536, S5_YG = S5_XT + 8 * 16 * S256;
static_assert(S5_YG + 64 * S512 <= LDSCTL_OFF, "s5 lds");
template <bool SAMPLE>
__device__ __forceinline__ void s5_pass2(Frame& F, int l, int ua, int ub) {
    LAS unsigned char* L = F.lds; LAS float* U = (LAS float*)(L + S5_U); LAS unsigned char* XT = L + S5_XT + (F.tid >> 6) * (16 * S256); LAS unsigned char* YG = L + S5_YG;
    int tid = F.tid; asm volatile("" : "+v"(tid)); const int lane = tid & 63, wv = tid >> 6, fr = lane & 15, fq = lane >> 4;
    constexpr int NSUB = SAMPLE ? 1 : 4;
    const int m0 = SAMPLE ? MP + 4 * ua : ua * SEQ + ub * 64;
    constexpr int NTT = SAMPLE ? 4 : 16;
    S5Par qq[2]; bf16x8 cbb[2][4]; float dskk[2];
#pragma unroll
    for (int gi = 0; gi < 2; ++gi) {
        const int g = 2 * wv + gi; s5_params(F, l, g, lane, qq[gi]);
        bf16x8 (&cb)[4] = cbb[gi];
#pragma unroll
        for (int ks = 0; ks < 4; ++ks) { const float* src = F.in[ks < 2 ? I_CRE : I_CIM] + (size_t)((l * 16 + g) * 16 + fr) * 64 + 32 * (ks & 1) + 8 * fq;
            const f32x4 c0 = *(const GAS f32x4*)src, c1 = *(const GAS f32x4*)(src + 4); const float sg = ks < 2 ? 1.f : -1.f;
            float f[8] = {sg * c0.x, sg * c0.y, sg * c0.z, sg * c0.w, sg * c1.x, sg * c1.y, sg * c1.z, sg * c1.w}; cb[ks] = pack8(f); }
        dskk[gi] = F.in[I_S5D][l * 256 + 16 * g + fr];
    }
    s5_stage_u(F, U, m0, SAMPLE ? 4 : 64);
    __syncthreads();
    const float* E = (const float*)(F.ws + WS_S5E);
#pragma unroll
    for (int gi = 0; gi < 2; ++gi) {
        const int g = 2 * wv + gi; const S5Par& q = qq[gi]; const bf16x8 (&cb)[4] = cbb[gi];
        const float dsk = dskk[gi];
        float xr = 0.f, xi = 0.f;
        if (!SAMPLE) {
            float pr = q.ar, pi = q.ai;
#pragma unroll
            for (int s = 0; s < 6; ++s) { const float nr = pr * pr - pi * pi, ni = 2.f * pr * pi; pr = nr; pi = ni; }
            float er[31], ei[31];
            const float* Eb = E + (size_t)((ua * 32) * 16 + g) * 128 + lane; asm volatile("" : "+v"(Eb));
#pragma unroll
            for (int cc = 0; cc < 31; ++cc) { er[cc] = Eb[cc * 2048]; ei[cc] = Eb[cc * 2048 + 64]; }
#pragma unroll
            for (int cc = 0; cc < 31; ++cc) { const float nr = pr * xr - pi * xi + er[cc], ni = pr * xi + pi * xr + ei[cc]; xr = cc < ub ? nr : xr; xi = cc < ub ? ni : xi; }
        }
        for (int sub = 0; sub < NSUB; ++sub) {
#pragma unroll
            for (int tt = 0; tt < NTT; ++tt) {
                if (SAMPLE && (tt & 3) == 0) { const int bs = ua; xr = F.in[I_S5RE][(size_t)((l * 128 + bs) * 16 + g) * 64 + lane]; xi = F.in[I_S5IM][(size_t)((l * 128 + bs) * 16 + g) * 64 + lane]; }
                s5_step(q, U + (16 * sub + tt) * 256 + 16 * g, xr, xi);
                *(LAS bf16*)(XT + t256(tt, lane)) = (bf16)f2bf(xr); *(LAS bf16*)(XT + t256(tt, 64 + lane)) = (bf16)f2bf(xi);
                if (SAMPLE && (tt & 3) == 3) { const int bs = ua; F.out[O_SS5RE + (size_t)((l * 128 + bs) * 16 + g) * 64 + lane] = xr; F.out[O_SS5IM + (size_t)((l * 128 + bs) * 16 + g) * 64 + lane] = xi; }
            }
            f32x4 acc = (f32x4){0.f, 0.f, 0.f, 0.f};
#pragma unroll
            for (int ks = 0; ks < 4; ++ks) { const bf16x8 af = *(const LAS bf16x8*)(XT + t256(fr, 32 * ks + 8 * fq)); acc = MFMA16(af, cb[ks], acc); }
#pragma unroll
            for (int r = 0; r < 4; ++r) { const int t = 16 * sub + 4 * fq + r; if (SAMPLE && t >= 4) continue; const float y = acc[r] + dsk * U[t * 256 + 16 * g + fr];
                *(LAS bf16*)(YG + t512(t, 16 * g + fr)) = (bf16)f2bf(gelu_tanh(y)); }
            asm volatile("" ::: "memory");
        }
        if (!SAMPLE && ub == 31) { F.out[O_PS5RE + (size_t)((l * 8 + ua) * 16 + g) * 64 + lane] = xr; F.out[O_PS5IM + (size_t)((l * 8 + ua) * 16 + g) * 64 + lane] = xi; }
    }
    __syncthreads();
    {
        const bf16* WG = (const bf16*)(F.ws + WS_WGLU); bf16* MX = (bf16*)(F.ws + WS_X);
#pragma unroll 1
        for (int ni = 0; ni < 2; ++ni) {
            const int nt = 2 * wv + ni; bf16x8 bw[8];
#pragma unroll
            for (int ks = 0; ks < 8; ++ks) bw[ks] = __builtin_bit_cast(bf16x8, *(const GAS v4u*)(WG + (size_t)(16 * nt + fr) * 256 + 32 * ks + 8 * fq));
            const float bg = F.in[I_BGLU][l * 256 + 16 * nt + fr];
#pragma unroll 1
            for (int mi = 0; mi < NSUB; ++mi) {
                f32x4 acc = (f32x4){0.f, 0.f, 0.f, 0.f};
#pragma unroll
                for (int ks = 0; ks < 8; ++ks) { const bf16x8 af = *(const LAS bf16x8*)(YG + t512(16 * mi + fr, 32 * ks + 8 * fq)); acc = MFMA16(af, bw[ks], acc); }
#pragma unroll
                for (int r = 0; r < 4; ++r) { const int t = 16 * mi + 4 * fq + r; if (SAMPLE && t >= 4) continue; const float yg = bf2f(*(const LAS bf16*)(YG + t512(t, 16 * nt + fr)));
                    MX[(size_t)(m0 + t) * DM + 16 * nt + fr] = (bf16)f2bf(yg * sigmoidf_(acc[r] + bg)); }
            }
        }
    }
    __syncthreads();
}

constexpr int LR_RAW = 0, LR_XC = 73728, LR_AGG = 139264;
struct LruW { float wa[32], wx[32], ba, bx, c8, cb, cw[4]; };
__device__ __forceinline__ void lru_weights(Frame& F, int l, int j, LruW& w) {
    const int blk = j >> 5, jj = j & 31;
#pragma unroll
    for (int i = 0; i < 32; ++i) { w.wa[i] = F.in[I_LWA][(size_t)((l * 8 + blk) * 32 + i) * 32 + jj]; w.wx[i] = F.in[I_LWX][(size_t)((l * 8 + blk) * 32 + i) * 32 + jj]; }
    w.ba = F.in[I_LBA][l * 256 + j]; w.bx = F.in[I_LBX][l * 256 + j]; w.c8 = -8.0f * softplusf_(-F.in[I_LLAM][l * 256 + j]); w.cb = F.in[I_LCB][l * 256 + j];
#pragma unroll
    for (int k = 0; k < 4; ++k) w.cw[k] = F.in[I_LCW][(l * 4 + k) * 256 + j];
}
__device__ __forceinline__ void lru_gate(const LruW& w, const LAS float* xrow, float xown, bool reset, float& a, float& bt) {
    float ra = w.ba, rx = w.bx;
#pragma unroll
    for (int i4 = 0; i4 < 8; ++i4) { const f32x4 xv = *(const LAS f32x4*)(xrow + 4 * i4);
#pragma unroll
        for (int e = 0; e < 4; ++e) { ra += w.wa[4 * i4 + e] * xv[e]; rx += w.wx[4 * i4 + e] * xv[e]; } }
    const float r = sigmoidf_(ra), gi = sigmoidf_(rx);
    const float la = w.c8 * r; a = __expf(la);
    const float mult = reset ? 1.0f : __builtin_amdgcn_sqrtf(fmaxf(1.0f - a * a, 0.f));
    bt = mult * gi * xown;
}
template <int PASS>
__device__ __forceinline__ void lru_pass(Frame& F, int l, int b, int c) {
    LAS float* RAW = (LAS float*)(F.lds + LR_RAW); LAS float* XC = (LAS float*)(F.lds + LR_XC); LAS float* AGG = (LAS float*)(F.lds + LR_AGG);
    int tid = F.tid; asm volatile("" : "+v"(tid)); const int j = tid & 255, hh = tid >> 8; const int row0 = b * SEQ + c * 64;
    const bf16* P = (const bf16*)(F.ws + WS_P); bf16* MX = (bf16*)(F.ws + WS_X); float* LA = (float*)(F.ws + WS_LAGG);
    for (int idx = tid; idx < 67 * 32; idx += NTHR) { const int r = idx >> 5, ck = idx & 31, tt = c * 64 - 3 + r;
        v4u w = (v4u){0u, 0u, 0u, 0u}; if (tt >= 0) w = *(const GAS v4u*)(P + (size_t)(b * SEQ + tt) * NPJ + PXL + ck * 8);
        *(LAS f32x4*)(RAW + r * 256 + ck * 8) = (f32x4){bflo(w.x), bfhi(w.x), bflo(w.y), bfhi(w.y)}; *(LAS f32x4*)(RAW + r * 256 + ck * 8 + 4) = (f32x4){bflo(w.z), bfhi(w.z), bflo(w.w), bfhi(w.w)}; }
    __syncthreads();
    LruW w; lru_weights(F, l, j, w);
    for (int ii = 0; ii < 32; ++ii) { const int i = 32 * hh + ii;
        XC[i * 256 + j] = w.cb + w.cw[0] * RAW[i * 256 + j] + w.cw[1] * RAW[(i + 1) * 256 + j] + w.cw[2] * RAW[(i + 2) * 256 + j] + w.cw[3] * RAW[(i + 3) * 256 + j]; }
    __syncthreads();
    float A = 1.f, B = 0.f; float hl[32], ca[32];
#pragma unroll
    for (int ii = 0; ii < 32; ++ii) { const int i = 32 * hh + ii; float a, bt;
        lru_gate(w, XC + i * 256 + (j & ~31), XC[i * 256 + j], (c == 0 && i == 0), a, bt);
        B = a * B + bt; A *= a; if (PASS == 2) { hl[ii] = B; ca[ii] = A; }
        if (ii & 1) __builtin_amdgcn_sched_barrier(0); }
    if (hh == 0) { AGG[j] = A; AGG[256 + j] = B; }
    __syncthreads();
    if (PASS == 1) {
        if (hh == 1) { const float A0 = AGG[j], B0 = AGG[256 + j]; LA[(size_t)((b * 32 + c) * 2) * 256 + j] = A0 * A; LA[(size_t)((b * 32 + c) * 2 + 1) * 256 + j] = A * B0 + B; }
    } else {
        float H = 0.f;
        {
            float la[31], lb[31];
            const float* Lb = LA + (size_t)(b * 32 * 2) * 256 + j; asm volatile("" : "+v"(Lb));
#pragma unroll
            for (int cc = 0; cc < 31; ++cc) { la[cc] = Lb[cc * 512]; lb[cc] = Lb[cc * 512 + 256]; }
#pragma unroll
            for (int cc = 0; cc < 31; ++cc) { const float nh = la[cc] * H + lb[cc]; H = cc < c ? nh : H; }
        }
        if (hh == 1) H = AGG[j] * H + AGG[256 + j];
#pragma unroll
        for (int ii = 0; ii < 32; ++ii) { const int i = 32 * hh + ii; const float hv = hl[ii] + ca[ii] * H;
            const float gt = bf2f(P[(size_t)(row0 + i) * NPJ + PGL + j]);
            MX[(size_t)(row0 + i) * DM + 256 + j] = (bf16)f2bf(hv * gelu_tanh(gt));
            if (c == 31 && hh == 1 && ii == 31) F.out[O_PLRUH + (size_t)(l * 8 + b) * 256 + j] = hv; }
        if (c == 31 && hh == 0) {
#pragma unroll
            for (int k = 0; k < 3; ++k) F.out[O_PLRUC + (size_t)((l * 8 + b) * 3 + k) * 256 + j] = RAW[(64 + k) * 256 + j]; }
    }
    __syncthreads();
}
__device__ __forceinline__ void lru_sample(Frame& F, int l, int q) {
    LAS float* XC = (LAS float*)F.lds;
    int tid = F.tid; asm volatile("" : "+v"(tid)); const int j = tid & 255, hh = tid >> 8;
    const bf16* P = (const bf16*)(F.ws + WS_P); bf16* MX = (bf16*)(F.ws + WS_X);
    LruW w; const int bs = q;
    if (hh == 0) {
        lru_weights(F, l, j, w);
        float r[7];
#pragma unroll
        for (int k = 0; k < 3; ++k) r[k] = F.in[I_LRUC][(size_t)((l * 128 + bs) * 3 + k) * 256 + j];
#pragma unroll
        for (int t = 0; t < 4; ++t) r[3 + t] = bf2f(P[(size_t)(MP + bs * 4 + t) * NPJ + PXL + j]);
#pragma unroll
        for (int t = 0; t < 4; ++t) XC[t * 256 + j] = w.cb + w.cw[0] * r[t] + w.cw[1] * r[t + 1] + w.cw[2] * r[t + 2] + w.cw[3] * r[t + 3];
#pragma unroll
        for (int k = 0; k < 3; ++k) F.out[O_SLRUC + (size_t)((l * 128 + bs) * 3 + k) * 256 + j] = r[4 + k];
    }
    float H = 0.f, gtv[4] = {0.f, 0.f, 0.f, 0.f};
    if (hh == 0) {
        H = F.in[I_LRUH][(size_t)(l * 128 + bs) * 256 + j];
#pragma unroll
        for (int t = 0; t < 4; ++t) gtv[t] = bf2f(P[(size_t)(MP + bs * 4 + t) * NPJ + PGL + j]);
    }
    __syncthreads();
    if (hh == 0) {
#pragma unroll
        for (int t = 0; t < 4; ++t) { float a, bt;
            lru_gate(w, XC + t * 256 + (j & ~31), XC[t * 256 + j], false, a, bt); H = a * H + bt;
            const float gt = gtv[t];
            MX[(size_t)(MP + bs * 4 + t) * DM + 256 + j] = (bf16)f2bf(H * gelu_tanh(gt)); }
        F.out[O_SLRUH + (size_t)(l * 128 + bs) * 256 + j] = H;
    }
    __syncthreads();
}

constexpr int S5M_U = 0, S5M_XT = 64 * S512, S5M_YG = S5M_XT + 8 * 16 * S256;
static_assert(S5M_YG + 64 * S512 <= LDSCTL_OFF, "s5m lds");
__device__ __forceinline__ void cmul_acc(float ar, float ai, float br, float bi, float& cr, float& ci) { cr += ar * br - ai * bi; ci += ar * bi + ai * br; }
struct S5Stage { v4u su[4]; };
__device__ __forceinline__ void s5m_stage_load(Frame& F, int m0, S5Stage& st) {
    const bf16* P = (const bf16*)(F.ws + WS_P);
#pragma unroll
    for (int k = 0; k < 4; ++k) { const int idx = F.tid + k * NTHR; const int r = idx >> 5, ck = idx & 31; st.su[k] = *(const GAS v4u*)(P + (size_t)(m0 + r) * NPJ + PU + ck * 8); }
}
struct NoHook { __device__ __forceinline__ void operator()() const {} };
template <int MODE, bool PRE = false, class Hook = NoHook>
__device__ __forceinline__ void s5m_unit(Frame& F, int l, int ua, int ub, const S5Stage* pre = nullptr, const Hook& hook = Hook()) {
    LAS unsigned char* L = F.lds;
    int tid = F.tid; asm volatile("" : "+v"(tid)); const int lane = tid & 63, wv = tid >> 6, fr = lane & 15, fq = lane >> 4;
    LAS unsigned char* U16 = L + S5M_U; LAS unsigned char* XT = L + S5M_XT + wv * (16 * S256); LAS float* SCR = (LAS float*)XT; LAS unsigned char* YG = L + S5M_YG;
    constexpr bool SAMPLE = MODE == 3; constexpr int NSUB = SAMPLE ? 1 : 4;
    const int m0 = SAMPLE ? MP + 4 * ua : ua * SEQ + ub * 64;
    { const bf16* P = (const bf16*)(F.ws + WS_P); constexpr int nrows = SAMPLE ? 4 : 64; constexpr int NK = (nrows * 32 + NTHR - 1) / NTHR;
      v4u su[NK];
#pragma unroll
      for (int k = 0; k < NK; ++k) { const int idx = tid + k * NTHR; const int r = idx >> 5, ck = idx & 31; if (PRE) su[k] = pre->su[k]; else if (idx < nrows * 32) su[k] = *(const GAS v4u*)(P + (size_t)(m0 + r) * NPJ + PU + ck * 8); }
#pragma unroll
      for (int k = 0; k < NK; ++k) { const int idx = tid + k * NTHR; const int r = idx >> 5, ck = idx & 31; if (idx < nrows * 32) *(LAS v4u*)(U16 + r * S512 + ck * 16) = su[k]; } }
    __syncthreads();
    float* Eo = (float*)(F.ws + WS_S5E);
#pragma unroll 1
    for (int gi = 0; gi < 2; ++gi) {
        const int g = 2 * wv + gi;
        S5Par q; s5_params(F, l, g, lane, q);
        bf16x8 bfrag[8];
#pragma unroll
        for (int part = 0; part < 2; ++part) {
#pragma unroll
            for (int h4 = 0; h4 < 4; ++h4) *(LAS f32x4*)(SCR + lane * 16 + 4 * h4) = part == 0 ? (f32x4){q.bbr[4 * h4], q.bbr[4 * h4 + 1], q.bbr[4 * h4 + 2], q.bbr[4 * h4 + 3]} : (f32x4){q.bbi[4 * h4], q.bbi[4 * h4 + 1], q.bbi[4 * h4 + 2], q.bbi[4 * h4 + 3]};
#pragma unroll
            for (int nt = 0; nt < 4; ++nt) { const LAS float* src = SCR + (16 * nt + fr) * 16 + 8 * (fq & 1);
                const f32x4 v0 = *(const LAS f32x4*)src, v1 = *(const LAS f32x4*)(src + 4); float f[8] = {v0.x, v0.y, v0.z, v0.w, v1.x, v1.y, v1.z, v1.w};
                if (fq >= 2) {
#pragma unroll
                    for (int e = 0; e < 8; ++e) f[e] = f[e] - bf2f(f2bf(f[e]));
                }
                bfrag[4 * part + nt] = pack8(f); }
        }
        float l1r[4], l1i[4], xinr[4], xini[4];
        *(LAS f32x2_t*)(SCR + lane * 2) = (f32x2_t){q.ar, q.ai};
        if (MODE == 2) {
            float pr = q.ar, pi = q.ai;
#pragma unroll
            for (int s = 0; s < 6; ++s) { const float nr = pr * pr - pi * pi, ni = 2.f * pr * pi; pr = nr; pi = ni; }
            float er[31], ei[31];
            const float* Eb = Eo + (size_t)((ua * 32) * 16 + g) * 128 + lane; asm volatile("" : "+v"(Eb));
#pragma unroll
            for (int cc = 0; cc < 31; ++cc) { er[cc] = Eb[cc * 2048]; ei[cc] = Eb[cc * 2048 + 64]; }
            float xr = 0.f, xi = 0.f;
#pragma unroll
            for (int cc = 0; cc < 31; ++cc) { const float nr = pr * xr - pi * xi + er[cc], ni = pr * xi + pi * xr + ei[cc]; xr = cc < ub ? nr : xr; xi = cc < ub ? ni : xi; }
            *(LAS f32x2_t*)(SCR + 128 + lane * 2) = (f32x2_t){xr, xi};
        }
#pragma unroll
        for (int s = 0; s < 4; ++s) { const f32x2_t lv = *(const LAS f32x2_t*)(SCR + (16 * s + fr) * 2); l1r[s] = lv.x; l1i[s] = lv.y;
            if (MODE == 2) { const f32x2_t xv = *(const LAS f32x2_t*)(SCR + 128 + (16 * s + fr) * 2); xinr[s] = xv.x; xini[s] = xv.y; }
            else if (MODE == 3) { xinr[s] = F.in[I_S5RE][(size_t)((l * 128 + ua) * 16 + g) * 64 + 16 * s + fr]; xini[s] = F.in[I_S5IM][(size_t)((l * 128 + ua) * 16 + g) * 64 + 16 * s + fr]; }
            else { xinr[s] = 0.f; xini[s] = 0.f; } }
        float l2r[4], l2i[4], l3r[4], l3i[4], l4r[4], l4i[4], l8r[4], l8i[4], lpr[4], lpi[4];
#pragma unroll
        for (int s = 0; s < 4; ++s) {
            l2r[s] = l1r[s] * l1r[s] - l1i[s] * l1i[s]; l2i[s] = 2.f * l1r[s] * l1i[s];
            l3r[s] = l2r[s] * l1r[s] - l2i[s] * l1i[s]; l3i[s] = l2r[s] * l1i[s] + l2i[s] * l1r[s];
            l4r[s] = l2r[s] * l2r[s] - l2i[s] * l2i[s]; l4i[s] = 2.f * l2r[s] * l2i[s];
            l8r[s] = l4r[s] * l4r[s] - l4i[s] * l4i[s]; l8i[s] = 2.f * l4r[s] * l4i[s];
            const float l12r = l8r[s] * l4r[s] - l8i[s] * l4i[s], l12i = l8r[s] * l4i[s] + l8i[s] * l4r[s];
            lpr[s] = fq == 0 ? 1.f : fq == 1 ? l4r[s] : fq == 2 ? l8r[s] : l12r; lpi[s] = fq == 0 ? 0.f : fq == 1 ? l4i[s] : fq == 2 ? l8i[s] : l12i;
        }
        bf16x8 cb[4]; float dsk = 0.f;
        if (MODE != 1) {
#pragma unroll
            for (int ks = 0; ks < 4; ++ks) { const float* src = F.in[ks < 2 ? I_CRE : I_CIM] + (size_t)((l * 16 + g) * 16 + fr) * 64 + 32 * (ks & 1) + 8 * fq;
                const f32x4 c0 = *(const GAS f32x4*)src, c1 = *(const GAS f32x4*)(src + 4); const float sg = ks < 2 ? 1.f : -1.f;
                float f[8] = {sg * c0.x, sg * c0.y, sg * c0.z, sg * c0.w, sg * c1.x, sg * c1.y, sg * c1.z, sg * c1.w}; cb[ks] = pack8(f); }
            dsk = F.in[I_S5D][l * 256 + 16 * g + fr];
        }
#pragma unroll 1
        for (int sub = 0; sub < NSUB; ++sub) {
            const bf16x8 au = *(const LAS bf16x8*)(U16 + (16 * sub + fr) * S512 + (16 * g + 8 * (fq & 1)) * 2);
            f32x4 d[8];
#pragma unroll
            for (int nt = 0; nt < 8; ++nt) d[nt] = MFMA16(au, bfrag[nt], ((f32x4){0.f, 0.f, 0.f, 0.f}));
            float Lr[4][4], Li[4][4], Er[4], Ei[4];
#pragma unroll
            for (int s = 0; s < 4; ++s) {
                Lr[s][0] = d[s][0]; Li[s][0] = d[4 + s][0];
#pragma unroll
                for (int r = 1; r < 4; ++r) { Lr[s][r] = d[s][r]; Li[s][r] = d[4 + s][r]; cmul_acc(l1r[s], l1i[s], Lr[s][r - 1], Li[s][r - 1], Lr[s][r], Li[s][r]); }
                Er[s] = Lr[s][3]; Ei[s] = Li[s][3];
            }
            {
                float pr_[4], pi_[4];
#pragma unroll
                for (int s = 0; s < 4; ++s) { pr_[s] = __shfl_up(Er[s], 16); pi_[s] = __shfl_up(Ei[s], 16); }
#pragma unroll
                for (int s = 0; s < 4; ++s) { float ar_ = 0.f, ai_ = 0.f; cmul_acc(l4r[s], l4i[s], pr_[s], pi_[s], ar_, ai_); if (fq >= 1) { Er[s] += ar_; Ei[s] += ai_; } }
#pragma unroll
                for (int s = 0; s < 4; ++s) { pr_[s] = __shfl_up(Er[s], 32); pi_[s] = __shfl_up(Ei[s], 32); }
#pragma unroll
                for (int s = 0; s < 4; ++s) { float ar_ = 0.f, ai_ = 0.f; cmul_acc(l8r[s], l8i[s], pr_[s], pi_[s], ar_, ai_); if (fq >= 2) { Er[s] += ar_; Ei[s] += ai_; } }
#pragma unroll
                for (int s = 0; s < 4; ++s) { pr_[s] = __shfl_up(Er[s], 16); pi_[s] = __shfl_up(Ei[s], 16); }
#pragma unroll
                for (int s = 0; s < 4; ++s) { float xr = fq >= 1 ? pr_[s] : 0.f, xi = fq >= 1 ? pi_[s] : 0.f; cmul_acc(lpr[s], lpi[s], xinr[s], xini[s], xr, xi); Er[s] = xr; Ei[s] = xi; }
            }
#pragma unroll
            for (int s = 0; s < 4; ++s) {
                cmul_acc(l1r[s], l1i[s], Er[s], Ei[s], Lr[s][0], Li[s][0]); cmul_acc(l2r[s], l2i[s], Er[s], Ei[s], Lr[s][1], Li[s][1]);
                cmul_acc(l3r[s], l3i[s], Er[s], Ei[s], Lr[s][2], Li[s][2]); cmul_acc(l4r[s], l4i[s], Er[s], Ei[s], Lr[s][3], Li[s][3]);
            }
#pragma unroll
            for (int s = 0; s < 4; ++s) { xinr[s] = __shfl(Lr[s][3], fr + (SAMPLE ? 0 : 48)); xini[s] = __shfl(Li[s][3], fr + (SAMPLE ? 0 : 48)); }
            if (MODE != 1) {
#pragma unroll
                for (int s = 0; s < 4; ++s)
#pragma unroll
                    for (int r = 0; r < 4; ++r) { *(LAS bf16*)(XT + t256(4 * fq + r, 16 * s + fr)) = (bf16)f2bf(Lr[s][r]); *(LAS bf16*)(XT + t256(4 * fq + r, 64 + 16 * s + fr)) = (bf16)f2bf(Li[s][r]); }
                f32x4 acc = (f32x4){0.f, 0.f, 0.f, 0.f};
#pragma unroll
                for (int ks = 0; ks < 4; ++ks) { const bf16x8 af = *(const LAS bf16x8*)(XT + t256(fr, 32 * ks + 8 * fq)); acc = MFMA16(af, cb[ks], acc); }
#pragma unroll
                for (int r = 0; r < 4; ++r) { const int t = 16 * sub + 4 * fq + r; if (SAMPLE && t >= 4) continue;
                    const float y = acc[r] + dsk * bf2f(*(const LAS bf16*)(U16 + t * S512 + (16 * g + fr) * 2));
                    *(LAS bf16*)(YG + t512(t, 16 * g + fr)) = (bf16)f2bf(gelu_tanh(y)); }
                asm volatile("" ::: "memory");
            }
        }
        if (MODE == 1 && gi == 0) hook();
        if (fq == 0) {
#pragma unroll
            for (int s = 0; s < 4; ++s) { const int p = 16 * s + fr;
                if (MODE == 1) { Eo[(size_t)((ua * 32 + ub) * 16 + g) * 128 + p] = xinr[s]; Eo[(size_t)((ua * 32 + ub) * 16 + g) * 128 + 64 + p] = xini[s]; }
                if (MODE == 2 && ub == 31) { F.out[O_PS5RE + (size_t)((l * 8 + ua) * 16 + g) * 64 + p] = xinr[s]; F.out[O_PS5IM + (size_t)((l * 8 + ua) * 16 + g) * 64 + p] = xini[s]; }
                if (MODE == 3) { F.out[O_SS5RE + (size_t)((l * 128 + ua) * 16 + g) * 64 + p] = xinr[s]; F.out[O_SS5IM + (size_t)((l * 128 + ua) * 16 + g) * 64 + p] = xini[s]; } }
        }
    }
    if (MODE != 1) hook();
    bf16x8 bwA[8], bwB[8]; float bgA = 0.f, bgB = 0.f;
    if (MODE != 1) {
        const bf16* WG = (const bf16*)(F.ws + WS_WGLU);
#pragma unroll
        for (int ks = 0; ks < 8; ++ks) { bwA[ks] = __builtin_bit_cast(bf16x8, *(const GAS v4u*)(WG + (size_t)(16 * (2 * wv) + fr) * 256 + 32 * ks + 8 * fq)); bwB[ks] = __builtin_bit_cast(bf16x8, *(const GAS v4u*)(WG + (size_t)(16 * (2 * wv + 1) + fr) * 256 + 32 * ks + 8 * fq)); }
        bgA = F.in[I_BGLU][l * 256 + 16 * (2 * wv) + fr]; bgB = F.in[I_BGLU][l * 256 + 16 * (2 * wv + 1) + fr];
    }
    __syncthreads();
    if (MODE != 1) {
        bf16* MX = (bf16*)(F.ws + WS_X);
        auto glu_block = [&](const bf16x8 (&bw)[8], const float bg, const int nt) {
#pragma unroll 1
            for (int mi = 0; mi < NSUB; ++mi) {
                f32x4 acc = (f32x4){0.f, 0.f, 0.f, 0.f};
#pragma unroll
                for (int ks = 0; ks < 8; ++ks) { const bf16x8 af = *(const LAS bf16x8*)(YG + t512(16 * mi + fr, 32 * ks + 8 * fq)); acc = MFMA16(af, bw[ks], acc); }
#pragma unroll
                for (int r = 0; r < 4; ++r) { const int t = 16 * mi + 4 * fq + r; if (SAMPLE && t >= 4) continue; const float yg = bf2f(*(const LAS bf16*)(YG + t512(t, 16 * nt + fr)));
                    MX[(size_t)(m0 + t) * DM + 16 * nt + fr] = (bf16)f2bf(yg * sigmoidf_(acc[r] + bg)); }
            }
        };
        glu_block(bwA, bgA, 2 * wv); glu_block(bwB, bgB, 2 * wv + 1);
        __syncthreads();
    }
}


constexpr int LM_RAW = 0, LM_XCB = 69632, LM_GT = LM_XCB + 64 * S512;
static_assert(LM_GT + 64 * S512 <= LDSCTL_OFF && 67 * 1024 <= LM_XCB, "lru mfma lds");
struct LruStage { v4u sw[5], sg[4]; };
template <int PASS>
__device__ __forceinline__ void lrum_stage_load(Frame& F, int b, int c, LruStage& st) {
    const bf16* P = (const bf16*)(F.ws + WS_P); const int row0 = b * SEQ + c * 64;
#pragma unroll
    for (int k5 = 0; k5 < 5; ++k5) { const int idx = F.tid + k5 * NTHR; const int r = idx >> 5, ck = idx & 31, tt = c * 64 - 3 + r;
        st.sw[k5] = (v4u){0u, 0u, 0u, 0u}; if (idx < 67 * 32 && tt >= 0) st.sw[k5] = *(const GAS v4u*)(P + (size_t)(b * SEQ + tt) * NPJ + PXL + ck * 8); }
    if (PASS == 2) {
#pragma unroll
        for (int k4 = 0; k4 < 4; ++k4) { const int idx = F.tid + k4 * NTHR; const int r = idx >> 5, ck = idx & 31; st.sg[k4] = *(const GAS v4u*)(P + (size_t)(row0 + r) * NPJ + PGL + ck * 8); }
    }
}
template <int PASS, bool PRE = false>
__device__ __forceinline__ void lrum_pass(Frame& F, int l, int b, int c, const LruStage* pre = nullptr) {
    LAS float* RAW = (LAS float*)(F.lds + LM_RAW); LAS unsigned char* XCB = F.lds + LM_XCB;
    int tid = F.tid; asm volatile("" : "+v"(tid)); const int lane = tid & 63, wv = tid >> 6, fr = lane & 15, fq = lane >> 4;
    const int row0 = b * SEQ + c * 64;
    const bf16* P = (const bf16*)(F.ws + WS_P); bf16* MX = (bf16*)(F.ws + WS_X); float* LA = (float*)(F.ws + WS_LAGG);
    {
        v4u sw[5], sg[4];
        if (PRE) {
#pragma unroll
            for (int k5 = 0; k5 < 5; ++k5) sw[k5] = pre->sw[k5];
            if (PASS == 2) {
#pragma unroll
                for (int k4 = 0; k4 < 4; ++k4) sg[k4] = pre->sg[k4];
            }
        } else {
#pragma unroll
        for (int k5 = 0; k5 < 5; ++k5) { const int idx = tid + k5 * NTHR; const int r = idx >> 5, ck = idx & 31, tt = c * 64 - 3 + r;
            sw[k5] = (v4u){0u, 0u, 0u, 0u}; if (idx < 67 * 32 && tt >= 0) sw[k5] = *(const GAS v4u*)(P + (size_t)(b * SEQ + tt) * NPJ + PXL + ck * 8); }
        if (PASS == 2) {
#pragma unroll
            for (int k4 = 0; k4 < 4; ++k4) { const int idx = tid + k4 * NTHR; const int r = idx >> 5, ck = idx & 31; sg[k4] = *(const GAS v4u*)(P + (size_t)(row0 + r) * NPJ + PGL + ck * 8); }
        }
        }
#pragma unroll
        for (int k5 = 0; k5 < 5; ++k5) { const int idx = tid + k5 * NTHR; const int r = idx >> 5, ck = idx & 31; const v4u w = sw[k5];
            if (idx < 67 * 32) { *(LAS f32x4*)(RAW + r * 256 + ck * 8) = (f32x4){bflo(w.x), bfhi(w.x), bflo(w.y), bfhi(w.y)}; *(LAS f32x4*)(RAW + r * 256 + ck * 8 + 4) = (f32x4){bflo(w.z), bfhi(w.z), bflo(w.w), bfhi(w.w)}; } }
        if (PASS == 2) {
#pragma unroll
            for (int k4 = 0; k4 < 4; ++k4) { const int idx = tid + k4 * NTHR; const int r = idx >> 5, ck = idx & 31; *(LAS v4u*)(F.lds + LM_GT + r * S512 + ck * 16) = sg[k4]; }
        }
    }
    bf16x8 wah[2], wal[2], wxh[2], wxl[2]; float ba[2], bx[2], c8[2];
#pragma unroll
    for (int nt = 0; nt < 2; ++nt) {
        const int jc = 16 * nt + fr; float fa[8], fx[8], ga[8], gx[8];
#pragma unroll
        for (int e = 0; e < 8; ++e) { fa[e] = F.in[I_LWA][(size_t)((l * 8 + wv) * 32 + 8 * fq + e) * 32 + jc]; fx[e] = F.in[I_LWX][(size_t)((l * 8 + wv) * 32 + 8 * fq + e) * 32 + jc]; }
        wah[nt] = pack8(fa); wxh[nt] = pack8(fx);
#pragma unroll
        for (int e = 0; e < 8; ++e) { ga[e] = fa[e] - bf2f(f2bf(fa[e])); gx[e] = fx[e] - bf2f(f2bf(fx[e])); }
        wal[nt] = pack8(ga); wxl[nt] = pack8(gx);
        const int j = 32 * wv + jc; ba[nt] = F.in[I_LBA][l * 256 + j]; bx[nt] = F.in[I_LBX][l * 256 + j]; c8[nt] = -8.0f * softplusf_(-F.in[I_LLAM][l * 256 + j]);
    }
    float Hin[2] = {0.f, 0.f};
    if (PASS == 2) {
        const int js = 32 * wv + 16 * (fq & 1) + fr; float H = 0.f;
        float la[31], lb[31];
        const float* Lb = LA + (size_t)(b * 32 * 2) * 256 + js; asm volatile("" : "+v"(Lb));
#pragma unroll
        for (int cc = 0; cc < 31; ++cc) { la[cc] = Lb[cc * 512]; lb[cc] = Lb[cc * 512 + 256]; }
#pragma unroll
        for (int cc = 0; cc < 31; ++cc) { const float nh = la[cc] * H + lb[cc]; H = cc < c ? nh : H; }
        Hin[0] = __shfl(H, fr); Hin[1] = __shfl(H, fr + 16);
    }
    float cw[4]; const float cb = F.in[I_LCB][l * 256 + (tid & 255)];
#pragma unroll
    for (int k = 0; k < 4; ++k) cw[k] = F.in[I_LCW][(l * 4 + k) * 256 + (tid & 255)];
    __syncthreads();
    {
        const int j = tid & 255, hh = tid >> 8; float xcv[32];
#pragma unroll
        for (int ii = 0; ii < 32; ++ii) { const int i = 32 * hh + ii; xcv[ii] = cb + cw[0] * RAW[i * 256 + j] + cw[1] * RAW[(i + 1) * 256 + j] + cw[2] * RAW[(i + 2) * 256 + j] + cw[3] * RAW[(i + 3) * 256 + j]; }
        __syncthreads();
#pragma unroll
        for (int ii = 0; ii < 32; ++ii) { const int i = 32 * hh + ii; RAW[i * 256 + j] = xcv[ii]; *(LAS bf16*)(XCB + i * S512 + j * 2) = (bf16)f2bf(xcv[ii]); }
    }
    __syncthreads();
    float At[2] = {1.f, 1.f}, Bt[2] = {0.f, 0.f};
#pragma unroll 1
    for (int sub = 0; sub < 4; ++sub) {
        const bf16x8 au = *(const LAS bf16x8*)(XCB + (16 * sub + fr) * S512 + (32 * wv + 8 * fq) * 2);
        unsigned short gt[2][4];
        if (PASS == 2) {
#pragma unroll
            for (int nt = 0; nt < 2; ++nt)
#pragma unroll
                for (int r = 0; r < 4; ++r) gt[nt][r] = *(const LAS unsigned short*)(F.lds + LM_GT + (16 * sub + 4 * fq + r) * S512 + (32 * wv + 16 * nt + fr) * 2);
        }
#pragma unroll
        for (int nt = 0; nt < 2; ++nt) {
            const f32x4 z = (f32x4){0.f, 0.f, 0.f, 0.f};
            f32x4 da = MFMA16(au, wah[nt], z); da = MFMA16(au, wal[nt], da);
            f32x4 dx = MFMA16(au, wxh[nt], z); dx = MFMA16(au, wxl[nt], dx);
            const int j = 32 * wv + 16 * nt + fr;
            float hl[4], ca[4]; float A = 1.f, B = 0.f;
#pragma unroll
            for (int r = 0; r < 4; ++r) { const int t = 16 * sub + 4 * fq + r;
                const float rr = sigmoidf_(da[r] + ba[nt]), gi = sigmoidf_(dx[r] + bx[nt]); const float a = __expf(c8[nt] * rr);
                const float mult = (c == 0 && t == 0) ? 1.0f : __builtin_amdgcn_sqrtf(fmaxf(1.0f - a * a, 0.f));
                const float bt = mult * gi * RAW[t * 256 + j];
                B = a * B + bt; A *= a; hl[r] = B; ca[r] = A; }
            float Ap = __shfl_up(A, 16), Bp = __shfl_up(B, 16); if (fq >= 1) { B = A * Bp + B; A = A * Ap; }
            Ap = __shfl_up(A, 32); Bp = __shfl_up(B, 32); if (fq >= 2) { B = A * Bp + B; A = A * Ap; }
            float Ae = __shfl_up(A, 16), Be = __shfl_up(B, 16); if (fq == 0) { Ae = 1.f; Be = 0.f; }
            const float As = __shfl(A, fr + 48), Bs = __shfl(B, fr + 48);
            if (PASS == 1) { Bt[nt] = As * Bt[nt] + Bs; At[nt] *= As; }
            else {
                const float Hs = Ae * Hin[nt] + Be;
#pragma unroll
                for (int r = 0; r < 4; ++r) { const float hv = hl[r] + ca[r] * Hs;
                    MX[(size_t)(row0 + 16 * sub + 4 * fq + r) * DM + 256 + j] = (bf16)f2bf(hv * gelu_tanh(bf2f(gt[nt][r]))); }
                Hin[nt] = As * Hin[nt] + Bs;
            }
        }
    }
    if (fq == 0) {
#pragma unroll
        for (int nt = 0; nt < 2; ++nt) { const int j = 32 * wv + 16 * nt + fr;
            if (PASS == 1) { LA[(size_t)((b * 32 + c) * 2) * 256 + j] = At[nt]; LA[(size_t)((b * 32 + c) * 2 + 1) * 256 + j] = Bt[nt]; }
            else if (c == 31) F.out[O_PLRUH + (size_t)(l * 8 + b) * 256 + j] = Hin[nt]; }
    }
    if (PASS == 2 && c == 31 && tid < 256) {
#pragma unroll
        for (int k = 0; k < 3; ++k) F.out[O_PLRUC + (size_t)((l * 8 + b) * 3 + k) * 256 + tid] = RAW[(64 + k) * 256 + tid]; }
    __syncthreads();
}
#ifndef MK_N_LAUNCHES
#define MK_N_LAUNCHES 1
#endif
constexpr int N_PHASES = 19;
#ifndef STAGE_AHEAD
#define STAGE_AHEAD 1
#endif
struct Args { const float* in[37]; float* out; unsigned char* ws; int ph_lo, ph_hi; };
#if MK_N_LAUNCHES == 1
#define GRID_BAR() xcd_barrier(bar)
#else
#define GRID_BAR() do { } while (0)
#endif
#ifndef DUPM
#define DUPM 0
#endif
#define REP(bit) for (int rep_ = 0; rep_ < (((DUPM) >> (bit)) & 1 ? 2 : 1); ++rep_)
#ifndef PH_MASK
#define PH_MASK 0x3ff
#endif
#define IN(k) (lo <= (k) && (k) < hi)
#define INL(i) (((PH_MASK >> ((i) + 1)) & 1) && IN(pb + (i)))
#define OPQ() asm volatile("" : "+s"(F.wg), "+s"(F.G), "+s"(F.ws), "+s"(F.out), "+s"(l), "+s"(F.lds))
#ifndef BAR_TWICE
#define BAR_TWICE 0
#endif
#define SEAM(k) do { if (IN(k) && IN((k) + 1)) { GRID_BAR(); if (BAR_TWICE) GRID_BAR(); } } while (0)
#define X ((bf16*)(F.ws + WS_X))
#define P ((bf16*)(F.ws + WS_P))
#define BIG ((bf16*)(F.ws + WS_BIG))
#define AB ((float*)(F.ws + WS_AB))
#define Y (F.out + O_YP)
#define X1B ((float*)(F.ws + WS_BIG + 34 * MiB))
#define RSA ((float*)(F.ws + WS_CTL + 512 * 1024))
#define RSB ((float*)(F.ws + WS_CTL + 768 * 1024))
#define X2B Y
template <int LAYER>
__device__ __forceinline__ void layer_phases(Frame& F, const XcdBarrier& bar, const int lo, const int hi) {
    int l = LAYER;
#if defined(SEGREP) || defined(SEGPRE)
    int seg_n = 0;
#endif
        const int pb = 1 + 9 * l;
#if (defined(SEGREP) || defined(SEGPRE)) && SEG_LO == 0
        seg_start: asm volatile("" : "+v"(F.tid), "+v"(F.lane)); F.wave = __builtin_amdgcn_readfirstlane(F.tid >> 6);
#endif
        if (INL(0)) REP(1) { OPQ();
            pg8::Gemm g{(const bf16*)X2B, (const bf16*)(F.ws + WS_WIN), MT, NPJ, DM}; pg8::StaticOrder S; S.init(MT, NPJ, F.G, F.wg);
            pg8::EpiBf16 E{P, NPJ, RSA};
            pg8::gemm_phase<pg8::EpiBf16, pg8::StaticOrder, true, true>(F.lds, g, S, E);
            if (LAYER == 0) convert_items<2 | 8>(F, l, ((MT / 256) * (NPJ / 256)) % F.G); else convert_items<8>(F, l, ((MT / 256) * (NPJ / 256)) % F.G);
        }
#if defined(SEGPRE) && SEG_HI == 0
        if (((SEGPRE >> LAYER) & 1) && seg_n < hi - (N_PHASES - 1)) { ++seg_n; if (SEGPRE_MODE == 1) xcd_barrier<true>(bar); else if (SEGPRE_MODE == 2) xcd_barrier<false>(bar); goto seg_start; }
#endif
        SEAM(pb + 0);
#if defined(SEGREP) && SEG_HI == 0
        if (((SEGREP >> LAYER) & 1) && seg_n < hi - (N_PHASES - 1)) { ++seg_n; if (0 == 8 && LAYER == 1) GRID_BAR(); goto seg_start; }
#endif
#if (defined(SEGREP) || defined(SEGPRE)) && SEG_LO == 1
        seg_start: asm volatile("" : "+v"(F.tid), "+v"(F.lane)); F.wave = __builtin_amdgcn_readfirstlane(F.tid >> 6);
#endif
        if (INL(1)) { OPQ();
#if STAGE_AHEAD
            S5Stage s5a;
#endif
            {
                int cw_head = -1; v4u pre[7]; float abn[2]; bool have = false; float SS[32]; GsAux gax;
                int ts = F.wg; const int NT = NB_S * GDH;
                if (ts < NT) { gdn_sample_load(F, l, ts, SS); gdn_sample_aux_load(F, l, ts, gax); }
                int k = 0;
                const int nun = NB_P * GDH * NCH / F.G;
                auto unit_of = [&](int kk) { return ((F.wg & 7) * GDH + (F.wg >> 6)) * NCH + ((F.wg >> 3) & 7) * 4 + kk; };
                for (; k < nun; ++k) { const int u = unit_of(k);
                    gdn_prep<0>(F, l, u, cw_head, pre, abn, have, k + 1 < nun ? unit_of(k + 1) : -1); have = true;
#if STAGE_AHEAD
                    if (k + 1 == nun && F.wg < NB_P * 31) s5m_stage_load(F, (F.wg / 31) * SEQ + (F.wg % 31) * 64, s5a);
#endif
                    if (ts < NT) { gdn_sample(F, l, ts, SS, gax); ts += F.G; if (ts < NT) { gdn_sample_load(F, l, ts, SS); gdn_sample_aux_load(F, l, ts, gax); } }
                }
                while (ts < NT) { gdn_sample(F, l, ts, SS, gax); ts += F.G; if (ts < NT) { gdn_sample_load(F, l, ts, SS); gdn_sample_aux_load(F, l, ts, gax); } }
            }
#ifdef GPC
            { int cw_head = -1; v4u pre[7]; float abn[2]; for (int u = F.wg; u < NB_P * GDH * NCH; u += F.G) { gdn_prep<GPC>(F, l, u, cw_head, pre, abn, false, -1); } __syncthreads(); }
#endif
#if STAGE_AHEAD
            if (F.wg < NB_P * 31) { const int u = F.wg; LruStage lra;
                auto hook = [&]() { lrum_stage_load<1>(F, u / 31, u % 31, lra); };
                s5m_unit<1, true>(F, l, u / 31, u % 31, &s5a, hook);
                lrum_pass<1, true>(F, l, u / 31, u % 31, &lra); }
#else
            for (int u = F.wg; u < NB_P * 31; u += F.G) { REP(3) s5m_unit<1>(F, l, u / 31, u % 31); REP(4) lrum_pass<1>(F, l, u / 31, u % 31); }
#endif
            for (int q = F.wg; q < 2 * NB_S; q += F.G) REP(6) { if (q < NB_S) s5m_unit<3>(F, l, q, 0); else lru_sample(F, l, q - NB_S); }
        }
#if defined(SEGPRE) && SEG_HI == 1
        if (((SEGPRE >> LAYER) & 1) && seg_n < hi - (N_PHASES - 1)) { ++seg_n; if (SEGPRE_MODE == 1) xcd_barrier<true>(bar); else if (SEGPRE_MODE == 2) xcd_barrier<false>(bar); goto seg_start; }
#endif
        SEAM(pb + 1);
#if defined(SEGREP) && SEG_HI == 1
        if (((SEGREP >> LAYER) & 1) && seg_n < hi - (N_PHASES - 1)) { ++seg_n; if (1 == 8 && LAYER == 1) GRID_BAR(); goto seg_start; }
#endif
#if (defined(SEGREP) || defined(SEGPRE)) && SEG_LO == 2
        seg_start: asm volatile("" : "+v"(F.tid), "+v"(F.lane)); F.wave = __builtin_amdgcn_readfirstlane(F.tid >> 6);
#endif
        if (INL(2)) { OPQ();
#if STAGE_AHEAD
            {
                const int u = F.wg; S5Stage s5s; LruStage lrs;
                s5m_stage_load(F, (u >> 5) * SEQ + (u & 31) * 64, s5s);
                gdn_chain<false>(F, l, F.wg);
                auto hook = [&]() { lrum_stage_load<2>(F, u >> 5, u & 31, lrs); };
                s5m_unit<2, true>(F, l, u >> 5, u & 31, &s5s, hook);
                lrum_pass<2, true>(F, l, u >> 5, u & 31, &lrs);
            }
#else
            for (int t = F.wg; t < 256; t += F.G) gdn_chain<false>(F, l, t);
            for (int u = F.wg; u < NB_P * NCH; u += F.G) { REP(7) s5m_unit<2>(F, l, u >> 5, u & 31); REP(8) lrum_pass<2>(F, l, u >> 5, u & 31); }
#endif
        }
#if defined(SEGPRE) && SEG_HI == 2
        if (((SEGPRE >> LAYER) & 1) && seg_n < hi - (N_PHASES - 1)) { ++seg_n; if (SEGPRE_MODE == 1) xcd_barrier<true>(bar); else if (SEGPRE_MODE == 2) xcd_barrier<false>(bar); goto seg_start; }
#endif
        SEAM(pb + 2);
#if defined(SEGREP) && SEG_HI == 2
        if (((SEGREP >> LAYER) & 1) && seg_n < hi - (N_PHASES - 1)) { ++seg_n; if (2 == 8 && LAYER == 1) GRID_BAR(); goto seg_start; }
#endif
#if (defined(SEGREP) || defined(SEGPRE)) && SEG_LO == 3
        seg_start: asm volatile("" : "+v"(F.tid), "+v"(F.lane)); F.wave = __builtin_amdgcn_readfirstlane(F.tid >> 6);
#endif
        if (!HEADNORM_IN_GEMM && INL(3)) { OPQ();
            gdn_finalize(F, l);
        }
#if defined(SEGPRE) && SEG_HI == 3
        if (((SEGPRE >> LAYER) & 1) && seg_n < hi - (N_PHASES - 1)) { ++seg_n; if (SEGPRE_MODE == 1) xcd_barrier<true>(bar); else if (SEGPRE_MODE == 2) xcd_barrier<false>(bar); goto seg_start; }
#endif
#if !HEADNORM_IN_GEMM
        SEAM(pb + 3);
#endif
#if defined(SEGREP) && SEG_HI == 3
        if (((SEGREP >> LAYER) & 1) && seg_n < hi - (N_PHASES - 1)) { ++seg_n; if (3 == 8 && LAYER == 1) GRID_BAR(); goto seg_start; }
#endif
#if (defined(SEGREP) || defined(SEGPRE)) && SEG_LO == 4
        seg_start: asm volatile("" : "+v"(F.tid), "+v"(F.lane)); F.wave = __builtin_amdgcn_readfirstlane(F.tid >> 6);
#endif
        if (INL(4)) REP(9) { OPQ();
            pg8::Gemm g{X, (const bf16*)(F.ws + WS_WOUT), MP, DM, DM}; pg8::StaticOrder S; S.init(MP, DM, F.G, F.wg);
#if HEADNORM_IN_GEMM
            pg8::EpiBf16HeadNorm E{BIG, DM, (const float*)(F.ws + WS_SSQ), 1.f / HD, EPS};
            pg8::gemm_phase<pg8::EpiBf16HeadNorm, pg8::StaticOrder, true, true>(F.lds, g, S, E);
#else
            pg8::EpiBf16 E{BIG, DM, nullptr};
            pg8::gemm_phase<pg8::EpiBf16, pg8::StaticOrder, true, true>(F.lds, g, S, E);
#endif
            sample_gemm_lds(F, X, (const bf16*)(F.ws + WS_WOUT), DM, BIG);
        }
#if defined(SEGPRE) && SEG_HI == 4
        if (((SEGPRE >> LAYER) & 1) && seg_n < hi - (N_PHASES - 1)) { ++seg_n; if (SEGPRE_MODE == 1) xcd_barrier<true>(bar); else if (SEGPRE_MODE == 2) xcd_barrier<false>(bar); goto seg_start; }
#endif
        SEAM(pb + 4);
#if defined(SEGREP) && SEG_HI == 4
        if (((SEGREP >> LAYER) & 1) && seg_n < hi - (N_PHASES - 1)) { ++seg_n; if (4 == 8 && LAYER == 1) GRID_BAR(); goto seg_start; }
#endif
#if (defined(SEGREP) || defined(SEGPRE)) && SEG_LO == 5
        seg_start: asm volatile("" : "+v"(F.tid), "+v"(F.lane)); F.wave = __builtin_amdgcn_readfirstlane(F.tid >> 6);
#endif
        if (INL(5)) { OPQ();
            REP(13) row_pass<true, true>(F, X2B, nullptr, BIG, F.in[I_NMPOST] + l * DM, X1B, nullptr, RSB, nullptr, nullptr);
        }
#if defined(SEGPRE) && SEG_HI == 5
        if (((SEGPRE >> LAYER) & 1) && seg_n < hi - (N_PHASES - 1)) { ++seg_n; if (SEGPRE_MODE == 1) xcd_barrier<true>(bar); else if (SEGPRE_MODE == 2) xcd_barrier<false>(bar); goto seg_start; }
#endif
        SEAM(pb + 5);
#if defined(SEGREP) && SEG_HI == 5
        if (((SEGREP >> LAYER) & 1) && seg_n < hi - (N_PHASES - 1)) { ++seg_n; if (5 == 8 && LAYER == 1) GRID_BAR(); goto seg_start; }
#endif
#if (defined(SEGREP) || defined(SEGPRE)) && SEG_LO == 6
        seg_start: asm volatile("" : "+v"(F.tid), "+v"(F.lane)); F.wave = __builtin_amdgcn_readfirstlane(F.tid >> 6);
#endif
        if (INL(6)) REP(10) { OPQ();
            pg8::Gemm g{(const bf16*)X1B, (const bf16*)(F.ws + WS_WGU), MT, 2 * FF, DM}; pg8::StaticOrder S; S.init(MT, 2 * FF, F.G, F.wg);
            pg8::EpiSwiGLU E{P, FF, RSB};
            pg8::gemm_phase<pg8::EpiSwiGLU, pg8::StaticOrder, true, true>(F.lds, g, S, E);
            if (LAYER + 1 < DEPTH) convert_items<1 | 2>(F, l + 1, ((MT / 256) * (2 * FF / 256)) % F.G);
        }
#if defined(SEGPRE) && SEG_HI == 6
        if (((SEGPRE >> LAYER) & 1) && seg_n < hi - (N_PHASES - 1)) { ++seg_n; if (SEGPRE_MODE == 1) xcd_barrier<true>(bar); else if (SEGPRE_MODE == 2) xcd_barrier<false>(bar); goto seg_start; }
#endif
        SEAM(pb + 6);
#if defined(SEGREP) && SEG_HI == 6
        if (((SEGREP >> LAYER) & 1) && seg_n < hi - (N_PHASES - 1)) { ++seg_n; if (6 == 8 && LAYER == 1) GRID_BAR(); goto seg_start; }
#endif
#if (defined(SEGREP) || defined(SEGPRE)) && SEG_LO == 7
        seg_start: asm volatile("" : "+v"(F.tid), "+v"(F.lane)); F.wave = __builtin_amdgcn_readfirstlane(F.tid >> 6);
#endif
        if (INL(7)) REP(11) { OPQ();
            pg8::Gemm g{P, (const bf16*)(F.ws + WS_WDN), MP, DM, FF}; pg8::StaticOrder S; S.init(MP, DM, F.G, F.wg);
            pg8::EpiBf16 E{BIG, DM, nullptr};
            pg8::gemm_phase<pg8::EpiBf16, pg8::StaticOrder, true, true>(F.lds, g, S, E);
            sample_gemm_lds(F, P, (const bf16*)(F.ws + WS_WDN), FF, BIG);
        }
#if defined(SEGPRE) && SEG_HI == 7
        if (((SEGPRE >> LAYER) & 1) && seg_n < hi - (N_PHASES - 1)) { ++seg_n; if (SEGPRE_MODE == 1) xcd_barrier<true>(bar); else if (SEGPRE_MODE == 2) xcd_barrier<false>(bar); goto seg_start; }
#endif
        SEAM(pb + 7);
#if defined(SEGREP) && SEG_HI == 7
        if (((SEGREP >> LAYER) & 1) && seg_n < hi - (N_PHASES - 1)) { ++seg_n; if (7 == 8 && LAYER == 1) GRID_BAR(); goto seg_start; }
#endif
#if (defined(SEGREP) || defined(SEGPRE)) && SEG_LO == 8
        seg_start: asm volatile("" : "+v"(F.tid), "+v"(F.lane)); F.wave = __builtin_amdgcn_readfirstlane(F.tid >> 6);
#endif
        if (INL(8)) { OPQ();
            if (l + 1 < DEPTH) {
                convert_items<4 | 16>(F, l + 1, 0);
                row_pass<true, true>(F, X1B, nullptr, BIG, F.in[I_NFPOST] + l * DM, X2B, F.in[I_NMPRE] + (l + 1) * DM, RSA, F.in[I_WIN] + (size_t)(l + 1) * DM * INC, AB);
            } else row_pass<true, false>(F, X1B, nullptr, BIG, F.in[I_NFPOST] + l * DM, Y, nullptr, nullptr, nullptr, nullptr);
        }
#if defined(SEGPRE) && SEG_HI == 8
        if (((SEGPRE >> LAYER) & 1) && seg_n < hi - (N_PHASES - 1)) { ++seg_n; if (SEGPRE_MODE == 1) xcd_barrier<true>(bar); else if (SEGPRE_MODE == 2) xcd_barrier<false>(bar); goto seg_start; }
#endif
        SEAM(pb + 8);
#if defined(SEGREP) && SEG_HI == 8
        if (((SEGREP >> LAYER) & 1) && seg_n < hi - (N_PHASES - 1)) { ++seg_n; if (8 == 8 && LAYER == 1) GRID_BAR(); goto seg_start; }
#endif
    }
__global__ void __launch_bounds__(NTHR, 2) mega_fwd(Args args) {
    extern __shared__ __attribute__((aligned(16))) unsigned char lds[];
    Frame F;
    F.lds = (LAS unsigned char*)lds;
    F.tid = threadIdx.x; F.lane = F.tid & 63; F.wave = __builtin_amdgcn_readfirstlane(F.tid >> 6);
    F.G = gridDim.x; F.wg = blockIdx.x;
    F.in = args.in;
    F.out = args.out; F.ws = args.ws;
    volatile LAS unsigned* MISC = (volatile LAS unsigned*)(F.lds + LDSCTL_OFF);
    for (int u = F.tid; u < (LDS_BYTES - LDSCTL_OFF) / 4; u += NTHR) ((LAS unsigned*)(F.lds + LDSCTL_OFF))[u] = 0u;
    __syncthreads();
#if MK_N_LAUNCHES == 1
    XcdBarrier bar = xcd_barrier_post((unsigned*)(F.ws + WS_CTL) + CW_BAR, MISC + 8);
#else
    (void)MISC; XcdBarrier bar; bar.bar = nullptr; bar.x = 0; bar.st = nullptr;
#endif
    const int lo = args.ph_lo, hi = args.ph_hi;
#ifdef FULLREP
    for (int rep2 = 0; rep2 < args.ph_hi - (N_PHASES - FULLREP); ++rep2) {
        F.tid = threadIdx.x; asm volatile("" : "+v"(F.tid)); F.lane = F.tid & 63; F.wave = __builtin_amdgcn_readfirstlane(F.tid >> 6);
#endif
    if ((PH_MASK & 1) && IN(0)) REP(12) {
        convert_items<1 | 4 | 16>(F, 0, 0);
        row_pass<false, true>(F, F.in[I_XP], F.in[I_XS], nullptr, nullptr, X2B, F.in[I_NMPRE], RSA, F.in[I_WIN], AB);
    }
    SEAM(0);
    layer_phases<0>(F, bar, lo, hi);
    layer_phases<1>(F, bar, lo, hi);
#ifdef FULLREP
    GRID_BAR(); }
#endif
}

extern "C" void kernel_launch(void* const* d_in, const int* in_sizes, int n_in, void* d_out, int out_size, void* d_ws, size_t ws_size, hipStream_t stream) {
    static int grid = 0;
    if (grid == 0) {
        if (n_in != 37 || (size_t)out_size != O_END || ws_size < WS_OL + 16 * MiB) { fprintf(stderr, "kernel_launch: unexpected shapes: n_in %d out %d ws %zu\n", n_in, out_size, ws_size); grid = -1; return; }
        int dev = 0, cus = 0, per_cu = 0;
        if (hipGetDevice(&dev) != hipSuccess || hipDeviceGetAttribute(&cus, hipDeviceAttributeMultiprocessorCount, dev) != hipSuccess) { grid = -1; return; }
        if (hipFuncSetAttribute((const void*)mega_fwd, hipFuncAttributeMaxDynamicSharedMemorySize, LDS_BYTES) != hipSuccess) { fprintf(stderr, "kernel_launch: hipFuncSetAttribute failed\n"); grid = -1; return; }
        if (hipOccupancyMaxActiveBlocksPerMultiprocessor(&per_cu, (const void*)mega_fwd, NTHR, LDS_BYTES) != hipSuccess || per_cu < 1) { fprintf(stderr, "kernel_launch: occupancy query says %d blocks per CU\n", per_cu); (void)hipGetLastError(); per_cu = 1; }
        grid = cus;
        if (grid > 256) grid = 256;
        if (HEADNORM_IN_GEMM && grid != 256) { fprintf(stderr, "kernel_launch: %d compute units, this build needs 256 (one out-projection unit per workgroup)\n", cus); grid = -1; return; }
    }
    if (grid < 0) return;
    (void)hipMemsetAsync((char*)d_ws + WS_CTL, 0, CTL_ZERO_BYTES, stream);
    Args a{};
    for (int i = 0; i < 37; ++i) a.in[i] = (const float*)d_in[i];
    a.out = (float*)d_out; a.ws = (unsigned char*)d_ws;
#if MK_N_LAUNCHES == 1
    a.ph_lo = 0; a.ph_hi = N_PHASES;
    hipLaunchKernelGGL(mega_fwd, dim3(grid), dim3(NTHR), LDS_BYTES, stream, a);
#else
    for (int ph = 0; ph < N_PHASES; ++ph) { a.ph_lo = ph; a.ph_hi = ph + 1; hipLaunchKernelGGL(mega_fwd, dim3(grid), dim3(NTHR), LDS_BYTES, stream, a); }
#endif
}
```
